# Optimizing an MI355X kernel written in HIP

```python
import math
import jax, jax.numpy as jnp
from jax import lax
import numpy as np

D_MODEL = 1024
BATCH = 8
SEQ = 2048
DEPTH = 2
DEC_BATCH = 32
DEC_SEQ = 4
PAST_LEN = 8192
PAGE_SIZE = 128

HEAD_DIM = 64
N_MIXERS = 2
N_A_LAYERS = (DEPTH + 1) // 2
N_B_LAYERS = DEPTH // 2
WINDOWS = (128, 512, 2048)
DILATIONS = (1, 4, 16)
N_GROUPS = 3
GROUP_HEADS = 4
A_HEADS = N_GROUPS * GROUP_HEADS
A_KEYS = WINDOWS[0] // DILATIONS[0] + 1
A_QKV = 3 * A_HEADS * HEAD_DIM
A_OUT = GROUP_HEADS * HEAD_DIM
Q_BLOCK = 128
N_MEM = 256
MEM_HEADS = 4
MEM_W = MEM_HEADS * HEAD_DIM
RWKV_W = 3 * D_MODEL // 4
RWKV_HEADS = RWKV_W // HEAD_DIM
LORA_DECAY = 64
LORA_A = 64
C_SHIFT = 3 * RWKV_W + LORA_DECAY + LORA_A
GN_EPS = 64e-5
A_GATE = A_OUT + MEM_W
A_IN = A_QKV + MEM_W + A_GATE
B_GATE = RWKV_W + MEM_W
B_IN = C_SHIFT + MEM_W + B_GATE
N_BUCKETS = 32
MAX_DISTANCE = WINDOWS[-1]
RMS_EPS = 1e-6
NEG_INF = -1e30
SCALE = HEAD_DIM ** -0.5

kernel_name = "hybrid_dilated_rwkv7_memory_decoder_step"


def rms_norm(x, g):
    xf = x.astype(jnp.float32)
    y = xf * lax.rsqrt(jnp.mean(xf * xf, axis=-1, keepdims=True) + RMS_EPS)
    return (y * g.astype(jnp.float32)).astype(x.dtype)


def t5_bucket(dist):
    max_exact = N_BUCKETS // 2
    d = jnp.maximum(dist, 1).astype(jnp.float32)
    large = max_exact + (jnp.log(d / max_exact) / math.log(MAX_DISTANCE / max_exact)
                         * (N_BUCKETS - max_exact)).astype(jnp.int32)
    large = jnp.minimum(large, N_BUCKETS - 1)
    return jnp.where(dist < max_exact, dist, large)


def group_bias(rel_bias, g):
    dist = DILATIONS[g] * jnp.arange(A_KEYS, dtype=jnp.int32)
    b = rel_bias[t5_bucket(dist)]
    return b[:, g * GROUP_HEADS:(g + 1) * GROUP_HEADS].T.astype(jnp.float32)


def memory_kv(mem, g, w):
    kv = rms_norm(mem, g) @ w
    return kv.reshape(mem.shape[0], mem.shape[1], 2, MEM_HEADS, HEAD_DIM)


def cross_attn(q, kv):
    logits = jnp.einsum('bthd,bmhd->bhtm', q.astype(jnp.float32), kv[:, :, 0].astype(jnp.float32)) * SCALE
    p = jax.nn.softmax(logits, axis=-1)
    o = jnp.einsum('bhtm,bmhd->bthd', p, kv[:, :, 1].astype(jnp.float32))
    return o.reshape(q.shape[0], q.shape[1], MEM_W).astype(q.dtype)


def dilated_group(q, ctx, q_idx, dil, bias):
    idx = q_idx[:, None] - dil * jnp.arange(A_KEYS, dtype=jnp.int32)[None, :]
    valid = idx >= 0
    kv = jnp.take(ctx, jnp.maximum(idx, 0), axis=1, mode='clip')
    logits = jnp.einsum('bthd,btkhd->bhtk', q.astype(jnp.float32), kv[:, :, :, 0].astype(jnp.float32)) * SCALE
    logits = jnp.where(valid[None, None], logits + bias[None, :, None, :], NEG_INF)
    m = jnp.max(logits, axis=-1)
    p = jnp.exp(logits - m[..., None])
    s = jnp.sum(p, axis=-1)
    o = jnp.einsum('bhtk,btkhd->bthd', p, kv[:, :, :, 1].astype(jnp.float32))
    o = o / s.transpose(0, 2, 1)[..., None]
    return o, m.transpose(0, 2, 1), s.transpose(0, 2, 1)


def mixer_a(xn, w_in, w_out, rel_bias, mem_kv, past):
    bsz, T, _ = xn.shape
    p = xn @ w_in
    qkv = p[..., :A_QKV].reshape(bsz, T, 3, A_HEADS, HEAD_DIM)
    q_mem = p[..., A_QKV:A_QKV + MEM_W].reshape(bsz, T, MEM_HEADS, HEAD_DIM)
    gate = p[..., A_QKV + MEM_W:]
    q = qkv[:, :, 0]
    kv = qkv[:, :, 1:]
    ctxs, offs, new_rows, biases = [], [], [], []
    for g in range(N_GROUPS):
        kv_g = kv[:, :, :, g * GROUP_HEADS:(g + 1) * GROUP_HEADS]
        if past is None:
            ctxs.append(kv_g)
            offs.append(0)
            new_rows.append(kv_g[:, T - min(WINDOWS[g], T):])
        else:
            ctxs.append(jnp.concatenate([past[g].astype(kv_g.dtype), kv_g], axis=1))
            offs.append(past[g].shape[1])
            new_rows.append(kv_g)
        biases.append(group_bias(rel_bias, g))

    def block(args):
        q_blk, t_blk = args
        os_, ms, ss = [], [], []
        for g in range(N_GROUPS):
            o, m, s = dilated_group(q_blk[:, :, g * GROUP_HEADS:(g + 1) * GROUP_HEADS], ctxs[g],
                                    offs[g] + t_blk, DILATIONS[g], biases[g])
            os_.append(o); ms.append(m); ss.append(s)
        ms = jnp.stack(ms); ss = jnp.stack(ss)
        wts = jnp.exp(ms - jnp.max(ms, axis=0, keepdims=True)) * ss
        return jnp.sum(wts[..., None] * jnp.stack(os_), axis=0) / jnp.sum(wts, axis=0)[..., None]

    nb = T // Q_BLOCK if T % Q_BLOCK == 0 else 1
    qb = T // nb
    q_blocks = q.reshape(bsz, nb, qb, A_HEADS, HEAD_DIM).swapaxes(0, 1)
    t_blocks = jnp.arange(T, dtype=jnp.int32).reshape(nb, qb)
    o = lax.map(block, (q_blocks, t_blocks)).swapaxes(0, 1).reshape(bsz, T, A_OUT).astype(xn.dtype)
    o_mem = cross_attn(q_mem, mem_kv)
    h = jnp.concatenate([o, o_mem], axis=-1) * jax.nn.silu(gate)
    return h @ w_out, new_rows


def wkv_scan(r, w, k, v, a, b, s0):
    seq = tuple(t.astype(jnp.float32).swapaxes(0, 1) for t in (r, w, k, v, a, b))

    def step(S, inp):
        r_t, w_t, k_t, v_t, a_t, b_t = inp
        sa = jnp.einsum('bhvk,bhk->bhv', S, a_t)
        S = S * w_t[:, :, None, :] + sa[..., None] * b_t[:, :, None, :] + v_t[..., None] * k_t[:, :, None, :]
        return S, jnp.einsum('bhvk,bhk->bhv', S, r_t)

    S, ys = lax.scan(step, s0.astype(jnp.float32), seq)
    return ys.swapaxes(0, 1), S


def mixer_b(xn, w_in, w_out, mu, w0, w_up, a0, a_up, k_k, k_a, r_k, ln_w, ln_b, mem_kv, shift_prev, s0):
    bsz, T, _ = xn.shape
    p = xn @ w_in
    cols = p[..., :C_SHIFT]
    q_mem = p[..., C_SHIFT:C_SHIFT + MEM_W].reshape(bsz, T, MEM_HEADS, HEAD_DIM)
    gate = p[..., C_SHIFT + MEM_W:]
    prev = jnp.concatenate([shift_prev[:, None].astype(cols.dtype), cols[:, :-1]], axis=1)
    xs = (cols + mu * (prev - cols)).astype(jnp.float32)
    r = xs[..., :RWKV_W]
    k = xs[..., RWKV_W:2 * RWKV_W]
    v = xs[..., 2 * RWKV_W:3 * RWKV_W]
    wd = xs[..., 3 * RWKV_W:3 * RWKV_W + LORA_DECAY]
    ad = xs[..., 3 * RWKV_W + LORA_DECAY:]
    w_log = -jax.nn.softplus(-(w0 + jnp.tanh(wd) @ w_up)) - 0.5
    decay = jnp.exp(-jnp.exp(w_log))
    a = jax.nn.sigmoid(a0 + ad @ a_up)
    hs = (bsz, T, RWKV_HEADS, HEAD_DIM)
    r, k, v, decay, a = (t.reshape(hs) for t in (r, k, v, decay, a))
    kk = k * k_k.reshape(RWKV_HEADS, HEAD_DIM)
    kk = kk / jnp.maximum(jnp.sqrt(jnp.sum(kk * kk, axis=-1, keepdims=True)), 1e-12)
    k = k * (1.0 + (a - 1.0) * k_a.reshape(RWKV_HEADS, HEAD_DIM))
    y, S = wkv_scan(r, decay, k, v, -kk, kk * a, s0)
    mean = jnp.mean(y, axis=-1, keepdims=True)
    var = jnp.mean(jnp.square(y - mean), axis=-1, keepdims=True)
    y = (y - mean) * lax.rsqrt(var + GN_EPS) * ln_w.reshape(RWKV_HEADS, HEAD_DIM) + ln_b.reshape(RWKV_HEADS, HEAD_DIM)
    y = y + jnp.sum(r * k * r_k, axis=-1, keepdims=True) * v
    y = y.reshape(bsz, T, RWKV_W).astype(xn.dtype)
    o_mem = cross_attn(q_mem, mem_kv)
    h = jnp.concatenate([y, o_mem], axis=-1) * jax.nn.silu(gate)
    return h @ w_out, cols[:, -1], S.astype(xn.dtype)


def setup_inputs(seed: int = 0) -> dict:
    key = jax.random.key(seed)
    ks = list(jax.random.split(key, 40))

    def nrm(shape, scale):
        return scale * jax.random.normal(ks.pop(), shape, jnp.float32)

    def unif(shape, lo, hi):
        return jax.random.uniform(ks.pop(), shape, jnp.float32, lo, hi)

    return {
        "x_prompt": nrm((BATCH, SEQ, D_MODEL), 1.0),
        "x_sample": nrm((DEC_BATCH, DEC_SEQ, D_MODEL), 1.0),
        "mem_prompt": nrm((BATCH, N_MEM, D_MODEL), 1.0),
        "cache_mem_kv": nrm((DEPTH, DEC_BATCH, N_MEM, 2, MEM_HEADS, HEAD_DIM), 1.0),
        "cache_win0": nrm((N_A_LAYERS, DEC_BATCH, min(WINDOWS[0], PAST_LEN), 2, GROUP_HEADS, HEAD_DIM), 1.0),
        "cache_win1": nrm((N_A_LAYERS, DEC_BATCH, min(WINDOWS[1], PAST_LEN), 2, GROUP_HEADS, HEAD_DIM), 1.0),
        "cache_win2": nrm((N_A_LAYERS, DEC_BATCH, min(WINDOWS[2], PAST_LEN), 2, GROUP_HEADS, HEAD_DIM), 1.0),
        "state_wkv": nrm((N_B_LAYERS, DEC_BATCH, RWKV_HEADS, HEAD_DIM, HEAD_DIM), 1.0),
        "state_shift": nrm((N_B_LAYERS, DEC_BATCH, C_SHIFT), 1.0),
        "norm_pre": 1.0 + nrm((DEPTH, D_MODEL), 0.05),
        "norm_post": 1.0 + nrm((DEPTH, D_MODEL), 0.05),
        "norm_mem": 1.0 + nrm((DEPTH, D_MODEL), 0.05),
        "w_mem_kv": nrm((DEPTH, D_MODEL, 2 * MEM_W), D_MODEL ** -0.5),
        "rel_bias": nrm((N_BUCKETS, A_HEADS), 0.5),
        "w_in_a": nrm((N_A_LAYERS, D_MODEL, A_IN), D_MODEL ** -0.5),
        "w_out_a": nrm((N_A_LAYERS, A_GATE, D_MODEL), A_GATE ** -0.5),
        "w_in_b": nrm((N_B_LAYERS, D_MODEL, B_IN), D_MODEL ** -0.5),
        "w_out_b": nrm((N_B_LAYERS, B_GATE, D_MODEL), B_GATE ** -0.5),
        "rwkv_mu": unif((N_B_LAYERS, C_SHIFT), 0.0, 1.0),
        "rwkv_w0": unif((N_B_LAYERS, RWKV_W), -4.0, 1.0),
        "rwkv_w_up": nrm((N_B_LAYERS, LORA_DECAY, RWKV_W), 0.5 * LORA_DECAY ** -0.5),
        "rwkv_a0": nrm((N_B_LAYERS, RWKV_W), 0.5),
        "rwkv_a_up": nrm((N_B_LAYERS, LORA_A, RWKV_W), LORA_A ** -0.5),
        "rwkv_k_k": 0.85 + nrm((N_B_LAYERS, RWKV_W), 0.05),
        "rwkv_k_a": 1.0 + nrm((N_B_LAYERS, RWKV_W), 0.05),
        "rwkv_r_k": nrm((N_B_LAYERS, RWKV_HEADS, HEAD_DIM), 0.1),
        "rwkv_ln_w": 1.0 + nrm((N_B_LAYERS, RWKV_W), 0.05),
        "rwkv_ln_b": nrm((N_B_LAYERS, RWKV_W), 0.02),
    }


def reference(x_prompt, x_sample, mem_prompt, cache_mem_kv, cache_win0, cache_win1, cache_win2, state_wkv,
              state_shift, norm_pre, norm_post, norm_mem, w_mem_kv, rel_bias, w_in_a, w_out_a, w_in_b, w_out_b,
              rwkv_mu, rwkv_w0, rwkv_w_up, rwkv_a0, rwkv_a_up, rwkv_k_k, rwkv_k_a, rwkv_r_k, rwkv_ln_w, rwkv_ln_b):
    xp, xs = x_prompt, x_sample
    mem_new = []
    win_p = [[], [], []]
    win_s = [[], [], []]
    wkv_p, wkv_s, sh_p, sh_s = [], [], [], []
    for i in range(DEPTH):
        j = i // N_MIXERS
        mkv_p = memory_kv(mem_prompt, norm_mem[i], w_mem_kv[i])
        mem_new.append(mkv_p)
        mkv_s = cache_mem_kv[i]
        xn_p = rms_norm(xp, norm_pre[i])
        xn_s = rms_norm(xs, norm_pre[i])
        if i % N_MIXERS == 0:
            hp, rows_p = mixer_a(xn_p, w_in_a[j], w_out_a[j], rel_bias, mkv_p, None)
            hs, rows_s = mixer_a(xn_s, w_in_a[j], w_out_a[j], rel_bias, mkv_s,
                                 (cache_win0[j], cache_win1[j], cache_win2[j]))
            for g in range(N_GROUPS):
                win_p[g].append(rows_p[g])
                win_s[g].append(rows_s[g])
        else:
            rw = (rwkv_mu[j], rwkv_w0[j], rwkv_w_up[j], rwkv_a0[j], rwkv_a_up[j], rwkv_k_k[j], rwkv_k_a[j],
                  rwkv_r_k[j], rwkv_ln_w[j], rwkv_ln_b[j])
            shift0 = jnp.zeros((xp.shape[0], C_SHIFT), xp.dtype)
            s0 = jnp.zeros((xp.shape[0], RWKV_HEADS, HEAD_DIM, HEAD_DIM), jnp.float32)
            hp, shp, Sp = mixer_b(xn_p, w_in_b[j], w_out_b[j], *rw, mkv_p, shift0, s0)
            hs, shs, Ss = mixer_b(xn_s, w_in_b[j], w_out_b[j], *rw, mkv_s, state_shift[j], state_wkv[j])
            wkv_p.append(Sp); wkv_s.append(Ss); sh_p.append(shp); sh_s.append(shs)
        xp = xp + rms_norm(hp, norm_post[i])
        xs = xs + rms_norm(hs, norm_post[i])
    new_mem_kv = jnp.stack(mem_new)
    win0_p, win1_p, win2_p = (jnp.stack(w) for w in win_p)
    win0_s, win1_s, win2_s = (jnp.stack(w) for w in win_s)
    wkv_prompt = jnp.stack(wkv_p)
    wkv_sample = jnp.stack(wkv_s)
    shift_prompt = jnp.stack(sh_p)
    shift_sample = jnp.stack(sh_s)
    return (xp, xs, new_mem_kv, win0_p, win1_p, win2_p, win0_s, win1_s, win2_s,
            wkv_prompt, wkv_sample, shift_prompt, shift_sample)
```

```cpp
#include <hip/hip_runtime.h>
#include <cstdio>
#include <cstdint>
namespace pg8 {
#define PG8_LAS __attribute__((address_space(3)))
typedef unsigned short bf16_t;
typedef short bf16x8 __attribute__((ext_vector_type(8)));
typedef float f32x4 __attribute__((ext_vector_type(4)));
typedef unsigned u32x4 __attribute__((ext_vector_type(4)));
constexpr int BM = 256, BK = 64, HALF = 128, HTB = HALF * BK * 2  , STAGE_BYTES = 8 * HTB, NXCD = 8, WGM = 8;

__host__ __device__ __forceinline__ int lds_byte(int r, int c) { const int st = (r >> 4) * 2 + (c >> 5), rr = r & 15, cc = c & 31, ob = rr * 64 + cc * 2; return st * 1024 + (ob ^ (((ob >> 9) & 1) << 5)); }
__host__ __device__ __forceinline__ void stage_rc(int b, int& R, int& C) { const int st = b / 1024, sb = b % 1024, swz = sb ^ (((sb >> 9) & 1) << 5); R = (st >> 1) * 16 + swz / 64; C = (st & 1) * 32 + (swz % 64) / 2; }
__host__ __device__ __forceinline__ int perm32(int rho) { const int n = rho >> 4, i = rho & 15; return 8 * (i >> 2) + 4 * n + (i & 3); }

struct Unit { int pm, pn; };
struct Gemm { const bf16_t* A; const bf16_t* Bt; int M, N, K; };

struct StaticOrder {
    int nM, nN, nwg, G, c;
    __host__ __device__ void init(int M, int N, int G_, int c_) { nM = M / BM; nN = N / BM; nwg = nM * nN; G = G_; c = c_; }
    __host__ __device__ bool next(int i, Unit& u) const {
        const long L = (long)i * G + c; if (L >= nwg) return false;
        int wgid = (int)L; { const int q = nwg / NXCD, r = nwg % NXCD, xcd = wgid % NXCD, off = wgid / NXCD; wgid = (xcd < r ? xcd * (q + 1) : r * (q + 1) + (xcd - r) * q) + off; }
        const int nig = WGM * nN, gid = wgid / nig, fm = gid * WGM, gsz = (nM - fm) < WGM ? (nM - fm) : WGM;
        u.pm = fm + ((wgid % nig) % gsz); u.pn = (wgid % nig) / gsz; return true;
    }
    __device__ __forceinline__ void a_ready(const Unit&) const {}
    __device__ __forceinline__ void done(const Unit&) const {}
};

__device__ __forceinline__ unsigned cvt_pk_bf16(float lo, float hi) { unsigned r; asm volatile("v_cvt_pk_bf16_f32 %0, %1, %2" : "=v"(r) : "v"(lo), "v"(hi)); return r; }
typedef float f32x2 __attribute__((ext_vector_type(2)));
__device__ __forceinline__ f32x2 gelu_pk(f32x2 v) {
    const f32x2 av = __builtin_elementwise_abs(v), d = av * 0.2316418882f + 1.0f;
    f32x2 t; t.x = __builtin_amdgcn_rcpf(d.x); t.y = __builtin_amdgcn_rcpf(d.y);
    f32x2 q = t * 0.5307027145f + (-0.7265760135f); q = q * t + 0.7107068705f; q = q * t + (-0.142248368f); q = q * t + 0.127414796f; q = q * t;
    const f32x2 s = (v * v) * (-0.72134752044f);
    f32x2 e; e.x = __builtin_amdgcn_exp2f(s.x); e.y = __builtin_amdgcn_exp2f(s.y);
    const f32x2 m = v * (q * e), r = v - m;
    f32x2 o; o.x = v.x < 0.f ? m.x : r.x; o.y = v.y < 0.f ? m.y : r.y; return o;
}

template <int ACT  > struct EpiBf16 {
    static constexpr bool PERM = true, AFTER_DRAIN = false; static_assert(ACT == 0 || ACT == 1, "EpiBf16: ACT is 0 (none) or 1 (gelu_pk)");
    bf16_t* O; int ldc; const float* bias; int split_cols; size_t split_stride; float scale0;
    __device__ __forceinline__ void operator()(const f32x4 (&acc)[2][2][4][2], const Unit& u, int wr, int wc, int fr, int fq) const {
        const int row0 = u.pm * BM + wr * 64 + fr; int colt = u.pn * BM; bf16_t* base = O;
        float sc = 1.f; if (split_cols) { const int t = colt / split_cols; base += (size_t)t * split_stride; colt -= t * split_cols; if (t == 0) sc = scale0; }
        const int col0 = colt + wc * 32 + 8 * fq, bcol0 = u.pn * BM + wc * 32 + 8 * fq;
        f32x4 bv[2][2];
#pragma unroll
        for (int bj = 0; bj < 2; ++bj)
#pragma unroll
            for (int n = 0; n < 2; ++n) bv[bj][n] = bias ? *(const f32x4*)(bias + bcol0 + bj * HALF + 4 * n) : (f32x4){0.f, 0.f, 0.f, 0.f};
#pragma unroll
        for (int ai = 0; ai < 2; ++ai)
#pragma unroll
            for (int m = 0; m < 4; ++m) { bf16_t* rowp = base + (size_t)(row0 + ai * HALF + m * 16) * ldc + col0;
#pragma unroll
                for (int bj = 0; bj < 2; ++bj) { f32x4 v0 = acc[ai][bj][m][0] + bv[bj][0], v1 = acc[ai][bj][m][1] + bv[bj][1];
                    if (ACT == 1) { f32x2 a = gelu_pk((f32x2){v0[0], v0[1]}), b = gelu_pk((f32x2){v0[2], v0[3]}), c = gelu_pk((f32x2){v1[0], v1[1]}), d = gelu_pk((f32x2){v1[2], v1[3]});
                        v0 = (f32x4){a.x, a.y, b.x, b.y}; v1 = (f32x4){c.x, c.y, d.x, d.y}; }
                    v0 = v0 * sc; v1 = v1 * sc; u32x4 w; w.x = cvt_pk_bf16(v0[0], v0[1]); w.y = cvt_pk_bf16(v0[2], v0[3]); w.z = cvt_pk_bf16(v1[0], v1[1]); w.w = cvt_pk_bf16(v1[2], v1[3]);
                    *(u32x4*)(rowp + bj * HALF) = w; } }
    }
};
template <class Epi, class Sched, bool ALIGN_EPI = false, bool SP2 = false>
__device__ __forceinline__ void gemm_phase(PG8_LAS unsigned char* lds, const Gemm g, const Sched& S, const Epi& E) {
    const int tid = threadIdx.x, wid = __builtin_amdgcn_readfirstlane(tid >> 6), lane = tid & 63, wr = wid >> 2, wc = wid & 3, fr = lane & 15, fq = lane >> 4;
    const int K = g.K, nt = K / BK;
    unsigned voffA[2], voffB[2];
#pragma unroll
    for (int i = 0; i < 2; ++i) { int R, C; stage_rc(tid * 16 + i * 8192, R, C); const int Rb = Epi::PERM ? ((R & ~31) + perm32(R & 31)) : R;
        voffA[i] = (unsigned)(R * K + C) * 2u; voffB[i] = (unsigned)(Rb * K + C) * 2u; }
    const size_t kstep = (size_t)(BK * 2);
    const size_t hstep = (size_t)HALF * K * 2;
    const size_t tstep = 2 * hstep;
    const unsigned ldsw = (unsigned)wid * 1024u;
    const int aoff = lds_byte(wr * 64 + fr, fq * 8), boff = lds_byte(wc * 32 + fr, fq * 8);
#define PG8_SA(b, h) (((b) * 2 + (h)) * HTB)
#define PG8_SB(b, h) ((4 + (b) * 2 + (h)) * HTB)
#define PG8_STAGE(bufoff, gbase, voff) do { _Pragma("unroll") for (int _i = 0; _i < 2; ++_i) \
        __builtin_amdgcn_global_load_lds((const unsigned*)((const char*)(gbase) + (voff)[_i]), (PG8_LAS unsigned*)(lds + (bufoff) + ldsw + _i * 8192), 16, 0, 0); } while (0)
#define PG8_LDA(dst, b, h) do { _Pragma("unroll") for (int m = 0; m < 4; ++m) _Pragma("unroll") for (int k = 0; k < 2; ++k) dst[m][k] = *(const PG8_LAS bf16x8*)(lds + PG8_SA(b, h) + aoff + m * 2048 + k * 1024); } while (0)
#define PG8_LDB(dst, b, h) do { _Pragma("unroll") for (int n = 0; n < 2; ++n) _Pragma("unroll") for (int k = 0; k < 2; ++k) dst[n][k] = *(const PG8_LAS bf16x8*)(lds + PG8_SB(b, h) + boff + n * 2048 + k * 1024); } while (0)
#define PG8_MMA(ai, bj, At, Bt) do { __builtin_amdgcn_s_setprio(1); _Pragma("unroll") for (int m = 0; m < 4; ++m) _Pragma("unroll") for (int n = 0; n < 2; ++n) _Pragma("unroll") for (int k = 0; k < 2; ++k) \
        acc[ai][bj][m][n] = __builtin_amdgcn_mfma_f32_16x16x32_bf16(Bt[n][k], At[m][k], acc[ai][bj][m][n], 0, 0, 0); __builtin_amdgcn_s_setprio(0); } while (0)
#define PG8_WAIT_V(n) asm volatile("s_waitcnt vmcnt(" #n ")" ::: "memory")
#define PG8_WAIT_L(n) asm volatile("s_waitcnt lgkmcnt(" #n ")" ::: "memory")
#define PG8_BAR __builtin_amdgcn_s_barrier()
#define PG8_SCHED __builtin_amdgcn_sched_barrier(0)
    Unit cur, nxt; int ui = 0;
    if (!S.next(0, cur)) return;
    f32x4 acc[2][2][4][2];
#pragma unroll
    for (int a = 0; a < 2; ++a)
#pragma unroll
        for (int b = 0; b < 2; ++b)
#pragma unroll
            for (int m = 0; m < 4; ++m)
#pragma unroll
                for (int n = 0; n < 2; ++n) acc[a][b][m][n] = (f32x4){0.f, 0.f, 0.f, 0.f};
    bf16x8 At[4][2], B0[2][2], B1[2][2];
    const char* cA = (const char*)g.A + (size_t)cur.pm * tstep; const char* cB = (const char*)g.Bt + (size_t)cur.pn * tstep;
    S.a_ready(cur);
    if constexpr (SP2) {
        PG8_STAGE(PG8_SB(0, 0), cB, voffB); PG8_STAGE(PG8_SB(0, 1), cB + hstep, voffB); PG8_STAGE(PG8_SA(0, 0), cA, voffA); PG8_STAGE(PG8_SA(0, 1), cA + hstep, voffA);
        if (wr == 1) PG8_BAR;
        PG8_WAIT_V(2); PG8_BAR;
        PG8_STAGE(PG8_SB(1, 0), cB + kstep, voffB); PG8_STAGE(PG8_SA(1, 0), cA + kstep, voffA); PG8_STAGE(PG8_SB(1, 1), cB + hstep + kstep, voffB);
        PG8_WAIT_V(6); PG8_BAR;
    } else {
        PG8_STAGE(PG8_SB(0, 0), cB, voffB); PG8_STAGE(PG8_SA(0, 0), cA, voffA); PG8_STAGE(PG8_SB(0, 1), cB + hstep, voffB); PG8_STAGE(PG8_SA(0, 1), cA + hstep, voffA);
        if (wr == 1) PG8_BAR;
        PG8_WAIT_V(4); PG8_BAR;
        PG8_STAGE(PG8_SB(1, 0), cB + kstep, voffB); PG8_STAGE(PG8_SA(1, 0), cA + kstep, voffA); PG8_STAGE(PG8_SB(1, 1), cB + hstep + kstep, voffB);
        PG8_WAIT_V(6); PG8_BAR;
    }
    for (;;) {
        const bool has_next = S.next(ui + 1, nxt);
        const char* nA = has_next ? (const char*)g.A + (size_t)nxt.pm * tstep : cA; const char* nB = has_next ? (const char*)g.Bt + (size_t)nxt.pn * tstep : cB;
        for (int t = 0; t < nt; t += 2) {
            const bool last = (t == nt - 2);
            const char* a1 = cA + (size_t)(t + 1) * kstep;
            const char* a2 = last ? nA : cA + (size_t)(t + 2) * kstep; const char* b2 = last ? nB : cB + (size_t)(t + 2) * kstep;
            const char* a3 = a2 + kstep; const char* b3 = b2 + kstep;
            if (last && has_next) S.a_ready(nxt);
            if constexpr (SP2) {
            PG8_LDB(B0, 0, 0); PG8_LDB(B1, 0, 1); PG8_SCHED; PG8_LDA(At, 0, 0); PG8_STAGE(PG8_SA(1, 1), a1 + hstep, voffA);
            PG8_WAIT_V(8); PG8_WAIT_L(0); PG8_BAR; PG8_MMA(0, 0, At, B0); PG8_MMA(0, 1, At, B1); PG8_BAR; PG8_SCHED;
            PG8_LDA(At, 0, 1); PG8_STAGE(PG8_SB(0, 0), b2, voffB); PG8_STAGE(PG8_SB(0, 1), b2 + hstep, voffB); PG8_STAGE(PG8_SA(0, 0), a2, voffA);
            PG8_WAIT_V(8); PG8_WAIT_L(0); PG8_BAR; PG8_MMA(1, 0, At, B0); PG8_MMA(1, 1, At, B1); PG8_BAR; PG8_SCHED;
            PG8_LDB(B0, 1, 0); PG8_LDB(B1, 1, 1); PG8_SCHED; PG8_LDA(At, 1, 0); PG8_STAGE(PG8_SA(0, 1), a2 + hstep, voffA);
            PG8_WAIT_V(8); PG8_WAIT_L(0); PG8_BAR; PG8_MMA(0, 0, At, B0); PG8_MMA(0, 1, At, B1); PG8_BAR; PG8_SCHED;
            PG8_LDA(At, 1, 1); PG8_STAGE(PG8_SB(1, 0), b3, voffB); PG8_STAGE(PG8_SB(1, 1), b3 + hstep, voffB); PG8_STAGE(PG8_SA(1, 0), a3, voffA);
            PG8_WAIT_V(8); PG8_WAIT_L(0); PG8_BAR; PG8_MMA(1, 0, At, B0); PG8_MMA(1, 1, At, B1); PG8_BAR; PG8_SCHED;
            } else {
            PG8_LDB(B0, 0, 0); PG8_SCHED; PG8_LDA(At, 0, 0); PG8_STAGE(PG8_SA(1, 1), a1 + hstep, voffA);
            PG8_WAIT_L(8); PG8_BAR; PG8_WAIT_L(0); PG8_MMA(0, 0, At, B0); PG8_BAR; PG8_SCHED;
            PG8_LDB(B1, 0, 1); PG8_STAGE(PG8_SB(0, 0), b2, voffB);
            PG8_BAR; PG8_WAIT_L(0); PG8_MMA(0, 1, At, B1); PG8_BAR;
            PG8_LDA(At, 0, 1); PG8_STAGE(PG8_SA(0, 0), a2, voffA);
            PG8_BAR; PG8_WAIT_L(0); PG8_MMA(1, 0, At, B0); PG8_BAR; PG8_SCHED;
            PG8_STAGE(PG8_SB(0, 1), b2 + hstep, voffB);
            PG8_WAIT_V(6); PG8_BAR; PG8_MMA(1, 1, At, B1); PG8_BAR;
            PG8_LDB(B0, 1, 0); PG8_SCHED; PG8_LDA(At, 1, 0); PG8_STAGE(PG8_SA(0, 1), a2 + hstep, voffA);
            PG8_WAIT_L(8); PG8_BAR; PG8_WAIT_L(0); PG8_MMA(0, 0, At, B0); PG8_BAR; PG8_SCHED;
            PG8_LDB(B1, 1, 1); PG8_STAGE(PG8_SB(1, 0), b3, voffB);
            PG8_BAR; PG8_WAIT_L(0); PG8_MMA(0, 1, At, B1); PG8_BAR;
            PG8_LDA(At, 1, 1); PG8_STAGE(PG8_SA(1, 0), a3, voffA);
            PG8_BAR; PG8_WAIT_L(0); PG8_MMA(1, 0, At, B0); PG8_BAR; PG8_SCHED;
            PG8_STAGE(PG8_SB(1, 1), b3 + hstep, voffB);
            PG8_WAIT_V(6); PG8_BAR; PG8_MMA(1, 1, At, B1); PG8_BAR;
            }
        }
        if constexpr (ALIGN_EPI) { if (wr == 0) PG8_BAR; }
        if constexpr (!Epi::AFTER_DRAIN) { E(acc, cur, wr, wc, fr, fq); S.done(cur); }
        if (!has_next) break;
#pragma unroll
        for (int a = 0; a < 2; ++a)
#pragma unroll
            for (int b = 0; b < 2; ++b)
#pragma unroll
                for (int m = 0; m < 4; ++m)
#pragma unroll
                    for (int n = 0; n < 2; ++n) acc[a][b][m][n] = (f32x4){0.f, 0.f, 0.f, 0.f};
        cur = nxt; cA = nA; cB = nB; ++ui;
        if constexpr (ALIGN_EPI) { if (wr == 1) PG8_BAR; }
    }
    PG8_WAIT_V(0);
    if constexpr (!ALIGN_EPI) { if (wr == 0) PG8_BAR; }
    PG8_BAR;
    if constexpr (Epi::AFTER_DRAIN) { E.fused(acc, cur, wr, wc, fr, fq, lds, wid, lane); S.done(cur); }
#undef PG8_SA
#undef PG8_SB
#undef PG8_STAGE
#undef PG8_LDA
#undef PG8_LDB
#undef PG8_MMA
#undef PG8_WAIT_V
#undef PG8_WAIT_L
#undef PG8_BAR
#undef PG8_SCHED
}
}

#ifndef PG8_SP2
#define PG8_SP2 true
#endif
#ifndef PG8_ALIGN
#define PG8_ALIGN true
#endif

constexpr int NWAVES = 8;
#ifndef MK_N_LAUNCHES
#define MK_N_LAUNCHES 11
#endif
constexpr int N_PHASES = 11;
constexpr int TP = 16384, NSAMP = 128, NREAL = TP + NSAMP, MROWS = 16640, DM = 1024;
constexpr int SEQ = 2048, NBATCH = 8, SBATCH = 32, STOK = 4, NMEM = 256;
constexpr int A_IN = 3072, B_IN = 3712, B_INP = 3840, CSH = 2432, RW = 768;
constexpr float RMS_EPS = 1e-6f, GN_EPS = 64e-5f;
constexpr size_t O_YP = 0, O_YS = 16777216, O_MEM = 16908288, O_W0P = 19005440, O_W1P = 19529728, O_W2P = 21626880,
                 O_W0S = 30015488, O_W1S = 30081024, O_W2S = 30146560, O_WKVP = 30212096, O_WKVS = 30605312, O_SHP = 32178176, O_SHS = 32197632, O_END = 32275456;
constexpr size_t MiB = 1u << 20;
constexpr size_t WS_CTL = 0, CTL_ZERO_BYTES = 1 * MiB;
constexpr size_t WS_WAIN = 1 * MiB, WS_WAOUT = 7 * MiB, WS_WBIN = 8 * MiB, WS_WBOUT = 16 * MiB, WS_WM = 18 * MiB, WS_WL = 20 * MiB, WS_BT = 20 * MiB + 512 * 1024;
constexpr size_t WS_MEMN = 21 * MiB, WS_MKV = 25 * MiB, WS_TW = 29 * MiB, WS_XN = 34 * MiB, WS_H = 67 * MiB, WS_F = 100 * MiB, WS_P = 149 * MiB, WS_END = 271 * MiB;
constexpr int CW_TMO = 0, CW_BAR = 4096;

constexpr int RING_OFF = 0, RING_BYTES = 131072;
constexpr int LDSCTL_OFF = RING_BYTES, MISC_OFF = LDSCTL_OFF + 320;
constexpr int LDS_BYTES = 147456;

#define GAS __attribute__((address_space(1)))
#define LAS __attribute__((address_space(3)))
typedef unsigned short bf16;
typedef unsigned v4u __attribute__((ext_vector_type(4)));
typedef unsigned v2u __attribute__((ext_vector_type(2)));
typedef float f32x4 __attribute__((ext_vector_type(4)));
typedef GAS unsigned gu32;
#define RLX_AGENT __ATOMIC_RELAXED, __HIP_MEMORY_SCOPE_AGENT
#define LDS_WAIT() asm volatile("s_waitcnt lgkmcnt(0)" ::: "memory")
#define VM_WAIT() asm volatile("s_waitcnt vmcnt(0)" ::: "memory")
__device__ __forceinline__ unsigned f2bf(float f) { unsigned u = __builtin_bit_cast(unsigned, f); return (u + 0x7fffu + ((u >> 16) & 1u)) >> 16; }
__device__ __forceinline__ unsigned pk2(float lo, float hi) { return f2bf(lo) | (f2bf(hi) << 16); }
__device__ __forceinline__ float bflo(unsigned u) { return __builtin_bit_cast(float, u << 16); }
__device__ __forceinline__ float bfhi(unsigned u) { return __builtin_bit_cast(float, u & 0xffff0000u); }
__device__ __forceinline__ float bf2f(bf16 h) { return __builtin_bit_cast(float, (unsigned)h << 16); }

#define XB_TMO      128
#define XB_XCNT(j)  (256  + 64 * (j))
#define XB_XSUB(j)  (1280 + 64 * (j))
#define XB_XGEN(j)  (2304 + 64 * (j))
#define XB_TOP      3328
#define XB_TOPGEN   3392
#define XCD_BAR_WORDS 3456
#define XB_SPIN_CAP (1u << 20)
__device__ __forceinline__ unsigned xb_ld(unsigned* p)              { return __hip_atomic_load(p, __ATOMIC_RELAXED, __HIP_MEMORY_SCOPE_AGENT); }
__device__ __forceinline__ unsigned xb_add(unsigned* p, unsigned v) { return __hip_atomic_fetch_add(p, v, __ATOMIC_RELAXED, __HIP_MEMORY_SCOPE_AGENT); }
__device__ __forceinline__ unsigned xb_xcc_id() { return (unsigned)__builtin_amdgcn_s_getreg((3 << 11) | 20) & 0xFu; }
#define XB_SPIN(cond, bar) do { unsigned _sp = 0; while (cond) { __builtin_amdgcn_s_sleep(1); \
    if ((++_sp & 255u) == 0u) { if (xb_ld(&(bar)[XB_TMO])) break; if (_sp > XB_SPIN_CAP) { atomicAdd(&(bar)[XB_TMO], 1u); break; } } } } while (0)
struct XcdBarrier { unsigned* bar; unsigned x; volatile LAS unsigned* st; };
__device__ __forceinline__ XcdBarrier xcd_barrier_post(unsigned* bar, volatile LAS unsigned* st) {
    XcdBarrier b; b.bar = bar; b.x = xb_xcc_id(); b.st = st;
    if (threadIdx.x == 0) (void)xb_add(&bar[XB_XCNT(b.x)], 1u);
    return b;
}
__device__ __forceinline__ void xcd_barrier_complete(unsigned* bar, unsigned x, unsigned& nloc, unsigned& nx) {
    const unsigned G = gridDim.x * gridDim.y * gridDim.z;
    unsigned sum, cnt, mine, sp = 0u;
    for (;;) {
        sum = 0u; cnt = 0u; mine = 0u;
#pragma unroll
        for (unsigned j = 0; j < 16; ++j) { const unsigned c = xb_ld(&bar[XB_XCNT(j)]); sum += c; cnt += (c > 0u) ? 1u : 0u; mine = (j == x) ? c : mine; }
        if (sum == G) break;
        __builtin_amdgcn_s_sleep(1);
        if ((++sp & 255u) == 0u) { if (xb_ld(&bar[XB_TMO])) break; if (sp > XB_SPIN_CAP) { atomicAdd(&bar[XB_TMO], 1u); break; } }
    }
    nloc = mine > 0u ? mine : 1u; nx = cnt > 0u ? cnt : 1u;
}
__device__ __forceinline__ void xcd_barrier(const XcdBarrier& b) {
    asm volatile("s_waitcnt vmcnt(0)" ::: "memory");
    __syncthreads();
    if (threadIdx.x == 0) {
        unsigned* bar = b.bar;
        __builtin_amdgcn_s_waitcnt(0);
        unsigned nloc = b.st[0], nx = b.st[1];
        if (nloc == 0u) { xcd_barrier_complete(bar, b.x, nloc, nx); b.st[0] = nloc; b.st[1] = nx; }
        const unsigned old = xb_add(&bar[XB_XSUB(b.x)], 1u);
        const unsigned gen = old / nloc;
        if (old + 1u == (gen + 1u) * nloc) {
            __builtin_amdgcn_fence(__ATOMIC_RELEASE, "agent");
            asm volatile("s_waitcnt vmcnt(0)" ::: "memory");
            const unsigned og = xb_add(&bar[XB_TOP], 1u);
            const unsigned tg = og / nx;
            if (og + 1u == (tg + 1u) * nx) xb_add(&bar[XB_TOPGEN], 1u);
            else XB_SPIN(xb_ld(&bar[XB_TOPGEN]) == tg, bar);
            __builtin_amdgcn_fence(__ATOMIC_ACQUIRE, "agent");
            xb_add(&bar[XB_XGEN(b.x)], 1u);
            asm volatile("s_waitcnt vmcnt(0)" ::: "memory");
        } else {
            XB_SPIN(xb_ld(&bar[XB_XGEN(b.x)]) == gen, bar);
            __builtin_amdgcn_fence(__ATOMIC_ACQUIRE, "agent");
            asm volatile("s_waitcnt vmcnt(0)" ::: "memory");
        }
    }
    __syncthreads();
}

struct Ctx { LAS unsigned char* lds; int tid, lane, wave, vcu, G, gw, NGW; };

__device__ __forceinline__ float wave_sum(float v) {
#pragma unroll
    for (int o = 1; o < 64; o <<= 1) v += __shfl_xor(v, o);
    return v;
}
__device__ __forceinline__ float wave_max(float v) {
#pragma unroll
    for (int o = 1; o < 64; o <<= 1) v = fmaxf(v, __shfl_xor(v, o));
    return v;
}
__device__ __forceinline__ float rdlane(float v, int l) { return __builtin_bit_cast(float, __builtin_amdgcn_readlane(__builtin_bit_cast(int, v), l)); }

__device__ __forceinline__ void p0_transpose_item(const float* W, int N, const float* gain, bf16* WT, int ldo, int col_off, int row_off, LAS float* scr, int item, int nblk, int lane) {
    const int kb = item / nblk, nb = item % nblk, k0 = 64 * kb, n0 = 32 * nb;
#pragma unroll 8
    for (int i = 0; i < 32; ++i) { const int kk = 2 * i + (lane >> 5); const float g = gain ? gain[k0 + kk] : 1.f; scr[kk * 33 + (lane & 31)] = W[(size_t)(k0 + kk) * N + n0 + (lane & 31)] * g; }
    LDS_WAIT(); asm volatile("" ::: "memory");
    const int c = lane & 7;
#pragma unroll
    for (int j = 0; j < 4; ++j) { const int n = (lane >> 3) + 8 * j; const LAS float* s = scr + (8 * c) * 33 + n;
        v4u o; o.x = pk2(s[0 * 33], s[1 * 33]); o.y = pk2(s[2 * 33], s[3 * 33]); o.z = pk2(s[4 * 33], s[5 * 33]); o.w = pk2(s[6 * 33], s[7 * 33]);
        *(GAS v4u*)(WT + (size_t)(row_off + n0 + n) * ldo + col_off + k0 + 8 * c) = o; }
    LDS_WAIT(); asm volatile("" ::: "memory");
}
__device__ __forceinline__ void rms_row_to_bf16(const float* xrow, bf16* orow, int lane) {
    const GAS f32x4* xr = (const GAS f32x4*)xrow + lane;
    f32x4 v[4]; float s = 0.f;
#pragma unroll
    for (int j = 0; j < 4; ++j) { v[j] = xr[64 * j]; s += (v[j].x * v[j].x + v[j].y * v[j].y) + (v[j].z * v[j].z + v[j].w * v[j].w); }
    const float r = 1.f / sqrtf(wave_sum(s) * (1.f / DM) + RMS_EPS);
    GAS unsigned long long* o8 = (GAS unsigned long long*)orow + lane;
#pragma unroll
    for (int j = 0; j < 4; ++j) o8[64 * j] = (unsigned long long)pk2(v[j].x * r, v[j].y * r) | ((unsigned long long)pk2(v[j].z * r, v[j].w * r) << 32);
}
__device__ __forceinline__ int t5_bucket(int dist) {
    if (dist < 16) return dist;
    const double x = log((double)dist / 16.0) / log(128.0) * 16.0;
    int large = 16 + (int)x; return large < 31 ? large : 31;
}

__device__ __forceinline__ void ldq64(const bf16* p, float (&q)[64]) {
#pragma unroll
    for (int i = 0; i < 8; ++i) { const v4u u = *(const GAS v4u*)(p + 8 * i);
        q[8 * i + 0] = bflo(u.x); q[8 * i + 1] = bfhi(u.x); q[8 * i + 2] = bflo(u.y); q[8 * i + 3] = bfhi(u.y);
        q[8 * i + 4] = bflo(u.z); q[8 * i + 5] = bfhi(u.z); q[8 * i + 6] = bflo(u.w); q[8 * i + 7] = bfhi(u.w); }
}
__device__ __forceinline__ float dot64_bf(const float (&q)[64], const bf16* p) {
    float s0 = 0.f, s1 = 0.f;
#pragma unroll
    for (int i = 0; i < 8; ++i) { const v4u u = *(const GAS v4u*)(p + 8 * i);
        s0 += q[8 * i + 0] * bflo(u.x); s1 += q[8 * i + 1] * bfhi(u.x); s0 += q[8 * i + 2] * bflo(u.y); s1 += q[8 * i + 3] * bfhi(u.y);
        s0 += q[8 * i + 4] * bflo(u.z); s1 += q[8 * i + 5] * bfhi(u.z); s0 += q[8 * i + 6] * bflo(u.w); s1 += q[8 * i + 7] * bfhi(u.w); }
    return s0 + s1;
}
__device__ __forceinline__ float dot64_f32(const float (&q)[64], const float* p) {
    float s0 = 0.f, s1 = 0.f;
#pragma unroll
    for (int i = 0; i < 16; ++i) { const f32x4 u = *(const GAS f32x4*)(p + 4 * i);
        s0 += q[4 * i + 0] * u.x; s1 += q[4 * i + 1] * u.y; s0 += q[4 * i + 2] * u.z; s1 += q[4 * i + 3] * u.w; }
    return s0 + s1;
}
__device__ __forceinline__ float silu(float x) { return x / (1.f + __expf(-x)); }

__device__ __forceinline__ float cross_attn_task(const bf16* MKV, const float* c_mem, const bf16* qptr, int m, int hh, int layer, int lane) {
    float q[64]; ldq64(qptr, q);
    const bool samp = m >= TP;
    float l[4]; float mx = -3.0e38f, o = 0.f, s = 0.f;
    if (!samp) {
        const bf16* kb = MKV + (size_t)((m >> 11) * NMEM) * 1024 + layer * 512 + hh * 64;
#pragma unroll
        for (int r = 0; r < 4; ++r) { l[r] = dot64_bf(q, kb + (size_t)(r * 64 + lane) * 1024) * 0.125f; mx = fmaxf(mx, l[r]); }
        mx = wave_max(mx);
#pragma unroll
        for (int r = 0; r < 4; ++r) { l[r] = __expf(l[r] - mx); s += l[r]; }
        s = wave_sum(s);
#pragma unroll
        for (int r = 0; r < 4; ++r)
            for (int kk = 0; kk < 64; ++kk) o += rdlane(l[r], kk) * bf2f(kb[(size_t)(r * 64 + kk) * 1024 + 256 + lane]);
    } else {
        const float* kf = c_mem + ((size_t)(layer * SBATCH + ((m - TP) >> 2)) * NMEM) * 512 + hh * 64;
#pragma unroll
        for (int r = 0; r < 4; ++r) { l[r] = dot64_f32(q, kf + (size_t)(r * 64 + lane) * 512) * 0.125f; mx = fmaxf(mx, l[r]); }
        mx = wave_max(mx);
#pragma unroll
        for (int r = 0; r < 4; ++r) { l[r] = __expf(l[r] - mx); s += l[r]; }
        s = wave_sum(s);
#pragma unroll
        for (int r = 0; r < 4; ++r)
            for (int kk = 0; kk < 64; ++kk) o += rdlane(l[r], kk) * kf[(size_t)(r * 64 + kk) * 512 + 256 + lane];
    }
    return o / s;
}

template <int G>
__device__ __forceinline__ void attn_group(const bf16* P, const float* BT, const float* cw, int m, int hh, int lane, float& Mx, float& Ss, float& O) {
    constexpr int dil = G == 0 ? 1 : (G == 1 ? 4 : 16), Wg = G == 0 ? 128 : (G == 1 ? 512 : 2048), head0 = G * 4;
    const bool samp = m >= TP;
    const int b = m >> 11, t = m & 2047, sb = (m - TP) >> 2, st = (m - TP) & 3, head = head0 + hh;
    float q[64]; ldq64(P + (size_t)m * A_IN + head * 64, q);
    const float* bt = BT + (G * 4 + hh) * 132;
    float l[3]; float gm = -3.0e38f;
#pragma unroll
    for (int r = 0; r < 3; ++r) { const int kidx = r * 64 + lane; float lv = -3.0e38f;
        if (kidx < 129) {
            if (!samp) { const int tk = t - dil * kidx; if (tk >= 0) lv = dot64_bf(q, P + (size_t)((b << 11) + tk) * A_IN + RW + head * 64) * 0.125f + bt[kidx]; }
            else { const int idx = Wg + st - dil * kidx;
                if (idx >= Wg) lv = dot64_bf(q, P + (size_t)(TP + sb * 4 + idx - Wg) * A_IN + RW + head * 64) * 0.125f + bt[kidx];
                else lv = dot64_f32(q, cw + ((size_t)(sb * Wg + idx) * 2) * 256 + hh * 64) * 0.125f + bt[kidx]; }
        }
        l[r] = lv; gm = fmaxf(gm, lv); }
    gm = wave_max(gm);
    const float Mn = fmaxf(Mx, gm), sc = __expf(Mx - Mn);
    float ps = 0.f;
#pragma unroll
    for (int r = 0; r < 3; ++r) { l[r] = l[r] > -1.0e38f ? __expf(l[r] - Mn) : 0.f; ps += l[r]; }
    Ss = Ss * sc + wave_sum(ps); O *= sc; Mx = Mn;
#pragma unroll
    for (int r = 0; r < 3; ++r)
        for (int kk = 0; kk < 64; ++kk) { const int kidx = r * 64 + kk; if (kidx >= 129) break;
            const float p = rdlane(l[r], kk);
            if (p != 0.f) { float v;
                if (!samp) { const int tk = t - dil * kidx; v = bf2f(P[(size_t)((b << 11) + tk) * A_IN + 2 * RW + head * 64 + lane]); }
                else { const int idx = Wg + st - dil * kidx;
                    if (idx >= Wg) v = bf2f(P[(size_t)(TP + sb * 4 + idx - Wg) * A_IN + 2 * RW + head * 64 + lane]);
                    else v = cw[((size_t)(sb * Wg + idx) * 2 + 1) * 256 + hh * 64 + lane]; }
                O += p * v; } }
}

__device__ __forceinline__ void row_pass(const bf16* hp, const float* xin, float* xout, const float* gpost, bf16* xn, int lane) {
    const GAS v2u* h2 = (const GAS v2u*)hp + lane; const GAS f32x4* xr = (const GAS f32x4*)xin + lane; const GAS f32x4* gp = (const GAS f32x4*)gpost + lane;
    f32x4 h[4], x[4]; float s = 0.f;
#pragma unroll
    for (int j = 0; j < 4; ++j) { const v2u u = h2[64 * j]; h[j] = (f32x4){bflo(u.x), bfhi(u.x), bflo(u.y), bfhi(u.y)}; x[j] = xr[64 * j];
        s += (h[j].x * h[j].x + h[j].y * h[j].y) + (h[j].z * h[j].z + h[j].w * h[j].w); }
    const float r = 1.f / sqrtf(wave_sum(s) * (1.f / DM) + RMS_EPS);
    float s2 = 0.f;
#pragma unroll
    for (int j = 0; j < 4; ++j) { const f32x4 g = gp[64 * j]; x[j] = x[j] + h[j] * r * g; s2 += (x[j].x * x[j].x + x[j].y * x[j].y) + (x[j].z * x[j].z + x[j].w * x[j].w);
        *((GAS f32x4*)xout + lane + 64 * j) = x[j]; }
    if (xn) { const float r2 = 1.f / sqrtf(wave_sum(s2) * (1.f / DM) + RMS_EPS);
        GAS unsigned long long* o8 = (GAS unsigned long long*)xn + lane;
#pragma unroll
        for (int j = 0; j < 4; ++j) o8[64 * j] = (unsigned long long)pk2(x[j].x * r2, x[j].y * r2) | ((unsigned long long)pk2(x[j].z * r2, x[j].w * r2) << 32); }
}

struct ScanP { const bf16 *P, *LORA; bf16* H; float* out; const float *st_wkv, *st_shift, *mu, *w0, *a0, *k_k, *k_a, *r_k, *ln_w, *ln_b; };
__device__ __forceinline__ void scan_unit(const Ctx& C, const ScanP& sp, int u) {
    LAS float* L = (LAS float*)(C.lds + RING_OFF);
    LAS float *LA = L, *LB = L + 4096, *LW = L + 8192, *LK = L + 12288, *LRW = L + 16384, *LV = L + 20480, *LSC = L + 24576, *LY = L + 24576 + 256;
    const bool samp = u >= 96; const int seq = samp ? (u - 96) / 12 : u / 12, h = samp ? (u - 96) % 12 : u % 12;
    const int T = samp ? STOK : SEQ, row0 = samp ? TP + seq * 4 : seq * SEQ;
    int row = C.wave * 8 + (C.lane >> 3), p = C.lane & 7;
    asm volatile("" : "+v"(row), "+v"(p));
    float S[8];
#pragma unroll
    for (int j = 0; j < 8; ++j) S[j] = samp ? sp.st_wkv[((size_t)(seq * 12 + h) * 64 + row) * 64 + p * 8 + j] : 0.f;
#pragma unroll 1
    for (int c0 = 0; c0 < T; c0 += 64) {
        const int n = (T - c0) < 64 ? (T - c0) : 64;
        int tok = C.tid >> 3, part = C.tid & 7;
        asm volatile("" : "+v"(tok), "+v"(part));
        __syncthreads();
        if (tok < n) {
            const int t = c0 + tok, m = row0 + t;
            const bf16* cur = sp.P + (size_t)m * B_INP; const bf16* prv = cur - B_INP; const bf16* lo = sp.LORA + (size_t)m * 1536;
            float xr[8], xk[8], xv[8], kk[8], av[8], dv[8];
            float nrm = 0.f;
#pragma unroll
            for (int j = 0; j < 8; ++j) { const int c = h * 64 + part * 8 + j;
                const float cr = bf2f(cur[c]), ck = bf2f(cur[RW + c]), cv = bf2f(cur[2 * RW + c]);
                float pr = 0.f, pk = 0.f, pv = 0.f;
                if (t > 0) { pr = bf2f(prv[c]); pk = bf2f(prv[RW + c]); pv = bf2f(prv[2 * RW + c]); }
                else if (samp) { const float* ss = sp.st_shift + (size_t)seq * CSH; pr = ss[c]; pk = ss[RW + c]; pv = ss[2 * RW + c]; }
                xr[j] = cr + sp.mu[c] * (pr - cr); xk[j] = ck + sp.mu[RW + c] * (pk - ck); xv[j] = cv + sp.mu[2 * RW + c] * (pv - cv);
                const float dpre = sp.w0[c] + bf2f(lo[c]), apre = sp.a0[c] + bf2f(lo[RW + c]);
                const float z = -dpre, spl = fmaxf(z, 0.f) + log1pf(expf(-fabsf(z)));
                const float wlog = -spl - 0.5f; dv[j] = expf(-expf(wlog));
                av[j] = 1.f / (1.f + expf(-apre));
                kk[j] = xk[j] * sp.k_k[c]; nrm += kk[j] * kk[j]; }
            nrm += __shfl_xor(nrm, 1); nrm += __shfl_xor(nrm, 2); nrm += __shfl_xor(nrm, 4);
            const float inv = 1.f / fmaxf(sqrtf(nrm), 1e-12f);
            float br = 0.f, kr = 0.f, bon = 0.f;
#pragma unroll
            for (int j = 0; j < 8; ++j) { const int c = h * 64 + part * 8 + j, d = part * 8 + j;
                const float kn = kk[j] * inv, k2 = xk[j] * (1.f + (av[j] - 1.f) * sp.k_a[c]);
                const float bb = kn * av[j];
                LA[tok * 64 + d] = -kn; LB[tok * 64 + d] = bb; LW[tok * 64 + d] = dv[j]; LK[tok * 64 + d] = k2; LRW[tok * 64 + d] = xr[j] * dv[j]; LV[tok * 64 + d] = xv[j];
                br += bb * xr[j]; kr += k2 * xr[j]; bon += xr[j] * k2 * sp.r_k[c]; }
            br += __shfl_xor(br, 1); br += __shfl_xor(br, 2); br += __shfl_xor(br, 4);
            kr += __shfl_xor(kr, 1); kr += __shfl_xor(kr, 2); kr += __shfl_xor(kr, 4);
            bon += __shfl_xor(bon, 1); bon += __shfl_xor(bon, 2); bon += __shfl_xor(bon, 4);
            if (part == 0) { LSC[tok * 4 + 0] = br; LSC[tok * 4 + 1] = kr; LSC[tok * 4 + 2] = bon; }
        }
        __syncthreads();
#pragma unroll 1
        for (int i = 0; i < n; ++i) {
            const LAS f32x4* a4 = (const LAS f32x4*)(LA + i * 64 + p * 8); const LAS f32x4* r4 = (const LAS f32x4*)(LRW + i * 64 + p * 8);
            const LAS f32x4* w4 = (const LAS f32x4*)(LW + i * 64 + p * 8); const LAS f32x4* b4 = (const LAS f32x4*)(LB + i * 64 + p * 8); const LAS f32x4* k4 = (const LAS f32x4*)(LK + i * 64 + p * 8);
            const f32x4 a0 = a4[0], a1 = a4[1], r0 = r4[0], r1 = r4[1];
            float sa = (S[0] * a0.x + S[1] * a0.y) + (S[2] * a0.z + S[3] * a0.w) + (S[4] * a1.x + S[5] * a1.y) + (S[6] * a1.z + S[7] * a1.w);
            float yp = (S[0] * r0.x + S[1] * r0.y) + (S[2] * r0.z + S[3] * r0.w) + (S[4] * r1.x + S[5] * r1.y) + (S[6] * r1.z + S[7] * r1.w);
            sa += __shfl_xor(sa, 1); sa += __shfl_xor(sa, 2); sa += __shfl_xor(sa, 4);
            yp += __shfl_xor(yp, 1); yp += __shfl_xor(yp, 2); yp += __shfl_xor(yp, 4);
            const float v = LV[i * 64 + row], br = LSC[i * 4 + 0], kr = LSC[i * 4 + 1];
            const f32x4 w0 = w4[0], w1 = w4[1], b0 = b4[0], b1 = b4[1], k0 = k4[0], k1 = k4[1];
            S[0] = S[0] * w0.x + sa * b0.x + v * k0.x; S[1] = S[1] * w0.y + sa * b0.y + v * k0.y; S[2] = S[2] * w0.z + sa * b0.z + v * k0.z; S[3] = S[3] * w0.w + sa * b0.w + v * k0.w;
            S[4] = S[4] * w1.x + sa * b1.x + v * k1.x; S[5] = S[5] * w1.y + sa * b1.y + v * k1.y; S[6] = S[6] * w1.z + sa * b1.z + v * k1.z; S[7] = S[7] * w1.w + sa * b1.w + v * k1.w;
            if (p == 0) LY[i * 64 + row] = yp + sa * br + v * kr;
        }
        __syncthreads();
        asm volatile("" : "+v"(tok), "+v"(part));
        if (tok < n) {
            const int m = row0 + c0 + tok;
            float y[8]; float s = 0.f;
#pragma unroll
            for (int j = 0; j < 8; ++j) { y[j] = LY[tok * 64 + part * 8 + j]; s += y[j]; }
            s += __shfl_xor(s, 1); s += __shfl_xor(s, 2); s += __shfl_xor(s, 4);
            const float mean = s * (1.f / 64.f); float q = 0.f;
#pragma unroll
            for (int j = 0; j < 8; ++j) { y[j] -= mean; q += y[j] * y[j]; }
            q += __shfl_xor(q, 1); q += __shfl_xor(q, 2); q += __shfl_xor(q, 4);
            const float rstd = 1.f / sqrtf(q * (1.f / 64.f) + GN_EPS), bon = LSC[tok * 4 + 2];
            unsigned w[4];
#pragma unroll
            for (int j = 0; j < 8; j += 2) { float o2[2];
#pragma unroll
                for (int e = 0; e < 2; ++e) { const int c = h * 64 + part * 8 + j + e;
                    const float yy = y[j + e] * rstd * sp.ln_w[c] + sp.ln_b[c] + bon * LV[tok * 64 + part * 8 + j + e];
                    o2[e] = yy * silu(bf2f(sp.P[(size_t)m * B_INP + 2688 + c])); }
                w[j >> 1] = pk2(o2[0], o2[1]); }
            *(GAS v4u*)(sp.H + (size_t)m * 1024 + h * 64 + part * 8) = (v4u){w[0], w[1], w[2], w[3]};
        }
    }
    float* so = sp.out + (samp ? O_WKVS : O_WKVP) + ((size_t)(seq * 12 + h) * 64 + row) * 64 + p * 8;
    *(GAS f32x4*)so = (f32x4){S[0], S[1], S[2], S[3]}; *((GAS f32x4*)so + 1) = (f32x4){S[4], S[5], S[6], S[7]};
    __syncthreads();
}

constexpr int PTAB_OFF = LDSCTL_OFF + 512;
__device__ __forceinline__ const float* inptr(LAS unsigned char* ldsb, int i) {
    const LAS unsigned* p = (const LAS unsigned*)(ldsb + PTAB_OFF) + 2 * i;
    const unsigned lo = __builtin_amdgcn_readfirstlane(p[0]), hi = __builtin_amdgcn_readfirstlane(p[1]);
    return (const float*)(((unsigned long long)hi << 32) | lo);
}
struct Args { const float* in[28]; float* out; unsigned char* ws; int ph_lo, ph_hi; };
#define WSP(T, off) ((T*)(args.ws + (off)))
#define GEMM_BF16(Aptr, Bptr, Optr, Mv, Nv, Kv) do { pg8::Gemm g{Aptr, Bptr, Mv, Nv, Kv}; pg8::StaticOrder S; S.init(Mv, Nv, C.G, (int)blockIdx.x); \
        pg8::EpiBf16<0> E{Optr, Nv, nullptr, 0, 0, 1.f}; pg8::gemm_phase<pg8::EpiBf16<0>, pg8::StaticOrder, PG8_ALIGN, PG8_SP2>(C.lds + RING_OFF, g, S, E); } while (0)
__global__ void __launch_bounds__(NWAVES * 64, 2) hyb_fwd(Args args) {
    extern __shared__ __attribute__((aligned(16))) unsigned char lds[];
    LAS unsigned char* const ldsb = (LAS unsigned char*)lds;
    for (int u = threadIdx.x; u < (LDS_BYTES - LDSCTL_OFF) / 4; u += NWAVES * 64) ((LAS unsigned*)(ldsb + LDSCTL_OFF))[u] = 0u;
    __syncthreads();
    if (threadIdx.x < 28) ((LAS unsigned long long*)(ldsb + PTAB_OFF))[threadIdx.x] = (unsigned long long)args.in[threadIdx.x];
    __syncthreads();
#define INP(i) inptr(ldsb, (i))
#define MKCTX() Ctx C; { int t_ = threadIdx.x; asm volatile("" : "+v"(t_)); C.lds = ldsb; C.tid = t_; C.lane = t_ & 63; C.wave = __builtin_amdgcn_readfirstlane(t_ >> 6); \
        C.G = gridDim.x; const int bx_ = blockIdx.x; C.vcu = (C.G % 8 == 0) ? (bx_ % 8) * (C.G / 8) + bx_ / 8 : bx_; C.gw = C.vcu * NWAVES + C.wave; C.NGW = C.G * NWAVES; } \
        const int gt = C.gw * 64 + C.lane, NGT = C.NGW * 64; (void)gt; (void)NGT
    const int lo = args.ph_lo, hi = args.ph_hi;
    const bool fused = (hi - lo) > 1;
    XcdBarrier bar; bar.bar = WSP(unsigned, WS_CTL) + CW_BAR; bar.x = 0; bar.st = nullptr;
    if (fused) bar = xcd_barrier_post(WSP(unsigned, WS_CTL) + CW_BAR, (volatile LAS unsigned*)(ldsb + MISC_OFF) + 8);
#define IN(k) (lo <= (k) && (k) < hi)
#define SEAM(k) do { if (IN(k) && IN((k) + 1)) xcd_barrier(bar); } while (0)

    if (IN(0)) { MKCTX();
        LAS float* scr = (LAS float*)(C.lds + RING_OFF + C.wave * 16384);
        constexpr int I0 = 16 * 96, I1 = 8 * 32, I2 = 16 * 116, I3 = 16 * 32, I4 = 16 * 16, I5 = 16 * 16, I6 = 24, I7 = 24;
        constexpr int NITEMS = I0 + I1 + I2 + I3 + I4 + I5 + I6 + I7;
        for (int it = C.gw; it < NITEMS; it += C.NGW) {
            int r = it;
            if (r < I0) { p0_transpose_item(INP(14), A_IN, INP(9), WSP(bf16, WS_WAIN), 1024, 0, 0, scr, r, 96, C.lane); continue; } r -= I0;
            if (r < I1) { p0_transpose_item(INP(15), 1024, nullptr, WSP(bf16, WS_WAOUT), 512, 0, 0, scr, r, 32, C.lane); continue; } r -= I1;
            if (r < I2) { p0_transpose_item(INP(16), B_IN, INP(9) + DM, WSP(bf16, WS_WBIN), 1024, 0, 0, scr, r, 116, C.lane); continue; } r -= I2;
            if (r < I3) { p0_transpose_item(INP(17), 1024, nullptr, WSP(bf16, WS_WBOUT), 1024, 0, 0, scr, r, 32, C.lane); continue; } r -= I3;
            if (r < I4) { p0_transpose_item(INP(12), 512, INP(11), WSP(bf16, WS_WM), 1024, 0, 0, scr, r, 16, C.lane); continue; } r -= I4;
            if (r < I5) { p0_transpose_item(INP(12) + 1024 * 512, 512, INP(11) + DM, WSP(bf16, WS_WM), 1024, 0, 512, scr, r, 16, C.lane); continue; } r -= I5;
            if (r < I6) { p0_transpose_item(INP(20), RW, nullptr, WSP(bf16, WS_WL), 128, 0, 0, scr, r, 24, C.lane); continue; } r -= I6;
            p0_transpose_item(INP(22), RW, nullptr, WSP(bf16, WS_WL), 128, 64, RW, scr, r, 24, C.lane);
        }
        const v4u z4 = {0u, 0u, 0u, 0u};
        for (int i = gt; i < 16384; i += NGT) *((GAS v4u*)(WSP(bf16, WS_WBIN) + (size_t)B_IN * 1024) + i) = z4;
        for (int i = gt; i < 1536 * 8; i += NGT) { const int n = i >> 3, c = i & 7; *(GAS v4u*)(WSP(bf16, WS_WL) + (size_t)n * 128 + (n < RW ? 64 : 0) + c * 8) = z4; }
        for (int i = gt; i < 128 * 128; i += NGT) *((GAS v4u*)(WSP(bf16, WS_XN) + (size_t)NREAL * 1024) + i) = z4;
        for (int i = gt; i < 3 * 4 * 129; i += NGT) { const int g = i / (4 * 129), r = i % (4 * 129), hh = r / 129, k = r % 129; const int dil = g == 0 ? 1 : (g == 1 ? 4 : 16);
            WSP(float, WS_BT)[(g * 4 + hh) * 132 + k] = INP(13)[t5_bucket(dil * k) * 12 + g * 4 + hh]; }
        for (int m = C.gw; m < NREAL + 2048; m += C.NGW) {
            if (m < TP) rms_row_to_bf16(INP(0) + (size_t)m * DM, WSP(bf16, WS_XN) + (size_t)m * DM, C.lane);
            else if (m < NREAL) rms_row_to_bf16(INP(1) + (size_t)(m - TP) * DM, WSP(bf16, WS_XN) + (size_t)m * DM, C.lane);
            else rms_row_to_bf16(INP(2) + (size_t)(m - NREAL) * DM, WSP(bf16, WS_MEMN) + (size_t)(m - NREAL) * DM, C.lane);
        }
    } SEAM(0);
    if (IN(1)) { MKCTX();
        GEMM_BF16(WSP(bf16, WS_XN), WSP(bf16, WS_WAIN), WSP(bf16, WS_P), MROWS, A_IN, DM);
        GEMM_BF16(WSP(bf16, WS_MEMN), WSP(bf16, WS_WM), WSP(bf16, WS_MKV), 2048, 1024, DM);
    } SEAM(1);
    if (IN(2)) { MKCTX();
        const bf16* P = WSP(bf16, WS_P); const bf16* MKV = WSP(bf16, WS_MKV); float* out = args.out;
        for (int i = gt; i < 2 * 2048 * 512; i += NGT) { const int l = i / (2048 * 512), r = (i / 512) % 2048, c = i % 512; out[O_MEM + i] = bf2f(MKV[(size_t)r * 1024 + l * 512 + c]); }
#pragma unroll
        for (int g = 0; g < 3; ++g) { const int Wg = g == 0 ? 128 : (g == 1 ? 512 : 2048); const size_t ob = g == 0 ? O_W0P : (g == 1 ? O_W1P : O_W2P);
            const int n = NBATCH * Wg * 512;
            for (int i = gt; i < n; i += NGT) { const int c = i % 512, ri = (i / 512) % Wg, b = i / (512 * Wg); const int t = SEQ - Wg + ri, kv = c >> 8, cc = c & 255;
                out[ob + i] = bf2f(P[(size_t)((b << 11) + t) * A_IN + RW + kv * RW + g * 256 + cc]); }
            const size_t os = g == 0 ? O_W0S : (g == 1 ? O_W1S : O_W2S);
            for (int i = gt; i < NSAMP * 512; i += NGT) { const int c = i % 512, r = i / 512, kv = c >> 8, cc = c & 255;
                out[os + i] = bf2f(P[(size_t)(TP + r) * A_IN + RW + kv * RW + g * 256 + cc]); } }
        bf16* H = WSP(bf16, WS_H); const float* BT = WSP(float, WS_BT);
        for (int task = C.gw; task < NREAL * 4; task += C.NGW) { const int m = task >> 2, hh = task & 3;
            float Mx = -3.0e38f, Ss = 0.f, O = 0.f;
            attn_group<0>(P, BT, INP(4), m, hh, C.lane, Mx, Ss, O);
            attn_group<1>(P, BT, INP(5), m, hh, C.lane, Mx, Ss, O);
            attn_group<2>(P, BT, INP(6), m, hh, C.lane, Mx, Ss, O);
            const bf16* prow = P + (size_t)m * A_IN;
            const float om = cross_attn_task(MKV, INP(3), prow + 2304 + hh * 64, m, hh, 0, C.lane);
            const float g0 = bf2f(prow[2560 + hh * 64 + C.lane]), g1 = bf2f(prow[2560 + 256 + hh * 64 + C.lane]);
            H[(size_t)m * 512 + hh * 64 + C.lane] = (bf16)f2bf((O / Ss) * silu(g0));
            H[(size_t)m * 512 + 256 + hh * 64 + C.lane] = (bf16)f2bf(om * silu(g1)); }
    } SEAM(2);
    if (IN(3)) { MKCTX(); GEMM_BF16(WSP(bf16, WS_H), WSP(bf16, WS_WAOUT), WSP(bf16, WS_F), MROWS, DM, 512); } SEAM(3);
    if (IN(4)) { MKCTX();
        for (int m = C.gw; m < NREAL; m += C.NGW) { const bool samp = m >= TP;
            row_pass(WSP(bf16, WS_F) + (size_t)m * DM, samp ? INP(1) + (size_t)(m - TP) * DM : INP(0) + (size_t)m * DM,
                     args.out + (samp ? O_YS + (size_t)(m - TP) * DM : O_YP + (size_t)m * DM), INP(10), WSP(bf16, WS_XN) + (size_t)m * DM, C.lane); }
    } SEAM(4);
    if (IN(5)) { MKCTX(); GEMM_BF16(WSP(bf16, WS_XN), WSP(bf16, WS_WBIN), WSP(bf16, WS_P), MROWS, B_INP, DM); } SEAM(5);
    if (IN(6)) { MKCTX();
        const bf16* P = WSP(bf16, WS_P); bf16* TW = WSP(bf16, WS_TW); const float* mu = INP(18); const float* stsh = INP(8);
        for (int m = C.gw; m < NREAL; m += C.NGW) {
            const bool samp = m >= TP; const int t = samp ? ((m - TP) & 3) : (m & 2047), sb = (m - TP) >> 2;
#pragma unroll
            for (int j = 0; j < 2; ++j) { const int c = 2304 + j * 64 + C.lane;
                const float cur = bf2f(P[(size_t)m * B_INP + c]);
                float prev = 0.f; if (t > 0) prev = bf2f(P[(size_t)(m - 1) * B_INP + c]); else if (samp) prev = stsh[(size_t)sb * CSH + c];
                const float xs = cur + mu[c] * (prev - cur);
                TW[(size_t)m * 128 + j * 64 + C.lane] = (bf16)f2bf(j == 0 ? tanhf(xs) : xs); }
        }
    } SEAM(6);
    if (IN(7)) { MKCTX(); GEMM_BF16(WSP(bf16, WS_TW), WSP(bf16, WS_WL), WSP(bf16, WS_F), MROWS, 1536, 128); } SEAM(7);
    if (IN(8)) { MKCTX();
        { ScanP sp{WSP(bf16, WS_P), WSP(bf16, WS_F), WSP(bf16, WS_H), args.out, INP(7), INP(8), INP(18), INP(19), INP(21), INP(23), INP(24), INP(25), INP(26), INP(27)};
          for (int u = blockIdx.x; u < 480; u += C.G) scan_unit(C, sp, u); }
        const bf16* P = WSP(bf16, WS_P); bf16* H = WSP(bf16, WS_H);
        for (int task = C.gw; task < NREAL * 4; task += C.NGW) { const int m = task >> 2, hh = task & 3;
            const bf16* prow = P + (size_t)m * B_INP;
            const float om = cross_attn_task(WSP(bf16, WS_MKV), INP(3), prow + CSH + hh * 64, m, hh, 1, C.lane);
            H[(size_t)m * 1024 + RW + hh * 64 + C.lane] = (bf16)f2bf(om * silu(bf2f(prow[2688 + RW + hh * 64 + C.lane]))); }
        for (int i = gt; i < NBATCH * CSH; i += NGT) { const int b = i / CSH, c = i % CSH; args.out[O_SHP + i] = bf2f(P[(size_t)(b * SEQ + SEQ - 1) * B_INP + c]); }
        for (int i = gt; i < SBATCH * CSH; i += NGT) { const int sb = i / CSH, c = i % CSH; args.out[O_SHS + i] = bf2f(P[(size_t)(TP + sb * 4 + 3) * B_INP + c]); }
    } SEAM(8);
    if (IN(9)) { MKCTX(); GEMM_BF16(WSP(bf16, WS_H), WSP(bf16, WS_WBOUT), WSP(bf16, WS_F), MROWS, DM, DM); } SEAM(9);
    if (IN(10)) { MKCTX();
        for (int m = C.gw; m < NREAL; m += C.NGW) { const bool samp = m >= TP;
            float* xo = args.out + (samp ? O_YS + (size_t)(m - TP) * DM : O_YP + (size_t)m * DM);
            row_pass(WSP(bf16, WS_F) + (size_t)m * DM, xo, xo, INP(10) + DM, nullptr, C.lane); }
    }
#undef IN
#undef SEAM
}

extern "C" void kernel_launch(void* const* d_in, const int* in_sizes, int n_in, void* d_out, int out_size, void* d_ws, size_t ws_size, hipStream_t stream) {
    static int grid = 0;
    if (grid == 0) {
        if (n_in != 28 || in_sizes[0] != TP * DM || (size_t)out_size != O_END || ws_size < WS_END) {
            fprintf(stderr, "kernel_launch: unexpected shapes: n_in %d in0 %d out %d ws %zu (need >= %zu); nothing launched\n", n_in, n_in > 0 ? in_sizes[0] : -1, out_size, ws_size, (size_t)WS_END); grid = -1; return; }
        int dev = 0, cus = 0, per_cu = 0;
        if (hipGetDevice(&dev) != hipSuccess || hipDeviceGetAttribute(&cus, hipDeviceAttributeMultiprocessorCount, dev) != hipSuccess) { fprintf(stderr, "kernel_launch: device query failed\n"); grid = -1; return; }
        if (hipFuncSetAttribute((const void*)hyb_fwd, hipFuncAttributeMaxDynamicSharedMemorySize, LDS_BYTES) != hipSuccess) { fprintf(stderr, "kernel_launch: hipFuncSetAttribute failed\n"); grid = -1; return; }
        if (hipOccupancyMaxActiveBlocksPerMultiprocessor(&per_cu, (const void*)hyb_fwd, NWAVES * 64, LDS_BYTES) != hipSuccess || per_cu < 1) {
            fprintf(stderr, "kernel_launch: occupancy query reports %d workgroups per CU\n", per_cu); }
        (void)hipGetLastError();
        grid = cus;
    }
    if (grid < 0) return;
    if (hipMemsetAsync((char*)d_ws + WS_CTL, 0, CTL_ZERO_BYTES, stream) != hipSuccess) { fprintf(stderr, "kernel_launch: memset failed\n"); return; }
    Args a{};
    for (int i = 0; i < 28; ++i) a.in[i] = (const float*)d_in[i];
    a.out = (float*)d_out; a.ws = (unsigned char*)d_ws;
#if MK_N_LAUNCHES == 1
    a.ph_lo = 0; a.ph_hi = N_PHASES;
    hipLaunchKernelGGL(hyb_fwd, dim3(grid), dim3(NWAVES * 64), LDS_BYTES, stream, a);
#else
    for (int li = 0; li < N_PHASES; ++li) { a.ph_lo = li; a.ph_hi = li + 1;
        hipLaunchKernelGGL(hyb_fwd, dim3(grid), dim3(NWAVES * 64), LDS_BYTES, stream, a); }
#endif
    const hipError_t le = hipPeekAtLastError();
    if (le != hipSuccess) fprintf(stderr, "kernel_launch: launch failed: %s\n", hipGetErrorName(le));
}
```

```cpp
#include <hip/hip_runtime.h>
#include <cstdio>
#include <cstdint>
namespace pg8 {
#define PG8_LAS __attribute__((address_space(3)))
typedef unsigned short bf16_t;
typedef short bf16x8 __attribute__((ext_vector_type(8)));
typedef float f32x4 __attribute__((ext_vector_type(4)));
typedef unsigned u32x4 __attribute__((ext_vector_type(4)));
constexpr int BM = 256, BK = 64, HALF = 128, HTB = HALF * BK * 2  , STAGE_BYTES = 8 * HTB, NXCD = 8, WGM = 8;

__host__ __device__ __forceinline__ int lds_byte(int r, int c) { const int st = (r >> 4) * 2 + (c >> 5), rr = r & 15, cc = c & 31, ob = rr * 64 + cc * 2; return st * 1024 + (ob ^ (((ob >> 9) & 1) << 5)); }
__host__ __device__ __forceinline__ void stage_rc(int b, int& R, int& C) { const int st = b / 1024, sb = b % 1024, swz = sb ^ (((sb >> 9) & 1) << 5); R = (st >> 1) * 16 + swz / 64; C = (st & 1) * 32 + (swz % 64) / 2; }
__host__ __device__ __forceinline__ int perm32(int rho) { const int n = rho >> 4, i = rho & 15; return 8 * (i >> 2) + 4 * n + (i & 3); }

struct Unit { int pm, pn; };
struct Gemm { const bf16_t* A; const bf16_t* Bt; int M, N, K; };

struct StaticOrder {
    int nM, nN, nwg, G, c;
    __host__ __device__ void init(int M, int N, int G_, int c_) { nM = M / BM; nN = N / BM; nwg = nM * nN; G = G_; c = c_; }
    __host__ __device__ bool next(int i, Unit& u) const {
        const long L = (long)i * G + c; if (L >= nwg) return false;
        int wgid = (int)L; { const int q = nwg / NXCD, r = nwg % NXCD, xcd = wgid % NXCD, off = wgid / NXCD; wgid = (xcd < r ? xcd * (q + 1) : r * (q + 1) + (xcd - r) * q) + off; }
        const int nig = WGM * nN, gid = wgid / nig, fm = gid * WGM, gsz = (nM - fm) < WGM ? (nM - fm) : WGM;
        u.pm = fm + ((wgid % nig) % gsz); u.pn = (wgid % nig) / gsz; return true;
    }
    __device__ __forceinline__ void a_ready(const Unit&) const {}
    __device__ __forceinline__ void done(const Unit&) const {}
};

__device__ __forceinline__ unsigned cvt_pk_bf16(float lo, float hi) { unsigned r; asm volatile("v_cvt_pk_bf16_f32 %0, %1, %2" : "=v"(r) : "v"(lo), "v"(hi)); return r; }
typedef float f32x2 __attribute__((ext_vector_type(2)));
__device__ __forceinline__ f32x2 gelu_pk(f32x2 v) {
    const f32x2 av = __builtin_elementwise_abs(v), d = av * 0.2316418882f + 1.0f;
    f32x2 t; t.x = __builtin_amdgcn_rcpf(d.x); t.y = __builtin_amdgcn_rcpf(d.y);
    f32x2 q = t * 0.5307027145f + (-0.7265760135f); q = q * t + 0.7107068705f; q = q * t + (-0.142248368f); q = q * t + 0.127414796f; q = q * t;
    const f32x2 s = (v * v) * (-0.72134752044f);
    f32x2 e; e.x = __builtin_amdgcn_exp2f(s.x); e.y = __builtin_amdgcn_exp2f(s.y);
    const f32x2 m = v * (q * e), r = v - m;
    f32x2 o; o.x = v.x < 0.f ? m.x : r.x; o.y = v.y < 0.f ? m.y : r.y; return o;
}

template <int ACT  > struct EpiBf16 {
    static constexpr bool PERM = true, AFTER_DRAIN = false; static_assert(ACT == 0 || ACT == 1, "EpiBf16: ACT is 0 (none) or 1 (gelu_pk)");
    bf16_t* O; int ldc; const float* bias; int split_cols; size_t split_stride; float scale0;
    __device__ __forceinline__ void operator()(const f32x4 (&acc)[2][2][4][2], const Unit& u, int wr, int wc, int fr, int fq) const {
        const int row0 = u.pm * BM + wr * 64 + fr; int colt = u.pn * BM; bf16_t* base = O;
        float sc = 1.f; if (split_cols) { const int t = colt / split_cols; base += (size_t)t * split_stride; colt -= t * split_cols; if (t == 0) sc = scale0; }
        const int col0 = colt + wc * 32 + 8 * fq, bcol0 = u.pn * BM + wc * 32 + 8 * fq;
        f32x4 bv[2][2];
#pragma unroll
        for (int bj = 0; bj < 2; ++bj)
#pragma unroll
            for (int n = 0; n < 2; ++n) bv[bj][n] = bias ? *(const f32x4*)(bias + bcol0 + bj * HALF + 4 * n) : (f32x4){0.f, 0.f, 0.f, 0.f};
#pragma unroll
        for (int ai = 0; ai < 2; ++ai)
#pragma unroll
            for (int m = 0; m < 4; ++m) { bf16_t* rowp = base + (size_t)(row0 + ai * HALF + m * 16) * ldc + col0;
#pragma unroll
                for (int bj = 0; bj < 2; ++bj) { f32x4 v0 = acc[ai][bj][m][0] + bv[bj][0], v1 = acc[ai][bj][m][1] + bv[bj][1];
                    if (ACT == 1) { f32x2 a = gelu_pk((f32x2){v0[0], v0[1]}), b = gelu_pk((f32x2){v0[2], v0[3]}), c = gelu_pk((f32x2){v1[0], v1[1]}), d = gelu_pk((f32x2){v1[2], v1[3]});
                        v0 = (f32x4){a.x, a.y, b.x, b.y}; v1 = (f32x4){c.x, c.y, d.x, d.y}; }
                    v0 = v0 * sc; v1 = v1 * sc; u32x4 w; w.x = cvt_pk_bf16(v0[0], v0[1]); w.y = cvt_pk_bf16(v0[2], v0[3]); w.z = cvt_pk_bf16(v1[0], v1[1]); w.w = cvt_pk_bf16(v1[2], v1[3]);
                    *(u32x4*)(rowp + bj * HALF) = w; } }
    }
};
template <class Epi, class Sched, bool ALIGN_EPI = false, bool SP2 = false>
__device__ __forceinline__ void gemm_phase(PG8_LAS unsigned char* lds, const Gemm g, const Sched& S, const Epi& E) {
    const int tid = threadIdx.x, wid = __builtin_amdgcn_readfirstlane(tid >> 6), lane = tid & 63, wr = wid >> 2, wc = wid & 3, fr = lane & 15, fq = lane >> 4;
    const int K = g.K, nt = K / BK;
    unsigned voffA[2], voffB[2];
#pragma unroll
    for (int i = 0; i < 2; ++i) { int R, C; stage_rc(tid * 16 + i * 8192, R, C); const int Rb = Epi::PERM ? ((R & ~31) + perm32(R & 31)) : R;
        voffA[i] = (unsigned)(R * K + C) * 2u; voffB[i] = (unsigned)(Rb * K + C) * 2u; }
    const size_t kstep = (size_t)(BK * 2);
    const size_t hstep = (size_t)HALF * K * 2;
    const size_t tstep = 2 * hstep;
    const unsigned ldsw = (unsigned)wid * 1024u;
    const int aoff = lds_byte(wr * 64 + fr, fq * 8), boff = lds_byte(wc * 32 + fr, fq * 8);
#define PG8_SA(b, h) (((b) * 2 + (h)) * HTB)
#define PG8_SB(b, h) ((4 + (b) * 2 + (h)) * HTB)
#define PG8_STAGE(bufoff, gbase, voff) do { _Pragma("unroll") for (int _i = 0; _i < 2; ++_i) \
        __builtin_amdgcn_global_load_lds((const unsigned*)((const char*)(gbase) + (voff)[_i]), (PG8_LAS unsigned*)(lds + (bufoff) + ldsw + _i * 8192), 16, 0, 0); } while (0)
#define PG8_LDA(dst, b, h) do { _Pragma("unroll") for (int m = 0; m < 4; ++m) _Pragma("unroll") for (int k = 0; k < 2; ++k) dst[m][k] = *(const PG8_LAS bf16x8*)(lds + PG8_SA(b, h) + aoff + m * 2048 + k * 1024); } while (0)
#define PG8_LDB(dst, b, h) do { _Pragma("unroll") for (int n = 0; n < 2; ++n) _Pragma("unroll") for (int k = 0; k < 2; ++k) dst[n][k] = *(const PG8_LAS bf16x8*)(lds + PG8_SB(b, h) + boff + n * 2048 + k * 1024); } while (0)
#define PG8_MMA(ai, bj, At, Bt) do { __builtin_amdgcn_s_setprio(1); _Pragma("unroll") for (int m = 0; m < 4; ++m) _Pragma("unroll") for (int n = 0; n < 2; ++n) _Pragma("unroll") for (int k = 0; k < 2; ++k) \
        acc[ai][bj][m][n] = __builtin_amdgcn_mfma_f32_16x16x32_bf16(Bt[n][k], At[m][k], acc[ai][bj][m][n], 0, 0, 0); __builtin_amdgcn_s_setprio(0); } while (0)
#define PG8_WAIT_V(n) asm volatile("s_waitcnt vmcnt(" #n ")" ::: "memory")
#define PG8_WAIT_L(n) asm volatile("s_waitcnt lgkmcnt(" #n ")" ::: "memory")
#define PG8_BAR __builtin_amdgcn_s_barrier()
#define PG8_SCHED __builtin_amdgcn_sched_barrier(0)
    Unit cur, nxt; int ui = 0;
    if (!S.next(0, cur)) return;
    f32x4 acc[2][2][4][2];
#pragma unroll
    for (int a = 0; a < 2; ++a)
#pragma unroll
        for (int b = 0; b < 2; ++b)
#pragma unroll
            for (int m = 0; m < 4; ++m)
#pragma unroll
                for (int n = 0; n < 2; ++n) acc[a][b][m][n] = (f32x4){0.f, 0.f, 0.f, 0.f};
    bf16x8 At[4][2], B0[2][2], B1[2][2];
    const char* cA = (const char*)g.A + (size_t)cur.pm * tstep; const char* cB = (const char*)g.Bt + (size_t)cur.pn * tstep;
    S.a_ready(cur);
    if constexpr (SP2) {
        PG8_STAGE(PG8_SB(0, 0), cB, voffB); PG8_STAGE(PG8_SB(0, 1), cB + hstep, voffB); PG8_STAGE(PG8_SA(0, 0), cA, voffA); PG8_STAGE(PG8_SA(0, 1), cA + hstep, voffA);
        if (wr == 1) PG8_BAR;
        PG8_WAIT_V(2); PG8_BAR;
        PG8_STAGE(PG8_SB(1, 0), cB + kstep, voffB); PG8_STAGE(PG8_SA(1, 0), cA + kstep, voffA); PG8_STAGE(PG8_SB(1, 1), cB + hstep + kstep, voffB);
        PG8_WAIT_V(6); PG8_BAR;
    } else {
        PG8_STAGE(PG8_SB(0, 0), cB, voffB); PG8_STAGE(PG8_SA(0, 0), cA, voffA); PG8_STAGE(PG8_SB(0, 1), cB + hstep, voffB); PG8_STAGE(PG8_SA(0, 1), cA + hstep, voffA);
        if (wr == 1) PG8_BAR;
        PG8_WAIT_V(4); PG8_BAR;
        PG8_STAGE(PG8_SB(1, 0), cB + kstep, voffB); PG8_STAGE(PG8_SA(1, 0), cA + kstep, voffA); PG8_STAGE(PG8_SB(1, 1), cB + hstep + kstep, voffB);
        PG8_WAIT_V(6); PG8_BAR;
    }
    for (;;) {
        const bool has_next = S.next(ui + 1, nxt);
        const char* nA = has_next ? (const char*)g.A + (size_t)nxt.pm * tstep : cA; const char* nB = has_next ? (const char*)g.Bt + (size_t)nxt.pn * tstep : cB;
        for (int t = 0; t < nt; t += 2) {
            const bool last = (t == nt - 2);
            const char* a1 = cA + (size_t)(t + 1) * kstep;
            const char* a2 = last ? nA : cA + (size_t)(t + 2) * kstep; const char* b2 = last ? nB : cB + (size_t)(t + 2) * kstep;
            const char* a3 = a2 + kstep; const char* b3 = b2 + kstep;
            if (last && has_next) S.a_ready(nxt);
            if constexpr (SP2) {
            PG8_LDB(B0, 0, 0); PG8_LDB(B1, 0, 1); PG8_SCHED; PG8_LDA(At, 0, 0); PG8_STAGE(PG8_SA(1, 1), a1 + hstep, voffA);
            PG8_WAIT_V(8); PG8_WAIT_L(0); PG8_BAR; PG8_MMA(0, 0, At, B0); PG8_MMA(0, 1, At, B1); PG8_BAR; PG8_SCHED;
            PG8_LDA(At, 0, 1); PG8_STAGE(PG8_SB(0, 0), b2, voffB); PG8_STAGE(PG8_SB(0, 1), b2 + hstep, voffB); PG8_STAGE(PG8_SA(0, 0), a2, voffA);
            PG8_WAIT_V(8); PG8_WAIT_L(0); PG8_BAR; PG8_MMA(1, 0, At, B0); PG8_MMA(1, 1, At, B1); PG8_BAR; PG8_SCHED;
            PG8_LDB(B0, 1, 0); PG8_LDB(B1, 1, 1); PG8_SCHED; PG8_LDA(At, 1, 0); PG8_STAGE(PG8_SA(0, 1), a2 + hstep, voffA);
            PG8_WAIT_V(8); PG8_WAIT_L(0); PG8_BAR; PG8_MMA(0, 0, At, B0); PG8_MMA(0, 1, At, B1); PG8_BAR; PG8_SCHED;
            PG8_LDA(At, 1, 1); PG8_STAGE(PG8_SB(1, 0), b3, voffB); PG8_STAGE(PG8_SB(1, 1), b3 + hstep, voffB); PG8_STAGE(PG8_SA(1, 0), a3, voffA);
            PG8_WAIT_V(8); PG8_WAIT_L(0); PG8_BAR; PG8_MMA(1, 0, At, B0); PG8_MMA(1, 1, At, B1); PG8_BAR; PG8_SCHED;
            } else {
            PG8_LDB(B0, 0, 0); PG8_SCHED; PG8_LDA(At, 0, 0); PG8_STAGE(PG8_SA(1, 1), a1 + hstep, voffA);
            PG8_WAIT_L(8); PG8_BAR; PG8_WAIT_L(0); PG8_MMA(0, 0, At, B0); PG8_BAR; PG8_SCHED;
            PG8_LDB(B1, 0, 1); PG8_STAGE(PG8_SB(0, 0), b2, voffB);
            PG8_BAR; PG8_WAIT_L(0); PG8_MMA(0, 1, At, B1); PG8_BAR;
            PG8_LDA(At, 0, 1); PG8_STAGE(PG8_SA(0, 0), a2, voffA);
            PG8_BAR; PG8_WAIT_L(0); PG8_MMA(1, 0, At, B0); PG8_BAR; PG8_SCHED;
            PG8_STAGE(PG8_SB(0, 1), b2 + hstep, voffB);
            PG8_WAIT_V(6); PG8_BAR; PG8_MMA(1, 1, At, B1); PG8_BAR;
            PG8_LDB(B0, 1, 0); PG8_SCHED; PG8_LDA(At, 1, 0); PG8_STAGE(PG8_SA(0, 1), a2 + hstep, voffA);
            PG8_WAIT_L(8); PG8_BAR; PG8_WAIT_L(0); PG8_MMA(0, 0, At, B0); PG8_BAR; PG8_SCHED;
            PG8_LDB(B1, 1, 1); PG8_STAGE(PG8_SB(1, 0), b3, voffB);
            PG8_BAR; PG8_WAIT_L(0); PG8_MMA(0, 1, At, B1); PG8_BAR;
            PG8_LDA(At, 1, 1); PG8_STAGE(PG8_SA(1, 0), a3, voffA);
            PG8_BAR; PG8_WAIT_L(0); PG8_MMA(1, 0, At, B0); PG8_BAR; PG8_SCHED;
            PG8_STAGE(PG8_SB(1, 1), b3 + hstep, voffB);
            PG8_WAIT_V(6); PG8_BAR; PG8_MMA(1, 1, At, B1); PG8_BAR;
            }
        }
        if constexpr (ALIGN_EPI) { if (wr == 0) PG8_BAR; }
        if constexpr (!Epi::AFTER_DRAIN) { E(acc, cur, wr, wc, fr, fq); S.done(cur); }
        if (!has_next) break;
#pragma unroll
        for (int a = 0; a < 2; ++a)
#pragma unroll
            for (int b = 0; b < 2; ++b)
#pragma unroll
                for (int m = 0; m < 4; ++m)
#pragma unroll
                    for (int n = 0; n < 2; ++n) acc[a][b][m][n] = (f32x4){0.f, 0.f, 0.f, 0.f};
        cur = nxt; cA = nA; cB = nB; ++ui;
        if constexpr (ALIGN_EPI) { if (wr == 1) PG8_BAR; }
    }
    PG8_WAIT_V(0);
    if constexpr (!ALIGN_EPI) { if (wr == 0) PG8_BAR; }
    PG8_BAR;
    if constexpr (Epi::AFTER_DRAIN) { E.fused(acc, cur, wr, wc, fr, fq, lds, wid, lane); S.done(cur); }
#undef PG8_SA
#undef PG8_SB
#undef PG8_STAGE
#undef PG8_LDA
#undef PG8_LDB
#undef PG8_MMA
#undef PG8_WAIT_V
#undef PG8_WAIT_L
#undef PG8_BAR
#undef PG8_SCHED
}
}

#ifndef PG8_SP2
#define PG8_SP2 true
#endif
#ifndef PG8_ALIGN
#define PG8_ALIGN true
#endif

constexpr int NWAVES = 8;
#ifndef MK_N_LAUNCHES
#define MK_N_LAUNCHES 1
#endif
constexpr int N_PHASES = 11;
constexpr int TP = 16384, NSAMP = 128, NREAL = TP + NSAMP, MROWS = 16640, DM = 1024;
constexpr int SEQ = 2048, NBATCH = 8, SBATCH = 32, STOK = 4, NMEM = 256;
constexpr int A_IN = 3072, B_IN = 3712, B_INP = 3840, CSH = 2432, RW = 768;
constexpr float RMS_EPS = 1e-6f, GN_EPS = 64e-5f;
constexpr size_t O_YP = 0, O_YS = 16777216, O_MEM = 16908288, O_W0P = 19005440, O_W1P = 19529728, O_W2P = 21626880,
                 O_W0S = 30015488, O_W1S = 30081024, O_W2S = 30146560, O_WKVP = 30212096, O_WKVS = 30605312, O_SHP = 32178176, O_SHS = 32197632, O_END = 32275456;
constexpr size_t MiB = 1u << 20;
constexpr size_t WS_CTL = 0, CTL_ZERO_BYTES = 1 * MiB;
constexpr size_t WS_WAIN = 1 * MiB, WS_WAOUT = 7 * MiB, WS_WBIN = 8 * MiB, WS_WBOUT = 16 * MiB, WS_WM = 18 * MiB, WS_WL = 20 * MiB, WS_BT = 20 * MiB + 512 * 1024;
constexpr size_t WS_MEMN = 21 * MiB, WS_MKV = 25 * MiB, WS_TW = 29 * MiB, WS_XN = 34 * MiB, WS_H = 67 * MiB, WS_F = 100 * MiB, WS_P = 149 * MiB, WS_END = 271 * MiB;
constexpr int CW_TMO = 0, CW_BAR = 4096;

constexpr int RING_OFF = 0, RING_BYTES = 131072;
constexpr int LDSCTL_OFF = RING_BYTES, MISC_OFF = LDSCTL_OFF + 320;
constexpr int LDS_BYTES = 147456;

#define GAS __attribute__((address_space(1)))
#define LAS __attribute__((address_space(3)))
typedef unsigned short bf16;
typedef unsigned v4u __attribute__((ext_vector_type(4)));
typedef unsigned v2u __attribute__((ext_vector_type(2)));
typedef float f32x4 __attribute__((ext_vector_type(4)));
typedef GAS unsigned gu32;
#define RLX_AGENT __ATOMIC_RELAXED, __HIP_MEMORY_SCOPE_AGENT
#define LDS_WAIT() asm volatile("s_waitcnt lgkmcnt(0)" ::: "memory")
#define VM_WAIT() asm volatile("s_waitcnt vmcnt(0)" ::: "memory")
__device__ __forceinline__ unsigned f2bf(float f) { unsigned u = __builtin_bit_cast(unsigned, f); return (u + 0x7fffu + ((u >> 16) & 1u)) >> 16; }
__device__ __forceinline__ unsigned pk2(float lo, float hi) { return f2bf(lo) | (f2bf(hi) << 16); }
__device__ __forceinline__ float bflo(unsigned u) { return __builtin_bit_cast(float, u << 16); }
__device__ __forceinline__ float bfhi(unsigned u) { return __builtin_bit_cast(float, u & 0xffff0000u); }
__device__ __forceinline__ float bf2f(bf16 h) { return __builtin_bit_cast(float, (unsigned)h << 16); }

#define XB_TMO      128
#define XB_XCNT(j)  (256  + 64 * (j))
#define XB_XSUB(j)  (1280 + 64 * (j))
#define XB_XGEN(j)  (2304 + 64 * (j))
#define XB_TOP      3328
#define XB_TOPGEN   3392
#define XCD_BAR_WORDS 3456
#define XB_SPIN_CAP (1u << 20)
__device__ __forceinline__ unsigned xb_ld(unsigned* p)              { return __hip_atomic_load(p, __ATOMIC_RELAXED, __HIP_MEMORY_SCOPE_AGENT); }
__device__ __forceinline__ unsigned xb_add(unsigned* p, unsigned v) { return __hip_atomic_fetch_add(p, v, __ATOMIC_RELAXED, __HIP_MEMORY_SCOPE_AGENT); }
__device__ __forceinline__ unsigned xb_xcc_id() { return (unsigned)__builtin_amdgcn_s_getreg((3 << 11) | 20) & 0xFu; }
#define XB_SPIN(cond, bar) do { unsigned _sp = 0; while (cond) { __builtin_amdgcn_s_sleep(1); \
    if ((++_sp & 255u) == 0u) { if (xb_ld(&(bar)[XB_TMO])) break; if (_sp > XB_SPIN_CAP) { atomicAdd(&(bar)[XB_TMO], 1u); break; } } } } while (0)
struct XcdBarrier { unsigned* bar; unsigned x; volatile LAS unsigned* st; };
__device__ __forceinline__ XcdBarrier xcd_barrier_post(unsigned* bar, volatile LAS unsigned* st) {
    XcdBarrier b; b.bar = bar; b.x = xb_xcc_id(); b.st = st;
    if (threadIdx.x == 0) (void)xb_add(&bar[XB_XCNT(b.x)], 1u);
    return b;
}
__device__ __forceinline__ void xcd_barrier_complete(unsigned* bar, unsigned x, unsigned& nloc, unsigned& nx) {
    const unsigned G = gridDim.x * gridDim.y * gridDim.z;
    unsigned sum, cnt, mine, sp = 0u;
    for (;;) {
        sum = 0u; cnt = 0u; mine = 0u;
#pragma unroll
        for (unsigned j = 0; j < 16; ++j) { const unsigned c = xb_ld(&bar[XB_XCNT(j)]); sum += c; cnt += (c > 0u) ? 1u : 0u; mine = (j == x) ? c : mine; }
        if (sum == G) break;
        __builtin_amdgcn_s_sleep(1);
        if ((++sp & 255u) == 0u) { if (xb_ld(&bar[XB_TMO])) break; if (sp > XB_SPIN_CAP) { atomicAdd(&bar[XB_TMO], 1u); break; } }
    }
    nloc = mine > 0u ? mine : 1u; nx = cnt > 0u ? cnt : 1u;
}
__device__ __forceinline__ void xcd_barrier(const XcdBarrier& b) {
    asm volatile("s_waitcnt vmcnt(0)" ::: "memory");
    __syncthreads();
    if (threadIdx.x == 0) {
        unsigned* bar = b.bar;
        __builtin_amdgcn_s_waitcnt(0);
        unsigned nloc = b.st[0], nx = b.st[1];
        if (nloc == 0u) { xcd_barrier_complete(bar, b.x, nloc, nx); b.st[0] = nloc; b.st[1] = nx; }
        const unsigned old = xb_add(&bar[XB_XSUB(b.x)], 1u);
        const unsigned gen = old / nloc;
        if (old + 1u == (gen + 1u) * nloc) {
            __builtin_amdgcn_fence(__ATOMIC_RELEASE, "agent");
            asm volatile("s_waitcnt vmcnt(0)" ::: "memory");
            const unsigned og = xb_add(&bar[XB_TOP], 1u);
            const unsigned tg = og / nx;
            if (og + 1u == (tg + 1u) * nx) xb_add(&bar[XB_TOPGEN], 1u);
            else XB_SPIN(xb_ld(&bar[XB_TOPGEN]) == tg, bar);
            __builtin_amdgcn_fence(__ATOMIC_ACQUIRE, "agent");
            xb_add(&bar[XB_XGEN(b.x)], 1u);
            asm volatile("s_waitcnt vmcnt(0)" ::: "memory");
        } else {
            XB_SPIN(xb_ld(&bar[XB_XGEN(b.x)]) == gen, bar);
            __builtin_amdgcn_fence(__ATOMIC_ACQUIRE, "agent");
            asm volatile("s_waitcnt vmcnt(0)" ::: "memory");
        }
    }
    __syncthreads();
}

struct Ctx { LAS unsigned char* lds; int tid, lane, wave, vcu, G, gw, NGW; };

__device__ __forceinline__ float wave_sum(float v) {
#pragma unroll
    for (int o = 1; o < 64; o <<= 1) v += __shfl_xor(v, o);
    return v;
}
__device__ __forceinline__ float wave_max(float v) {
#pragma unroll
    for (int o = 1; o < 64; o <<= 1) v = fmaxf(v, __shfl_xor(v, o));
    return v;
}
__device__ __forceinline__ float rdlane(float v, int l) { return __builtin_bit_cast(float, __builtin_amdgcn_readlane(__builtin_bit_cast(int, v), l)); }

__device__ __forceinline__ void p0_transpose_item(const float* W, int N, const float* gain, bf16* WT, int ldo, int col_off, int row_off, LAS float* scr, int item, int nblk, int lane) {
    const int kb = item / nblk, nb = item % nblk, k0 = 64 * kb, n0 = 32 * nb;
#pragma unroll 8
    for (int i = 0; i < 32; ++i) { const int kk = 2 * i + (lane >> 5); const float g = gain ? gain[k0 + kk] : 1.f; scr[kk * 33 + (lane & 31)] = W[(size_t)(k0 + kk) * N + n0 + (lane & 31)] * g; }
    LDS_WAIT(); asm volatile("" ::: "memory");
    const int c = lane & 7;
#pragma unroll
    for (int j = 0; j < 4; ++j) { const int n = (lane >> 3) + 8 * j; const LAS float* s = scr + (8 * c) * 33 + n;
        v4u o; o.x = pk2(s[0 * 33], s[1 * 33]); o.y = pk2(s[2 * 33], s[3 * 33]); o.z = pk2(s[4 * 33], s[5 * 33]); o.w = pk2(s[6 * 33], s[7 * 33]);
        *(GAS v4u*)(WT + (size_t)(row_off + n0 + n) * ldo + col_off + k0 + 8 * c) = o; }
    LDS_WAIT(); asm volatile("" ::: "memory");
}
__device__ __forceinline__ void rms_row_to_bf16(const float* xrow, bf16* orow, int lane) {
    const GAS f32x4* xr = (const GAS f32x4*)xrow + lane;
    f32x4 v[4]; float s = 0.f;
#pragma unroll
    for (int j = 0; j < 4; ++j) { v[j] = xr[64 * j]; s += (v[j].x * v[j].x + v[j].y * v[j].y) + (v[j].z * v[j].z + v[j].w * v[j].w); }
    const float r = 1.f / sqrtf(wave_sum(s) * (1.f / DM) + RMS_EPS);
    GAS unsigned long long* o8 = (GAS unsigned long long*)orow + lane;
#pragma unroll
    for (int j = 0; j < 4; ++j) o8[64 * j] = (unsigned long long)pk2(v[j].x * r, v[j].y * r) | ((unsigned long long)pk2(v[j].z * r, v[j].w * r) << 32);
}
__device__ __forceinline__ int t5_bucket(int dist) {
    if (dist < 16) return dist;
    const double x = log((double)dist / 16.0) / log(128.0) * 16.0;
    int large = 16 + (int)x; return large < 31 ? large : 31;
}

__device__ __forceinline__ void ldq64(const bf16* p, float (&q)[64]) {
#pragma unroll
    for (int i = 0; i < 8; ++i) { const v4u u = *(const GAS v4u*)(p + 8 * i);
        q[8 * i + 0] = bflo(u.x); q[8 * i + 1] = bfhi(u.x); q[8 * i + 2] = bflo(u.y); q[8 * i + 3] = bfhi(u.y);
        q[8 * i + 4] = bflo(u.z); q[8 * i + 5] = bfhi(u.z); q[8 * i + 6] = bflo(u.w); q[8 * i + 7] = bfhi(u.w); }
}
__device__ __forceinline__ float dot64_bf(const float (&q)[64], const bf16* p) {
    float s0 = 0.f, s1 = 0.f;
#pragma unroll
    for (int i = 0; i < 8; ++i) { const v4u u = *(const GAS v4u*)(p + 8 * i);
        s0 += q[8 * i + 0] * bflo(u.x); s1 += q[8 * i + 1] * bfhi(u.x); s0 += q[8 * i + 2] * bflo(u.y); s1 += q[8 * i + 3] * bfhi(u.y);
        s0 += q[8 * i + 4] * bflo(u.z); s1 += q[8 * i + 5] * bfhi(u.z); s0 += q[8 * i + 6] * bflo(u.w); s1 += q[8 * i + 7] * bfhi(u.w); }
    return s0 + s1;
}
__device__ __forceinline__ float dot64_f32(const float (&q)[64], const float* p) {
    float s0 = 0.f, s1 = 0.f;
#pragma unroll
    for (int i = 0; i < 16; ++i) { const f32x4 u = *(const GAS f32x4*)(p + 4 * i);
        s0 += q[4 * i + 0] * u.x; s1 += q[4 * i + 1] * u.y; s0 += q[4 * i + 2] * u.z; s1 += q[4 * i + 3] * u.w; }
    return s0 + s1;
}
__device__ __forceinline__ float silu(float x) { return x / (1.f + __expf(-x)); }

__device__ __forceinline__ float cross_attn_task(const bf16* MKV, const float* c_mem, const bf16* qptr, int m, int hh, int layer, int lane) {
    float q[64]; ldq64(qptr, q);
    const bool samp = m >= TP;
    float l[4]; float mx = -3.0e38f, o = 0.f, s = 0.f;
    if (!samp) {
        const bf16* kb = MKV + (size_t)((m >> 11) * NMEM) * 1024 + layer * 512 + hh * 64;
#pragma unroll
        for (int r = 0; r < 4; ++r) { l[r] = dot64_bf(q, kb + (size_t)(r * 64 + lane) * 1024) * 0.125f; mx = fmaxf(mx, l[r]); }
        mx = wave_max(mx);
#pragma unroll
        for (int r = 0; r < 4; ++r) { l[r] = __expf(l[r] - mx); s += l[r]; }
        s = wave_sum(s);
#pragma unroll
        for (int r = 0; r < 4; ++r)
            for (int kk = 0; kk < 64; ++kk) o += rdlane(l[r], kk) * bf2f(kb[(size_t)(r * 64 + kk) * 1024 + 256 + lane]);
    } else {
        const float* kf = c_mem + ((size_t)(layer * SBATCH + ((m - TP) >> 2)) * NMEM) * 512 + hh * 64;
#pragma unroll
        for (int r = 0; r < 4; ++r) { l[r] = dot64_f32(q, kf + (size_t)(r * 64 + lane) * 512) * 0.125f; mx = fmaxf(mx, l[r]); }
        mx = wave_max(mx);
#pragma unroll
        for (int r = 0; r < 4; ++r) { l[r] = __expf(l[r] - mx); s += l[r]; }
        s = wave_sum(s);
#pragma unroll
        for (int r = 0; r < 4; ++r)
            for (int kk = 0; kk < 64; ++kk) o += rdlane(l[r], kk) * kf[(size_t)(r * 64 + kk) * 512 + 256 + lane];
    }
    return o / s;
}

template <int G>
__device__ __forceinline__ void attn_group(const bf16* P, const float* BT, const float* cw, int m, int hh, int lane, float& Mx, float& Ss, float& O) {
    constexpr int dil = G == 0 ? 1 : (G == 1 ? 4 : 16), Wg = G == 0 ? 128 : (G == 1 ? 512 : 2048), head0 = G * 4;
    const bool samp = m >= TP;
    const int b = m >> 11, t = m & 2047, sb = (m - TP) >> 2, st = (m - TP) & 3, head = head0 + hh;
    float q[64]; ldq64(P + (size_t)m * A_IN + head * 64, q);
    const float* bt = BT + (G * 4 + hh) * 132;
    float l[3]; float gm = -3.0e38f;
#pragma unroll
    for (int r = 0; r < 3; ++r) { const int kidx = r * 64 + lane; float lv = -3.0e38f;
        if (kidx < 129) {
            if (!samp) { const int tk = t - dil * kidx; if (tk >= 0) lv = dot64_bf(q, P + (size_t)((b << 11) + tk) * A_IN + RW + head * 64) * 0.125f + bt[kidx]; }
            else { const int idx = Wg + st - dil * kidx;
                if (idx >= Wg) lv = dot64_bf(q, P + (size_t)(TP + sb * 4 + idx - Wg) * A_IN + RW + head * 64) * 0.125f + bt[kidx];
                else lv = dot64_f32(q, cw + ((size_t)(sb * Wg + idx) * 2) * 256 + hh * 64) * 0.125f + bt[kidx]; }
        }
        l[r] = lv; gm = fmaxf(gm, lv); }
    gm = wave_max(gm);
    const float Mn = fmaxf(Mx, gm), sc = __expf(Mx - Mn);
    float ps = 0.f;
#pragma unroll
    for (int r = 0; r < 3; ++r) { l[r] = l[r] > -1.0e38f ? __expf(l[r] - Mn) : 0.f; ps += l[r]; }
    Ss = Ss * sc + wave_sum(ps); O *= sc; Mx = Mn;
#pragma unroll
    for (int r = 0; r < 3; ++r)
        for (int kk = 0; kk < 64; ++kk) { const int kidx = r * 64 + kk; if (kidx >= 129) break;
            const float p = rdlane(l[r], kk);
            if (p != 0.f) { float v;
                if (!samp) { const int tk = t - dil * kidx; v = bf2f(P[(size_t)((b << 11) + tk) * A_IN + 2 * RW + head * 64 + lane]); }
                else { const int idx = Wg + st - dil * kidx;
                    if (idx >= Wg) v = bf2f(P[(size_t)(TP + sb * 4 + idx - Wg) * A_IN + 2 * RW + head * 64 + lane]);
                    else v = cw[((size_t)(sb * Wg + idx) * 2 + 1) * 256 + hh * 64 + lane]; }
                O += p * v; } }
}

__device__ __forceinline__ void row_pass(const bf16* hp, const float* xin, float* xout, const float* gpost, bf16* xn, int lane) {
    const GAS v2u* h2 = (const GAS v2u*)hp + lane; const GAS f32x4* xr = (const GAS f32x4*)xin + lane; const GAS f32x4* gp = (const GAS f32x4*)gpost + lane;
    f32x4 h[4], x[4]; float s = 0.f;
#pragma unroll
    for (int j = 0; j < 4; ++j) { const v2u u = h2[64 * j]; h[j] = (f32x4){bflo(u.x), bfhi(u.x), bflo(u.y), bfhi(u.y)}; x[j] = xr[64 * j];
        s += (h[j].x * h[j].x + h[j].y * h[j].y) + (h[j].z * h[j].z + h[j].w * h[j].w); }
    const float r = 1.f / sqrtf(wave_sum(s) * (1.f / DM) + RMS_EPS);
    float s2 = 0.f;
#pragma unroll
    for (int j = 0; j < 4; ++j) { const f32x4 g = gp[64 * j]; x[j] = x[j] + h[j] * r * g; s2 += (x[j].x * x[j].x + x[j].y * x[j].y) + (x[j].z * x[j].z + x[j].w * x[j].w);
        *((GAS f32x4*)xout + lane + 64 * j) = x[j]; }
    if (xn) { const float r2 = 1.f / sqrtf(wave_sum(s2) * (1.f / DM) + RMS_EPS);
        GAS unsigned long long* o8 = (GAS unsigned long long*)xn + lane;
#pragma unroll
        for (int j = 0; j < 4; ++j) o8[64 * j] = (unsigned long long)pk2(x[j].x * r2, x[j].y * r2) | ((unsigned long long)pk2(x[j].z * r2, x[j].w * r2) << 32); }
}

struct ScanP { const bf16 *P, *LORA; bf16* H; float* out; const float *st_wkv, *st_shift, *mu, *w0, *a0, *k_k, *k_a, *r_k, *ln_w, *ln_b; };
__device__ __forceinline__ void scan_unit(const Ctx& C, const ScanP& sp, int u) {
    LAS float* L = (LAS float*)(C.lds + RING_OFF);
    LAS float *LA = L, *LB = L + 4096, *LW = L + 8192, *LK = L + 12288, *LRW = L + 16384, *LV = L + 20480, *LSC = L + 24576, *LY = L + 24576 + 256;
    const bool samp = u >= 96; const int seq = samp ? (u - 96) / 12 : u / 12, h = samp ? (u - 96) % 12 : u % 12;
    const int T = samp ? STOK : SEQ, row0 = samp ? TP + seq * 4 : seq * SEQ;
    int row = C.wave * 8 + (C.lane >> 3), p = C.lane & 7;
    asm volatile("" : "+v"(row), "+v"(p));
    float S[8];
#pragma unroll
    for (int j = 0; j < 8; ++j) S[j] = samp ? sp.st_wkv[((size_t)(seq * 12 + h) * 64 + row) * 64 + p * 8 + j] : 0.f;
#pragma unroll 1
    for (int c0 = 0; c0 < T; c0 += 64) {
        const int n = (T - c0) < 64 ? (T - c0) : 64;
        int tok = C.tid >> 3, part = C.tid & 7;
        asm volatile("" : "+v"(tok), "+v"(part));
        __syncthreads();
        if (tok < n) {
            const int t = c0 + tok, m = row0 + t;
            const bf16* cur = sp.P + (size_t)m * B_INP; const bf16* prv = cur - B_INP; const bf16* lo = sp.LORA + (size_t)m * 1536;
            float xr[8], xk[8], xv[8], kk[8], av[8], dv[8];
            float nrm = 0.f;
#pragma unroll
            for (int j = 0; j < 8; ++j) { const int c = h * 64 + part * 8 + j;
                const float cr = bf2f(cur[c]), ck = bf2f(cur[RW + c]), cv = bf2f(cur[2 * RW + c]);
                float pr = 0.f, pk = 0.f, pv = 0.f;
                if (t > 0) { pr = bf2f(prv[c]); pk = bf2f(prv[RW + c]); pv = bf2f(prv[2 * RW + c]); }
                else if (samp) { const float* ss = sp.st_shift + (size_t)seq * CSH; pr = ss[c]; pk = ss[RW + c]; pv = ss[2 * RW + c]; }
                xr[j] = cr + sp.mu[c] * (pr - cr); xk[j] = ck + sp.mu[RW + c] * (pk - ck); xv[j] = cv + sp.mu[2 * RW + c] * (pv - cv);
                const float dpre = sp.w0[c] + bf2f(lo[c]), apre = sp.a0[c] + bf2f(lo[RW + c]);
                const float z = -dpre, spl = fmaxf(z, 0.f) + log1pf(expf(-fabsf(z)));
                const float wlog = -spl - 0.5f; dv[j] = expf(-expf(wlog));
                av[j] = 1.f / (1.f + expf(-apre));
                kk[j] = xk[j] * sp.k_k[c]; nrm += kk[j] * kk[j]; }
            nrm += __shfl_xor(nrm, 1); nrm += __shfl_xor(nrm, 2); nrm += __shfl_xor(nrm, 4);
            const float inv = 1.f / fmaxf(sqrtf(nrm), 1e-12f);
            float br = 0.f, kr = 0.f, bon = 0.f;
#pragma unroll
            for (int j = 0; j < 8; ++j) { const int c = h * 64 + part * 8 + j, d = part * 8 + j;
                const float kn = kk[j] * inv, k2 = xk[j] * (1.f + (av[j] - 1.f) * sp.k_a[c]);
                const float bb = kn * av[j];
                LA[tok * 64 + d] = -kn; LB[tok * 64 + d] = bb; LW[tok * 64 + d] = dv[j]; LK[tok * 64 + d] = k2; LRW[tok * 64 + d] = xr[j] * dv[j]; LV[tok * 64 + d] = xv[j];
                br += bb * xr[j]; kr += k2 * xr[j]; bon += xr[j] * k2 * sp.r_k[c]; }
            br += __shfl_xor(br, 1); br += __shfl_xor(br, 2); br += __shfl_xor(br, 4);
            kr += __shfl_xor(kr, 1); kr += __shfl_xor(kr, 2); kr += __shfl_xor(kr, 4);
            bon += __shfl_xor(bon, 1); bon += __shfl_xor(bon, 2); bon += __shfl_xor(bon, 4);
            if (part == 0) { LSC[tok * 4 + 0] = br; LSC[tok * 4 + 1] = kr; LSC[tok * 4 + 2] = bon; }
        }
        __syncthreads();
#pragma unroll 1
        for (int i = 0; i < n; ++i) {
            const LAS f32x4* a4 = (const LAS f32x4*)(LA + i * 64 + p * 8); const LAS f32x4* r4 = (const LAS f32x4*)(LRW + i * 64 + p * 8);
            const LAS f32x4* w4 = (const LAS f32x4*)(LW + i * 64 + p * 8); const LAS f32x4* b4 = (const LAS f32x4*)(LB + i * 64 + p * 8); const LAS f32x4* k4 = (const LAS f32x4*)(LK + i * 64 + p * 8);
            const f32x4 a0 = a4[0], a1 = a4[1], r0 = r4[0], r1 = r4[1];
            float sa = (S[0] * a0.x + S[1] * a0.y) + (S[2] * a0.z + S[3] * a0.w) + (S[4] * a1.x + S[5] * a1.y) + (S[6] * a1.z + S[7] * a1.w);
            float yp = (S[0] * r0.x + S[1] * r0.y) + (S[2] * r0.z + S[3] * r0.w) + (S[4] * r1.x + S[5] * r1.y) + (S[6] * r1.z + S[7] * r1.w);
            sa += __shfl_xor(sa, 1); sa += __shfl_xor(sa, 2); sa += __shfl_xor(sa, 4);
            yp += __shfl_xor(yp, 1); yp += __shfl_xor(yp, 2); yp += __shfl_xor(yp, 4);
            const float v = LV[i * 64 + row], br = LSC[i * 4 + 0], kr = LSC[i * 4 + 1];
            const f32x4 w0 = w4[0], w1 = w4[1], b0 = b4[0], b1 = b4[1], k0 = k4[0], k1 = k4[1];
            S[0] = S[0] * w0.x + sa * b0.x + v * k0.x; S[1] = S[1] * w0.y + sa * b0.y + v * k0.y; S[2] = S[2] * w0.z + sa * b0.z + v * k0.z; S[3] = S[3] * w0.w + sa * b0.w + v * k0.w;
            S[4] = S[4] * w1.x + sa * b1.x + v * k1.x; S[5] = S[5] * w1.y + sa * b1.y + v * k1.y; S[6] = S[6] * w1.z + sa * b1.z + v * k1.z; S[7] = S[7] * w1.w + sa * b1.w + v * k1.w;
            if (p == 0) LY[i * 64 + row] = yp + sa * br + v * kr;
        }
        __syncthreads();
        asm volatile("" : "+v"(tok), "+v"(part));
        if (tok < n) {
            const int m = row0 + c0 + tok;
            float y[8]; float s = 0.f;
#pragma unroll
            for (int j = 0; j < 8; ++j) { y[j] = LY[tok * 64 + part * 8 + j]; s += y[j]; }
            s += __shfl_xor(s, 1); s += __shfl_xor(s, 2); s += __shfl_xor(s, 4);
            const float mean = s * (1.f / 64.f); float q = 0.f;
#pragma unroll
            for (int j = 0; j < 8; ++j) { y[j] -= mean; q += y[j] * y[j]; }
            q += __shfl_xor(q, 1); q += __shfl_xor(q, 2); q += __shfl_xor(q, 4);
            const float rstd = 1.f / sqrtf(q * (1.f / 64.f) + GN_EPS), bon = LSC[tok * 4 + 2];
            unsigned w[4];
#pragma unroll
            for (int j = 0; j < 8; j += 2) { float o2[2];
#pragma unroll
                for (int e = 0; e < 2; ++e) { const int c = h * 64 + part * 8 + j + e;
                    const float yy = y[j + e] * rstd * sp.ln_w[c] + sp.ln_b[c] + bon * LV[tok * 64 + part * 8 + j + e];
                    o2[e] = yy * silu(bf2f(sp.P[(size_t)m * B_INP + 2688 + c])); }
                w[j >> 1] = pk2(o2[0], o2[1]); }
            *(GAS v4u*)(sp.H + (size_t)m * 1024 + h * 64 + part * 8) = (v4u){w[0], w[1], w[2], w[3]};
        }
    }
    float* so = sp.out + (samp ? O_WKVS : O_WKVP) + ((size_t)(seq * 12 + h) * 64 + row) * 64 + p * 8;
    *(GAS f32x4*)so = (f32x4){S[0], S[1], S[2], S[3]}; *((GAS f32x4*)so + 1) = (f32x4){S[4], S[5], S[6], S[7]};
    __syncthreads();
}

constexpr int PTAB_OFF = LDSCTL_OFF + 512;
__device__ __forceinline__ const float* inptr(LAS unsigned char* ldsb, int i) {
    const LAS unsigned* p = (const LAS unsigned*)(ldsb + PTAB_OFF) + 2 * i;
    const unsigned lo = __builtin_amdgcn_readfirstlane(p[0]), hi = __builtin_amdgcn_readfirstlane(p[1]);
    return (const float*)(((unsigned long long)hi << 32) | lo);
}
struct Args { const float* in[28]; float* out; unsigned char* ws; int ph_lo, ph_hi; };
#define WSP(T, off) ((T*)(args.ws + (off)))
#define GEMM_BF16(Aptr, Bptr, Optr, Mv, Nv, Kv) do { pg8::Gemm g{Aptr, Bptr, Mv, Nv, Kv}; pg8::StaticOrder S; S.init(Mv, Nv, C.G, (int)blockIdx.x); \
        pg8::EpiBf16<0> E{Optr, Nv, nullptr, 0, 0, 1.f}; pg8::gemm_phase<pg8::EpiBf16<0>, pg8::StaticOrder, PG8_ALIGN, PG8_SP2>(C.lds + RING_OFF, g, S, E); } while (0)
__global__ void __launch_bounds__(NWAVES * 64, 2) hyb_fwd(Args args) {
    extern __shared__ __attribute__((aligned(16))) unsigned char lds[];
    LAS unsigned char* const ldsb = (LAS unsigned char*)lds;
    for (int u = threadIdx.x; u < (LDS_BYTES - LDSCTL_OFF) / 4; u += NWAVES * 64) ((LAS unsigned*)(ldsb + LDSCTL_OFF))[u] = 0u;
    __syncthreads();
    if (threadIdx.x < 28) ((LAS unsigned long long*)(ldsb + PTAB_OFF))[threadIdx.x] = (unsigned long long)args.in[threadIdx.x];
    __syncthreads();
#define INP(i) inptr(ldsb, (i))
#define MKCTX() Ctx C; { int t_ = threadIdx.x; asm volatile("" : "+v"(t_)); C.lds = ldsb; C.tid = t_; C.lane = t_ & 63; C.wave = __builtin_amdgcn_readfirstlane(t_ >> 6); \
        C.G = gridDim.x; const int bx_ = blockIdx.x; C.vcu = (C.G % 8 == 0) ? (bx_ % 8) * (C.G / 8) + bx_ / 8 : bx_; C.gw = C.vcu * NWAVES + C.wave; C.NGW = C.G * NWAVES; } \
        const int gt = C.gw * 64 + C.lane, NGT = C.NGW * 64; (void)gt; (void)NGT
    const int lo = args.ph_lo, hi = args.ph_hi;
    const bool fused = (hi - lo) > 1;
    XcdBarrier bar; bar.bar = WSP(unsigned, WS_CTL) + CW_BAR; bar.x = 0; bar.st = nullptr;
    if (fused) bar = xcd_barrier_post(WSP(unsigned, WS_CTL) + CW_BAR, (volatile LAS unsigned*)(ldsb + MISC_OFF) + 8);
#define IN(k) (lo <= (k) && (k) < hi)
#define SEAM(k) do { if (IN(k) && IN((k) + 1)) xcd_barrier(bar); } while (0)

    if (IN(0)) { MKCTX();
        LAS float* scr = (LAS float*)(C.lds + RING_OFF + C.wave * 16384);
        constexpr int I0 = 16 * 96, I1 = 8 * 32, I2 = 16 * 116, I3 = 16 * 32, I4 = 16 * 16, I5 = 16 * 16, I6 = 24, I7 = 24;
        constexpr int NITEMS = I0 + I1 + I2 + I3 + I4 + I5 + I6 + I7;
        for (int it = C.gw; it < NITEMS; it += C.NGW) {
            int r = it;
            if (r < I0) { p0_transpose_item(INP(14), A_IN, INP(9), WSP(bf16, WS_WAIN), 1024, 0, 0, scr, r, 96, C.lane); continue; } r -= I0;
            if (r < I1) { p0_transpose_item(INP(15), 1024, nullptr, WSP(bf16, WS_WAOUT), 512, 0, 0, scr, r, 32, C.lane); continue; } r -= I1;
            if (r < I2) { p0_transpose_item(INP(16), B_IN, INP(9) + DM, WSP(bf16, WS_WBIN), 1024, 0, 0, scr, r, 116, C.lane); continue; } r -= I2;
            if (r < I3) { p0_transpose_item(INP(17), 1024, nullptr, WSP(bf16, WS_WBOUT), 1024, 0, 0, scr, r, 32, C.lane); continue; } r -= I3;
            if (r < I4) { p0_transpose_item(INP(12), 512, INP(11), WSP(bf16, WS_WM), 1024, 0, 0, scr, r, 16, C.lane); continue; } r -= I4;
            if (r < I5) { p0_transpose_item(INP(12) + 1024 * 512, 512, INP(11) + DM, WSP(bf16, WS_WM), 1024, 0, 512, scr, r, 16, C.lane); continue; } r -= I5;
            if (r < I6) { p0_transpose_item(INP(20), RW, nullptr, WSP(bf16, WS_WL), 128, 0, 0, scr, r, 24, C.lane); continue; } r -= I6;
            p0_transpose_item(INP(22), RW, nullptr, WSP(bf16, WS_WL), 128, 64, RW, scr, r, 24, C.lane);
        }
        const v4u z4 = {0u, 0u, 0u, 0u};
        for (int i = gt; i < 16384; i += NGT) *((GAS v4u*)(WSP(bf16, WS_WBIN) + (size_t)B_IN * 1024) + i) = z4;
        for (int i = gt; i < 1536 * 8; i += NGT) { const int n = i >> 3, c = i & 7; *(GAS v4u*)(WSP(bf16, WS_WL) + (size_t)n * 128 + (n < RW ? 64 : 0) + c * 8) = z4; }
        for (int i = gt; i < 128 * 128; i += NGT) *((GAS v4u*)(WSP(bf16, WS_XN) + (size_t)NREAL * 1024) + i) = z4;
        for (int i = gt; i < 3 * 4 * 129; i += NGT) { const int g = i / (4 * 129), r = i % (4 * 129), hh = r / 129, k = r % 129; const int dil = g == 0 ? 1 : (g == 1 ? 4 : 16);
            WSP(float, WS_BT)[(g * 4 + hh) * 132 + k] = INP(13)[t5_bucket(dil * k) * 12 + g * 4 + hh]; }
        for (int m = C.gw; m < NREAL + 2048; m += C.NGW) {
            if (m < TP) rms_row_to_bf16(INP(0) + (size_t)m * DM, WSP(bf16, WS_XN) + (size_t)m * DM, C.lane);
            else if (m < NREAL) rms_row_to_bf16(INP(1) + (size_t)(m - TP) * DM, WSP(bf16, WS_XN) + (size_t)m * DM, C.lane);
            else rms_row_to_bf16(INP(2) + (size_t)(m - NREAL) * DM, WSP(bf16, WS_MEMN) + (size_t)(m - NREAL) * DM, C.lane);
        }
    } SEAM(0);
    if (IN(1)) { MKCTX();
        GEMM_BF16(WSP(bf16, WS_XN), WSP(bf16, WS_WAIN), WSP(bf16, WS_P), MROWS, A_IN, DM);
        GEMM_BF16(WSP(bf16, WS_MEMN), WSP(bf16, WS_WM), WSP(bf16, WS_MKV), 2048, 1024, DM);
    } SEAM(1);
    if (IN(2)) { MKCTX();
        const bf16* P = WSP(bf16, WS_P); const bf16* MKV = WSP(bf16, WS_MKV); float* out = args.out;
        for (int i = gt; i < 2 * 2048 * 512; i += NGT) { const int l = i / (2048 * 512), r = (i / 512) % 2048, c = i % 512; out[O_MEM + i] = bf2f(MKV[(size_t)r * 1024 + l * 512 + c]); }
#pragma unroll
        for (int g = 0; g < 3; ++g) { const int Wg = g == 0 ? 128 : (g == 1 ? 512 : 2048); const size_t ob = g == 0 ? O_W0P : (g == 1 ? O_W1P : O_W2P);
            const int n = NBATCH * Wg * 512;
            for (int i = gt; i < n; i += NGT) { const int c = i % 512, ri = (i / 512) % Wg, b = i / (512 * Wg); const int t = SEQ - Wg + ri, kv = c >> 8, cc = c & 255;
                out[ob + i] = bf2f(P[(size_t)((b << 11) + t) * A_IN + RW + kv * RW + g * 256 + cc]); }
            const size_t os = g == 0 ? O_W0S : (g == 1 ? O_W1S : O_W2S);
            for (int i = gt; i < NSAMP * 512; i += NGT) { const int c = i % 512, r = i / 512, kv = c >> 8, cc = c & 255;
                out[os + i] = bf2f(P[(size_t)(TP + r) * A_IN + RW + kv * RW + g * 256 + cc]); } }
        bf16* H = WSP(bf16, WS_H); const float* BT = WSP(float, WS_BT);
        for (int task = C.gw; task < NREAL * 4; task += C.NGW) { const int m = task >> 2, hh = task & 3;
            float Mx = -3.0e38f, Ss = 0.f, O = 0.f;
            attn_group<0>(P, BT, INP(4), m, hh, C.lane, Mx, Ss, O);
            attn_group<1>(P, BT, INP(5), m, hh, C.lane, Mx, Ss, O);
            attn_group<2>(P, BT, INP(6), m, hh, C.lane, Mx, Ss, O);
            const bf16* prow = P + (size_t)m * A_IN;
            const float om = cross_attn_task(MKV, INP(3), prow + 2304 + hh * 64, m, hh, 0, C.lane);
            const float g0 = bf2f(prow[2560 + hh * 64 + C.lane]), g1 = bf2f(prow[2560 + 256 + hh * 64 + C.lane]);
            H[(size_t)m * 512 + hh * 64 + C.lane] = (bf16)f2bf((O / Ss) * silu(g0));
            H[(size_t)m * 512 + 256 + hh * 64 + C.lane] = (bf16)f2bf(om * silu(g1)); }
    } SEAM(2);
    if (IN(3)) { MKCTX(); GEMM_BF16(WSP(bf16, WS_H), WSP(bf16, WS_WAOUT), WSP(bf16, WS_F), MROWS, DM, 512); } SEAM(3);
    if (IN(4)) { MKCTX();
        for (int m = C.gw; m < NREAL; m += C.NGW) { const bool samp = m >= TP;
            row_pass(WSP(bf16, WS_F) + (size_t)m * DM, samp ? INP(1) + (size_t)(m - TP) * DM : INP(0) + (size_t)m * DM,
                     args.out + (samp ? O_YS + (size_t)(m - TP) * DM : O_YP + (size_t)m * DM), INP(10), WSP(bf16, WS_XN) + (size_t)m * DM, C.lane); }
    } SEAM(4);
    if (IN(5)) { MKCTX(); GEMM_BF16(WSP(bf16, WS_XN), WSP(bf16, WS_WBIN), WSP(bf16, WS_P), MROWS, B_INP, DM); } SEAM(5);
    if (IN(6)) { MKCTX();
        const bf16* P = WSP(bf16, WS_P); bf16* TW = WSP(bf16, WS_TW); const float* mu = INP(18); const float* stsh = INP(8);
        for (int m = C.gw; m < NREAL; m += C.NGW) {
            const bool samp = m >= TP; const int t = samp ? ((m - TP) & 3) : (m & 2047), sb = (m - TP) >> 2;
#pragma unroll
            for (int j = 0; j < 2; ++j) { const int c = 2304 + j * 64 + C.lane;
                const float cur = bf2f(P[(size_t)m * B_INP + c]);
                float prev = 0.f; if (t > 0) prev = bf2f(P[(size_t)(m - 1) * B_INP + c]); else if (samp) prev = stsh[(size_t)sb * CSH + c];
                const float xs = cur + mu[c] * (prev - cur);
                TW[(size_t)m * 128 + j * 64 + C.lane] = (bf16)f2bf(j == 0 ? tanhf(xs) : xs); }
        }
    } SEAM(6);
    if (IN(7)) { MKCTX(); GEMM_BF16(WSP(bf16, WS_TW), WSP(bf16, WS_WL), WSP(bf16, WS_F), MROWS, 1536, 128); } SEAM(7);
    if (IN(8)) { MKCTX();
        { ScanP sp{WSP(bf16, WS_P), WSP(bf16, WS_F), WSP(bf16, WS_H), args.out, INP(7), INP(8), INP(18), INP(19), INP(21), INP(23), INP(24), INP(25), INP(26), INP(27)};
          for (int u = blockIdx.x; u < 480; u += C.G) scan_unit(C, sp, u); }
        const bf16* P = WSP(bf16, WS_P); bf16* H = WSP(bf16, WS_H);
        for (int task = C.gw; task < NREAL * 4; task += C.NGW) { const int m = task >> 2, hh = task & 3;
            const bf16* prow = P + (size_t)m * B_INP;
            const float om = cross_attn_task(WSP(bf16, WS_MKV), INP(3), prow + CSH + hh * 64, m, hh, 1, C.lane);
            H[(size_t)m * 1024 + RW + hh * 64 + C.lane] = (bf16)f2bf(om * silu(bf2f(prow[2688 + RW + hh * 64 + C.lane]))); }
        for (int i = gt; i < NBATCH * CSH; i += NGT) { const int b = i / CSH, c = i % CSH; args.out[O_SHP + i] = bf2f(P[(size_t)(b * SEQ + SEQ - 1) * B_INP + c]); }
        for (int i = gt; i < SBATCH * CSH; i += NGT) { const int sb = i / CSH, c = i % CSH; args.out[O_SHS + i] = bf2f(P[(size_t)(TP + sb * 4 + 3) * B_INP + c]); }
    } SEAM(8);
    if (IN(9)) { MKCTX(); GEMM_BF16(WSP(bf16, WS_H), WSP(bf16, WS_WBOUT), WSP(bf16, WS_F), MROWS, DM, DM); } SEAM(9);
    if (IN(10)) { MKCTX();
        for (int m = C.gw; m < NREAL; m += C.NGW) { const bool samp = m >= TP;
            float* xo = args.out + (samp ? O_YS + (size_t)(m - TP) * DM : O_YP + (size_t)m * DM);
            row_pass(WSP(bf16, WS_F) + (size_t)m * DM, xo, xo, INP(10) + DM, nullptr, C.lane); }
    }
#undef IN
#undef SEAM
}

extern "C" void kernel_launch(void* const* d_in, const int* in_sizes, int n_in, void* d_out, int out_size, void* d_ws, size_t ws_size, hipStream_t stream) {
    static int grid = 0;
    if (grid == 0) {
        if (n_in != 28 || in_sizes[0] != TP * DM || (size_t)out_size != O_END || ws_size < WS_END) {
            fprintf(stderr, "kernel_launch: unexpected shapes: n_in %d in0 %d out %d ws %zu (need >= %zu); nothing launched\n", n_in, n_in > 0 ? in_sizes[0] : -1, out_size, ws_size, (size_t)WS_END); grid = -1; return; }
        int dev = 0, cus = 0, per_cu = 0;
        if (hipGetDevice(&dev) != hipSuccess || hipDeviceGetAttribute(&cus, hipDeviceAttributeMultiprocessorCount, dev) != hipSuccess) { fprintf(stderr, "kernel_launch: device query failed\n"); grid = -1; return; }
        if (hipFuncSetAttribute((const void*)hyb_fwd, hipFuncAttributeMaxDynamicSharedMemorySize, LDS_BYTES) != hipSuccess) { fprintf(stderr, "kernel_launch: hipFuncSetAttribute failed\n"); grid = -1; return; }
        if (hipOccupancyMaxActiveBlocksPerMultiprocessor(&per_cu, (const void*)hyb_fwd, NWAVES * 64, LDS_BYTES) != hipSuccess || per_cu < 1) {
            fprintf(stderr, "kernel_launch: occupancy query reports %d workgroups per CU\n", per_cu); }
        (void)hipGetLastError();
        grid = cus;
    }
    if (grid < 0) return;
    if (hipMemsetAsync((char*)d_ws + WS_CTL, 0, CTL_ZERO_BYTES, stream) != hipSuccess) { fprintf(stderr, "kernel_launch: memset failed\n"); return; }
    Args a{};
    for (int i = 0; i < 28; ++i) a.in[i] = (const float*)d_in[i];
    a.out = (float*)d_out; a.ws = (unsigned char*)d_ws;
#if MK_N_LAUNCHES == 1
    a.ph_lo = 0; a.ph_hi = N_PHASES;
    hipLaunchKernelGGL(hyb_fwd, dim3(grid), dim3(NWAVES * 64), LDS_BYTES, stream, a);
#else
    for (int li = 0; li < N_PHASES; ++li) { a.ph_lo = li; a.ph_hi = li + 1;
        hipLaunchKernelGGL(hyb_fwd, dim3(grid), dim3(NWAVES * 64), LDS_BYTES, stream, a); }
#endif
    const hipError_t le = hipPeekAtLastError();
    if (le != hipSuccess) fprintf(stderr, "kernel_launch: launch failed: %s\n", hipGetErrorName(le));
}
```

```cpp
#include <hip/hip_runtime.h>
#include <cstdio>
#include <cstdint>
namespace pg8 {
#define PG8_LAS __attribute__((address_space(3)))
typedef unsigned short bf16_t;
typedef short bf16x8 __attribute__((ext_vector_type(8)));
typedef float f32x4 __attribute__((ext_vector_type(4)));
typedef unsigned u32x4 __attribute__((ext_vector_type(4)));
constexpr int BM = 256, BK = 64, HALF = 128, HTB = HALF * BK * 2  , STAGE_BYTES = 8 * HTB, NXCD = 8, WGM = 8;

__host__ __device__ __forceinline__ int lds_byte(int r, int c) { const int st = (r >> 4) * 2 + (c >> 5), rr = r & 15, cc = c & 31, ob = rr * 64 + cc * 2; return st * 1024 + (ob ^ (((ob >> 9) & 1) << 5)); }
__host__ __device__ __forceinline__ void stage_rc(int b, int& R, int& C) { const int st = b / 1024, sb = b % 1024, swz = sb ^ (((sb >> 9) & 1) << 5); R = (st >> 1) * 16 + swz / 64; C = (st & 1) * 32 + (swz % 64) / 2; }
__host__ __device__ __forceinline__ int perm32(int rho) { const int n = rho >> 4, i = rho & 15; return 8 * (i >> 2) + 4 * n + (i & 3); }

struct Unit { int pm, pn; };
struct Gemm { const bf16_t* A; const bf16_t* Bt; int M, N, K; };

struct StaticOrder {
    int nM, nN, nwg, G, c;
    __host__ __device__ void init(int M, int N, int G_, int c_) { nM = M / BM; nN = N / BM; nwg = nM * nN; G = G_; c = c_; }
    __host__ __device__ bool next(int i, Unit& u) const {
        const long L = (long)i * G + c; if (L >= nwg) return false;
        int wgid = (int)L; { const int q = nwg / NXCD, r = nwg % NXCD, xcd = wgid % NXCD, off = wgid / NXCD; wgid = (xcd < r ? xcd * (q + 1) : r * (q + 1) + (xcd - r) * q) + off; }
        const int nig = WGM * nN, gid = wgid / nig, fm = gid * WGM, gsz = (nM - fm) < WGM ? (nM - fm) : WGM;
        u.pm = fm + ((wgid % nig) % gsz); u.pn = (wgid % nig) / gsz; return true;
    }
    __device__ __forceinline__ void a_ready(const Unit&) const {}
    __device__ __forceinline__ void done(const Unit&) const {}
};

__device__ __forceinline__ unsigned cvt_pk_bf16(float lo, float hi) { unsigned r; asm volatile("v_cvt_pk_bf16_f32 %0, %1, %2" : "=v"(r) : "v"(lo), "v"(hi)); return r; }
typedef float f32x2 __attribute__((ext_vector_type(2)));
__device__ __forceinline__ f32x2 gelu_pk(f32x2 v) {
    const f32x2 av = __builtin_elementwise_abs(v), d = av * 0.2316418882f + 1.0f;
    f32x2 t; t.x = __builtin_amdgcn_rcpf(d.x); t.y = __builtin_amdgcn_rcpf(d.y);
    f32x2 q = t * 0.5307027145f + (-0.7265760135f); q = q * t + 0.7107068705f; q = q * t + (-0.142248368f); q = q * t + 0.127414796f; q = q * t;
    const f32x2 s = (v * v) * (-0.72134752044f);
    f32x2 e; e.x = __builtin_amdgcn_exp2f(s.x); e.y = __builtin_amdgcn_exp2f(s.y);
    const f32x2 m = v * (q * e), r = v - m;
    f32x2 o; o.x = v.x < 0.f ? m.x : r.x; o.y = v.y < 0.f ? m.y : r.y; return o;
}

template <int ACT  > struct EpiBf16 {
    static constexpr bool PERM = true, AFTER_DRAIN = false; static_assert(ACT == 0 || ACT == 1, "EpiBf16: ACT is 0 (none) or 1 (gelu_pk)");
    bf16_t* O; int ldc; const float* bias; int split_cols; size_t split_stride; float scale0;
    __device__ __forceinline__ void operator()(const f32x4 (&acc)[2][2][4][2], const Unit& u, int wr, int wc, int fr, int fq) const {
        const int row0 = u.pm * BM + wr * 64 + fr; int colt = u.pn * BM; bf16_t* base = O;
        float sc = 1.f; if (split_cols) { const int t = colt / split_cols; base += (size_t)t * split_stride; colt -= t * split_cols; if (t == 0) sc = scale0; }
        const int col0 = colt + wc * 32 + 8 * fq, bcol0 = u.pn * BM + wc * 32 + 8 * fq;
        f32x4 bv[2][2];
#pragma unroll
        for (int bj = 0; bj < 2; ++bj)
#pragma unroll
            for (int n = 0; n < 2; ++n) bv[bj][n] = bias ? *(const f32x4*)(bias + bcol0 + bj * HALF + 4 * n) : (f32x4){0.f, 0.f, 0.f, 0.f};
#pragma unroll
        for (int ai = 0; ai < 2; ++ai)
#pragma unroll
            for (int m = 0; m < 4; ++m) { bf16_t* rowp = base + (size_t)(row0 + ai * HALF + m * 16) * ldc + col0;
#pragma unroll
                for (int bj = 0; bj < 2; ++bj) { f32x4 v0 = acc[ai][bj][m][0] + bv[bj][0], v1 = acc[ai][bj][m][1] + bv[bj][1];
                    if (ACT == 1) { f32x2 a = gelu_pk((f32x2){v0[0], v0[1]}), b = gelu_pk((f32x2){v0[2], v0[3]}), c = gelu_pk((f32x2){v1[0], v1[1]}), d = gelu_pk((f32x2){v1[2], v1[3]});
                        v0 = (f32x4){a.x, a.y, b.x, b.y}; v1 = (f32x4){c.x, c.y, d.x, d.y}; }
                    v0 = v0 * sc; v1 = v1 * sc; u32x4 w; w.x = cvt_pk_bf16(v0[0], v0[1]); w.y = cvt_pk_bf16(v0[2], v0[3]); w.z = cvt_pk_bf16(v1[0], v1[1]); w.w = cvt_pk_bf16(v1[2], v1[3]);
                    *(u32x4*)(rowp + bj * HALF) = w; } }
    }
};
template <class Epi, class Sched, bool ALIGN_EPI = false, bool SP2 = false>
__device__ __forceinline__ void gemm_phase(PG8_LAS unsigned char* lds, const Gemm g, const Sched& S, const Epi& E) {
    const int tid = threadIdx.x, wid = __builtin_amdgcn_readfirstlane(tid >> 6), lane = tid & 63, wr = wid >> 2, wc = wid & 3, fr = lane & 15, fq = lane >> 4;
    const int K = g.K, nt = K / BK;
    unsigned voffA[2], voffB[2];
#pragma unroll
    for (int i = 0; i < 2; ++i) { int R, C; stage_rc(tid * 16 + i * 8192, R, C); const int Rb = Epi::PERM ? ((R & ~31) + perm32(R & 31)) : R;
        voffA[i] = (unsigned)(R * K + C) * 2u; voffB[i] = (unsigned)(Rb * K + C) * 2u; }
    const size_t kstep = (size_t)(BK * 2);
    const size_t hstep = (size_t)HALF * K * 2;
    const size_t tstep = 2 * hstep;
    const unsigned ldsw = (unsigned)wid * 1024u;
    const int aoff = lds_byte(wr * 64 + fr, fq * 8), boff = lds_byte(wc * 32 + fr, fq * 8);
#define PG8_SA(b, h) (((b) * 2 + (h)) * HTB)
#define PG8_SB(b, h) ((4 + (b) * 2 + (h)) * HTB)
#define PG8_STAGE(bufoff, gbase, voff) do { _Pragma("unroll") for (int _i = 0; _i < 2; ++_i) \
        __builtin_amdgcn_global_load_lds((const unsigned*)((const char*)(gbase) + (voff)[_i]), (PG8_LAS unsigned*)(lds + (bufoff) + ldsw + _i * 8192), 16, 0, 0); } while (0)
#define PG8_LDA(dst, b, h) do { _Pragma("unroll") for (int m = 0; m < 4; ++m) _Pragma("unroll") for (int k = 0; k < 2; ++k) dst[m][k] = *(const PG8_LAS bf16x8*)(lds + PG8_SA(b, h) + aoff + m * 2048 + k * 1024); } while (0)
#define PG8_LDB(dst, b, h) do { _Pragma("unroll") for (int n = 0; n < 2; ++n) _Pragma("unroll") for (int k = 0; k < 2; ++k) dst[n][k] = *(const PG8_LAS bf16x8*)(lds + PG8_SB(b, h) + boff + n * 2048 + k * 1024); } while (0)
#define PG8_MMA(ai, bj, At, Bt) do { __builtin_amdgcn_s_setprio(1); _Pragma("unroll") for (int m = 0; m < 4; ++m) _Pragma("unroll") for (int n = 0; n < 2; ++n) _Pragma("unroll") for (int k = 0; k < 2; ++k) \
        acc[ai][bj][m][n] = __builtin_amdgcn_mfma_f32_16x16x32_bf16(Bt[n][k], At[m][k], acc[ai][bj][m][n], 0, 0, 0); __builtin_amdgcn_s_setprio(0); } while (0)
#define PG8_WAIT_V(n) asm volatile("s_waitcnt vmcnt(" #n ")" ::: "memory")
#define PG8_WAIT_L(n) asm volatile("s_waitcnt lgkmcnt(" #n ")" ::: "memory")
#define PG8_BAR __builtin_amdgcn_s_barrier()
#define PG8_SCHED __builtin_amdgcn_sched_barrier(0)
    Unit cur, nxt; int ui = 0;
    if (!S.next(0, cur)) return;
    f32x4 acc[2][2][4][2];
#pragma unroll
    for (int a = 0; a < 2; ++a)
#pragma unroll
        for (int b = 0; b < 2; ++b)
#pragma unroll
            for (int m = 0; m < 4; ++m)
#pragma unroll
                for (int n = 0; n < 2; ++n) acc[a][b][m][n] = (f32x4){0.f, 0.f, 0.f, 0.f};
    bf16x8 At[4][2], B0[2][2], B1[2][2];
    const char* cA = (const char*)g.A + (size_t)cur.pm * tstep; const char* cB = (const char*)g.Bt + (size_t)cur.pn * tstep;
    S.a_ready(cur);
    if constexpr (SP2) {
        PG8_STAGE(PG8_SB(0, 0), cB, voffB); PG8_STAGE(PG8_SB(0, 1), cB + hstep, voffB); PG8_STAGE(PG8_SA(0, 0), cA, voffA); PG8_STAGE(PG8_SA(0, 1), cA + hstep, voffA);
        if (wr == 1) PG8_BAR;
        PG8_WAIT_V(2); PG8_BAR;
        PG8_STAGE(PG8_SB(1, 0), cB + kstep, voffB); PG8_STAGE(PG8_SA(1, 0), cA + kstep, voffA); PG8_STAGE(PG8_SB(1, 1), cB + hstep + kstep, voffB);
        PG8_WAIT_V(6); PG8_BAR;
    } else {
        PG8_STAGE(PG8_SB(0, 0), cB, voffB); PG8_STAGE(PG8_SA(0, 0), cA, voffA); PG8_STAGE(PG8_SB(0, 1), cB + hstep, voffB); PG8_STAGE(PG8_SA(0, 1), cA + hstep, voffA);
        if (wr == 1) PG8_BAR;
        PG8_WAIT_V(4); PG8_BAR;
        PG8_STAGE(PG8_SB(1, 0), cB + kstep, voffB); PG8_STAGE(PG8_SA(1, 0), cA + kstep, voffA); PG8_STAGE(PG8_SB(1, 1), cB + hstep + kstep, voffB);
        PG8_WAIT_V(6); PG8_BAR;
    }
    for (;;) {
        const bool has_next = S.next(ui + 1, nxt);
        const char* nA = has_next ? (const char*)g.A + (size_t)nxt.pm * tstep : cA; const char* nB = has_next ? (const char*)g.Bt + (size_t)nxt.pn * tstep : cB;
        for (int t = 0; t < nt; t += 2) {
            const bool last = (t == nt - 2);
            const char* a1 = cA + (size_t)(t + 1) * kstep;
            const char* a2 = last ? nA : cA + (size_t)(t + 2) * kstep; const char* b2 = last ? nB : cB + (size_t)(t + 2) * kstep;
            const char* a3 = a2 + kstep; const char* b3 = b2 + kstep;
            if (last && has_next) S.a_ready(nxt);
            if constexpr (SP2) {
            PG8_LDB(B0, 0, 0); PG8_LDB(B1, 0, 1); PG8_SCHED; PG8_LDA(At, 0, 0); PG8_STAGE(PG8_SA(1, 1), a1 + hstep, voffA);
            PG8_WAIT_V(8); PG8_WAIT_L(0); PG8_BAR; PG8_MMA(0, 0, At, B0); PG8_MMA(0, 1, At, B1); PG8_BAR; PG8_SCHED;
            PG8_LDA(At, 0, 1); PG8_STAGE(PG8_SB(0, 0), b2, voffB); PG8_STAGE(PG8_SB(0, 1), b2 + hstep, voffB); PG8_STAGE(PG8_SA(0, 0), a2, voffA);
            PG8_WAIT_V(8); PG8_WAIT_L(0); PG8_BAR; PG8_MMA(1, 0, At, B0); PG8_MMA(1, 1, At, B1); PG8_BAR; PG8_SCHED;
            PG8_LDB(B0, 1, 0); PG8_LDB(B1, 1, 1); PG8_SCHED; PG8_LDA(At, 1, 0); PG8_STAGE(PG8_SA(0, 1), a2 + hstep, voffA);
            PG8_WAIT_V(8); PG8_WAIT_L(0); PG8_BAR; PG8_MMA(0, 0, At, B0); PG8_MMA(0, 1, At, B1); PG8_BAR; PG8_SCHED;
            PG8_LDA(At, 1, 1); PG8_STAGE(PG8_SB(1, 0), b3, voffB); PG8_STAGE(PG8_SB(1, 1), b3 + hstep, voffB); PG8_STAGE(PG8_SA(1, 0), a3, voffA);
            PG8_WAIT_V(8); PG8_WAIT_L(0); PG8_BAR; PG8_MMA(1, 0, At, B0); PG8_MMA(1, 1, At, B1); PG8_BAR; PG8_SCHED;
            } else {
            PG8_LDB(B0, 0, 0); PG8_SCHED; PG8_LDA(At, 0, 0); PG8_STAGE(PG8_SA(1, 1), a1 + hstep, voffA);
            PG8_WAIT_L(8); PG8_BAR; PG8_WAIT_L(0); PG8_MMA(0, 0, At, B0); PG8_BAR; PG8_SCHED;
            PG8_LDB(B1, 0, 1); PG8_STAGE(PG8_SB(0, 0), b2, voffB);
            PG8_BAR; PG8_WAIT_L(0); PG8_MMA(0, 1, At, B1); PG8_BAR;
            PG8_LDA(At, 0, 1); PG8_STAGE(PG8_SA(0, 0), a2, voffA);
            PG8_BAR; PG8_WAIT_L(0); PG8_MMA(1, 0, At, B0); PG8_BAR; PG8_SCHED;
            PG8_STAGE(PG8_SB(0, 1), b2 + hstep, voffB);
            PG8_WAIT_V(6); PG8_BAR; PG8_MMA(1, 1, At, B1); PG8_BAR;
            PG8_LDB(B0, 1, 0); PG8_SCHED; PG8_LDA(At, 1, 0); PG8_STAGE(PG8_SA(0, 1), a2 + hstep, voffA);
            PG8_WAIT_L(8); PG8_BAR; PG8_WAIT_L(0); PG8_MMA(0, 0, At, B0); PG8_BAR; PG8_SCHED;
            PG8_LDB(B1, 1, 1); PG8_STAGE(PG8_SB(1, 0), b3, voffB);
            PG8_BAR; PG8_WAIT_L(0); PG8_MMA(0, 1, At, B1); PG8_BAR;
            PG8_LDA(At, 1, 1); PG8_STAGE(PG8_SA(1, 0), a3, voffA);
            PG8_BAR; PG8_WAIT_L(0); PG8_MMA(1, 0, At, B0); PG8_BAR; PG8_SCHED;
            PG8_STAGE(PG8_SB(1, 1), b3 + hstep, voffB);
            PG8_WAIT_V(6); PG8_BAR; PG8_MMA(1, 1, At, B1); PG8_BAR;
            }
        }
        if constexpr (ALIGN_EPI) { if (wr == 0) PG8_BAR; }
        if constexpr (!Epi::AFTER_DRAIN) { E(acc, cur, wr, wc, fr, fq); S.done(cur); }
        if (!has_next) break;
#pragma unroll
        for (int a = 0; a < 2; ++a)
#pragma unroll
            for (int b = 0; b < 2; ++b)
#pragma unroll
                for (int m = 0; m < 4; ++m)
#pragma unroll
                    for (int n = 0; n < 2; ++n) acc[a][b][m][n] = (f32x4){0.f, 0.f, 0.f, 0.f};
        cur = nxt; cA = nA; cB = nB; ++ui;
        if constexpr (ALIGN_EPI) { if (wr == 1) PG8_BAR; }
    }
    PG8_WAIT_V(0);
    if constexpr (!ALIGN_EPI) { if (wr == 0) PG8_BAR; }
    PG8_BAR;
    if constexpr (Epi::AFTER_DRAIN) { E.fused(acc, cur, wr, wc, fr, fq, lds, wid, lane); S.done(cur); }
#undef PG8_SA
#undef PG8_SB
#undef PG8_STAGE
#undef PG8_LDA
#undef PG8_LDB
#undef PG8_MMA
#undef PG8_WAIT_V
#undef PG8_WAIT_L
#undef PG8_BAR
#undef PG8_SCHED
}
}

#ifndef PG8_SP2
#define PG8_SP2 true
#endif
#ifndef PG8_ALIGN
#define PG8_ALIGN true
#endif

constexpr int NWAVES = 8;
#ifndef MK_N_LAUNCHES
#define MK_N_LAUNCHES 1
#endif
constexpr int N_PHASES = 11;
constexpr int TP = 16384, NSAMP = 128, NREAL = TP + NSAMP, MROWS = 16640, DM = 1024;
constexpr int SEQ = 2048, NBATCH = 8, SBATCH = 32, STOK = 4, NMEM = 256;
constexpr int A_IN = 3072, B_IN = 3712, B_INP = 3840, CSH = 2432, RW = 768;
constexpr float RMS_EPS = 1e-6f, GN_EPS = 64e-5f;
constexpr size_t O_YP = 0, O_YS = 16777216, O_MEM = 16908288, O_W0P = 19005440, O_W1P = 19529728, O_W2P = 21626880,
                 O_W0S = 30015488, O_W1S = 30081024, O_W2S = 30146560, O_WKVP = 30212096, O_WKVS = 30605312, O_SHP = 32178176, O_SHS = 32197632, O_END = 32275456;
constexpr size_t MiB = 1u << 20;
constexpr size_t WS_CTL = 0, CTL_ZERO_BYTES = 1 * MiB;
constexpr size_t WS_WAIN = 1 * MiB, WS_WAOUT = 7 * MiB, WS_WBIN = 8 * MiB, WS_WBOUT = 16 * MiB, WS_WM = 18 * MiB, WS_WL = 20 * MiB, WS_BT = 20 * MiB + 512 * 1024;
constexpr size_t WS_MEMN = 21 * MiB, WS_MKV = 25 * MiB, WS_TW = 29 * MiB, WS_XN = 34 * MiB, WS_H = 67 * MiB, WS_F = 100 * MiB, WS_P = 149 * MiB, WS_END = 271 * MiB;
constexpr int CW_TMO = 0, CW_BAR = 4096;

constexpr int RING_OFF = 0, RING_BYTES = 131072;
constexpr int LDSCTL_OFF = RING_BYTES, MISC_OFF = LDSCTL_OFF + 320;
constexpr int LDS_BYTES = 147456;

#define GAS __attribute__((address_space(1)))
#define LAS __attribute__((address_space(3)))
typedef unsigned short bf16;
typedef unsigned v4u __attribute__((ext_vector_type(4)));
typedef unsigned v2u __attribute__((ext_vector_type(2)));
typedef float f32x4 __attribute__((ext_vector_type(4)));
typedef GAS unsigned gu32;
#define RLX_AGENT __ATOMIC_RELAXED, __HIP_MEMORY_SCOPE_AGENT
#define LDS_WAIT() asm volatile("s_waitcnt lgkmcnt(0)" ::: "memory")
#define VM_WAIT() asm volatile("s_waitcnt vmcnt(0)" ::: "memory")
__device__ __forceinline__ unsigned f2bf(float f) { unsigned u = __builtin_bit_cast(unsigned, f); return (u + 0x7fffu + ((u >> 16) & 1u)) >> 16; }
__device__ __forceinline__ unsigned pk2(float lo, float hi) { return f2bf(lo) | (f2bf(hi) << 16); }
__device__ __forceinline__ float bflo(unsigned u) { return __builtin_bit_cast(float, u << 16); }
__device__ __forceinline__ float bfhi(unsigned u) { return __builtin_bit_cast(float, u & 0xffff0000u); }
__device__ __forceinline__ float bf2f(bf16 h) { return __builtin_bit_cast(float, (unsigned)h << 16); }

#define XB_TMO      128
#define XB_XCNT(j)  (256  + 64 * (j))
#define XB_XSUB(j)  (1280 + 64 * (j))
#define XB_XGEN(j)  (2304 + 64 * (j))
#define XB_TOP      3328
#define XB_TOPGEN   3392
#define XCD_BAR_WORDS 3456
#define XB_SPIN_CAP (1u << 20)
__device__ __forceinline__ unsigned xb_ld(unsigned* p)              { return __hip_atomic_load(p, __ATOMIC_RELAXED, __HIP_MEMORY_SCOPE_AGENT); }
__device__ __forceinline__ unsigned xb_add(unsigned* p, unsigned v) { return __hip_atomic_fetch_add(p, v, __ATOMIC_RELAXED, __HIP_MEMORY_SCOPE_AGENT); }
__device__ __forceinline__ unsigned xb_xcc_id() { return (unsigned)__builtin_amdgcn_s_getreg((3 << 11) | 20) & 0xFu; }
#define XB_SPIN(cond, bar) do { unsigned _sp = 0; while (cond) { __builtin_amdgcn_s_sleep(1); \
    if ((++_sp & 255u) == 0u) { if (xb_ld(&(bar)[XB_TMO])) break; if (_sp > XB_SPIN_CAP) { atomicAdd(&(bar)[XB_TMO], 1u); break; } } } } while (0)
struct XcdBarrier { unsigned* bar; unsigned x; volatile LAS unsigned* st; };
__device__ __forceinline__ XcdBarrier xcd_barrier_post(unsigned* bar, volatile LAS unsigned* st) {
    XcdBarrier b; b.bar = bar; b.x = xb_xcc_id(); b.st = st;
    if (threadIdx.x == 0) (void)xb_add(&bar[XB_XCNT(b.x)], 1u);
    return b;
}
__device__ __forceinline__ void xcd_barrier_complete(unsigned* bar, unsigned x, unsigned& nloc, unsigned& nx) {
    const unsigned G = gridDim.x * gridDim.y * gridDim.z;
    unsigned sum, cnt, mine, sp = 0u;
    for (;;) {
        sum = 0u; cnt = 0u; mine = 0u;
#pragma unroll
        for (unsigned j = 0; j < 16; ++j) { const unsigned c = xb_ld(&bar[XB_XCNT(j)]); sum += c; cnt += (c > 0u) ? 1u : 0u; mine = (j == x) ? c : mine; }
        if (sum == G) break;
        __builtin_amdgcn_s_sleep(1);
        if ((++sp & 255u) == 0u) { if (xb_ld(&bar[XB_TMO])) break; if (sp > XB_SPIN_CAP) { atomicAdd(&bar[XB_TMO], 1u); break; } }
    }
    nloc = mine > 0u ? mine : 1u; nx = cnt > 0u ? cnt : 1u;
}
__device__ __forceinline__ void xcd_barrier(const XcdBarrier& b) {
    asm volatile("s_waitcnt vmcnt(0)" ::: "memory");
    __syncthreads();
    if (threadIdx.x == 0) {
        unsigned* bar = b.bar;
        __builtin_amdgcn_s_waitcnt(0);
        unsigned nloc = b.st[0], nx = b.st[1];
        if (nloc == 0u) { xcd_barrier_complete(bar, b.x, nloc, nx); b.st[0] = nloc; b.st[1] = nx; }
        const unsigned old = xb_add(&bar[XB_XSUB(b.x)], 1u);
        const unsigned gen = old / nloc;
        if (old + 1u == (gen + 1u) * nloc) {
            __builtin_amdgcn_fence(__ATOMIC_RELEASE, "agent");
            asm volatile("s_waitcnt vmcnt(0)" ::: "memory");
            const unsigned og = xb_add(&bar[XB_TOP], 1u);
            const unsigned tg = og / nx;
            if (og + 1u == (tg + 1u) * nx) xb_add(&bar[XB_TOPGEN], 1u);
            else XB_SPIN(xb_ld(&bar[XB_TOPGEN]) == tg, bar);
            __builtin_amdgcn_fence(__ATOMIC_ACQUIRE, "agent");
            xb_add(&bar[XB_XGEN(b.x)], 1u);
            asm volatile("s_waitcnt vmcnt(0)" ::: "memory");
        } else {
            XB_SPIN(xb_ld(&bar[XB_XGEN(b.x)]) == gen, bar);
            __builtin_amdgcn_fence(__ATOMIC_ACQUIRE, "agent");
            asm volatile("s_waitcnt vmcnt(0)" ::: "memory");
        }
    }
    __syncthreads();
}

struct Ctx { LAS unsigned char* lds; int tid, lane, wave, vcu, G, gw, NGW; };

__device__ __forceinline__ float wave_sum(float v) {
#pragma unroll
    for (int o = 1; o < 64; o <<= 1) v += __shfl_xor(v, o);
    return v;
}
__device__ __forceinline__ float wave_max(float v) {
#pragma unroll
    for (int o = 1; o < 64; o <<= 1) v = fmaxf(v, __shfl_xor(v, o));
    return v;
}
__device__ __forceinline__ float rdlane(float v, int l) { return __builtin_bit_cast(float, __builtin_amdgcn_readlane(__builtin_bit_cast(int, v), l)); }

__device__ __forceinline__ void p0_transpose_item(const float* W, int N, const float* gain, bf16* WT, int ldo, int col_off, int row_off, LAS float* scr, int item, int nblk, int lane) {
    const int kb = item / nblk, nb = item % nblk, k0 = 64 * kb, n0 = 32 * nb;
#pragma unroll 8
    for (int i = 0; i < 32; ++i) { const int kk = 2 * i + (lane >> 5); const float g = gain ? gain[k0 + kk] : 1.f; scr[kk * 33 + (lane & 31)] = W[(size_t)(k0 + kk) * N + n0 + (lane & 31)] * g; }
    LDS_WAIT(); asm volatile("" ::: "memory");
    const int c = lane & 7;
#pragma unroll
    for (int j = 0; j < 4; ++j) { const int n = (lane >> 3) + 8 * j; const LAS float* s = scr + (8 * c) * 33 + n;
        v4u o; o.x = pk2(s[0 * 33], s[1 * 33]); o.y = pk2(s[2 * 33], s[3 * 33]); o.z = pk2(s[4 * 33], s[5 * 33]); o.w = pk2(s[6 * 33], s[7 * 33]);
        *(GAS v4u*)(WT + (size_t)(row_off + n0 + n) * ldo + col_off + k0 + 8 * c) = o; }
    LDS_WAIT(); asm volatile("" ::: "memory");
}
__device__ __forceinline__ void rms_row_to_bf16(const float* xrow, bf16* orow, int lane) {
    const GAS f32x4* xr = (const GAS f32x4*)xrow + lane;
    f32x4 v[4]; float s = 0.f;
#pragma unroll
    for (int j = 0; j < 4; ++j) { v[j] = xr[64 * j]; s += (v[j].x * v[j].x + v[j].y * v[j].y) + (v[j].z * v[j].z + v[j].w * v[j].w); }
    const float r = 1.f / sqrtf(wave_sum(s) * (1.f / DM) + RMS_EPS);
    GAS unsigned long long* o8 = (GAS unsigned long long*)orow + lane;
#pragma unroll
    for (int j = 0; j < 4; ++j) o8[64 * j] = (unsigned long long)pk2(v[j].x * r, v[j].y * r) | ((unsigned long long)pk2(v[j].z * r, v[j].w * r) << 32);
}
__device__ __forceinline__ int t5_bucket(int dist) {
    if (dist < 16) return dist;
    const double x = log((double)dist / 16.0) / log(128.0) * 16.0;
    int large = 16 + (int)x; return large < 31 ? large : 31;
}

__device__ __forceinline__ void ldq64(const bf16* p, float (&q)[64]) {
#pragma unroll
    for (int i = 0; i < 8; ++i) { const v4u u = *(const GAS v4u*)(p + 8 * i);
        q[8 * i + 0] = bflo(u.x); q[8 * i + 1] = bfhi(u.x); q[8 * i + 2] = bflo(u.y); q[8 * i + 3] = bfhi(u.y);
        q[8 * i + 4] = bflo(u.z); q[8 * i + 5] = bfhi(u.z); q[8 * i + 6] = bflo(u.w); q[8 * i + 7] = bfhi(u.w); }
}
__device__ __forceinline__ float dot64_bf(const float (&q)[64], const bf16* p) {
    float s0 = 0.f, s1 = 0.f;
#pragma unroll
    for (int i = 0; i < 8; ++i) { const v4u u = *(const GAS v4u*)(p + 8 * i);
        s0 += q[8 * i + 0] * bflo(u.x); s1 += q[8 * i + 1] * bfhi(u.x); s0 += q[8 * i + 2] * bflo(u.y); s1 += q[8 * i + 3] * bfhi(u.y);
        s0 += q[8 * i + 4] * bflo(u.z); s1 += q[8 * i + 5] * bfhi(u.z); s0 += q[8 * i + 6] * bflo(u.w); s1 += q[8 * i + 7] * bfhi(u.w); }
    return s0 + s1;
}
__device__ __forceinline__ float dot64_f32(const float (&q)[64], const float* p) {
    float s0 = 0.f, s1 = 0.f;
#pragma unroll
    for (int i = 0; i < 16; ++i) { const f32x4 u = *(const GAS f32x4*)(p + 4 * i);
        s0 += q[4 * i + 0] * u.x; s1 += q[4 * i + 1] * u.y; s0 += q[4 * i + 2] * u.z; s1 += q[4 * i + 3] * u.w; }
    return s0 + s1;
}
__device__ __forceinline__ float silu(float x) { return x / (1.f + __expf(-x)); }

__device__ __forceinline__ float cross_attn_task(const bf16* MKV, const float* c_mem, const bf16* qptr, int m, int hh, int layer, int lane) {
    float q[64]; ldq64(qptr, q);
    const bool samp = m >= TP;
    float l[4]; float mx = -3.0e38f, o = 0.f, s = 0.f;
    if (!samp) {
        const bf16* kb = MKV + (size_t)((m >> 11) * NMEM) * 1024 + layer * 512 + hh * 64;
#pragma unroll
        for (int r = 0; r < 4; ++r) { l[r] = dot64_bf(q, kb + (size_t)(r * 64 + lane) * 1024) * 0.125f; mx = fmaxf(mx, l[r]); }
        mx = wave_max(mx);
#pragma unroll
        for (int r = 0; r < 4; ++r) { l[r] = __expf(l[r] - mx); s += l[r]; }
        s = wave_sum(s);
#pragma unroll
        for (int r = 0; r < 4; ++r)
            for (int kk = 0; kk < 64; ++kk) o += rdlane(l[r], kk) * bf2f(kb[(size_t)(r * 64 + kk) * 1024 + 256 + lane]);
    } else {
        const float* kf = c_mem + ((size_t)(layer * SBATCH + ((m - TP) >> 2)) * NMEM) * 512 + hh * 64;
#pragma unroll
        for (int r = 0; r < 4; ++r) { l[r] = dot64_f32(q, kf + (size_t)(r * 64 + lane) * 512) * 0.125f; mx = fmaxf(mx, l[r]); }
        mx = wave_max(mx);
#pragma unroll
        for (int r = 0; r < 4; ++r) { l[r] = __expf(l[r] - mx); s += l[r]; }
        s = wave_sum(s);
#pragma unroll
        for (int r = 0; r < 4; ++r)
            for (int kk = 0; kk < 64; ++kk) o += rdlane(l[r], kk) * kf[(size_t)(r * 64 + kk) * 512 + 256 + lane];
    }
    return o / s;
}

template <int G>
__device__ __forceinline__ void attn_group(const bf16* P, const float* BT, const float* cw, int m, int hh, int lane, float& Mx, float& Ss, float& O) {
    constexpr int dil = G == 0 ? 1 : (G == 1 ? 4 : 16), Wg = G == 0 ? 128 : (G == 1 ? 512 : 2048), head0 = G * 4;
    const bool samp = m >= TP;
    const int b = m >> 11, t = m & 2047, sb = (m - TP) >> 2, st = (m - TP) & 3, head = head0 + hh;
    float q[64]; ldq64(P + (size_t)m * A_IN + head * 64, q);
    const float* bt = BT + (G * 4 + hh) * 132;
    float l[3]; float gm = -3.0e38f;
#pragma unroll
    for (int r = 0; r < 3; ++r) { const int kidx = r * 64 + lane; float lv = -3.0e38f;
        if (kidx < 129) {
            if (!samp) { const int tk = t - dil * kidx; if (tk >= 0) lv = dot64_bf(q, P + (size_t)((b << 11) + tk) * A_IN + RW + head * 64) * 0.125f + bt[kidx]; }
            else { const int idx = Wg + st - dil * kidx;
                if (idx >= Wg) lv = dot64_bf(q, P + (size_t)(TP + sb * 4 + idx - Wg) * A_IN + RW + head * 64) * 0.125f + bt[kidx];
                else lv = dot64_f32(q, cw + ((size_t)(sb * Wg + idx) * 2) * 256 + hh * 64) * 0.125f + bt[kidx]; }
        }
        l[r] = lv; gm = fmaxf(gm, lv); }
    gm = wave_max(gm);
    const float Mn = fmaxf(Mx, gm), sc = __expf(Mx - Mn);
    float ps = 0.f;
#pragma unroll
    for (int r = 0; r < 3; ++r) { l[r] = l[r] > -1.0e38f ? __expf(l[r] - Mn) : 0.f; ps += l[r]; }
    Ss = Ss * sc + wave_sum(ps); O *= sc; Mx = Mn;
#pragma unroll
    for (int r = 0; r < 3; ++r)
        for (int kk = 0; kk < 64; ++kk) { const int kidx = r * 64 + kk; if (kidx >= 129) break;
            const float p = rdlane(l[r], kk);
            if (p != 0.f) { float v;
                if (!samp) { const int tk = t - dil * kidx; v = bf2f(P[(size_t)((b << 11) + tk) * A_IN + 2 * RW + head * 64 + lane]); }
                else { const int idx = Wg + st - dil * kidx;
                    if (idx >= Wg) v = bf2f(P[(size_t)(TP + sb * 4 + idx - Wg) * A_IN + 2 * RW + head * 64 + lane]);
                    else v = cw[((size_t)(sb * Wg + idx) * 2 + 1) * 256 + hh * 64 + lane]; }
                O += p * v; } }
}

typedef short s16x4 __attribute__((ext_vector_type(4)));
typedef short bf16x8 __attribute__((ext_vector_type(8)));
constexpr int VROW = 160;
constexpr int VBUF = 32 * VROW;
constexpr float LOG2E = 1.4426950408889634f;
template <int OFF> __device__ __forceinline__ s16x4 tr_read(unsigned vb) {
    s16x4 r; asm volatile("ds_read_b64_tr_b16 %0, %1 offset:%2" : "=&v"(r) : "v"(vb), "i"(OFF) : "memory"); return r;
}
struct AttnSt { float m, s; f32x4 o[4]; };
__device__ __forceinline__ void attn_init(AttnSt& st) { st.m = -1.0e30f; st.s = 0.f;
#pragma unroll
    for (int i = 0; i < 4; ++i) st.o[i] = (f32x4){0.f, 0.f, 0.f, 0.f}; }
__device__ __forceinline__ unsigned cvt_pk_bf16f(float lo, float hi) { unsigned r; asm volatile("v_cvt_pk_bf16_f32 %0, %1, %2" : "=v"(r) : "v"(lo), "v"(hi)); return r; }

template <bool MASKED>
__device__ __forceinline__ void attn_pairs(const bf16* kbase, const bf16* vbase, int pitch, int tb, int dil, int qs, int tmax, int j0, int j1,
                                           const bf16x8 (&qf)[2], const LAS float* bias2, LAS unsigned char* vbuf, int lane, AttnSt& st) {
    const int n = lane & 15, quad = lane >> 4, vr8 = lane >> 3, vc8 = lane & 7;
    const unsigned vwr = (unsigned)(size_t)vbuf + (unsigned)(vr8 * VROW + vc8 * 16);
    const unsigned vrd = (unsigned)(size_t)vbuf + (unsigned)((4 * quad + (n >> 2)) * VROW + 8 * (n & 3));
    const float C2 = 0.125f * LOG2E;
#pragma unroll 1
    for (int jp = j0; jp < j1; ++jp) {
        bf16x8 ka[2][2]; v4u vr[4];
#pragma unroll
        for (int tt = 0; tt < 2; ++tt) { int tk = tb + dil * (32 * jp + 16 * tt + n); if (MASKED) tk = tk < 0 ? 0 : (tk > tmax ? tmax : tk);
            const bf16* kp = kbase + (size_t)tk * pitch + 8 * quad;
            ka[tt][0] = __builtin_bit_cast(bf16x8, *(const GAS v4u*)kp); ka[tt][1] = __builtin_bit_cast(bf16x8, *(const GAS v4u*)(kp + 32)); }
#pragma unroll
        for (int c = 0; c < 4; ++c) { int tk = tb + dil * (32 * jp + 8 * c + vr8); if (MASKED) tk = tk < 0 ? 0 : (tk > tmax ? tmax : tk);
            vr[c] = *(const GAS v4u*)(vbase + (size_t)tk * pitch + 8 * vc8); }
        f32x4 sA = {0.f, 0.f, 0.f, 0.f}, sB = {0.f, 0.f, 0.f, 0.f};
        sA = __builtin_amdgcn_mfma_f32_16x16x32_bf16(ka[0][0], qf[0], sA, 0, 0, 0); sA = __builtin_amdgcn_mfma_f32_16x16x32_bf16(ka[0][1], qf[1], sA, 0, 0, 0);
        sB = __builtin_amdgcn_mfma_f32_16x16x32_bf16(ka[1][0], qf[0], sB, 0, 0, 0); sB = __builtin_amdgcn_mfma_f32_16x16x32_bf16(ka[1][1], qf[1], sB, 0, 0, 0);
        float l[8]; bool ok[8]; float mloc = -1.0e30f;
#pragma unroll
        for (int e = 0; e < 8; ++e) { const int u = 32 * jp + (e >> 2) * 16 + 4 * quad + (e & 3); const float a = (e < 4 ? sA[e & 3] : sB[e & 3]) * C2;
            if (MASKED) { const int kidx = 128 + qs * n - u; ok[e] = (kidx >= 0) && (kidx <= 128) && (tb + dil * u >= 0);
                const int kc = kidx < 0 ? 0 : (kidx > 128 ? 128 : kidx); l[e] = ok[e] ? a + bias2[kc] : -1.0e30f; }
            else { ok[e] = true; l[e] = a; }
            mloc = fmaxf(mloc, l[e]); }
        mloc = fmaxf(mloc, __shfl_xor(mloc, 16)); mloc = fmaxf(mloc, __shfl_xor(mloc, 32));
        const float mn = fmaxf(st.m, mloc), alpha = __builtin_amdgcn_exp2f(st.m - mn);
        float ps = 0.f; float p[8];
#pragma unroll
        for (int e = 0; e < 8; ++e) { p[e] = ok[e] ? __builtin_amdgcn_exp2f(l[e] - mn) : 0.f; ps += p[e]; }
        st.s = st.s * alpha + ps; st.m = mn;
#pragma unroll
        for (int i = 0; i < 4; ++i) st.o[i] = st.o[i] * alpha;
        v4u pk; pk.x = cvt_pk_bf16f(p[0], p[1]); pk.y = cvt_pk_bf16f(p[2], p[3]); pk.z = cvt_pk_bf16f(p[4], p[5]); pk.w = cvt_pk_bf16f(p[6], p[7]);
        const bf16x8 pb = __builtin_bit_cast(bf16x8, pk);
#pragma unroll
        for (int c = 0; c < 4; ++c) *(LAS v4u*)(size_t)(vwr + c * 8 * VROW) = vr[c];
        asm volatile("s_waitcnt lgkmcnt(0)" ::: "memory");
        const s16x4 a0 = tr_read<0>(vrd), b0 = tr_read<16 * VROW>(vrd), a1 = tr_read<32>(vrd), b1 = tr_read<16 * VROW + 32>(vrd);
        const s16x4 a2 = tr_read<64>(vrd), b2 = tr_read<16 * VROW + 64>(vrd), a3 = tr_read<96>(vrd), b3 = tr_read<16 * VROW + 96>(vrd);
        asm volatile("s_waitcnt lgkmcnt(0)" ::: "memory"); __builtin_amdgcn_sched_barrier(0);
#define PKV(L, H) (bf16x8){L[0], L[1], L[2], L[3], H[0], H[1], H[2], H[3]}
        st.o[0] = __builtin_amdgcn_mfma_f32_16x16x32_bf16(PKV(a0, b0), pb, st.o[0], 0, 0, 0);
        st.o[1] = __builtin_amdgcn_mfma_f32_16x16x32_bf16(PKV(a1, b1), pb, st.o[1], 0, 0, 0);
        st.o[2] = __builtin_amdgcn_mfma_f32_16x16x32_bf16(PKV(a2, b2), pb, st.o[2], 0, 0, 0);
        st.o[3] = __builtin_amdgcn_mfma_f32_16x16x32_bf16(PKV(a3, b3), pb, st.o[3], 0, 0, 0);
#undef PKV
        __builtin_amdgcn_sched_barrier(0);
    }
}
__device__ __forceinline__ void attn_store(const AttnSt& st, const bf16* gate_row  , bf16* out_row, int lane) {
    const int quad = lane >> 4;
    float s = st.s; s += __shfl_xor(s, 16); s += __shfl_xor(s, 32);
    const float inv = 1.f / s;
#pragma unroll
    for (int mt = 0; mt < 4; ++mt) { const v2u g = *(const GAS v2u*)(gate_row + 16 * mt + 4 * quad);
        const float o0 = st.o[mt][0] * inv * silu(bflo(g.x)), o1 = st.o[mt][1] * inv * silu(bfhi(g.x)), o2 = st.o[mt][2] * inv * silu(bflo(g.y)), o3 = st.o[mt][3] * inv * silu(bfhi(g.y));
        *(GAS v2u*)(out_row + 16 * mt + 4 * quad) = (v2u){pk2(o0, o1), pk2(o2, o3)}; }
}
__device__ __forceinline__ void load_qf(const bf16* qrow, int lane, bf16x8 (&qf)[2]) {
    const int quad = lane >> 4;
    qf[0] = __builtin_bit_cast(bf16x8, *(const GAS v4u*)(qrow + 8 * quad)); qf[1] = __builtin_bit_cast(bf16x8, *(const GAS v4u*)(qrow + 32 + 8 * quad));
}
__device__ __forceinline__ void attn_a_unit(const Ctx& C, const bf16* P, const bf16* MKV, bf16* H, const float* BT, int unit) {
    const int b = unit >> 5, hh = (unit >> 3) & 3, t0 = (unit & 7) * 256;
    LAS float* bias2 = (LAS float*)(C.lds + RING_OFF);
    LAS unsigned char* vbuf = C.lds + RING_OFF + 4096 + C.wave * VBUF;
    __syncthreads();
    for (int i = C.tid; i < 3 * 132; i += NWAVES * 64) { const int g = i / 132, k = i % 132; bias2[i] = k < 129 ? BT[(g * 4 + hh) * 132 + k] * LOG2E : 0.f; }
    __syncthreads();
    const int n = C.lane & 15;
    const bf16* Pb = P + (size_t)(b << 11) * A_IN;
#pragma unroll 1
    for (int set = 0; set < 2; ++set) {
        const int r = 2 * C.wave + set, tq = t0 + r + 16 * n;
        const bf16* qrow = Pb + (size_t)tq * A_IN;
        AttnSt st; attn_init(st);
#pragma unroll 1
        for (int g = 0; g < 3; ++g) {
            const int dil = g == 0 ? 1 : (g == 1 ? 4 : 16), qs = 16 / dil, np = g == 0 ? 12 : (g == 1 ? 6 : 5), head = g * 4 + hh;
            const int tb = t0 + r - 128 * dil;
            int j0 = 0; if (tb < 0) { j0 = (-tb - 31 * dil + 32 * dil - 1) / (32 * dil); if (j0 < 0) j0 = 0; }
            bf16x8 qf[2]; load_qf(qrow + head * 64, C.lane, qf);
            attn_pairs<true>(Pb + RW + head * 64, Pb + 2 * RW + head * 64, A_IN, tb, dil, qs, SEQ - 1, j0, np, qf, bias2 + g * 132, vbuf, C.lane, st);
        }
        attn_store(st, qrow + 2560 + hh * 64, H + ((size_t)(b << 11) + tq) * 512 + hh * 64, C.lane);
        AttnSt sm; attn_init(sm);
        { bf16x8 qf[2]; load_qf(qrow + 2304 + hh * 64, C.lane, qf);
          const bf16* kb = MKV + (size_t)(b * NMEM) * 1024 + hh * 64;
          attn_pairs<false>(kb, kb + 256, 1024, 0, 1, 0, NMEM - 1, 0, 8, qf, nullptr, vbuf, C.lane, sm); }
        attn_store(sm, qrow + 2560 + 256 + hh * 64, H + ((size_t)(b << 11) + tq) * 512 + 256 + hh * 64, C.lane);
    }
}
__device__ __forceinline__ void attn_b_unit(const Ctx& C, const bf16* P, const bf16* MKV, bf16* H, int unit) {
    const int b = unit >> 5, hh = (unit >> 3) & 3, t0 = (unit & 7) * 256;
    LAS unsigned char* vbuf = C.lds + RING_OFF + 4096 + C.wave * VBUF;
    const int n = C.lane & 15;
#pragma unroll 1
    for (int set = 0; set < 2; ++set) {
        const int r = 2 * C.wave + set, tq = t0 + r + 16 * n;
        const bf16* qrow = P + ((size_t)(b << 11) + tq) * B_INP;
        AttnSt sm; attn_init(sm);
        bf16x8 qf[2]; load_qf(qrow + CSH + hh * 64, C.lane, qf);
        const bf16* kb = MKV + (size_t)(b * NMEM) * 1024 + 512 + hh * 64;
        attn_pairs<false>(kb, kb + 256, 1024, 0, 1, 0, NMEM - 1, 0, 8, qf, nullptr, vbuf, C.lane, sm);
        attn_store(sm, qrow + 2688 + RW + hh * 64, H + ((size_t)(b << 11) + tq) * 1024 + RW + hh * 64, C.lane);
    }
}

__device__ __forceinline__ void row_pass(const bf16* hp, const float* xin, float* xout, const float* gpost, bf16* xn, int lane) {
    const GAS v2u* h2 = (const GAS v2u*)hp + lane; const GAS f32x4* xr = (const GAS f32x4*)xin + lane; const GAS f32x4* gp = (const GAS f32x4*)gpost + lane;
    f32x4 h[4], x[4]; float s = 0.f;
#pragma unroll
    for (int j = 0; j < 4; ++j) { const v2u u = h2[64 * j]; h[j] = (f32x4){bflo(u.x), bfhi(u.x), bflo(u.y), bfhi(u.y)}; x[j] = xr[64 * j];
        s += (h[j].x * h[j].x + h[j].y * h[j].y) + (h[j].z * h[j].z + h[j].w * h[j].w); }
    const float r = 1.f / sqrtf(wave_sum(s) * (1.f / DM) + RMS_EPS);
    float s2 = 0.f;
#pragma unroll
    for (int j = 0; j < 4; ++j) { const f32x4 g = gp[64 * j]; x[j] = x[j] + h[j] * r * g; s2 += (x[j].x * x[j].x + x[j].y * x[j].y) + (x[j].z * x[j].z + x[j].w * x[j].w);
        *((GAS f32x4*)xout + lane + 64 * j) = x[j]; }
    if (xn) { const float r2 = 1.f / sqrtf(wave_sum(s2) * (1.f / DM) + RMS_EPS);
        GAS unsigned long long* o8 = (GAS unsigned long long*)xn + lane;
#pragma unroll
        for (int j = 0; j < 4; ++j) o8[64 * j] = (unsigned long long)pk2(x[j].x * r2, x[j].y * r2) | ((unsigned long long)pk2(x[j].z * r2, x[j].w * r2) << 32); }
}

struct ScanP { const bf16 *P, *LORA; bf16* H; float* out; const float *st_wkv, *st_shift, *mu, *w0, *a0, *k_k, *k_a, *r_k, *ln_w, *ln_b; };
__device__ __forceinline__ void scan_unit(const Ctx& C, const ScanP& sp, int u) {
    LAS float* L = (LAS float*)(C.lds + RING_OFF);
    LAS float *LA = L, *LB = L + 4096, *LW = L + 8192, *LK = L + 12288, *LRW = L + 16384, *LV = L + 20480, *LSC = L + 24576, *LY = L + 24576 + 256;
    const bool samp = u >= 96; const int seq = samp ? (u - 96) / 12 : u / 12, h = samp ? (u - 96) % 12 : u % 12;
    const int T = samp ? STOK : SEQ, row0 = samp ? TP + seq * 4 : seq * SEQ;
    int row = C.wave * 8 + (C.lane >> 3), p = C.lane & 7;
    asm volatile("" : "+v"(row), "+v"(p));
    float S[8];
#pragma unroll
    for (int j = 0; j < 8; ++j) S[j] = samp ? sp.st_wkv[((size_t)(seq * 12 + h) * 64 + row) * 64 + p * 8 + j] : 0.f;
#pragma unroll 1
    for (int c0 = 0; c0 < T; c0 += 64) {
        const int n = (T - c0) < 64 ? (T - c0) : 64;
        int tok = C.tid >> 3, part = C.tid & 7;
        asm volatile("" : "+v"(tok), "+v"(part));
        __syncthreads();
        if (tok < n) {
            const int t = c0 + tok, m = row0 + t;
            const bf16* cur = sp.P + (size_t)m * B_INP; const bf16* prv = cur - B_INP; const bf16* lo = sp.LORA + (size_t)m * 1536;
            float xr[8], xk[8], xv[8], kk[8], av[8], dv[8];
            float nrm = 0.f;
#pragma unroll
            for (int j = 0; j < 8; ++j) { const int c = h * 64 + part * 8 + j;
                const float cr = bf2f(cur[c]), ck = bf2f(cur[RW + c]), cv = bf2f(cur[2 * RW + c]);
                float pr = 0.f, pk = 0.f, pv = 0.f;
                if (t > 0) { pr = bf2f(prv[c]); pk = bf2f(prv[RW + c]); pv = bf2f(prv[2 * RW + c]); }
                else if (samp) { const float* ss = sp.st_shift + (size_t)seq * CSH; pr = ss[c]; pk = ss[RW + c]; pv = ss[2 * RW + c]; }
                xr[j] = cr + sp.mu[c] * (pr - cr); xk[j] = ck + sp.mu[RW + c] * (pk - ck); xv[j] = cv + sp.mu[2 * RW + c] * (pv - cv);
                const float dpre = sp.w0[c] + bf2f(lo[c]), apre = sp.a0[c] + bf2f(lo[RW + c]);
                const float z = -dpre, spl = fmaxf(z, 0.f) + log1pf(expf(-fabsf(z)));
                const float wlog = -spl - 0.5f; dv[j] = expf(-expf(wlog));
                av[j] = 1.f / (1.f + expf(-apre));
                kk[j] = xk[j] * sp.k_k[c]; nrm += kk[j] * kk[j]; }
            nrm += __shfl_xor(nrm, 1); nrm += __shfl_xor(nrm, 2); nrm += __shfl_xor(nrm, 4);
            const float inv = 1.f / fmaxf(sqrtf(nrm), 1e-12f);
            float br = 0.f, kr = 0.f, bon = 0.f;
#pragma unroll
            for (int j = 0; j < 8; ++j) { const int c = h * 64 + part * 8 + j, d = part * 8 + j;
                const float kn = kk[j] * inv, k2 = xk[j] * (1.f + (av[j] - 1.f) * sp.k_a[c]);
                const float bb = kn * av[j];
                LA[tok * 64 + d] = -kn; LB[tok * 64 + d] = bb; LW[tok * 64 + d] = dv[j]; LK[tok * 64 + d] = k2; LRW[tok * 64 + d] = xr[j] * dv[j]; LV[tok * 64 + d] = xv[j];
                br += bb * xr[j]; kr += k2 * xr[j]; bon += xr[j] * k2 * sp.r_k[c]; }
            br += __shfl_xor(br, 1); br += __shfl_xor(br, 2); br += __shfl_xor(br, 4);
            kr += __shfl_xor(kr, 1); kr += __shfl_xor(kr, 2); kr += __shfl_xor(kr, 4);
            bon += __shfl_xor(bon, 1); bon += __shfl_xor(bon, 2); bon += __shfl_xor(bon, 4);
            if (part == 0) { LSC[tok * 4 + 0] = br; LSC[tok * 4 + 1] = kr; LSC[tok * 4 + 2] = bon; }
        }
        __syncthreads();
#pragma unroll 1
        for (int i = 0; i < n; ++i) {
            const LAS f32x4* a4 = (const LAS f32x4*)(LA + i * 64 + p * 8); const LAS f32x4* r4 = (const LAS f32x4*)(LRW + i * 64 + p * 8);
            const LAS f32x4* w4 = (const LAS f32x4*)(LW + i * 64 + p * 8); const LAS f32x4* b4 = (const LAS f32x4*)(LB + i * 64 + p * 8); const LAS f32x4* k4 = (const LAS f32x4*)(LK + i * 64 + p * 8);
            const f32x4 a0 = a4[0], a1 = a4[1], r0 = r4[0], r1 = r4[1];
            float sa = (S[0] * a0.x + S[1] * a0.y) + (S[2] * a0.z + S[3] * a0.w) + (S[4] * a1.x + S[5] * a1.y) + (S[6] * a1.z + S[7] * a1.w);
            float yp = (S[0] * r0.x + S[1] * r0.y) + (S[2] * r0.z + S[3] * r0.w) + (S[4] * r1.x + S[5] * r1.y) + (S[6] * r1.z + S[7] * r1.w);
            sa += __shfl_xor(sa, 1); sa += __shfl_xor(sa, 2); sa += __shfl_xor(sa, 4);
            yp += __shfl_xor(yp, 1); yp += __shfl_xor(yp, 2); yp += __shfl_xor(yp, 4);
            const float v = LV[i * 64 + row], br = LSC[i * 4 + 0], kr = LSC[i * 4 + 1];
            const f32x4 w0 = w4[0], w1 = w4[1], b0 = b4[0], b1 = b4[1], k0 = k4[0], k1 = k4[1];
            S[0] = S[0] * w0.x + sa * b0.x + v * k0.x; S[1] = S[1] * w0.y + sa * b0.y + v * k0.y; S[2] = S[2] * w0.z + sa * b0.z + v * k0.z; S[3] = S[3] * w0.w + sa * b0.w + v * k0.w;
            S[4] = S[4] * w1.x + sa * b1.x + v * k1.x; S[5] = S[5] * w1.y + sa * b1.y + v * k1.y; S[6] = S[6] * w1.z + sa * b1.z + v * k1.z; S[7] = S[7] * w1.w + sa * b1.w + v * k1.w;
            if (p == 0) LY[i * 64 + row] = yp + sa * br + v * kr;
        }
        __syncthreads();
        asm volatile("" : "+v"(tok), "+v"(part));
        if (tok < n) {
            const int m = row0 + c0 + tok;
            float y[8]; float s = 0.f;
#pragma unroll
            for (int j = 0; j < 8; ++j) { y[j] = LY[tok * 64 + part * 8 + j]; s += y[j]; }
            s += __shfl_xor(s, 1); s += __shfl_xor(s, 2); s += __shfl_xor(s, 4);
            const float mean = s * (1.f / 64.f); float q = 0.f;
#pragma unroll
            for (int j = 0; j < 8; ++j) { y[j] -= mean; q += y[j] * y[j]; }
            q += __shfl_xor(q, 1); q += __shfl_xor(q, 2); q += __shfl_xor(q, 4);
            const float rstd = 1.f / sqrtf(q * (1.f / 64.f) + GN_EPS), bon = LSC[tok * 4 + 2];
            unsigned w[4];
#pragma unroll
            for (int j = 0; j < 8; j += 2) { float o2[2];
#pragma unroll
                for (int e = 0; e < 2; ++e) { const int c = h * 64 + part * 8 + j + e;
                    const float yy = y[j + e] * rstd * sp.ln_w[c] + sp.ln_b[c] + bon * LV[tok * 64 + part * 8 + j + e];
                    o2[e] = yy * silu(bf2f(sp.P[(size_t)m * B_INP + 2688 + c])); }
                w[j >> 1] = pk2(o2[0], o2[1]); }
            *(GAS v4u*)(sp.H + (size_t)m * 1024 + h * 64 + part * 8) = (v4u){w[0], w[1], w[2], w[3]};
        }
    }
    float* so = sp.out + (samp ? O_WKVS : O_WKVP) + ((size_t)(seq * 12 + h) * 64 + row) * 64 + p * 8;
    *(GAS f32x4*)so = (f32x4){S[0], S[1], S[2], S[3]}; *((GAS f32x4*)so + 1) = (f32x4){S[4], S[5], S[6], S[7]};
    __syncthreads();
}

constexpr int PTAB_OFF = LDSCTL_OFF + 512;
__device__ __forceinline__ const float* inptr(LAS unsigned char* ldsb, int i) {
    const LAS unsigned* p = (const LAS unsigned*)(ldsb + PTAB_OFF) + 2 * i;
    const unsigned lo = __builtin_amdgcn_readfirstlane(p[0]), hi = __builtin_amdgcn_readfirstlane(p[1]);
    return (const float*)(((unsigned long long)hi << 32) | lo);
}
struct Args { const float* in[28]; float* out; unsigned char* ws; int ph_lo, ph_hi; };
#define WSP(T, off) ((T*)(args.ws + (off)))
#define GEMM_BF16(Aptr, Bptr, Optr, Mv, Nv, Kv) do { pg8::Gemm g{Aptr, Bptr, Mv, Nv, Kv}; pg8::StaticOrder S; S.init(Mv, Nv, C.G, (int)blockIdx.x); \
        pg8::EpiBf16<0> E{Optr, Nv, nullptr, 0, 0, 1.f}; pg8::gemm_phase<pg8::EpiBf16<0>, pg8::StaticOrder, PG8_ALIGN, PG8_SP2>(C.lds + RING_OFF, g, S, E); } while (0)
__global__ void __launch_bounds__(NWAVES * 64, 2) hyb_fwd(Args args) {
    extern __shared__ __attribute__((aligned(16))) unsigned char lds[];
    LAS unsigned char* const ldsb = (LAS unsigned char*)lds;
    for (int u = threadIdx.x; u < (LDS_BYTES - LDSCTL_OFF) / 4; u += NWAVES * 64) ((LAS unsigned*)(ldsb + LDSCTL_OFF))[u] = 0u;
    __syncthreads();
    if (threadIdx.x < 28) ((LAS unsigned long long*)(ldsb + PTAB_OFF))[threadIdx.x] = (unsigned long long)args.in[threadIdx.x];
    __syncthreads();
#define INP(i) inptr(ldsb, (i))
#define MKCTX() Ctx C; { int t_ = threadIdx.x; asm volatile("" : "+v"(t_)); C.lds = ldsb; C.tid = t_; C.lane = t_ & 63; C.wave = __builtin_amdgcn_readfirstlane(t_ >> 6); \
        C.G = gridDim.x; const int bx_ = blockIdx.x; C.vcu = (C.G % 8 == 0) ? (bx_ % 8) * (C.G / 8) + bx_ / 8 : bx_; C.gw = C.vcu * NWAVES + C.wave; C.NGW = C.G * NWAVES; } \
        const int gt = C.gw * 64 + C.lane, NGT = C.NGW * 64; (void)gt; (void)NGT
    const int lo = args.ph_lo, hi = args.ph_hi;
    const bool fused = (hi - lo) > 1;
    XcdBarrier bar; bar.bar = WSP(unsigned, WS_CTL) + CW_BAR; bar.x = 0; bar.st = nullptr;
    if (fused) bar = xcd_barrier_post(WSP(unsigned, WS_CTL) + CW_BAR, (volatile LAS unsigned*)(ldsb + MISC_OFF) + 8);
#define IN(k) (lo <= (k) && (k) < hi)
#define SEAM(k) do { if (IN(k) && IN((k) + 1)) xcd_barrier(bar); } while (0)

    if (IN(0)) { MKCTX();
        LAS float* scr = (LAS float*)(C.lds + RING_OFF + C.wave * 16384);
        constexpr int I0 = 16 * 96, I1 = 8 * 32, I2 = 16 * 116, I3 = 16 * 32, I4 = 16 * 16, I5 = 16 * 16, I6 = 24, I7 = 24;
        constexpr int NITEMS = I0 + I1 + I2 + I3 + I4 + I5 + I6 + I7;
        for (int it = C.gw; it < NITEMS; it += C.NGW) {
            int r = it;
            if (r < I0) { p0_transpose_item(INP(14), A_IN, INP(9), WSP(bf16, WS_WAIN), 1024, 0, 0, scr, r, 96, C.lane); continue; } r -= I0;
            if (r < I1) { p0_transpose_item(INP(15), 1024, nullptr, WSP(bf16, WS_WAOUT), 512, 0, 0, scr, r, 32, C.lane); continue; } r -= I1;
            if (r < I2) { p0_transpose_item(INP(16), B_IN, INP(9) + DM, WSP(bf16, WS_WBIN), 1024, 0, 0, scr, r, 116, C.lane); continue; } r -= I2;
            if (r < I3) { p0_transpose_item(INP(17), 1024, nullptr, WSP(bf16, WS_WBOUT), 1024, 0, 0, scr, r, 32, C.lane); continue; } r -= I3;
            if (r < I4) { p0_transpose_item(INP(12), 512, INP(11), WSP(bf16, WS_WM), 1024, 0, 0, scr, r, 16, C.lane); continue; } r -= I4;
            if (r < I5) { p0_transpose_item(INP(12) + 1024 * 512, 512, INP(11) + DM, WSP(bf16, WS_WM), 1024, 0, 512, scr, r, 16, C.lane); continue; } r -= I5;
            if (r < I6) { p0_transpose_item(INP(20), RW, nullptr, WSP(bf16, WS_WL), 128, 0, 0, scr, r, 24, C.lane); continue; } r -= I6;
            p0_transpose_item(INP(22), RW, nullptr, WSP(bf16, WS_WL), 128, 64, RW, scr, r, 24, C.lane);
        }
        const v4u z4 = {0u, 0u, 0u, 0u};
        for (int i = gt; i < 16384; i += NGT) *((GAS v4u*)(WSP(bf16, WS_WBIN) + (size_t)B_IN * 1024) + i) = z4;
        for (int i = gt; i < 1536 * 8; i += NGT) { const int n = i >> 3, c = i & 7; *(GAS v4u*)(WSP(bf16, WS_WL) + (size_t)n * 128 + (n < RW ? 64 : 0) + c * 8) = z4; }
        for (int i = gt; i < 128 * 128; i += NGT) *((GAS v4u*)(WSP(bf16, WS_XN) + (size_t)NREAL * 1024) + i) = z4;
        for (int i = gt; i < 3 * 4 * 129; i += NGT) { const int g = i / (4 * 129), r = i % (4 * 129), hh = r / 129, k = r % 129; const int dil = g == 0 ? 1 : (g == 1 ? 4 : 16);
            WSP(float, WS_BT)[(g * 4 + hh) * 132 + k] = INP(13)[t5_bucket(dil * k) * 12 + g * 4 + hh]; }
        for (int m = C.gw; m < NREAL + 2048; m += C.NGW) {
            if (m < TP) rms_row_to_bf16(INP(0) + (size_t)m * DM, WSP(bf16, WS_XN) + (size_t)m * DM, C.lane);
            else if (m < NREAL) rms_row_to_bf16(INP(1) + (size_t)(m - TP) * DM, WSP(bf16, WS_XN) + (size_t)m * DM, C.lane);
            else rms_row_to_bf16(INP(2) + (size_t)(m - NREAL) * DM, WSP(bf16, WS_MEMN) + (size_t)(m - NREAL) * DM, C.lane);
        }
    } SEAM(0);
    if (IN(1)) { MKCTX();
        GEMM_BF16(WSP(bf16, WS_XN), WSP(bf16, WS_WAIN), WSP(bf16, WS_P), MROWS, A_IN, DM);
        GEMM_BF16(WSP(bf16, WS_MEMN), WSP(bf16, WS_WM), WSP(bf16, WS_MKV), 2048, 1024, DM);
    } SEAM(1);
    if (IN(2)) { MKCTX();
        const bf16* P = WSP(bf16, WS_P); const bf16* MKV = WSP(bf16, WS_MKV); float* out = args.out;
        for (int i = gt; i < 2 * 2048 * 512; i += NGT) { const int l = i / (2048 * 512), r = (i / 512) % 2048, c = i % 512; out[O_MEM + i] = bf2f(MKV[(size_t)r * 1024 + l * 512 + c]); }
#pragma unroll
        for (int g = 0; g < 3; ++g) { const int Wg = g == 0 ? 128 : (g == 1 ? 512 : 2048); const size_t ob = g == 0 ? O_W0P : (g == 1 ? O_W1P : O_W2P);
            const int n = NBATCH * Wg * 512;
            for (int i = gt; i < n; i += NGT) { const int c = i % 512, ri = (i / 512) % Wg, b = i / (512 * Wg); const int t = SEQ - Wg + ri, kv = c >> 8, cc = c & 255;
                out[ob + i] = bf2f(P[(size_t)((b << 11) + t) * A_IN + RW + kv * RW + g * 256 + cc]); }
            const size_t os = g == 0 ? O_W0S : (g == 1 ? O_W1S : O_W2S);
            for (int i = gt; i < NSAMP * 512; i += NGT) { const int c = i % 512, r = i / 512, kv = c >> 8, cc = c & 255;
                out[os + i] = bf2f(P[(size_t)(TP + r) * A_IN + RW + kv * RW + g * 256 + cc]); } }
        bf16* H = WSP(bf16, WS_H); const float* BT = WSP(float, WS_BT);
        for (int unit = blockIdx.x; unit < 256; unit += C.G) attn_a_unit(C, P, MKV, H, BT, unit);
        for (int task = C.gw; task < NSAMP * 4; task += C.NGW) { const int m = TP + (task >> 2), hh = task & 3;
            float Mx = -3.0e38f, Ss = 0.f, O = 0.f;
            attn_group<0>(P, BT, INP(4), m, hh, C.lane, Mx, Ss, O);
            attn_group<1>(P, BT, INP(5), m, hh, C.lane, Mx, Ss, O);
            attn_group<2>(P, BT, INP(6), m, hh, C.lane, Mx, Ss, O);
            const bf16* prow = P + (size_t)m * A_IN;
            const float om = cross_attn_task(MKV, INP(3), prow + 2304 + hh * 64, m, hh, 0, C.lane);
            const float g0 = bf2f(prow[2560 + hh * 64 + C.lane]), g1 = bf2f(prow[2560 + 256 + hh * 64 + C.lane]);
            H[(size_t)m * 512 + hh * 64 + C.lane] = (bf16)f2bf((O / Ss) * silu(g0));
            H[(size_t)m * 512 + 256 + hh * 64 + C.lane] = (bf16)f2bf(om * silu(g1)); }
    } SEAM(2);
    if (IN(3)) { MKCTX(); GEMM_BF16(WSP(bf16, WS_H), WSP(bf16, WS_WAOUT), WSP(bf16, WS_F), MROWS, DM, 512); } SEAM(3);
    if (IN(4)) { MKCTX();
        for (int m = C.gw; m < NREAL; m += C.NGW) { const bool samp = m >= TP;
            row_pass(WSP(bf16, WS_F) + (size_t)m * DM, samp ? INP(1) + (size_t)(m - TP) * DM : INP(0) + (size_t)m * DM,
                     args.out + (samp ? O_YS + (size_t)(m - TP) * DM : O_YP + (size_t)m * DM), INP(10), WSP(bf16, WS_XN) + (size_t)m * DM, C.lane); }
    } SEAM(4);
    if (IN(5)) { MKCTX(); GEMM_BF16(WSP(bf16, WS_XN), WSP(bf16, WS_WBIN), WSP(bf16, WS_P), MROWS, B_INP, DM); } SEAM(5);
    if (IN(6)) { MKCTX();
        const bf16* P = WSP(bf16, WS_P); bf16* TW = WSP(bf16, WS_TW); const float* mu = INP(18); const float* stsh = INP(8);
        for (int m = C.gw; m < NREAL; m += C.NGW) {
            const bool samp = m >= TP; const int t = samp ? ((m - TP) & 3) : (m & 2047), sb = (m - TP) >> 2;
#pragma unroll
            for (int j = 0; j < 2; ++j) { const int c = 2304 + j * 64 + C.lane;
                const float cur = bf2f(P[(size_t)m * B_INP + c]);
                float prev = 0.f; if (t > 0) prev = bf2f(P[(size_t)(m - 1) * B_INP + c]); else if (samp) prev = stsh[(size_t)sb * CSH + c];
                const float xs = cur + mu[c] * (prev - cur);
                TW[(size_t)m * 128 + j * 64 + C.lane] = (bf16)f2bf(j == 0 ? tanhf(xs) : xs); }
        }
    } SEAM(6);
    if (IN(7)) { MKCTX(); GEMM_BF16(WSP(bf16, WS_TW), WSP(bf16, WS_WL), WSP(bf16, WS_F), MROWS, 1536, 128); } SEAM(7);
    if (IN(8)) { MKCTX();
        const bf16* P = WSP(bf16, WS_P); bf16* H = WSP(bf16, WS_H);
        for (int unit = blockIdx.x; unit < 256; unit += C.G) attn_b_unit(C, P, WSP(bf16, WS_MKV), H, unit);
        __syncthreads();
        { ScanP sp{WSP(bf16, WS_P), WSP(bf16, WS_F), WSP(bf16, WS_H), args.out, INP(7), INP(8), INP(18), INP(19), INP(21), INP(23), INP(24), INP(25), INP(26), INP(27)};
          for (int u = blockIdx.x; u < 480; u += C.G) scan_unit(C, sp, u); }
        for (int task = C.gw; task < NSAMP * 4; task += C.NGW) { const int m = TP + (task >> 2), hh = task & 3;
            const bf16* prow = P + (size_t)m * B_INP;
            const float om = cross_attn_task(WSP(bf16, WS_MKV), INP(3), prow + CSH + hh * 64, m, hh, 1, C.lane);
            H[(size_t)m * 1024 + RW + hh * 64 + C.lane] = (bf16)f2bf(om * silu(bf2f(prow[2688 + RW + hh * 64 + C.lane]))); }
        for (int i = gt; i < NBATCH * CSH; i += NGT) { const int b = i / CSH, c = i % CSH; args.out[O_SHP + i] = bf2f(P[(size_t)(b * SEQ + SEQ - 1) * B_INP + c]); }
        for (int i = gt; i < SBATCH * CSH; i += NGT) { const int sb = i / CSH, c = i % CSH; args.out[O_SHS + i] = bf2f(P[(size_t)(TP + sb * 4 + 3) * B_INP + c]); }
    } SEAM(8);
    if (IN(9)) { MKCTX(); GEMM_BF16(WSP(bf16, WS_H), WSP(bf16, WS_WBOUT), WSP(bf16, WS_F), MROWS, DM, DM); } SEAM(9);
    if (IN(10)) { MKCTX();
        for (int m = C.gw; m < NREAL; m += C.NGW) { const bool samp = m >= TP;
            float* xo = args.out + (samp ? O_YS + (size_t)(m - TP) * DM : O_YP + (size_t)m * DM);
            row_pass(WSP(bf16, WS_F) + (size_t)m * DM, xo, xo, INP(10) + DM, nullptr, C.lane); }
    }
#undef IN
#undef SEAM
}

extern "C" void kernel_launch(void* const* d_in, const int* in_sizes, int n_in, void* d_out, int out_size, void* d_ws, size_t ws_size, hipStream_t stream) {
    static int grid = 0;
    if (grid == 0) {
        if (n_in != 28 || in_sizes[0] != TP * DM || (size_t)out_size != O_END || ws_size < WS_END) {
            fprintf(stderr, "kernel_launch: unexpected shapes: n_in %d in0 %d out %d ws %zu (need >= %zu); nothing launched\n", n_in, n_in > 0 ? in_sizes[0] : -1, out_size, ws_size, (size_t)WS_END); grid = -1; return; }
        int dev = 0, cus = 0, per_cu = 0;
        if (hipGetDevice(&dev) != hipSuccess || hipDeviceGetAttribute(&cus, hipDeviceAttributeMultiprocessorCount, dev) != hipSuccess) { fprintf(stderr, "kernel_launch: device query failed\n"); grid = -1; return; }
        if (hipFuncSetAttribute((const void*)hyb_fwd, hipFuncAttributeMaxDynamicSharedMemorySize, LDS_BYTES) != hipSuccess) { fprintf(stderr, "kernel_launch: hipFuncSetAttribute failed\n"); grid = -1; return; }
        if (hipOccupancyMaxActiveBlocksPerMultiprocessor(&per_cu, (const void*)hyb_fwd, NWAVES * 64, LDS_BYTES) != hipSuccess || per_cu < 1) {
            fprintf(stderr, "kernel_launch: occupancy query reports %d workgroups per CU\n", per_cu); }
        (void)hipGetLastError();
        grid = cus;
    }
    if (grid < 0) return;
    if (hipMemsetAsync((char*)d_ws + WS_CTL, 0, CTL_ZERO_BYTES, stream) != hipSuccess) { fprintf(stderr, "kernel_launch: memset failed\n"); return; }
    Args a{};
    for (int i = 0; i < 28; ++i) a.in[i] = (const float*)d_in[i];
    a.out = (float*)d_out; a.ws = (unsigned char*)d_ws;
#if MK_N_LAUNCHES == 1
    a.ph_lo = 0; a.ph_hi = N_PHASES;
    hipLaunchKernelGGL(hyb_fwd, dim3(grid), dim3(NWAVES * 64), LDS_BYTES, stream, a);
#else
    for (int li = 0; li < N_PHASES; ++li) { a.ph_lo = li; a.ph_hi = li + 1;
        hipLaunchKernelGGL(hyb_fwd, dim3(grid), dim3(NWAVES * 64), LDS_BYTES, stream, a); }
#endif
    const hipError_t le = hipPeekAtLastError();
    if (le != hipSuccess) fprintf(stderr, "kernel_launch: launch failed: %s\n", hipGetErrorName(le));
}
```

```cpp
#include <hip/hip_runtime.h>
#include <cstdio>
#include <cstdint>
namespace pg8 {
#define PG8_LAS __attribute__((address_space(3)))
typedef unsigned short bf16_t;
typedef short bf16x8 __attribute__((ext_vector_type(8)));
typedef float f32x4 __attribute__((ext_vector_type(4)));
typedef unsigned u32x4 __attribute__((ext_vector_type(4)));
constexpr int BM = 256, BK = 64, HALF = 128, HTB = HALF * BK * 2  , STAGE_BYTES = 8 * HTB, NXCD = 8, WGM = 8;

__host__ __device__ __forceinline__ int lds_byte(int r, int c) { const int st = (r >> 4) * 2 + (c >> 5), rr = r & 15, cc = c & 31, ob = rr * 64 + cc * 2; return st * 1024 + (ob ^ (((ob >> 9) & 1) << 5)); }
__host__ __device__ __forceinline__ void stage_rc(int b, int& R, int& C) { const int st = b / 1024, sb = b % 1024, swz = sb ^ (((sb >> 9) & 1) << 5); R = (st >> 1) * 16 + swz / 64; C = (st & 1) * 32 + (swz % 64) / 2; }
__host__ __device__ __forceinline__ int perm32(int rho) { const int n = rho >> 4, i = rho & 15; return 8 * (i >> 2) + 4 * n + (i & 3); }

struct Unit { int pm, pn; };
struct Gemm { const bf16_t* A; const bf16_t* Bt; int M, N, K; };

struct StaticOrder {
    int nM, nN, nwg, G, c;
    __host__ __device__ void init(int M, int N, int G_, int c_) { nM = M / BM; nN = N / BM; nwg = nM * nN; G = G_; c = c_; }
    __host__ __device__ bool next(int i, Unit& u) const {
        const long L = (long)i * G + c; if (L >= nwg) return false;
        int wgid = (int)L; { const int q = nwg / NXCD, r = nwg % NXCD, xcd = wgid % NXCD, off = wgid / NXCD; wgid = (xcd < r ? xcd * (q + 1) : r * (q + 1) + (xcd - r) * q) + off; }
        const int nig = WGM * nN, gid = wgid / nig, fm = gid * WGM, gsz = (nM - fm) < WGM ? (nM - fm) : WGM;
        u.pm = fm + ((wgid % nig) % gsz); u.pn = (wgid % nig) / gsz; return true;
    }
    __device__ __forceinline__ void a_ready(const Unit&) const {}
    __device__ __forceinline__ void done(const Unit&) const {}
};

__device__ __forceinline__ unsigned cvt_pk_bf16(float lo, float hi) { unsigned r; asm volatile("v_cvt_pk_bf16_f32 %0, %1, %2" : "=v"(r) : "v"(lo), "v"(hi)); return r; }
typedef float f32x2 __attribute__((ext_vector_type(2)));
__device__ __forceinline__ f32x2 gelu_pk(f32x2 v) {
    const f32x2 av = __builtin_elementwise_abs(v), d = av * 0.2316418882f + 1.0f;
    f32x2 t; t.x = __builtin_amdgcn_rcpf(d.x); t.y = __builtin_amdgcn_rcpf(d.y);
    f32x2 q = t * 0.5307027145f + (-0.7265760135f); q = q * t + 0.7107068705f; q = q * t + (-0.142248368f); q = q * t + 0.127414796f; q = q * t;
    const f32x2 s = (v * v) * (-0.72134752044f);
    f32x2 e; e.x = __builtin_amdgcn_exp2f(s.x); e.y = __builtin_amdgcn_exp2f(s.y);
    const f32x2 m = v * (q * e), r = v - m;
    f32x2 o; o.x = v.x < 0.f ? m.x : r.x; o.y = v.y < 0.f ? m.y : r.y; return o;
}

template <int ACT  > struct EpiBf16 {
    static constexpr bool PERM = true, AFTER_DRAIN = false; static_assert(ACT == 0 || ACT == 1, "EpiBf16: ACT is 0 (none) or 1 (gelu_pk)");
    bf16_t* O; int ldc; const float* bias; int split_cols; size_t split_stride; float scale0;
    __device__ __forceinline__ void operator()(const f32x4 (&acc)[2][2][4][2], const Unit& u, int wr, int wc, int fr, int fq) const {
        const int row0 = u.pm * BM + wr * 64 + fr; int colt = u.pn * BM; bf16_t* base = O;
        float sc = 1.f; if (split_cols) { const int t = colt / split_cols; base += (size_t)t * split_stride; colt -= t * split_cols; if (t == 0) sc = scale0; }
        const int col0 = colt + wc * 32 + 8 * fq, bcol0 = u.pn * BM + wc * 32 + 8 * fq;
        f32x4 bv[2][2];
#pragma unroll
        for (int bj = 0; bj < 2; ++bj)
#pragma unroll
            for (int n = 0; n < 2; ++n) bv[bj][n] = bias ? *(const f32x4*)(bias + bcol0 + bj * HALF + 4 * n) : (f32x4){0.f, 0.f, 0.f, 0.f};
#pragma unroll
        for (int ai = 0; ai < 2; ++ai)
#pragma unroll
            for (int m = 0; m < 4; ++m) { bf16_t* rowp = base + (size_t)(row0 + ai * HALF + m * 16) * ldc + col0;
#pragma unroll
                for (int bj = 0; bj < 2; ++bj) { f32x4 v0 = acc[ai][bj][m][0] + bv[bj][0], v1 = acc[ai][bj][m][1] + bv[bj][1];
                    if (ACT == 1) { f32x2 a = gelu_pk((f32x2){v0[0], v0[1]}), b = gelu_pk((f32x2){v0[2], v0[3]}), c = gelu_pk((f32x2){v1[0], v1[1]}), d = gelu_pk((f32x2){v1[2], v1[3]});
                        v0 = (f32x4){a.x, a.y, b.x, b.y}; v1 = (f32x4){c.x, c.y, d.x, d.y}; }
                    v0 = v0 * sc; v1 = v1 * sc; u32x4 w; w.x = cvt_pk_bf16(v0[0], v0[1]); w.y = cvt_pk_bf16(v0[2], v0[3]); w.z = cvt_pk_bf16(v1[0], v1[1]); w.w = cvt_pk_bf16(v1[2], v1[3]);
                    *(u32x4*)(rowp + bj * HALF) = w; } }
    }
};
template <class Epi, class Sched, bool ALIGN_EPI = false, bool SP2 = false>
__device__ __forceinline__ void gemm_phase(PG8_LAS unsigned char* lds, const Gemm g, const Sched& S, const Epi& E) {
    const int tid = threadIdx.x, wid = __builtin_amdgcn_readfirstlane(tid >> 6), lane = tid & 63, wr = wid >> 2, wc = wid & 3, fr = lane & 15, fq = lane >> 4;
    const int K = g.K, nt = K / BK;
    unsigned voffA[2], voffB[2];
#pragma unroll
    for (int i = 0; i < 2; ++i) { int R, C; stage_rc(tid * 16 + i * 8192, R, C); const int Rb = Epi::PERM ? ((R & ~31) + perm32(R & 31)) : R;
        voffA[i] = (unsigned)(R * K + C) * 2u; voffB[i] = (unsigned)(Rb * K + C) * 2u; }
    const size_t kstep = (size_t)(BK * 2);
    const size_t hstep = (size_t)HALF * K * 2;
    const size_t tstep = 2 * hstep;
    const unsigned ldsw = (unsigned)wid * 1024u;
    const int aoff = lds_byte(wr * 64 + fr, fq * 8), boff = lds_byte(wc * 32 + fr, fq * 8);
#define PG8_SA(b, h) (((b) * 2 + (h)) * HTB)
#define PG8_SB(b, h) ((4 + (b) * 2 + (h)) * HTB)
#define PG8_STAGE(bufoff, gbase, voff) do { _Pragma("unroll") for (int _i = 0; _i < 2; ++_i) \
        __builtin_amdgcn_global_load_lds((const unsigned*)((const char*)(gbase) + (voff)[_i]), (PG8_LAS unsigned*)(lds + (bufoff) + ldsw + _i * 8192), 16, 0, 0); } while (0)
#define PG8_LDA(dst, b, h) do { _Pragma("unroll") for (int m = 0; m < 4; ++m) _Pragma("unroll") for (int k = 0; k < 2; ++k) dst[m][k] = *(const PG8_LAS bf16x8*)(lds + PG8_SA(b, h) + aoff + m * 2048 + k * 1024); } while (0)
#define PG8_LDB(dst, b, h) do { _Pragma("unroll") for (int n = 0; n < 2; ++n) _Pragma("unroll") for (int k = 0; k < 2; ++k) dst[n][k] = *(const PG8_LAS bf16x8*)(lds + PG8_SB(b, h) + boff + n * 2048 + k * 1024); } while (0)
#define PG8_MMA(ai, bj, At, Bt) do { __builtin_amdgcn_s_setprio(1); _Pragma("unroll") for (int m = 0; m < 4; ++m) _Pragma("unroll") for (int n = 0; n < 2; ++n) _Pragma("unroll") for (int k = 0; k < 2; ++k) \
        acc[ai][bj][m][n] = __builtin_amdgcn_mfma_f32_16x16x32_bf16(Bt[n][k], At[m][k], acc[ai][bj][m][n], 0, 0, 0); __builtin_amdgcn_s_setprio(0); } while (0)
#define PG8_WAIT_V(n) asm volatile("s_waitcnt vmcnt(" #n ")" ::: "memory")
#define PG8_WAIT_L(n) asm volatile("s_waitcnt lgkmcnt(" #n ")" ::: "memory")
#define PG8_BAR __builtin_amdgcn_s_barrier()
#define PG8_SCHED __builtin_amdgcn_sched_barrier(0)
    Unit cur, nxt; int ui = 0;
    if (!S.next(0, cur)) return;
    f32x4 acc[2][2][4][2];
#pragma unroll
    for (int a = 0; a < 2; ++a)
#pragma unroll
        for (int b = 0; b < 2; ++b)
#pragma unroll
            for (int m = 0; m < 4; ++m)
#pragma unroll
                for (int n = 0; n < 2; ++n) acc[a][b][m][n] = (f32x4){0.f, 0.f, 0.f, 0.f};
    bf16x8 At[4][2], B0[2][2], B1[2][2];
    const char* cA = (const char*)g.A + (size_t)cur.pm * tstep; const char* cB = (const char*)g.Bt + (size_t)cur.pn * tstep;
    S.a_ready(cur);
    if constexpr (SP2) {
        PG8_STAGE(PG8_SB(0, 0), cB, voffB); PG8_STAGE(PG8_SB(0, 1), cB + hstep, voffB); PG8_STAGE(PG8_SA(0, 0), cA, voffA); PG8_STAGE(PG8_SA(0, 1), cA + hstep, voffA);
        if (wr == 1) PG8_BAR;
        PG8_WAIT_V(2); PG8_BAR;
        PG8_STAGE(PG8_SB(1, 0), cB + kstep, voffB); PG8_STAGE(PG8_SA(1, 0), cA + kstep, voffA); PG8_STAGE(PG8_SB(1, 1), cB + hstep + kstep, voffB);
        PG8_WAIT_V(6); PG8_BAR;
    } else {
        PG8_STAGE(PG8_SB(0, 0), cB, voffB); PG8_STAGE(PG8_SA(0, 0), cA, voffA); PG8_STAGE(PG8_SB(0, 1), cB + hstep, voffB); PG8_STAGE(PG8_SA(0, 1), cA + hstep, voffA);
        if (wr == 1) PG8_BAR;
        PG8_WAIT_V(4); PG8_BAR;
        PG8_STAGE(PG8_SB(1, 0), cB + kstep, voffB); PG8_STAGE(PG8_SA(1, 0), cA + kstep, voffA); PG8_STAGE(PG8_SB(1, 1), cB + hstep + kstep, voffB);
        PG8_WAIT_V(6); PG8_BAR;
    }
    for (;;) {
        const bool has_next = S.next(ui + 1, nxt);
        const char* nA = has_next ? (const char*)g.A + (size_t)nxt.pm * tstep : cA; const char* nB = has_next ? (const char*)g.Bt + (size_t)nxt.pn * tstep : cB;
        for (int t = 0; t < nt; t += 2) {
            const bool last = (t == nt - 2);
            const char* a1 = cA + (size_t)(t + 1) * kstep;
            const char* a2 = last ? nA : cA + (size_t)(t + 2) * kstep; const char* b2 = last ? nB : cB + (size_t)(t + 2) * kstep;
            const char* a3 = a2 + kstep; const char* b3 = b2 + kstep;
            if (last && has_next) S.a_ready(nxt);
            if constexpr (SP2) {
            PG8_LDB(B0, 0, 0); PG8_LDB(B1, 0, 1); PG8_SCHED; PG8_LDA(At, 0, 0); PG8_STAGE(PG8_SA(1, 1), a1 + hstep, voffA);
            PG8_WAIT_V(8); PG8_WAIT_L(0); PG8_BAR; PG8_MMA(0, 0, At, B0); PG8_MMA(0, 1, At, B1); PG8_BAR; PG8_SCHED;
            PG8_LDA(At, 0, 1); PG8_STAGE(PG8_SB(0, 0), b2, voffB); PG8_STAGE(PG8_SB(0, 1), b2 + hstep, voffB); PG8_STAGE(PG8_SA(0, 0), a2, voffA);
            PG8_WAIT_V(8); PG8_WAIT_L(0); PG8_BAR; PG8_MMA(1, 0, At, B0); PG8_MMA(1, 1, At, B1); PG8_BAR; PG8_SCHED;
            PG8_LDB(B0, 1, 0); PG8_LDB(B1, 1, 1); PG8_SCHED; PG8_LDA(At, 1, 0); PG8_STAGE(PG8_SA(0, 1), a2 + hstep, voffA);
            PG8_WAIT_V(8); PG8_WAIT_L(0); PG8_BAR; PG8_MMA(0, 0, At, B0); PG8_MMA(0, 1, At, B1); PG8_BAR; PG8_SCHED;
            PG8_LDA(At, 1, 1); PG8_STAGE(PG8_SB(1, 0), b3, voffB); PG8_STAGE(PG8_SB(1, 1), b3 + hstep, voffB); PG8_STAGE(PG8_SA(1, 0), a3, voffA);
            PG8_WAIT_V(8); PG8_WAIT_L(0); PG8_BAR; PG8_MMA(1, 0, At, B0); PG8_MMA(1, 1, At, B1); PG8_BAR; PG8_SCHED;
            } else {
            PG8_LDB(B0, 0, 0); PG8_SCHED; PG8_LDA(At, 0, 0); PG8_STAGE(PG8_SA(1, 1), a1 + hstep, voffA);
            PG8_WAIT_L(8); PG8_BAR; PG8_WAIT_L(0); PG8_MMA(0, 0, At, B0); PG8_BAR; PG8_SCHED;
            PG8_LDB(B1, 0, 1); PG8_STAGE(PG8_SB(0, 0), b2, voffB);
            PG8_BAR; PG8_WAIT_L(0); PG8_MMA(0, 1, At, B1); PG8_BAR;
            PG8_LDA(At, 0, 1); PG8_STAGE(PG8_SA(0, 0), a2, voffA);
            PG8_BAR; PG8_WAIT_L(0); PG8_MMA(1, 0, At, B0); PG8_BAR; PG8_SCHED;
            PG8_STAGE(PG8_SB(0, 1), b2 + hstep, voffB);
            PG8_WAIT_V(6); PG8_BAR; PG8_MMA(1, 1, At, B1); PG8_BAR;
            PG8_LDB(B0, 1, 0); PG8_SCHED; PG8_LDA(At, 1, 0); PG8_STAGE(PG8_SA(0, 1), a2 + hstep, voffA);
            PG8_WAIT_L(8); PG8_BAR; PG8_WAIT_L(0); PG8_MMA(0, 0, At, B0); PG8_BAR; PG8_SCHED;
            PG8_LDB(B1, 1, 1); PG8_STAGE(PG8_SB(1, 0), b3, voffB);
            PG8_BAR; PG8_WAIT_L(0); PG8_MMA(0, 1, At, B1); PG8_BAR;
            PG8_LDA(At, 1, 1); PG8_STAGE(PG8_SA(1, 0), a3, voffA);
            PG8_BAR; PG8_WAIT_L(0); PG8_MMA(1, 0, At, B0); PG8_BAR; PG8_SCHED;
            PG8_STAGE(PG8_SB(1, 1), b3 + hstep, voffB);
            PG8_WAIT_V(6); PG8_BAR; PG8_MMA(1, 1, At, B1); PG8_BAR;
            }
        }
        if constexpr (ALIGN_EPI) { if (wr == 0) PG8_BAR; }
        if constexpr (!Epi::AFTER_DRAIN) { E(acc, cur, wr, wc, fr, fq); S.done(cur); }
        if (!has_next) break;
#pragma unroll
        for (int a = 0; a < 2; ++a)
#pragma unroll
            for (int b = 0; b < 2; ++b)
#pragma unroll
                for (int m = 0; m < 4; ++m)
#pragma unroll
                    for (int n = 0; n < 2; ++n) acc[a][b][m][n] = (f32x4){0.f, 0.f, 0.f, 0.f};
        cur = nxt; cA = nA; cB = nB; ++ui;
        if constexpr (ALIGN_EPI) { if (wr == 1) PG8_BAR; }
    }
    PG8_WAIT_V(0);
    if constexpr (!ALIGN_EPI) { if (wr == 0) PG8_BAR; }
    PG8_BAR;
    if constexpr (Epi::AFTER_DRAIN) { E.fused(acc, cur, wr, wc, fr, fq, lds, wid, lane); S.done(cur); }
#undef PG8_SA
#undef PG8_SB
#undef PG8_STAGE
#undef PG8_LDA
#undef PG8_LDB
#undef PG8_MMA
#undef PG8_WAIT_V
#undef PG8_WAIT_L
#undef PG8_BAR
#undef PG8_SCHED
}
}

#ifndef PG8_SP2
#define PG8_SP2 true
#endif
#ifndef PG8_ALIGN
#define PG8_ALIGN true
#endif

constexpr int NWAVES = 8;
#ifndef MK_N_LAUNCHES
#define MK_N_LAUNCHES 1
#endif
constexpr int N_PHASES = 12;
constexpr int TP = 16384, NSAMP = 128, NREAL = TP + NSAMP, MROWS = 16640, DM = 1024;
constexpr int SEQ = 2048, NBATCH = 8, SBATCH = 32, STOK = 4, NMEM = 256;
constexpr int A_IN = 3072, B_IN = 3712, B_INP = 3840, CSH = 2432, RW = 768;
constexpr float RMS_EPS = 1e-6f, GN_EPS = 64e-5f;
constexpr size_t O_YP = 0, O_YS = 16777216, O_MEM = 16908288, O_W0P = 19005440, O_W1P = 19529728, O_W2P = 21626880,
                 O_W0S = 30015488, O_W1S = 30081024, O_W2S = 30146560, O_WKVP = 30212096, O_WKVS = 30605312, O_SHP = 32178176, O_SHS = 32197632, O_END = 32275456;
constexpr size_t MiB = 1u << 20;
constexpr size_t WS_CTL = 0, CTL_ZERO_BYTES = 1 * MiB;
constexpr size_t WS_WAIN = 1 * MiB, WS_WAOUT = 7 * MiB, WS_WBIN = 8 * MiB, WS_WBOUT = 16 * MiB, WS_WM = 18 * MiB, WS_WL = 20 * MiB, WS_BT = 20 * MiB + 512 * 1024;
constexpr size_t WS_MEMN = 21 * MiB, WS_MKV = 25 * MiB, WS_TW = 29 * MiB, WS_XN = 34 * MiB, WS_H = 67 * MiB, WS_F = 100 * MiB, WS_P = 149 * MiB, WS_END = 271 * MiB;
constexpr int CW_TMO = 0, CW_BAR = 4096;

constexpr int RING_OFF = 0, RING_BYTES = 161792;
constexpr int LDSCTL_OFF = RING_BYTES, MISC_OFF = LDSCTL_OFF + 320;
constexpr int LDS_BYTES = 163840;

#define GAS __attribute__((address_space(1)))
#define LAS __attribute__((address_space(3)))
typedef unsigned short bf16;
typedef unsigned v4u __attribute__((ext_vector_type(4)));
typedef unsigned v2u __attribute__((ext_vector_type(2)));
typedef float f32x4 __attribute__((ext_vector_type(4)));
typedef GAS unsigned gu32;
#define RLX_AGENT __ATOMIC_RELAXED, __HIP_MEMORY_SCOPE_AGENT
#define LDS_WAIT() asm volatile("s_waitcnt lgkmcnt(0)" ::: "memory")
#define VM_WAIT() asm volatile("s_waitcnt vmcnt(0)" ::: "memory")
__device__ __forceinline__ unsigned f2bf(float f) { unsigned u = __builtin_bit_cast(unsigned, f); return (u + 0x7fffu + ((u >> 16) & 1u)) >> 16; }
__device__ __forceinline__ unsigned pk2(float lo, float hi) { return f2bf(lo) | (f2bf(hi) << 16); }
__device__ __forceinline__ float bflo(unsigned u) { return __builtin_bit_cast(float, u << 16); }
__device__ __forceinline__ float bfhi(unsigned u) { return __builtin_bit_cast(float, u & 0xffff0000u); }
__device__ __forceinline__ float bf2f(bf16 h) { return __builtin_bit_cast(float, (unsigned)h << 16); }

#define XB_TMO      128
#define XB_XCNT(j)  (256  + 64 * (j))
#define XB_XSUB(j)  (1280 + 64 * (j))
#define XB_XGEN(j)  (2304 + 64 * (j))
#define XB_TOP      3328
#define XB_TOPGEN   3392
#define XCD_BAR_WORDS 3456
#define XB_SPIN_CAP (1u << 20)
__device__ __forceinline__ unsigned xb_ld(unsigned* p)              { return __hip_atomic_load(p, __ATOMIC_RELAXED, __HIP_MEMORY_SCOPE_AGENT); }
__device__ __forceinline__ unsigned xb_add(unsigned* p, unsigned v) { return __hip_atomic_fetch_add(p, v, __ATOMIC_RELAXED, __HIP_MEMORY_SCOPE_AGENT); }
__device__ __forceinline__ unsigned xb_xcc_id() { return (unsigned)__builtin_amdgcn_s_getreg((3 << 11) | 20) & 0xFu; }
#define XB_SPIN(cond, bar) do { unsigned _sp = 0; while (cond) { __builtin_amdgcn_s_sleep(1); \
    if ((++_sp & 255u) == 0u) { if (xb_ld(&(bar)[XB_TMO])) break; if (_sp > XB_SPIN_CAP) { atomicAdd(&(bar)[XB_TMO], 1u); break; } } } } while (0)
struct XcdBarrier { unsigned* bar; unsigned x; volatile LAS unsigned* st; };
__device__ __forceinline__ XcdBarrier xcd_barrier_post(unsigned* bar, volatile LAS unsigned* st) {
    XcdBarrier b; b.bar = bar; b.x = xb_xcc_id(); b.st = st;
    if (threadIdx.x == 0) (void)xb_add(&bar[XB_XCNT(b.x)], 1u);
    return b;
}
__device__ __forceinline__ void xcd_barrier_complete(unsigned* bar, unsigned x, unsigned& nloc, unsigned& nx) {
    const unsigned G = gridDim.x * gridDim.y * gridDim.z;
    unsigned sum, cnt, mine, sp = 0u;
    for (;;) {
        sum = 0u; cnt = 0u; mine = 0u;
#pragma unroll
        for (unsigned j = 0; j < 16; ++j) { const unsigned c = xb_ld(&bar[XB_XCNT(j)]); sum += c; cnt += (c > 0u) ? 1u : 0u; mine = (j == x) ? c : mine; }
        if (sum == G) break;
        __builtin_amdgcn_s_sleep(1);
        if ((++sp & 255u) == 0u) { if (xb_ld(&bar[XB_TMO])) break; if (sp > XB_SPIN_CAP) { atomicAdd(&bar[XB_TMO], 1u); break; } }
    }
    nloc = mine > 0u ? mine : 1u; nx = cnt > 0u ? cnt : 1u;
}
__device__ __forceinline__ void xcd_barrier(const XcdBarrier& b) {
    asm volatile("s_waitcnt vmcnt(0)" ::: "memory");
    __syncthreads();
    if (threadIdx.x == 0) {
        unsigned* bar = b.bar;
        __builtin_amdgcn_s_waitcnt(0);
        unsigned nloc = b.st[0], nx = b.st[1];
        if (nloc == 0u) { xcd_barrier_complete(bar, b.x, nloc, nx); b.st[0] = nloc; b.st[1] = nx; }
        const unsigned old = xb_add(&bar[XB_XSUB(b.x)], 1u);
        const unsigned gen = old / nloc;
        if (old + 1u == (gen + 1u) * nloc) {
            __builtin_amdgcn_fence(__ATOMIC_RELEASE, "agent");
            asm volatile("s_waitcnt vmcnt(0)" ::: "memory");
            const unsigned og = xb_add(&bar[XB_TOP], 1u);
            const unsigned tg = og / nx;
            if (og + 1u == (tg + 1u) * nx) xb_add(&bar[XB_TOPGEN], 1u);
            else XB_SPIN(xb_ld(&bar[XB_TOPGEN]) == tg, bar);
            __builtin_amdgcn_fence(__ATOMIC_ACQUIRE, "agent");
            xb_add(&bar[XB_XGEN(b.x)], 1u);
            asm volatile("s_waitcnt vmcnt(0)" ::: "memory");
        } else {
            XB_SPIN(xb_ld(&bar[XB_XGEN(b.x)]) == gen, bar);
            __builtin_amdgcn_fence(__ATOMIC_ACQUIRE, "agent");
            asm volatile("s_waitcnt vmcnt(0)" ::: "memory");
        }
    }
    __syncthreads();
}

struct Ctx { LAS unsigned char* lds; int tid, lane, wave, vcu, G, gw, NGW; };

__device__ __forceinline__ float wave_sum(float v) {
#pragma unroll
    for (int o = 1; o < 64; o <<= 1) v += __shfl_xor(v, o);
    return v;
}
__device__ __forceinline__ float wave_max(float v) {
#pragma unroll
    for (int o = 1; o < 64; o <<= 1) v = fmaxf(v, __shfl_xor(v, o));
    return v;
}
__device__ __forceinline__ float rdlane(float v, int l) { return __builtin_bit_cast(float, __builtin_amdgcn_readlane(__builtin_bit_cast(int, v), l)); }

__device__ __forceinline__ void p0_transpose_item(const float* W, int N, const float* gain, bf16* WT, int ldo, int col_off, int row_off, LAS float* scr, int item, int nblk, int lane) {
    const int kb = item / nblk, nb = item % nblk, k0 = 64 * kb, n0 = 32 * nb;
#pragma unroll 8
    for (int i = 0; i < 32; ++i) { const int kk = 2 * i + (lane >> 5); const float g = gain ? gain[k0 + kk] : 1.f; scr[kk * 33 + (lane & 31)] = W[(size_t)(k0 + kk) * N + n0 + (lane & 31)] * g; }
    LDS_WAIT(); asm volatile("" ::: "memory");
    const int c = lane & 7;
#pragma unroll
    for (int j = 0; j < 4; ++j) { const int n = (lane >> 3) + 8 * j; const LAS float* s = scr + (8 * c) * 33 + n;
        v4u o; o.x = pk2(s[0 * 33], s[1 * 33]); o.y = pk2(s[2 * 33], s[3 * 33]); o.z = pk2(s[4 * 33], s[5 * 33]); o.w = pk2(s[6 * 33], s[7 * 33]);
        *(GAS v4u*)(WT + (size_t)(row_off + n0 + n) * ldo + col_off + k0 + 8 * c) = o; }
    LDS_WAIT(); asm volatile("" ::: "memory");
}
__device__ __forceinline__ void rms_row_to_bf16(const float* xrow, bf16* orow, int lane) {
    const GAS f32x4* xr = (const GAS f32x4*)xrow + lane;
    f32x4 v[4]; float s = 0.f;
#pragma unroll
    for (int j = 0; j < 4; ++j) { v[j] = xr[64 * j]; s += (v[j].x * v[j].x + v[j].y * v[j].y) + (v[j].z * v[j].z + v[j].w * v[j].w); }
    const float r = 1.f / sqrtf(wave_sum(s) * (1.f / DM) + RMS_EPS);
    GAS unsigned long long* o8 = (GAS unsigned long long*)orow + lane;
#pragma unroll
    for (int j = 0; j < 4; ++j) o8[64 * j] = (unsigned long long)pk2(v[j].x * r, v[j].y * r) | ((unsigned long long)pk2(v[j].z * r, v[j].w * r) << 32);
}
__device__ __forceinline__ int t5_bucket(int dist) {
    if (dist < 16) return dist;
    const double x = log((double)dist / 16.0) / log(128.0) * 16.0;
    int large = 16 + (int)x; return large < 31 ? large : 31;
}

__device__ __forceinline__ void ldq64(const bf16* p, float (&q)[64]) {
#pragma unroll
    for (int i = 0; i < 8; ++i) { const v4u u = *(const GAS v4u*)(p + 8 * i);
        q[8 * i + 0] = bflo(u.x); q[8 * i + 1] = bfhi(u.x); q[8 * i + 2] = bflo(u.y); q[8 * i + 3] = bfhi(u.y);
        q[8 * i + 4] = bflo(u.z); q[8 * i + 5] = bfhi(u.z); q[8 * i + 6] = bflo(u.w); q[8 * i + 7] = bfhi(u.w); }
}
__device__ __forceinline__ float dot64_bf(const float (&q)[64], const bf16* p) {
    float s0 = 0.f, s1 = 0.f;
#pragma unroll
    for (int i = 0; i < 8; ++i) { const v4u u = *(const GAS v4u*)(p + 8 * i);
        s0 += q[8 * i + 0] * bflo(u.x); s1 += q[8 * i + 1] * bfhi(u.x); s0 += q[8 * i + 2] * bflo(u.y); s1 += q[8 * i + 3] * bfhi(u.y);
        s0 += q[8 * i + 4] * bflo(u.z); s1 += q[8 * i + 5] * bfhi(u.z); s0 += q[8 * i + 6] * bflo(u.w); s1 += q[8 * i + 7] * bfhi(u.w); }
    return s0 + s1;
}
__device__ __forceinline__ float dot64_f32(const float (&q)[64], const float* p) {
    float s0 = 0.f, s1 = 0.f;
#pragma unroll
    for (int i = 0; i < 16; ++i) { const f32x4 u = *(const GAS f32x4*)(p + 4 * i);
        s0 += q[4 * i + 0] * u.x; s1 += q[4 * i + 1] * u.y; s0 += q[4 * i + 2] * u.z; s1 += q[4 * i + 3] * u.w; }
    return s0 + s1;
}
__device__ __forceinline__ float silu(float x) { return x / (1.f + __expf(-x)); }

__device__ __forceinline__ float cross_attn_task(const bf16* MKV, const float* c_mem, const bf16* qptr, int m, int hh, int layer, int lane) {
    float q[64]; ldq64(qptr, q);
    const bool samp = m >= TP;
    float l[4]; float mx = -3.0e38f, o = 0.f, s = 0.f;
    if (!samp) {
        const bf16* kb = MKV + (size_t)((m >> 11) * NMEM) * 1024 + layer * 512 + hh * 64;
#pragma unroll
        for (int r = 0; r < 4; ++r) { l[r] = dot64_bf(q, kb + (size_t)(r * 64 + lane) * 1024) * 0.125f; mx = fmaxf(mx, l[r]); }
        mx = wave_max(mx);
#pragma unroll
        for (int r = 0; r < 4; ++r) { l[r] = __expf(l[r] - mx); s += l[r]; }
        s = wave_sum(s);
#pragma unroll
        for (int r = 0; r < 4; ++r)
            for (int kk = 0; kk < 64; ++kk) o += rdlane(l[r], kk) * bf2f(kb[(size_t)(r * 64 + kk) * 1024 + 256 + lane]);
    } else {
        const float* kf = c_mem + ((size_t)(layer * SBATCH + ((m - TP) >> 2)) * NMEM) * 512 + hh * 64;
#pragma unroll
        for (int r = 0; r < 4; ++r) { l[r] = dot64_f32(q, kf + (size_t)(r * 64 + lane) * 512) * 0.125f; mx = fmaxf(mx, l[r]); }
        mx = wave_max(mx);
#pragma unroll
        for (int r = 0; r < 4; ++r) { l[r] = __expf(l[r] - mx); s += l[r]; }
        s = wave_sum(s);
#pragma unroll
        for (int r = 0; r < 4; ++r)
            for (int kk = 0; kk < 64; ++kk) o += rdlane(l[r], kk) * kf[(size_t)(r * 64 + kk) * 512 + 256 + lane];
    }
    return o / s;
}

template <int G>
__device__ __forceinline__ void attn_group(const bf16* P, const float* BT, const float* cw, int m, int hh, int lane, float& Mx, float& Ss, float& O) {
    constexpr int dil = G == 0 ? 1 : (G == 1 ? 4 : 16), Wg = G == 0 ? 128 : (G == 1 ? 512 : 2048), head0 = G * 4;
    const bool samp = m >= TP;
    const int b = m >> 11, t = m & 2047, sb = (m - TP) >> 2, st = (m - TP) & 3, head = head0 + hh;
    float q[64]; ldq64(P + (size_t)m * A_IN + head * 64, q);
    const float* bt = BT + (G * 4 + hh) * 132;
    float l[3]; float gm = -3.0e38f;
#pragma unroll
    for (int r = 0; r < 3; ++r) { const int kidx = r * 64 + lane; float lv = -3.0e38f;
        if (kidx < 129) {
            if (!samp) { const int tk = t - dil * kidx; if (tk >= 0) lv = dot64_bf(q, P + (size_t)((b << 11) + tk) * A_IN + RW + head * 64) * 0.125f + bt[kidx]; }
            else { const int idx = Wg + st - dil * kidx;
                if (idx >= Wg) lv = dot64_bf(q, P + (size_t)(TP + sb * 4 + idx - Wg) * A_IN + RW + head * 64) * 0.125f + bt[kidx];
                else lv = dot64_f32(q, cw + ((size_t)(sb * Wg + idx) * 2) * 256 + hh * 64) * 0.125f + bt[kidx]; }
        }
        l[r] = lv; gm = fmaxf(gm, lv); }
    gm = wave_max(gm);
    const float Mn = fmaxf(Mx, gm), sc = __expf(Mx - Mn);
    float ps = 0.f;
#pragma unroll
    for (int r = 0; r < 3; ++r) { l[r] = l[r] > -1.0e38f ? __expf(l[r] - Mn) : 0.f; ps += l[r]; }
    Ss = Ss * sc + wave_sum(ps); O *= sc; Mx = Mn;
#pragma unroll
    for (int r = 0; r < 3; ++r)
        for (int kk = 0; kk < 64; ++kk) { const int kidx = r * 64 + kk; if (kidx >= 129) break;
            const float p = rdlane(l[r], kk);
            if (p != 0.f) { float v;
                if (!samp) { const int tk = t - dil * kidx; v = bf2f(P[(size_t)((b << 11) + tk) * A_IN + 2 * RW + head * 64 + lane]); }
                else { const int idx = Wg + st - dil * kidx;
                    if (idx >= Wg) v = bf2f(P[(size_t)(TP + sb * 4 + idx - Wg) * A_IN + 2 * RW + head * 64 + lane]);
                    else v = cw[((size_t)(sb * Wg + idx) * 2 + 1) * 256 + hh * 64 + lane]; }
                O += p * v; } }
}

typedef short s16x4 __attribute__((ext_vector_type(4)));
typedef short bf16x8 __attribute__((ext_vector_type(8)));
constexpr int VROW = 160;
constexpr int VBUF = 32 * VROW;
constexpr float LOG2E = 1.4426950408889634f;
template <int OFF> __device__ __forceinline__ s16x4 tr_read(unsigned vb) {
    s16x4 r; asm volatile("ds_read_b64_tr_b16 %0, %1 offset:%2" : "=&v"(r) : "v"(vb), "i"(OFF) : "memory"); return r;
}
struct AttnSt { float m, s; f32x4 o[4]; };
__device__ __forceinline__ void attn_init(AttnSt& st) { st.m = -1.0e30f; st.s = 0.f;
#pragma unroll
    for (int i = 0; i < 4; ++i) st.o[i] = (f32x4){0.f, 0.f, 0.f, 0.f}; }
__device__ __forceinline__ unsigned cvt_pk_bf16f(float lo, float hi) { unsigned r; asm volatile("v_cvt_pk_bf16_f32 %0, %1, %2" : "=v"(r) : "v"(lo), "v"(hi)); return r; }

template <bool MASKED>
__device__ __forceinline__ void attn_pairs(const bf16* kbase, const bf16* vbase, int pitch, int tb, int dil, int qs, int tmax, int j0, int j1,
                                           const bf16x8 (&qf)[2], const LAS float* bias2, LAS unsigned char* vbuf, int lane, AttnSt& st) {
    const int n = lane & 15, quad = lane >> 4, vr8 = lane >> 3, vc8 = lane & 7;
    const unsigned vwr = (unsigned)(size_t)vbuf + (unsigned)(vr8 * VROW + vc8 * 16);
    const unsigned vrd = (unsigned)(size_t)vbuf + (unsigned)((4 * quad + (n >> 2)) * VROW + 8 * (n & 3));
    const float C2 = 0.125f * LOG2E;
#pragma unroll 1
    for (int jp = j0; jp < j1; ++jp) {
        bf16x8 ka[2][2]; v4u vr[4];
#pragma unroll
        for (int tt = 0; tt < 2; ++tt) { int tk = tb + dil * (32 * jp + 16 * tt + n); if (MASKED) tk = tk < 0 ? 0 : (tk > tmax ? tmax : tk);
            const bf16* kp = kbase + (size_t)tk * pitch + 8 * quad;
            ka[tt][0] = __builtin_bit_cast(bf16x8, *(const GAS v4u*)kp); ka[tt][1] = __builtin_bit_cast(bf16x8, *(const GAS v4u*)(kp + 32)); }
#pragma unroll
        for (int c = 0; c < 4; ++c) { int tk = tb + dil * (32 * jp + 8 * c + vr8); if (MASKED) tk = tk < 0 ? 0 : (tk > tmax ? tmax : tk);
            vr[c] = *(const GAS v4u*)(vbase + (size_t)tk * pitch + 8 * vc8); }
        f32x4 sA = {0.f, 0.f, 0.f, 0.f}, sB = {0.f, 0.f, 0.f, 0.f};
        sA = __builtin_amdgcn_mfma_f32_16x16x32_bf16(ka[0][0], qf[0], sA, 0, 0, 0); sA = __builtin_amdgcn_mfma_f32_16x16x32_bf16(ka[0][1], qf[1], sA, 0, 0, 0);
        sB = __builtin_amdgcn_mfma_f32_16x16x32_bf16(ka[1][0], qf[0], sB, 0, 0, 0); sB = __builtin_amdgcn_mfma_f32_16x16x32_bf16(ka[1][1], qf[1], sB, 0, 0, 0);
        float l[8]; bool ok[8]; float mloc = -1.0e30f;
#pragma unroll
        for (int e = 0; e < 8; ++e) { const int u = 32 * jp + (e >> 2) * 16 + 4 * quad + (e & 3); const float a = (e < 4 ? sA[e & 3] : sB[e & 3]) * C2;
            if (MASKED) { const int kidx = 128 + qs * n - u; ok[e] = (kidx >= 0) && (kidx <= 128) && (tb + dil * u >= 0);
                const int kc = kidx < 0 ? 0 : (kidx > 128 ? 128 : kidx); l[e] = ok[e] ? a + bias2[kc] : -1.0e30f; }
            else { ok[e] = true; l[e] = a; }
            mloc = fmaxf(mloc, l[e]); }
        mloc = fmaxf(mloc, __shfl_xor(mloc, 16)); mloc = fmaxf(mloc, __shfl_xor(mloc, 32));
        const float mn = fmaxf(st.m, mloc), alpha = __builtin_amdgcn_exp2f(st.m - mn);
        float ps = 0.f; float p[8];
#pragma unroll
        for (int e = 0; e < 8; ++e) { p[e] = ok[e] ? __builtin_amdgcn_exp2f(l[e] - mn) : 0.f; ps += p[e]; }
        st.s = st.s * alpha + ps; st.m = mn;
#pragma unroll
        for (int i = 0; i < 4; ++i) st.o[i] = st.o[i] * alpha;
        v4u pk; pk.x = cvt_pk_bf16f(p[0], p[1]); pk.y = cvt_pk_bf16f(p[2], p[3]); pk.z = cvt_pk_bf16f(p[4], p[5]); pk.w = cvt_pk_bf16f(p[6], p[7]);
        const bf16x8 pb = __builtin_bit_cast(bf16x8, pk);
#pragma unroll
        for (int c = 0; c < 4; ++c) *(LAS v4u*)(size_t)(vwr + c * 8 * VROW) = vr[c];
        asm volatile("s_waitcnt lgkmcnt(0)" ::: "memory");
        const s16x4 a0 = tr_read<0>(vrd), b0 = tr_read<16 * VROW>(vrd), a1 = tr_read<32>(vrd), b1 = tr_read<16 * VROW + 32>(vrd);
        const s16x4 a2 = tr_read<64>(vrd), b2 = tr_read<16 * VROW + 64>(vrd), a3 = tr_read<96>(vrd), b3 = tr_read<16 * VROW + 96>(vrd);
        asm volatile("s_waitcnt lgkmcnt(0)" ::: "memory"); __builtin_amdgcn_sched_barrier(0);
#define PKV(L, H) (bf16x8){L[0], L[1], L[2], L[3], H[0], H[1], H[2], H[3]}
        st.o[0] = __builtin_amdgcn_mfma_f32_16x16x32_bf16(PKV(a0, b0), pb, st.o[0], 0, 0, 0);
        st.o[1] = __builtin_amdgcn_mfma_f32_16x16x32_bf16(PKV(a1, b1), pb, st.o[1], 0, 0, 0);
        st.o[2] = __builtin_amdgcn_mfma_f32_16x16x32_bf16(PKV(a2, b2), pb, st.o[2], 0, 0, 0);
        st.o[3] = __builtin_amdgcn_mfma_f32_16x16x32_bf16(PKV(a3, b3), pb, st.o[3], 0, 0, 0);
#undef PKV
        __builtin_amdgcn_sched_barrier(0);
    }
}
__device__ __forceinline__ void attn_store(const AttnSt& st, const bf16* gate_row  , bf16* out_row, int lane) {
    const int quad = lane >> 4;
    float s = st.s; s += __shfl_xor(s, 16); s += __shfl_xor(s, 32);
    const float inv = 1.f / s;
#pragma unroll
    for (int mt = 0; mt < 4; ++mt) { const v2u g = *(const GAS v2u*)(gate_row + 16 * mt + 4 * quad);
        const float o0 = st.o[mt][0] * inv * silu(bflo(g.x)), o1 = st.o[mt][1] * inv * silu(bfhi(g.x)), o2 = st.o[mt][2] * inv * silu(bflo(g.y)), o3 = st.o[mt][3] * inv * silu(bfhi(g.y));
        *(GAS v2u*)(out_row + 16 * mt + 4 * quad) = (v2u){pk2(o0, o1), pk2(o2, o3)}; }
}
__device__ __forceinline__ void load_qf(const bf16* qrow, int lane, bf16x8 (&qf)[2]) {
    const int quad = lane >> 4;
    qf[0] = __builtin_bit_cast(bf16x8, *(const GAS v4u*)(qrow + 8 * quad)); qf[1] = __builtin_bit_cast(bf16x8, *(const GAS v4u*)(qrow + 32 + 8 * quad));
}
__device__ __forceinline__ void attn_a_unit(const Ctx& C, const bf16* P, const bf16* MKV, bf16* H, const float* BT, int unit) {
    const int b = unit >> 5, hh = (unit >> 3) & 3, t0 = (unit & 7) * 256;
    LAS float* bias2 = (LAS float*)(C.lds + RING_OFF);
    LAS unsigned char* vbuf = C.lds + RING_OFF + 4096 + C.wave * VBUF;
    __syncthreads();
    for (int i = C.tid; i < 3 * 132; i += NWAVES * 64) { const int g = i / 132, k = i % 132; bias2[i] = k < 129 ? BT[(g * 4 + hh) * 132 + k] * LOG2E : 0.f; }
    __syncthreads();
    const int n = C.lane & 15;
    const bf16* Pb = P + (size_t)(b << 11) * A_IN;
#pragma unroll 1
    for (int set = 0; set < 2; ++set) {
        const int r = 2 * C.wave + set, tq = t0 + r + 16 * n;
        const bf16* qrow = Pb + (size_t)tq * A_IN;
        AttnSt st; attn_init(st);
#pragma unroll 1
        for (int g = 0; g < 3; ++g) {
            const int dil = g == 0 ? 1 : (g == 1 ? 4 : 16), qs = 16 / dil, np = g == 0 ? 12 : (g == 1 ? 6 : 5), head = g * 4 + hh;
            const int tb = t0 + r - 128 * dil;
            int j0 = 0; if (tb < 0) { j0 = (-tb - 31 * dil + 32 * dil - 1) / (32 * dil); if (j0 < 0) j0 = 0; }
            bf16x8 qf[2]; load_qf(qrow + head * 64, C.lane, qf);
            attn_pairs<true>(Pb + RW + head * 64, Pb + 2 * RW + head * 64, A_IN, tb, dil, qs, SEQ - 1, j0, np, qf, bias2 + g * 132, vbuf, C.lane, st);
        }
        attn_store(st, qrow + 2560 + hh * 64, H + ((size_t)(b << 11) + tq) * 512 + hh * 64, C.lane);
        AttnSt sm; attn_init(sm);
        { bf16x8 qf[2]; load_qf(qrow + 2304 + hh * 64, C.lane, qf);
          const bf16* kb = MKV + (size_t)(b * NMEM) * 1024 + hh * 64;
          attn_pairs<false>(kb, kb + 256, 1024, 0, 1, 0, NMEM - 1, 0, 8, qf, nullptr, vbuf, C.lane, sm); }
        attn_store(sm, qrow + 2560 + 256 + hh * 64, H + ((size_t)(b << 11) + tq) * 512 + 256 + hh * 64, C.lane);
    }
}
__device__ __forceinline__ void attn_b_unit(const Ctx& C, const bf16* P, const bf16* MKV, bf16* H, int unit) {
    const int b = unit >> 5, hh = (unit >> 3) & 3, t0 = (unit & 7) * 256;
    LAS unsigned char* vbuf = C.lds + RING_OFF + 4096 + C.wave * VBUF;
    const int n = C.lane & 15;
#pragma unroll 1
    for (int set = 0; set < 2; ++set) {
        const int r = 2 * C.wave + set, tq = t0 + r + 16 * n;
        const bf16* qrow = P + ((size_t)(b << 11) + tq) * B_INP;
        AttnSt sm; attn_init(sm);
        bf16x8 qf[2]; load_qf(qrow + CSH + hh * 64, C.lane, qf);
        const bf16* kb = MKV + (size_t)(b * NMEM) * 1024 + 512 + hh * 64;
        attn_pairs<false>(kb, kb + 256, 1024, 0, 1, 0, NMEM - 1, 0, 8, qf, nullptr, vbuf, C.lane, sm);
        attn_store(sm, qrow + 2688 + RW + hh * 64, H + ((size_t)(b << 11) + tq) * 1024 + RW + hh * 64, C.lane);
    }
}

__device__ __forceinline__ void row_pass(const bf16* hp, const float* xin, float* xout, const float* gpost, bf16* xn, int lane) {
    const GAS v2u* h2 = (const GAS v2u*)hp + lane; const GAS f32x4* xr = (const GAS f32x4*)xin + lane; const GAS f32x4* gp = (const GAS f32x4*)gpost + lane;
    f32x4 h[4], x[4]; float s = 0.f;
#pragma unroll
    for (int j = 0; j < 4; ++j) { const v2u u = h2[64 * j]; h[j] = (f32x4){bflo(u.x), bfhi(u.x), bflo(u.y), bfhi(u.y)}; x[j] = xr[64 * j];
        s += (h[j].x * h[j].x + h[j].y * h[j].y) + (h[j].z * h[j].z + h[j].w * h[j].w); }
    const float r = 1.f / sqrtf(wave_sum(s) * (1.f / DM) + RMS_EPS);
    float s2 = 0.f;
#pragma unroll
    for (int j = 0; j < 4; ++j) { const f32x4 g = gp[64 * j]; x[j] = x[j] + h[j] * r * g; s2 += (x[j].x * x[j].x + x[j].y * x[j].y) + (x[j].z * x[j].z + x[j].w * x[j].w);
        *((GAS f32x4*)xout + lane + 64 * j) = x[j]; }
    if (xn) { const float r2 = 1.f / sqrtf(wave_sum(s2) * (1.f / DM) + RMS_EPS);
        GAS unsigned long long* o8 = (GAS unsigned long long*)xn + lane;
#pragma unroll
        for (int j = 0; j < 4; ++j) o8[64 * j] = (unsigned long long)pk2(x[j].x * r2, x[j].y * r2) | ((unsigned long long)pk2(x[j].z * r2, x[j].w * r2) << 32); }
}

struct ScanP { const bf16 *P, *LORA; bf16* H; float* out; const float *st_wkv, *st_shift, *mu, *w0, *a0, *k_k, *k_a, *r_k, *ln_w, *ln_b; };
__device__ __forceinline__ void scan_unit(const Ctx& C, const ScanP& sp, int u) {
    LAS float* L = (LAS float*)(C.lds + RING_OFF);
    LAS float *LA = L, *LB = L + 4096, *LW = L + 8192, *LK = L + 12288, *LRW = L + 16384, *LV = L + 20480, *LSC = L + 24576, *LY = L + 24576 + 256;
    const bool samp = u >= 96; const int seq = samp ? (u - 96) / 12 : u / 12, h = samp ? (u - 96) % 12 : u % 12;
    const int T = samp ? STOK : SEQ, row0 = samp ? TP + seq * 4 : seq * SEQ;
    int row = C.wave * 8 + (C.lane >> 3), p = C.lane & 7;
    asm volatile("" : "+v"(row), "+v"(p));
    float S[8];
#pragma unroll
    for (int j = 0; j < 8; ++j) S[j] = samp ? sp.st_wkv[((size_t)(seq * 12 + h) * 64 + row) * 64 + p * 8 + j] : 0.f;
#pragma unroll 1
    for (int c0 = 0; c0 < T; c0 += 64) {
        const int n = (T - c0) < 64 ? (T - c0) : 64;
        int tok = C.tid >> 3, part = C.tid & 7;
        asm volatile("" : "+v"(tok), "+v"(part));
        __syncthreads();
        if (tok < n) {
            const int t = c0 + tok, m = row0 + t;
            const bf16* cur = sp.P + (size_t)m * B_INP; const bf16* prv = cur - B_INP; const bf16* lo = sp.LORA + (size_t)m * 1536;
            float xr[8], xk[8], xv[8], kk[8], av[8], dv[8];
            float nrm = 0.f;
#pragma unroll
            for (int j = 0; j < 8; ++j) { const int c = h * 64 + part * 8 + j;
                const float cr = bf2f(cur[c]), ck = bf2f(cur[RW + c]), cv = bf2f(cur[2 * RW + c]);
                float pr = 0.f, pk = 0.f, pv = 0.f;
                if (t > 0) { pr = bf2f(prv[c]); pk = bf2f(prv[RW + c]); pv = bf2f(prv[2 * RW + c]); }
                else if (samp) { const float* ss = sp.st_shift + (size_t)seq * CSH; pr = ss[c]; pk = ss[RW + c]; pv = ss[2 * RW + c]; }
                xr[j] = cr + sp.mu[c] * (pr - cr); xk[j] = ck + sp.mu[RW + c] * (pk - ck); xv[j] = cv + sp.mu[2 * RW + c] * (pv - cv);
                const float dpre = sp.w0[c] + bf2f(lo[c]), apre = sp.a0[c] + bf2f(lo[RW + c]);
                const float z = -dpre, spl = fmaxf(z, 0.f) + log1pf(expf(-fabsf(z)));
                const float wlog = -spl - 0.5f; dv[j] = expf(-expf(wlog));
                av[j] = 1.f / (1.f + expf(-apre));
                kk[j] = xk[j] * sp.k_k[c]; nrm += kk[j] * kk[j]; }
            nrm += __shfl_xor(nrm, 1); nrm += __shfl_xor(nrm, 2); nrm += __shfl_xor(nrm, 4);
            const float inv = 1.f / fmaxf(sqrtf(nrm), 1e-12f);
            float br = 0.f, kr = 0.f, bon = 0.f;
#pragma unroll
            for (int j = 0; j < 8; ++j) { const int c = h * 64 + part * 8 + j, d = part * 8 + j;
                const float kn = kk[j] * inv, k2 = xk[j] * (1.f + (av[j] - 1.f) * sp.k_a[c]);
                const float bb = kn * av[j];
                LA[tok * 64 + d] = -kn; LB[tok * 64 + d] = bb; LW[tok * 64 + d] = dv[j]; LK[tok * 64 + d] = k2; LRW[tok * 64 + d] = xr[j] * dv[j]; LV[tok * 64 + d] = xv[j];
                br += bb * xr[j]; kr += k2 * xr[j]; bon += xr[j] * k2 * sp.r_k[c]; }
            br += __shfl_xor(br, 1); br += __shfl_xor(br, 2); br += __shfl_xor(br, 4);
            kr += __shfl_xor(kr, 1); kr += __shfl_xor(kr, 2); kr += __shfl_xor(kr, 4);
            bon += __shfl_xor(bon, 1); bon += __shfl_xor(bon, 2); bon += __shfl_xor(bon, 4);
            if (part == 0) { LSC[tok * 4 + 0] = br; LSC[tok * 4 + 1] = kr; LSC[tok * 4 + 2] = bon; }
        }
        __syncthreads();
#pragma unroll 1
        for (int i = 0; i < n; ++i) {
            const LAS f32x4* a4 = (const LAS f32x4*)(LA + i * 64 + p * 8); const LAS f32x4* r4 = (const LAS f32x4*)(LRW + i * 64 + p * 8);
            const LAS f32x4* w4 = (const LAS f32x4*)(LW + i * 64 + p * 8); const LAS f32x4* b4 = (const LAS f32x4*)(LB + i * 64 + p * 8); const LAS f32x4* k4 = (const LAS f32x4*)(LK + i * 64 + p * 8);
            const f32x4 a0 = a4[0], a1 = a4[1], r0 = r4[0], r1 = r4[1];
            float sa = (S[0] * a0.x + S[1] * a0.y) + (S[2] * a0.z + S[3] * a0.w) + (S[4] * a1.x + S[5] * a1.y) + (S[6] * a1.z + S[7] * a1.w);
            float yp = (S[0] * r0.x + S[1] * r0.y) + (S[2] * r0.z + S[3] * r0.w) + (S[4] * r1.x + S[5] * r1.y) + (S[6] * r1.z + S[7] * r1.w);
            sa += __shfl_xor(sa, 1); sa += __shfl_xor(sa, 2); sa += __shfl_xor(sa, 4);
            yp += __shfl_xor(yp, 1); yp += __shfl_xor(yp, 2); yp += __shfl_xor(yp, 4);
            const float v = LV[i * 64 + row], br = LSC[i * 4 + 0], kr = LSC[i * 4 + 1];
            const f32x4 w0 = w4[0], w1 = w4[1], b0 = b4[0], b1 = b4[1], k0 = k4[0], k1 = k4[1];
            S[0] = S[0] * w0.x + sa * b0.x + v * k0.x; S[1] = S[1] * w0.y + sa * b0.y + v * k0.y; S[2] = S[2] * w0.z + sa * b0.z + v * k0.z; S[3] = S[3] * w0.w + sa * b0.w + v * k0.w;
            S[4] = S[4] * w1.x + sa * b1.x + v * k1.x; S[5] = S[5] * w1.y + sa * b1.y + v * k1.y; S[6] = S[6] * w1.z + sa * b1.z + v * k1.z; S[7] = S[7] * w1.w + sa * b1.w + v * k1.w;
            if (p == 0) LY[i * 64 + row] = yp + sa * br + v * kr;
        }
        __syncthreads();
        asm volatile("" : "+v"(tok), "+v"(part));
        if (tok < n) {
            const int m = row0 + c0 + tok;
            float y[8]; float s = 0.f;
#pragma unroll
            for (int j = 0; j < 8; ++j) { y[j] = LY[tok * 64 + part * 8 + j]; s += y[j]; }
            s += __shfl_xor(s, 1); s += __shfl_xor(s, 2); s += __shfl_xor(s, 4);
            const float mean = s * (1.f / 64.f); float q = 0.f;
#pragma unroll
            for (int j = 0; j < 8; ++j) { y[j] -= mean; q += y[j] * y[j]; }
            q += __shfl_xor(q, 1); q += __shfl_xor(q, 2); q += __shfl_xor(q, 4);
            const float rstd = 1.f / sqrtf(q * (1.f / 64.f) + GN_EPS), bon = LSC[tok * 4 + 2];
            unsigned w[4];
#pragma unroll
            for (int j = 0; j < 8; j += 2) { float o2[2];
#pragma unroll
                for (int e = 0; e < 2; ++e) { const int c = h * 64 + part * 8 + j + e;
                    const float yy = y[j + e] * rstd * sp.ln_w[c] + sp.ln_b[c] + bon * LV[tok * 64 + part * 8 + j + e];
                    o2[e] = yy * silu(bf2f(sp.P[(size_t)m * B_INP + 2688 + c])); }
                w[j >> 1] = pk2(o2[0], o2[1]); }
            *(GAS v4u*)(sp.H + (size_t)m * 1024 + h * 64 + part * 8) = (v4u){w[0], w[1], w[2], w[3]};
        }
    }
    float* so = sp.out + (samp ? O_WKVS : O_WKVP) + ((size_t)(seq * 12 + h) * 64 + row) * 64 + p * 8;
    *(GAS f32x4*)so = (f32x4){S[0], S[1], S[2], S[3]}; *((GAS f32x4*)so + 1) = (f32x4){S[4], S[5], S[6], S[7]};
    __syncthreads();
}

constexpr int TS = 72;
constexpr int IMG = 64 * TS * 2;
constexpr int L_AT = 0, L_RT = IMG, L_BT = 2 * IMG, L_KT = 3 * IMG, L_VV = 4 * IMG, L_SB = 5 * IMG, L_Z = 6 * IMG, L_SA = 7 * IMG,
              L_NKA = 8 * IMG, L_NBR = 9 * IMG, L_NKR = 10 * IMG, L_TT = 11 * IMG, L_E = 12 * IMG, L_PC = L_E + 16384, L_BON = L_PC + 256, L_SEG = L_BON + 256, L_CH_END = L_SEG + 2048;
constexpr int NSLOT = 7, L_SLOT0 = 3 * IMG + 16384 + 256 + 256 + 2048;
static_assert(L_CH_END <= RING_BYTES && L_SLOT0 + NSLOT * 16384 <= RING_BYTES, "chunk-scan LDS map");
constexpr int LA_AT = 0, LA_BT = IMG, LA_E = 2 * IMG, LA_PC = LA_E + 16384, LA_BON = LA_PC + 256, LA_SEG = LA_BON + 256;

struct ChunkP { const bf16 *P, *LORA; const float *mu, *w0, *a0, *k_k, *k_a, *r_k; };
struct PrepR { float xr[8], xv[8], kn[8], as[8], k2[8], e[8], bon; };
__device__ __forceinline__ void prep_step1(const ChunkP& cp, int m0, int t0tok, int h, int tok, int part, LAS unsigned char* lds, int offE, PrepR& R) {
    const int m = m0 + tok; const bool first = (t0tok + tok) == 0;
    const bf16* cur = cp.P + (size_t)m * B_INP + h * 64 + part * 8; const bf16* lo = cp.LORA + (size_t)m * 1536 + h * 64 + part * 8;
    const v4u cr4 = *(const GAS v4u*)cur, ck4 = *(const GAS v4u*)(cur + RW), cv4 = *(const GAS v4u*)(cur + 2 * RW);
    v4u pr4 = {0u, 0u, 0u, 0u}, pk4 = pr4, pv4 = pr4;
    if (!first) { pr4 = *(const GAS v4u*)(cur - B_INP); pk4 = *(const GAS v4u*)(cur - B_INP + RW); pv4 = *(const GAS v4u*)(cur - B_INP + 2 * RW); }
    const v4u lw4 = *(const GAS v4u*)lo, la4 = *(const GAS v4u*)(lo + RW);
    float xk[8], kk[8]; float nrm = 0.f;
#pragma unroll
    for (int j = 0; j < 8; ++j) { const int c = h * 64 + part * 8 + j;
        const unsigned ur = cr4[j >> 1], uk = ck4[j >> 1], uv = cv4[j >> 1], upr = pr4[j >> 1], upk = pk4[j >> 1], upv = pv4[j >> 1], ulw = lw4[j >> 1], ula = la4[j >> 1];
        const float cr = (j & 1) ? bfhi(ur) : bflo(ur), ck = (j & 1) ? bfhi(uk) : bflo(uk), cv = (j & 1) ? bfhi(uv) : bflo(uv);
        const float pr = (j & 1) ? bfhi(upr) : bflo(upr), pk = (j & 1) ? bfhi(upk) : bflo(upk), pv = (j & 1) ? bfhi(upv) : bflo(upv);
        const float lw = (j & 1) ? bfhi(ulw) : bflo(ulw), la = (j & 1) ? bfhi(ula) : bflo(ula);
        R.xr[j] = cr + cp.mu[c] * (pr - cr); xk[j] = ck + cp.mu[RW + c] * (pk - ck); R.xv[j] = cv + cp.mu[2 * RW + c] * (pv - cv);
        const float dpre = cp.w0[c] + lw, apre = cp.a0[c] + la;
        const float z = -dpre, spl = fmaxf(z, 0.f) + log1pf(expf(-fabsf(z)));
        R.e[j] = expf(-spl - 0.5f);
        R.as[j] = 1.f / (1.f + expf(-apre));
        kk[j] = xk[j] * cp.k_k[c]; nrm += kk[j] * kk[j]; }
    nrm += __shfl_xor(nrm, 1); nrm += __shfl_xor(nrm, 2); nrm += __shfl_xor(nrm, 4);
    const float inv = 1.f / fmaxf(sqrtf(nrm), 1e-12f);
    float bon = 0.f;
#pragma unroll
    for (int j = 0; j < 8; ++j) { const int c = h * 64 + part * 8 + j; R.kn[j] = kk[j] * inv; R.k2[j] = xk[j] * (1.f + (R.as[j] - 1.f) * cp.k_a[c]); bon += R.xr[j] * R.k2[j] * cp.r_k[c]; }
    bon += __shfl_xor(bon, 1); bon += __shfl_xor(bon, 2); bon += __shfl_xor(bon, 4);
    R.bon = bon;
    LAS float* E = (LAS float*)(lds + offE) + tok * 64 + part * 8;
    *(LAS f32x4*)E = (f32x4){R.e[0], R.e[1], R.e[2], R.e[3]}; *((LAS f32x4*)E + 1) = (f32x4){R.e[4], R.e[5], R.e[6], R.e[7]};
}
__device__ __forceinline__ void prep_cumsum(int tid, LAS unsigned char* lds, int offE, int offSEG) {
    LAS float* E = (LAS float*)(lds + offE); LAS float* SEG = (LAS float*)(lds + offSEG);
    const int d = tid & 63, seg = tid >> 6;
    float v[8]; float run = 0.f;
#pragma unroll
    for (int j = 0; j < 8; ++j) { run += E[(seg * 8 + j) * 64 + d]; v[j] = run; }
    SEG[seg * 64 + d] = run;
    __syncthreads();
    float off = 0.f;
#pragma unroll
    for (int s = 0; s < 7; ++s) off += (s < seg) ? SEG[s * 64 + d] : 0.f;
#pragma unroll
    for (int j = 0; j < 8; ++j) E[(seg * 8 + j) * 64 + d] = v[j] + off;
}
__device__ __forceinline__ void st8bf(LAS unsigned char* lds, int off, int tok, int part, const float (&x)[8]) {
    *(LAS v4u*)(lds + off + (tok * TS + part * 8) * 2) = (v4u){pk2(x[0], x[1]), pk2(x[2], x[3]), pk2(x[4], x[5]), pk2(x[6], x[7])};
}
template <bool FULL>
__device__ __forceinline__ void prep_step3(int tok, int part, LAS unsigned char* lds, int offE, int offAT, int offBT, int offRT, int offKT, int offVV, int offPC, int offBON, const PrepR& R) {
    const LAS float* E = (const LAS float*)(lds + offE) + tok * 64 + part * 8;
    const f32x4 c0 = *(const LAS f32x4*)E, c1 = *((const LAS f32x4*)E + 1);
    float at[8], bt[8], rt[8], kt[8];
#pragma unroll
    for (int j = 0; j < 8; ++j) { const float cum = j < 4 ? c0[j & 3] : c1[j & 3];
        const float pm1 = __expf(-(cum - R.e[j])), ip = __expf(cum);
        at[j] = -R.kn[j] * pm1; bt[j] = R.kn[j] * R.as[j] * ip;
        if (FULL) { const float pt = __expf(-cum); rt[j] = R.xr[j] * pt; kt[j] = R.k2[j] * ip;
            if (tok == 63) ((LAS float*)(lds + offPC))[part * 8 + j] = pt; } }
    st8bf(lds, offAT, tok, part, at); st8bf(lds, offBT, tok, part, bt);
    if (FULL) { st8bf(lds, offRT, tok, part, rt); st8bf(lds, offKT, tok, part, kt); st8bf(lds, offVV, tok, part, R.xv);
        if (part == 0) ((LAS float*)(lds + offBON))[tok] = R.bon; }
}
__device__ __forceinline__ bf16x8 frag_nat(const LAS unsigned char* img, int R0, int ks, int lane) {
    return __builtin_bit_cast(bf16x8, *(const LAS v4u*)(img + ((R0 + (lane & 15)) * TS + 32 * ks + 8 * (lane >> 4)) * 2));
}
__device__ __forceinline__ bf16x8 frag_tr(const LAS unsigned char* img, int I0, int ks, int lane) {
    const int i16 = lane & 15, quad = lane >> 4;
    const unsigned a = (unsigned)(size_t)img + (unsigned)(((32 * ks + 8 * quad + (i16 >> 2)) * TS + I0 + 4 * (i16 & 3)) * 2);
    const s16x4 lo = tr_read<0>(a), hi = tr_read<4 * TS * 2>(a);
    asm volatile("s_waitcnt lgkmcnt(0)" ::: "memory"); __builtin_amdgcn_sched_barrier(0);
    return (bf16x8){lo[0], lo[1], lo[2], lo[3], hi[0], hi[1], hi[2], hi[3]};
}
#define MFMA16(a, b, c) __builtin_amdgcn_mfma_f32_16x16x32_bf16((a), (b), (c), 0, 0, 0)
__device__ __forceinline__ void st_tile_T(LAS unsigned char* img, int C0, int R0, int lane, f32x4 v) {
    *(LAS v2u*)(img + ((C0 + (lane & 15)) * TS + R0 + 4 * (lane >> 4)) * 2) = (v2u){pk2(v[0], v[1]), pk2(v[2], v[3])};
}

__device__ __forceinline__ void scan_stage_a(const Ctx& C, const ChunkP& cp, bf16* TT, int task0, int ntask) {
    LAS unsigned char* lds = C.lds + RING_OFF;
    const int tok = C.tid >> 3, part = C.tid & 7, vs = C.wave & 3, rh = C.wave >> 2;
#pragma unroll 1
    for (int base = 0; base < ntask; base += NSLOT) {
        const int nr = (ntask - base) < NSLOT ? (ntask - base) : NSLOT;
#pragma unroll 1
        for (int s = 0; s < nr; ++s) {
            const int task = task0 + base + s, bh = task >> 5, c = task & 31, b = bh / 12, h = bh % 12;
            PrepR R;
            __syncthreads();
            prep_step1(cp, b * SEQ + c * 64, c * 64, h, tok, part, lds, LA_E, R);
            __syncthreads();
            prep_cumsum(C.tid, lds, LA_E, LA_SEG);
            __syncthreads();
            prep_step3<false>(tok, part, lds, LA_E, LA_AT, LA_BT, 0, 0, 0, 0, 0, R);
            __syncthreads();
            LAS float* slot = (LAS float*)(lds + L_SLOT0 + s * 16384);
            const bf16x8 b0 = frag_nat(lds + LA_AT, 16 * vs, 0, C.lane), b1 = frag_nat(lds + LA_AT, 16 * vs, 1, C.lane);
#pragma unroll
            for (int q = 0; q < 2; ++q) { const int it = 2 * rh + q;
                f32x4 acc = {0.f, 0.f, 0.f, 0.f};
                acc = MFMA16(frag_nat(lds + LA_BT, 16 * it, 0, C.lane), b0, acc); acc = MFMA16(frag_nat(lds + LA_BT, 16 * it, 1, C.lane), b1, acc);
                const int t = 16 * vs + (C.lane & 15), i0 = 16 * it + 4 * (C.lane >> 4);
                f32x4 o; o[0] = (i0 + 0 < t) ? acc[0] : 0.f; o[1] = (i0 + 1 < t) ? acc[1] : 0.f; o[2] = (i0 + 2 < t) ? acc[2] : 0.f; o[3] = (i0 + 3 < t) ? acc[3] : 0.f;
                *(LAS f32x4*)(slot + t * 64 + i0) = o; }
        }
        __syncthreads();
        if (C.wave < nr) {
            const LAS float* Nl = (const LAS float*)(lds + L_SLOT0 + C.wave * 16384);
            float Tr[64];
#pragma unroll
            for (int t = 0; t < 64; ++t) { float acc = (C.lane == t) ? 1.f : 0.f;
#pragma unroll
                for (int i = 0; i < t; ++i) acc += Tr[i] * Nl[t * 64 + i];
                Tr[t] = acc; }
            bf16* o = TT + (size_t)(task0 + base + C.wave) * 4096 + C.lane;
#pragma unroll
            for (int t = 0; t < 64; ++t) o[t * 64] = (bf16)f2bf(Tr[t]);
        }
    }
    __syncthreads();
}

struct ScanBP { ChunkP cp; const bf16* TT; bf16* H; float* out; const float *ln_w, *ln_b; };
__device__ __forceinline__ void scan_stage_b(const Ctx& C, const ScanBP& sb, int bh) {
    LAS unsigned char* lds = C.lds + RING_OFF;
    const int b = bh / 12, h = bh % 12;
    const int tok = C.tid >> 3, part = C.tid & 7, vs = C.wave & 3, rh = C.wave >> 2, l15 = C.lane & 15, quad = C.lane >> 4;
    f32x4 St[2] = {{0.f, 0.f, 0.f, 0.f}, {0.f, 0.f, 0.f, 0.f}};
    __syncthreads();
    for (int i = C.tid; i < IMG / 4; i += NWAVES * 64) ((LAS unsigned*)(lds + L_SB))[i] = 0u;
#pragma unroll 1
    for (int c = 0; c < 32; ++c) {
        const int m0 = b * SEQ + c * 64;
        PrepR R;
        __syncthreads();
        prep_step1(sb.cp, m0, c * 64, h, tok, part, lds, L_E, R);
        { const v4u tv = *((const GAS v4u*)(sb.TT + (size_t)(bh * 32 + c) * 4096) + C.tid);
          *(LAS v4u*)(lds + L_TT + ((C.tid >> 3) * TS + (C.tid & 7) * 8) * 2) = tv; }
        __syncthreads();
        prep_cumsum(C.tid, lds, L_E, L_SEG);
        __syncthreads();
        prep_step3<true>(tok, part, lds, L_E, L_AT, L_BT, L_RT, L_KT, L_VV, L_PC, L_BON, R);
        __syncthreads();
        {   const bf16x8 a0 = frag_nat(lds + L_AT, 16 * vs, 0, C.lane), a1 = frag_nat(lds + L_AT, 16 * vs, 1, C.lane);
            const bf16x8 r0 = frag_nat(lds + L_RT, 16 * vs, 0, C.lane), r1 = frag_nat(lds + L_RT, 16 * vs, 1, C.lane);
#pragma unroll
            for (int q = 0; q < 2; ++q) { const int it = 2 * rh + q;
                const bf16x8 k0 = frag_nat(lds + L_KT, 16 * it, 0, C.lane), k1 = frag_nat(lds + L_KT, 16 * it, 1, C.lane);
                const bf16x8 bb0 = frag_nat(lds + L_BT, 16 * it, 0, C.lane), bb1 = frag_nat(lds + L_BT, 16 * it, 1, C.lane);
                f32x4 nka = {0.f, 0.f, 0.f, 0.f}, nbr = nka, nkr = nka;
                nka = MFMA16(k0, a0, nka); nka = MFMA16(k1, a1, nka);
                nbr = MFMA16(bb0, r0, nbr); nbr = MFMA16(bb1, r1, nbr);
                nkr = MFMA16(k0, r0, nkr); nkr = MFMA16(k1, r1, nkr);
                const int t = 16 * vs + l15, i0 = 16 * it + 4 * quad;
#pragma unroll
                for (int e = 0; e < 4; ++e) { if (!(i0 + e < t)) nka[e] = 0.f; if (!(i0 + e <= t)) { nbr[e] = 0.f; nkr[e] = 0.f; } }
                st_tile_T(lds + L_NKA, 16 * vs, 16 * it, C.lane, nka); st_tile_T(lds + L_NBR, 16 * vs, 16 * it, C.lane, nbr); st_tile_T(lds + L_NKR, 16 * vs, 16 * it, C.lane, nkr); }
        }
        __syncthreads();
        {   const bf16x8 s0 = frag_nat(lds + L_SB, 16 * vs, 0, C.lane), s1 = frag_nat(lds + L_SB, 16 * vs, 1, C.lane);
            const bf16x8 v0 = frag_tr(lds + L_VV, 16 * vs, 0, C.lane), v1 = frag_tr(lds + L_VV, 16 * vs, 1, C.lane);
#pragma unroll
            for (int q = 0; q < 2; ++q) { const int tt = 2 * rh + q; f32x4 z = {0.f, 0.f, 0.f, 0.f};
                z = MFMA16(frag_nat(lds + L_AT, 16 * tt, 0, C.lane), s0, z); z = MFMA16(frag_nat(lds + L_AT, 16 * tt, 1, C.lane), s1, z);
                z = MFMA16(frag_nat(lds + L_NKA, 16 * tt, 0, C.lane), v0, z); z = MFMA16(frag_nat(lds + L_NKA, 16 * tt, 1, C.lane), v1, z);
                st_tile_T(lds + L_Z, 16 * vs, 16 * tt, C.lane, z); }
        }
        __syncthreads();
        {   const bf16x8 z0 = frag_nat(lds + L_Z, 16 * vs, 0, C.lane), z1 = frag_nat(lds + L_Z, 16 * vs, 1, C.lane);
#pragma unroll
            for (int q = 0; q < 2; ++q) { const int tt = 2 * rh + q; f32x4 sa = {0.f, 0.f, 0.f, 0.f};
                sa = MFMA16(frag_nat(lds + L_TT, 16 * tt, 0, C.lane), z0, sa); sa = MFMA16(frag_nat(lds + L_TT, 16 * tt, 1, C.lane), z1, sa);
                st_tile_T(lds + L_SA, 16 * vs, 16 * tt, C.lane, sa); }
        }
        __syncthreads();
        {   const bf16x8 s0 = frag_nat(lds + L_SB, 16 * vs, 0, C.lane), s1 = frag_nat(lds + L_SB, 16 * vs, 1, C.lane);
            const bf16x8 sa0 = frag_nat(lds + L_SA, 16 * vs, 0, C.lane), sa1 = frag_nat(lds + L_SA, 16 * vs, 1, C.lane);
            const bf16x8 v0 = frag_tr(lds + L_VV, 16 * vs, 0, C.lane), v1 = frag_tr(lds + L_VV, 16 * vs, 1, C.lane);
            f32x4 y[2], d[2];
#pragma unroll
            for (int q = 0; q < 2; ++q) { const int tt = 2 * rh + q; f32x4 yy = {0.f, 0.f, 0.f, 0.f};
                yy = MFMA16(frag_nat(lds + L_RT, 16 * tt, 0, C.lane), s0, yy); yy = MFMA16(frag_nat(lds + L_RT, 16 * tt, 1, C.lane), s1, yy);
                yy = MFMA16(frag_nat(lds + L_NBR, 16 * tt, 0, C.lane), sa0, yy); yy = MFMA16(frag_nat(lds + L_NBR, 16 * tt, 1, C.lane), sa1, yy);
                yy = MFMA16(frag_nat(lds + L_NKR, 16 * tt, 0, C.lane), v0, yy); yy = MFMA16(frag_nat(lds + L_NKR, 16 * tt, 1, C.lane), v1, yy);
                y[q] = yy;
                f32x4 dd = {0.f, 0.f, 0.f, 0.f};
                dd = MFMA16(frag_tr(lds + L_BT, 16 * tt, 0, C.lane), sa0, dd); dd = MFMA16(frag_tr(lds + L_BT, 16 * tt, 1, C.lane), sa1, dd);
                dd = MFMA16(frag_tr(lds + L_KT, 16 * tt, 0, C.lane), v0, dd); dd = MFMA16(frag_tr(lds + L_KT, 16 * tt, 1, C.lane), v1, dd);
                d[q] = dd; }
            __syncthreads();
            LAS float* Y = (LAS float*)(lds + L_E);
#pragma unroll
            for (int q = 0; q < 2; ++q) { const int r0 = 16 * (2 * rh + q) + 4 * quad, v = 16 * vs + l15;
#pragma unroll
                for (int e = 0; e < 4; ++e) Y[(r0 + e) * 64 + v] = y[q][e];
                const f32x4 pc = *(const LAS f32x4*)(lds + L_PC + r0 * 4);
                St[q] = (St[q] + d[q]) * pc;
                st_tile_T(lds + L_SB, 16 * vs, 16 * (2 * rh + q), C.lane, St[q]); }
        }
        __syncthreads();
        {   const int m = m0 + tok; const LAS float* Y = (const LAS float*)(lds + L_E) + tok * 64 + part * 8;
            const f32x4 y0 = *(const LAS f32x4*)Y, y1 = *((const LAS f32x4*)Y + 1);
            float y[8] = {y0[0], y0[1], y0[2], y0[3], y1[0], y1[1], y1[2], y1[3]}; float s = 0.f;
#pragma unroll
            for (int j = 0; j < 8; ++j) s += y[j];
            s += __shfl_xor(s, 1); s += __shfl_xor(s, 2); s += __shfl_xor(s, 4);
            const float mean = s * (1.f / 64.f); float qq = 0.f;
#pragma unroll
            for (int j = 0; j < 8; ++j) { y[j] -= mean; qq += y[j] * y[j]; }
            qq += __shfl_xor(qq, 1); qq += __shfl_xor(qq, 2); qq += __shfl_xor(qq, 4);
            const float rstd = 1.f / sqrtf(qq * (1.f / 64.f) + GN_EPS), bon = R.bon;
            const v4u g4 = *(const GAS v4u*)(sb.cp.P + (size_t)m * B_INP + 2688 + h * 64 + part * 8);
            float o[8];
#pragma unroll
            for (int j = 0; j < 8; ++j) { const int cc = h * 64 + part * 8 + j; const unsigned ug = g4[j >> 1]; const float g = (j & 1) ? bfhi(ug) : bflo(ug);
                o[j] = (y[j] * rstd * sb.ln_w[cc] + sb.ln_b[cc] + bon * R.xv[j]) * silu(g); }
            *(GAS v4u*)(sb.H + (size_t)m * 1024 + h * 64 + part * 8) = (v4u){pk2(o[0], o[1]), pk2(o[2], o[3]), pk2(o[4], o[5]), pk2(o[6], o[7])};
        }
    }
#pragma unroll
    for (int q = 0; q < 2; ++q) { float* so = sb.out + O_WKVP + ((size_t)bh * 64 + 16 * vs + l15) * 64 + 16 * (2 * rh + q) + 4 * quad; *(GAS f32x4*)so = St[q]; }
    __syncthreads();
}

constexpr int PTAB_OFF = LDSCTL_OFF + 512;
__device__ __forceinline__ const float* inptr(LAS unsigned char* ldsb, int i) {
    const LAS unsigned* p = (const LAS unsigned*)(ldsb + PTAB_OFF) + 2 * i;
    const unsigned lo = __builtin_amdgcn_readfirstlane(p[0]), hi = __builtin_amdgcn_readfirstlane(p[1]);
    return (const float*)(((unsigned long long)hi << 32) | lo);
}
struct Args { const float* in[28]; float* out; unsigned char* ws; int ph_lo, ph_hi; };
#define WSP(T, off) ((T*)(args.ws + (off)))
#define GEMM_BF16(Aptr, Bptr, Optr, Mv, Nv, Kv) do { pg8::Gemm g{Aptr, Bptr, Mv, Nv, Kv}; pg8::StaticOrder S; S.init(Mv, Nv, C.G, (int)blockIdx.x); \
        pg8::EpiBf16<0> E{Optr, Nv, nullptr, 0, 0, 1.f}; pg8::gemm_phase<pg8::EpiBf16<0>, pg8::StaticOrder, PG8_ALIGN, PG8_SP2>(C.lds + RING_OFF, g, S, E); } while (0)
__global__ void __launch_bounds__(NWAVES * 64, 2) hyb_fwd(Args args) {
    extern __shared__ __attribute__((aligned(16))) unsigned char lds[];
    LAS unsigned char* const ldsb = (LAS unsigned char*)lds;
    for (int u = threadIdx.x; u < (LDS_BYTES - LDSCTL_OFF) / 4; u += NWAVES * 64) ((LAS unsigned*)(ldsb + LDSCTL_OFF))[u] = 0u;
    __syncthreads();
    if (threadIdx.x < 28) ((LAS unsigned long long*)(ldsb + PTAB_OFF))[threadIdx.x] = (unsigned long long)args.in[threadIdx.x];
    __syncthreads();
#define INP(i) inptr(ldsb, (i))
#define MKCTX() Ctx C; { int t_ = threadIdx.x; asm volatile("" : "+v"(t_)); C.lds = ldsb; C.tid = t_; C.lane = t_ & 63; C.wave = __builtin_amdgcn_readfirstlane(t_ >> 6); \
        C.G = gridDim.x; const int bx_ = blockIdx.x; C.vcu = (C.G % 8 == 0) ? (bx_ % 8) * (C.G / 8) + bx_ / 8 : bx_; C.gw = C.vcu * NWAVES + C.wave; C.NGW = C.G * NWAVES; } \
        const int gt = C.gw * 64 + C.lane, NGT = C.NGW * 64; (void)gt; (void)NGT
    const int lo = args.ph_lo, hi = args.ph_hi;
    const bool fused = (hi - lo) > 1;
    XcdBarrier bar; bar.bar = WSP(unsigned, WS_CTL) + CW_BAR; bar.x = 0; bar.st = nullptr;
    if (fused) bar = xcd_barrier_post(WSP(unsigned, WS_CTL) + CW_BAR, (volatile LAS unsigned*)(ldsb + MISC_OFF) + 8);
#ifndef PROBE_PHASE
#define PROBE_PHASE -1
#endif
#define IN(k) (lo <= (k) && (k) < hi)
#define REP(k) for (int rep_ = 0; rep_ < ((k) == PROBE_PHASE ? 2 : 1); ++rep_)
#define SEAM(k) do { if (IN(k) && IN((k) + 1)) xcd_barrier(bar); } while (0)

    if (IN(0)) REP(0) { MKCTX();
        LAS float* scr = (LAS float*)(C.lds + RING_OFF + C.wave * 16384);
        constexpr int I0 = 16 * 96, I1 = 8 * 32, I2 = 16 * 116, I3 = 16 * 32, I4 = 16 * 16, I5 = 16 * 16, I6 = 24, I7 = 24;
        constexpr int NITEMS = I0 + I1 + I2 + I3 + I4 + I5 + I6 + I7;
        for (int it = C.gw; it < NITEMS; it += C.NGW) {
            int r = it;
            if (r < I0) { p0_transpose_item(INP(14), A_IN, INP(9), WSP(bf16, WS_WAIN), 1024, 0, 0, scr, r, 96, C.lane); continue; } r -= I0;
            if (r < I1) { p0_transpose_item(INP(15), 1024, nullptr, WSP(bf16, WS_WAOUT), 512, 0, 0, scr, r, 32, C.lane); continue; } r -= I1;
            if (r < I2) { p0_transpose_item(INP(16), B_IN, INP(9) + DM, WSP(bf16, WS_WBIN), 1024, 0, 0, scr, r, 116, C.lane); continue; } r -= I2;
            if (r < I3) { p0_transpose_item(INP(17), 1024, nullptr, WSP(bf16, WS_WBOUT), 1024, 0, 0, scr, r, 32, C.lane); continue; } r -= I3;
            if (r < I4) { p0_transpose_item(INP(12), 512, INP(11), WSP(bf16, WS_WM), 1024, 0, 0, scr, r, 16, C.lane); continue; } r -= I4;
            if (r < I5) { p0_transpose_item(INP(12) + 1024 * 512, 512, INP(11) + DM, WSP(bf16, WS_WM), 1024, 0, 512, scr, r, 16, C.lane); continue; } r -= I5;
            if (r < I6) { p0_transpose_item(INP(20), RW, nullptr, WSP(bf16, WS_WL), 128, 0, 0, scr, r, 24, C.lane); continue; } r -= I6;
            p0_transpose_item(INP(22), RW, nullptr, WSP(bf16, WS_WL), 128, 64, RW, scr, r, 24, C.lane);
        }
        const v4u z4 = {0u, 0u, 0u, 0u};
        for (int i = gt; i < 16384; i += NGT) *((GAS v4u*)(WSP(bf16, WS_WBIN) + (size_t)B_IN * 1024) + i) = z4;
        for (int i = gt; i < 1536 * 8; i += NGT) { const int n = i >> 3, c = i & 7; *(GAS v4u*)(WSP(bf16, WS_WL) + (size_t)n * 128 + (n < RW ? 64 : 0) + c * 8) = z4; }
        for (int i = gt; i < 128 * 128; i += NGT) *((GAS v4u*)(WSP(bf16, WS_XN) + (size_t)NREAL * 1024) + i) = z4;
        for (int i = gt; i < 3 * 4 * 129; i += NGT) { const int g = i / (4 * 129), r = i % (4 * 129), hh = r / 129, k = r % 129; const int dil = g == 0 ? 1 : (g == 1 ? 4 : 16);
            WSP(float, WS_BT)[(g * 4 + hh) * 132 + k] = INP(13)[t5_bucket(dil * k) * 12 + g * 4 + hh]; }
        for (int m = C.gw; m < NREAL + 2048; m += C.NGW) {
            if (m < TP) rms_row_to_bf16(INP(0) + (size_t)m * DM, WSP(bf16, WS_XN) + (size_t)m * DM, C.lane);
            else if (m < NREAL) rms_row_to_bf16(INP(1) + (size_t)(m - TP) * DM, WSP(bf16, WS_XN) + (size_t)m * DM, C.lane);
            else rms_row_to_bf16(INP(2) + (size_t)(m - NREAL) * DM, WSP(bf16, WS_MEMN) + (size_t)(m - NREAL) * DM, C.lane);
        }
    } SEAM(0);
    if (IN(1)) REP(1) { MKCTX();
        GEMM_BF16(WSP(bf16, WS_XN), WSP(bf16, WS_WAIN), WSP(bf16, WS_P), MROWS, A_IN, DM);
        GEMM_BF16(WSP(bf16, WS_MEMN), WSP(bf16, WS_WM), WSP(bf16, WS_MKV), 2048, 1024, DM);
    } SEAM(1);
    if (IN(2)) REP(2) { MKCTX();
        const bf16* P = WSP(bf16, WS_P); const bf16* MKV = WSP(bf16, WS_MKV); float* out = args.out;
        for (int i = gt; i < 2 * 2048 * 512; i += NGT) { const int l = i / (2048 * 512), r = (i / 512) % 2048, c = i % 512; out[O_MEM + i] = bf2f(MKV[(size_t)r * 1024 + l * 512 + c]); }
#pragma unroll
        for (int g = 0; g < 3; ++g) { const int Wg = g == 0 ? 128 : (g == 1 ? 512 : 2048); const size_t ob = g == 0 ? O_W0P : (g == 1 ? O_W1P : O_W2P);
            const int n = NBATCH * Wg * 512;
            for (int i = gt; i < n; i += NGT) { const int c = i % 512, ri = (i / 512) % Wg, b = i / (512 * Wg); const int t = SEQ - Wg + ri, kv = c >> 8, cc = c & 255;
                out[ob + i] = bf2f(P[(size_t)((b << 11) + t) * A_IN + RW + kv * RW + g * 256 + cc]); }
            const size_t os = g == 0 ? O_W0S : (g == 1 ? O_W1S : O_W2S);
            for (int i = gt; i < NSAMP * 512; i += NGT) { const int c = i % 512, r = i / 512, kv = c >> 8, cc = c & 255;
                out[os + i] = bf2f(P[(size_t)(TP + r) * A_IN + RW + kv * RW + g * 256 + cc]); } }
        bf16* H = WSP(bf16, WS_H); const float* BT = WSP(float, WS_BT);
        for (int unit = blockIdx.x; unit < 256; unit += C.G) attn_a_unit(C, P, MKV, H, BT, unit);
        for (int task = C.gw; task < NSAMP * 4; task += C.NGW) { const int m = TP + (task >> 2), hh = task & 3;
            float Mx = -3.0e38f, Ss = 0.f, O = 0.f;
            attn_group<0>(P, BT, INP(4), m, hh, C.lane, Mx, Ss, O);
            attn_group<1>(P, BT, INP(5), m, hh, C.lane, Mx, Ss, O);
            attn_group<2>(P, BT, INP(6), m, hh, C.lane, Mx, Ss, O);
            const bf16* prow = P + (size_t)m * A_IN;
            const float om = cross_attn_task(MKV, INP(3), prow + 2304 + hh * 64, m, hh, 0, C.lane);
            const float g0 = bf2f(prow[2560 + hh * 64 + C.lane]), g1 = bf2f(prow[2560 + 256 + hh * 64 + C.lane]);
            H[(size_t)m * 512 + hh * 64 + C.lane] = (bf16)f2bf((O / Ss) * silu(g0));
            H[(size_t)m * 512 + 256 + hh * 64 + C.lane] = (bf16)f2bf(om * silu(g1)); }
    } SEAM(2);
    if (IN(3)) REP(3) { MKCTX(); GEMM_BF16(WSP(bf16, WS_H), WSP(bf16, WS_WAOUT), WSP(bf16, WS_F), MROWS, DM, 512); } SEAM(3);
    if (IN(4)) REP(4) { MKCTX();
        for (int m = C.gw; m < NREAL; m += C.NGW) { const bool samp = m >= TP;
            row_pass(WSP(bf16, WS_F) + (size_t)m * DM, samp ? INP(1) + (size_t)(m - TP) * DM : INP(0) + (size_t)m * DM,
                     args.out + (samp ? O_YS + (size_t)(m - TP) * DM : O_YP + (size_t)m * DM), INP(10), WSP(bf16, WS_XN) + (size_t)m * DM, C.lane); }
    } SEAM(4);
    if (IN(5)) REP(5) { MKCTX(); GEMM_BF16(WSP(bf16, WS_XN), WSP(bf16, WS_WBIN), WSP(bf16, WS_P), MROWS, B_INP, DM); } SEAM(5);
    if (IN(6)) REP(6) { MKCTX();
        const bf16* P = WSP(bf16, WS_P); bf16* TW = WSP(bf16, WS_TW); const float* mu = INP(18); const float* stsh = INP(8);
        for (int m = C.gw; m < NREAL; m += C.NGW) {
            const bool samp = m >= TP; const int t = samp ? ((m - TP) & 3) : (m & 2047), sb = (m - TP) >> 2;
#pragma unroll
            for (int j = 0; j < 2; ++j) { const int c = 2304 + j * 64 + C.lane;
                const float cur = bf2f(P[(size_t)m * B_INP + c]);
                float prev = 0.f; if (t > 0) prev = bf2f(P[(size_t)(m - 1) * B_INP + c]); else if (samp) prev = stsh[(size_t)sb * CSH + c];
                const float xs = cur + mu[c] * (prev - cur);
                TW[(size_t)m * 128 + j * 64 + C.lane] = (bf16)f2bf(j == 0 ? tanhf(xs) : xs); }
        }
    } SEAM(6);
    if (IN(7)) REP(7) { MKCTX(); GEMM_BF16(WSP(bf16, WS_TW), WSP(bf16, WS_WL), WSP(bf16, WS_F), MROWS, 1536, 128); } SEAM(7);
    if (IN(8)) REP(8) { MKCTX();
        ChunkP cp{WSP(bf16, WS_P), WSP(bf16, WS_F), INP(18), INP(19), INP(21), INP(23), INP(24), INP(25)};
        const int per = (3072 + C.G - 1) / C.G, task0 = (int)blockIdx.x * per; int nt = 3072 - task0; if (nt > per) nt = per;
        if (nt > 0) scan_stage_a(C, cp, WSP(bf16, WS_XN), task0, nt);
    } SEAM(8);
    if (IN(9)) REP(9) { MKCTX();
        const bf16* P = WSP(bf16, WS_P); bf16* H = WSP(bf16, WS_H);
        const int GB = C.G > 96 ? 96 : C.G, vb = (int)blockIdx.x;
        if (vb < GB) {
            ScanBP sb{{WSP(bf16, WS_P), WSP(bf16, WS_F), INP(18), INP(19), INP(21), INP(23), INP(24), INP(25)}, WSP(bf16, WS_XN), WSP(bf16, WS_H), args.out, INP(26), INP(27)};
            for (int bh = vb; bh < 96; bh += GB) scan_stage_b(C, sb, bh);
        }
        const int GO = C.G > 96 ? C.G - 96 : C.G, ob = C.G > 96 ? vb - 96 : vb;
        if (ob >= 0) {
            for (int unit = ob; unit < 256; unit += GO) attn_b_unit(C, P, WSP(bf16, WS_MKV), H, unit);
            __syncthreads();
            { ScanP sp{WSP(bf16, WS_P), WSP(bf16, WS_F), WSP(bf16, WS_H), args.out, INP(7), INP(8), INP(18), INP(19), INP(21), INP(23), INP(24), INP(25), INP(26), INP(27)};
              for (int u = 96 + ob; u < 480; u += GO) scan_unit(C, sp, u); }
            const int ogw = ob * NWAVES + C.wave, ONGW = GO * NWAVES, ogt = ogw * 64 + C.lane, ONGT = ONGW * 64;
            for (int task = ogw; task < NSAMP * 4; task += ONGW) { const int m = TP + (task >> 2), hh = task & 3;
                const bf16* prow = P + (size_t)m * B_INP;
                const float om = cross_attn_task(WSP(bf16, WS_MKV), INP(3), prow + CSH + hh * 64, m, hh, 1, C.lane);
                H[(size_t)m * 1024 + RW + hh * 64 + C.lane] = (bf16)f2bf(om * silu(bf2f(prow[2688 + RW + hh * 64 + C.lane]))); }
            for (int i = ogt; i < NBATCH * CSH; i += ONGT) { const int b = i / CSH, c = i % CSH; args.out[O_SHP + i] = bf2f(P[(size_t)(b * SEQ + SEQ - 1) * B_INP + c]); }
            for (int i = ogt; i < SBATCH * CSH; i += ONGT) { const int sb = i / CSH, c = i % CSH; args.out[O_SHS + i] = bf2f(P[(size_t)(TP + sb * 4 + 3) * B_INP + c]); }
        }
    } SEAM(9);
    if (IN(10)) REP(10) { MKCTX(); GEMM_BF16(WSP(bf16, WS_H), WSP(bf16, WS_WBOUT), WSP(bf16, WS_F), MROWS, DM, DM); } SEAM(10);
    if (IN(11)) { MKCTX();
        for (int m = C.gw; m < NREAL; m += C.NGW) { const bool samp = m >= TP;
            float* xo = args.out + (samp ? O_YS + (size_t)(m - TP) * DM : O_YP + (size_t)m * DM);
            row_pass(WSP(bf16, WS_F) + (size_t)m * DM, xo, xo, INP(10) + DM, nullptr, C.lane); }
    }
#undef IN
#undef SEAM
}

extern "C" void kernel_launch(void* const* d_in, const int* in_sizes, int n_in, void* d_out, int out_size, void* d_ws, size_t ws_size, hipStream_t stream) {
    static int grid = 0;
    if (grid == 0) {
        if (n_in != 28 || in_sizes[0] != TP * DM || (size_t)out_size != O_END || ws_size < WS_END) {
            fprintf(stderr, "kernel_launch: unexpected shapes: n_in %d in0 %d out %d ws %zu (need >= %zu); nothing launched\n", n_in, n_in > 0 ? in_sizes[0] : -1, out_size, ws_size, (size_t)WS_END); grid = -1; return; }
        int dev = 0, cus = 0, per_cu = 0;
        if (hipGetDevice(&dev) != hipSuccess || hipDeviceGetAttribute(&cus, hipDeviceAttributeMultiprocessorCount, dev) != hipSuccess) { fprintf(stderr, "kernel_launch: device query failed\n"); grid = -1; return; }
        if (hipFuncSetAttribute((const void*)hyb_fwd, hipFuncAttributeMaxDynamicSharedMemorySize, LDS_BYTES) != hipSuccess) { fprintf(stderr, "kernel_launch: hipFuncSetAttribute failed\n"); grid = -1; return; }
        if (hipOccupancyMaxActiveBlocksPerMultiprocessor(&per_cu, (const void*)hyb_fwd, NWAVES * 64, LDS_BYTES) != hipSuccess || per_cu < 1) {
            fprintf(stderr, "kernel_launch: occupancy query reports %d workgroups per CU\n", per_cu); }
        (void)hipGetLastError();
        grid = cus;
    }
    if (grid < 0) return;
    if (hipMemsetAsync((char*)d_ws + WS_CTL, 0, CTL_ZERO_BYTES, stream) != hipSuccess) { fprintf(stderr, "kernel_launch: memset failed\n"); return; }
    Args a{};
    for (int i = 0; i < 28; ++i) a.in[i] = (const float*)d_in[i];
    a.out = (float*)d_out; a.ws = (unsigned char*)d_ws;
#if MK_N_LAUNCHES == 1
    a.ph_lo = 0; a.ph_hi = N_PHASES;
    hipLaunchKernelGGL(hyb_fwd, dim3(grid), dim3(NWAVES * 64), LDS_BYTES, stream, a);
#else
    for (int li = 0; li < N_PHASES; ++li) { a.ph_lo = li; a.ph_hi = li + 1;
        hipLaunchKernelGGL(hyb_fwd, dim3(grid), dim3(NWAVES * 64), LDS_BYTES, stream, a); }
#endif
    const hipError_t le = hipPeekAtLastError();
    if (le != hipSuccess) fprintf(stderr, "kernel_launch: launch failed: %s\n", hipGetErrorName(le));
}
```

```cpp
#include <hip/hip_runtime.h>
#include <cstdio>
#include <cstdint>
namespace pg8 {
#define PG8_LAS __attribute__((address_space(3)))
typedef unsigned short bf16_t;
typedef short bf16x8 __attribute__((ext_vector_type(8)));
typedef float f32x4 __attribute__((ext_vector_type(4)));
typedef unsigned u32x4 __attribute__((ext_vector_type(4)));
constexpr int BM = 256, BK = 64, HALF = 128, HTB = HALF * BK * 2  , STAGE_BYTES = 8 * HTB, NXCD = 8, WGM = 8;

__host__ __device__ __forceinline__ int lds_byte(int r, int c) { const int st = (r >> 4) * 2 + (c >> 5), rr = r & 15, cc = c & 31, ob = rr * 64 + cc * 2; return st * 1024 + (ob ^ (((ob >> 9) & 1) << 5)); }
__host__ __device__ __forceinline__ void stage_rc(int b, int& R, int& C) { const int st = b / 1024, sb = b % 1024, swz = sb ^ (((sb >> 9) & 1) << 5); R = (st >> 1) * 16 + swz / 64; C = (st & 1) * 32 + (swz % 64) / 2; }
__host__ __device__ __forceinline__ int perm32(int rho) { const int n = rho >> 4, i = rho & 15; return 8 * (i >> 2) + 4 * n + (i & 3); }

struct Unit { int pm, pn; };
struct Gemm { const bf16_t* A; const bf16_t* Bt; int M, N, K; };

struct StaticOrder {
    int nM, nN, nwg, G, c;
    __host__ __device__ void init(int M, int N, int G_, int c_) { nM = M / BM; nN = N / BM; nwg = nM * nN; G = G_; c = c_; }
    __host__ __device__ bool next(int i, Unit& u) const {
        const long L = (long)i * G + c; if (L >= nwg) return false;
        int wgid = (int)L; { const int q = nwg / NXCD, r = nwg % NXCD, xcd = wgid % NXCD, off = wgid / NXCD; wgid = (xcd < r ? xcd * (q + 1) : r * (q + 1) + (xcd - r) * q) + off; }
        const int nig = WGM * nN, gid = wgid / nig, fm = gid * WGM, gsz = (nM - fm) < WGM ? (nM - fm) : WGM;
        u.pm = fm + ((wgid % nig) % gsz); u.pn = (wgid % nig) / gsz; return true;
    }
    __device__ __forceinline__ void a_ready(const Unit&) const {}
    __device__ __forceinline__ void done(const Unit&) const {}
};

__device__ __forceinline__ unsigned cvt_pk_bf16(float lo, float hi) { unsigned r; asm volatile("v_cvt_pk_bf16_f32 %0, %1, %2" : "=v"(r) : "v"(lo), "v"(hi)); return r; }
typedef float f32x2 __attribute__((ext_vector_type(2)));
__device__ __forceinline__ f32x2 gelu_pk(f32x2 v) {
    const f32x2 av = __builtin_elementwise_abs(v), d = av * 0.2316418882f + 1.0f;
    f32x2 t; t.x = __builtin_amdgcn_rcpf(d.x); t.y = __builtin_amdgcn_rcpf(d.y);
    f32x2 q = t * 0.5307027145f + (-0.7265760135f); q = q * t + 0.7107068705f; q = q * t + (-0.142248368f); q = q * t + 0.127414796f; q = q * t;
    const f32x2 s = (v * v) * (-0.72134752044f);
    f32x2 e; e.x = __builtin_amdgcn_exp2f(s.x); e.y = __builtin_amdgcn_exp2f(s.y);
    const f32x2 m = v * (q * e), r = v - m;
    f32x2 o; o.x = v.x < 0.f ? m.x : r.x; o.y = v.y < 0.f ? m.y : r.y; return o;
}

template <int ACT  > struct EpiBf16 {
    static constexpr bool PERM = true, AFTER_DRAIN = false; static_assert(ACT == 0 || ACT == 1, "EpiBf16: ACT is 0 (none) or 1 (gelu_pk)");
    bf16_t* O; int ldc; const float* bias; int split_cols; size_t split_stride; float scale0;
    __device__ __forceinline__ void operator()(const f32x4 (&acc)[2][2][4][2], const Unit& u, int wr, int wc, int fr, int fq) const {
        const int row0 = u.pm * BM + wr * 64 + fr; int colt = u.pn * BM; bf16_t* base = O;
        float sc = 1.f; if (split_cols) { const int t = colt / split_cols; base += (size_t)t * split_stride; colt -= t * split_cols; if (t == 0) sc = scale0; }
        const int col0 = colt + wc * 32 + 8 * fq, bcol0 = u.pn * BM + wc * 32 + 8 * fq;
        f32x4 bv[2][2];
#pragma unroll
        for (int bj = 0; bj < 2; ++bj)
#pragma unroll
            for (int n = 0; n < 2; ++n) bv[bj][n] = bias ? *(const f32x4*)(bias + bcol0 + bj * HALF + 4 * n) : (f32x4){0.f, 0.f, 0.f, 0.f};
#pragma unroll
        for (int ai = 0; ai < 2; ++ai)
#pragma unroll
            for (int m = 0; m < 4; ++m) { bf16_t* rowp = base + (size_t)(row0 + ai * HALF + m * 16) * ldc + col0;
#pragma unroll
                for (int bj = 0; bj < 2; ++bj) { f32x4 v0 = acc[ai][bj][m][0] + bv[bj][0], v1 = acc[ai][bj][m][1] + bv[bj][1];
                    if (ACT == 1) { f32x2 a = gelu_pk((f32x2){v0[0], v0[1]}), b = gelu_pk((f32x2){v0[2], v0[3]}), c = gelu_pk((f32x2){v1[0], v1[1]}), d = gelu_pk((f32x2){v1[2], v1[3]});
                        v0 = (f32x4){a.x, a.y, b.x, b.y}; v1 = (f32x4){c.x, c.y, d.x, d.y}; }
                    v0 = v0 * sc; v1 = v1 * sc; u32x4 w; w.x = cvt_pk_bf16(v0[0], v0[1]); w.y = cvt_pk_bf16(v0[2], v0[3]); w.z = cvt_pk_bf16(v1[0], v1[1]); w.w = cvt_pk_bf16(v1[2], v1[3]);
                    *(u32x4*)(rowp + bj * HALF) = w; } }
    }
};
template <class Epi, class Sched, bool ALIGN_EPI = false, bool SP2 = false>
__device__ __forceinline__ void gemm_phase(PG8_LAS unsigned char* lds, const Gemm g, const Sched& S, const Epi& E) {
    const int tid = threadIdx.x, wid = __builtin_amdgcn_readfirstlane(tid >> 6), lane = tid & 63, wr = wid >> 2, wc = wid & 3, fr = lane & 15, fq = lane >> 4;
    const int K = g.K, nt = K / BK;
    unsigned voffA[2], voffB[2];
#pragma unroll
    for (int i = 0; i < 2; ++i) { int R, C; stage_rc(tid * 16 + i * 8192, R, C); const int Rb = Epi::PERM ? ((R & ~31) + perm32(R & 31)) : R;
        voffA[i] = (unsigned)(R * K + C) * 2u; voffB[i] = (unsigned)(Rb * K + C) * 2u; }
    const size_t kstep = (size_t)(BK * 2);
    const size_t hstep = (size_t)HALF * K * 2;
    const size_t tstep = 2 * hstep;
    const unsigned ldsw = (unsigned)wid * 1024u;
    const int aoff = lds_byte(wr * 64 + fr, fq * 8), boff = lds_byte(wc * 32 + fr, fq * 8);
#define PG8_SA(b, h) (((b) * 2 + (h)) * HTB)
#define PG8_SB(b, h) ((4 + (b) * 2 + (h)) * HTB)
#define PG8_STAGE(bufoff, gbase, voff) do { _Pragma("unroll") for (int _i = 0; _i < 2; ++_i) \
        __builtin_amdgcn_global_load_lds((const unsigned*)((const char*)(gbase) + (voff)[_i]), (PG8_LAS unsigned*)(lds + (bufoff) + ldsw + _i * 8192), 16, 0, 0); } while (0)
#define PG8_LDA(dst, b, h) do { _Pragma("unroll") for (int m = 0; m < 4; ++m) _Pragma("unroll") for (int k = 0; k < 2; ++k) dst[m][k] = *(const PG8_LAS bf16x8*)(lds + PG8_SA(b, h) + aoff + m * 2048 + k * 1024); } while (0)
#define PG8_LDB(dst, b, h) do { _Pragma("unroll") for (int n = 0; n < 2; ++n) _Pragma("unroll") for (int k = 0; k < 2; ++k) dst[n][k] = *(const PG8_LAS bf16x8*)(lds + PG8_SB(b, h) + boff + n * 2048 + k * 1024); } while (0)
#define PG8_MMA(ai, bj, At, Bt) do { __builtin_amdgcn_s_setprio(1); _Pragma("unroll") for (int m = 0; m < 4; ++m) _Pragma("unroll") for (int n = 0; n < 2; ++n) _Pragma("unroll") for (int k = 0; k < 2; ++k) \
        acc[ai][bj][m][n] = __builtin_amdgcn_mfma_f32_16x16x32_bf16(Bt[n][k], At[m][k], acc[ai][bj][m][n], 0, 0, 0); __builtin_amdgcn_s_setprio(0); } while (0)
#define PG8_WAIT_V(n) asm volatile("s_waitcnt vmcnt(" #n ")" ::: "memory")
#define PG8_WAIT_L(n) asm volatile("s_waitcnt lgkmcnt(" #n ")" ::: "memory")
#define PG8_BAR __builtin_amdgcn_s_barrier()
#define PG8_SCHED __builtin_amdgcn_sched_barrier(0)
    Unit cur, nxt; int ui = 0;
    if (!S.next(0, cur)) return;
    f32x4 acc[2][2][4][2];
#pragma unroll
    for (int a = 0; a < 2; ++a)
#pragma unroll
        for (int b = 0; b < 2; ++b)
#pragma unroll
            for (int m = 0; m < 4; ++m)
#pragma unroll
                for (int n = 0; n < 2; ++n) acc[a][b][m][n] = (f32x4){0.f, 0.f, 0.f, 0.f};
    bf16x8 At[4][2], B0[2][2], B1[2][2];
    const char* cA = (const char*)g.A + (size_t)cur.pm * tstep; const char* cB = (const char*)g.Bt + (size_t)cur.pn * tstep;
    S.a_ready(cur);
    if constexpr (SP2) {
        PG8_STAGE(PG8_SB(0, 0), cB, voffB); PG8_STAGE(PG8_SB(0, 1), cB + hstep, voffB); PG8_STAGE(PG8_SA(0, 0), cA, voffA); PG8_STAGE(PG8_SA(0, 1), cA + hstep, voffA);
        if (wr == 1) PG8_BAR;
        PG8_WAIT_V(2); PG8_BAR;
        PG8_STAGE(PG8_SB(1, 0), cB + kstep, voffB); PG8_STAGE(PG8_SA(1, 0), cA + kstep, voffA); PG8_STAGE(PG8_SB(1, 1), cB + hstep + kstep, voffB);
        PG8_WAIT_V(6); PG8_BAR;
    } else {
        PG8_STAGE(PG8_SB(0, 0), cB, voffB); PG8_STAGE(PG8_SA(0, 0), cA, voffA); PG8_STAGE(PG8_SB(0, 1), cB + hstep, voffB); PG8_STAGE(PG8_SA(0, 1), cA + hstep, voffA);
        if (wr == 1) PG8_BAR;
        PG8_WAIT_V(4); PG8_BAR;
        PG8_STAGE(PG8_SB(1, 0), cB + kstep, voffB); PG8_STAGE(PG8_SA(1, 0), cA + kstep, voffA); PG8_STAGE(PG8_SB(1, 1), cB + hstep + kstep, voffB);
        PG8_WAIT_V(6); PG8_BAR;
    }
    for (;;) {
        const bool has_next = S.next(ui + 1, nxt);
        const char* nA = has_next ? (const char*)g.A + (size_t)nxt.pm * tstep : cA; const char* nB = has_next ? (const char*)g.Bt + (size_t)nxt.pn * tstep : cB;
        for (int t = 0; t < nt; t += 2) {
            const bool last = (t == nt - 2);
            const char* a1 = cA + (size_t)(t + 1) * kstep;
            const char* a2 = last ? nA : cA + (size_t)(t + 2) * kstep; const char* b2 = last ? nB : cB + (size_t)(t + 2) * kstep;
            const char* a3 = a2 + kstep; const char* b3 = b2 + kstep;
            if (last && has_next) S.a_ready(nxt);
            if constexpr (SP2) {
            PG8_LDB(B0, 0, 0); PG8_LDB(B1, 0, 1); PG8_SCHED; PG8_LDA(At, 0, 0); PG8_STAGE(PG8_SA(1, 1), a1 + hstep, voffA);
            PG8_WAIT_V(8); PG8_WAIT_L(0); PG8_BAR; PG8_MMA(0, 0, At, B0); PG8_MMA(0, 1, At, B1); PG8_BAR; PG8_SCHED;
            PG8_LDA(At, 0, 1); PG8_STAGE(PG8_SB(0, 0), b2, voffB); PG8_STAGE(PG8_SB(0, 1), b2 + hstep, voffB); PG8_STAGE(PG8_SA(0, 0), a2, voffA);
            PG8_WAIT_V(8); PG8_WAIT_L(0); PG8_BAR; PG8_MMA(1, 0, At, B0); PG8_MMA(1, 1, At, B1); PG8_BAR; PG8_SCHED;
            PG8_LDB(B0, 1, 0); PG8_LDB(B1, 1, 1); PG8_SCHED; PG8_LDA(At, 1, 0); PG8_STAGE(PG8_SA(0, 1), a2 + hstep, voffA);
            PG8_WAIT_V(8); PG8_WAIT_L(0); PG8_BAR; PG8_MMA(0, 0, At, B0); PG8_MMA(0, 1, At, B1); PG8_BAR; PG8_SCHED;
            PG8_LDA(At, 1, 1); PG8_STAGE(PG8_SB(1, 0), b3, voffB); PG8_STAGE(PG8_SB(1, 1), b3 + hstep, voffB); PG8_STAGE(PG8_SA(1, 0), a3, voffA);
            PG8_WAIT_V(8); PG8_WAIT_L(0); PG8_BAR; PG8_MMA(1, 0, At, B0); PG8_MMA(1, 1, At, B1); PG8_BAR; PG8_SCHED;
            } else {
            PG8_LDB(B0, 0, 0); PG8_SCHED; PG8_LDA(At, 0, 0); PG8_STAGE(PG8_SA(1, 1), a1 + hstep, voffA);
            PG8_WAIT_L(8); PG8_BAR; PG8_WAIT_L(0); PG8_MMA(0, 0, At, B0); PG8_BAR; PG8_SCHED;
            PG8_LDB(B1, 0, 1); PG8_STAGE(PG8_SB(0, 0), b2, voffB);
            PG8_BAR; PG8_WAIT_L(0); PG8_MMA(0, 1, At, B1); PG8_BAR;
            PG8_LDA(At, 0, 1); PG8_STAGE(PG8_SA(0, 0), a2, voffA);
            PG8_BAR; PG8_WAIT_L(0); PG8_MMA(1, 0, At, B0); PG8_BAR; PG8_SCHED;
            PG8_STAGE(PG8_SB(0, 1), b2 + hstep, voffB);
            PG8_WAIT_V(6); PG8_BAR; PG8_MMA(1, 1, At, B1); PG8_BAR;
            PG8_LDB(B0, 1, 0); PG8_SCHED; PG8_LDA(At, 1, 0); PG8_STAGE(PG8_SA(0, 1), a2 + hstep, voffA);
            PG8_WAIT_L(8); PG8_BAR; PG8_WAIT_L(0); PG8_MMA(0, 0, At, B0); PG8_BAR; PG8_SCHED;
            PG8_LDB(B1, 1, 1); PG8_STAGE(PG8_SB(1, 0), b3, voffB);
            PG8_BAR; PG8_WAIT_L(0); PG8_MMA(0, 1, At, B1); PG8_BAR;
            PG8_LDA(At, 1, 1); PG8_STAGE(PG8_SA(1, 0), a3, voffA);
            PG8_BAR; PG8_WAIT_L(0); PG8_MMA(1, 0, At, B0); PG8_BAR; PG8_SCHED;
            PG8_STAGE(PG8_SB(1, 1), b3 + hstep, voffB);
            PG8_WAIT_V(6); PG8_BAR; PG8_MMA(1, 1, At, B1); PG8_BAR;
            }
        }
        if constexpr (ALIGN_EPI) { if (wr == 0) PG8_BAR; }
        if constexpr (!Epi::AFTER_DRAIN) { E(acc, cur, wr, wc, fr, fq); S.done(cur); }
        if (!has_next) break;
#pragma unroll
        for (int a = 0; a < 2; ++a)
#pragma unroll
            for (int b = 0; b < 2; ++b)
#pragma unroll
                for (int m = 0; m < 4; ++m)
#pragma unroll
                    for (int n = 0; n < 2; ++n) acc[a][b][m][n] = (f32x4){0.f, 0.f, 0.f, 0.f};
        cur = nxt; cA = nA; cB = nB; ++ui;
        if constexpr (ALIGN_EPI) { if (wr == 1) PG8_BAR; }
    }
    PG8_WAIT_V(0);
    if constexpr (!ALIGN_EPI) { if (wr == 0) PG8_BAR; }
    PG8_BAR;
    if constexpr (Epi::AFTER_DRAIN) { E.fused(acc, cur, wr, wc, fr, fq, lds, wid, lane); S.done(cur); }
#undef PG8_SA
#undef PG8_SB
#undef PG8_STAGE
#undef PG8_LDA
#undef PG8_LDB
#undef PG8_MMA
#undef PG8_WAIT_V
#undef PG8_WAIT_L
#undef PG8_BAR
#undef PG8_SCHED
}
}

#ifndef PG8_SP2
#define PG8_SP2 true
#endif
#ifndef PG8_ALIGN
#define PG8_ALIGN true
#endif

constexpr int NWAVES = 8;
#ifndef MK_N_LAUNCHES
#define MK_N_LAUNCHES 1
#endif
constexpr int N_PHASES = 12;
constexpr int TP = 16384, NSAMP = 128, NREAL = TP + NSAMP, MROWS = 16640, DM = 1024;
constexpr int SEQ = 2048, NBATCH = 8, SBATCH = 32, STOK = 4, NMEM = 256;
constexpr int A_IN = 3072, B_IN = 3712, B_INP = 3840, CSH = 2432, RW = 768;
constexpr float RMS_EPS = 1e-6f, GN_EPS = 64e-5f;
constexpr size_t O_YP = 0, O_YS = 16777216, O_MEM = 16908288, O_W0P = 19005440, O_W1P = 19529728, O_W2P = 21626880,
                 O_W0S = 30015488, O_W1S = 30081024, O_W2S = 30146560, O_WKVP = 30212096, O_WKVS = 30605312, O_SHP = 32178176, O_SHS = 32197632, O_END = 32275456;
constexpr size_t MiB = 1u << 20;
constexpr size_t WS_CTL = 0, CTL_ZERO_BYTES = 1 * MiB;
constexpr size_t WS_WAIN = 1 * MiB, WS_WAOUT = 7 * MiB, WS_WBIN = 8 * MiB, WS_WBOUT = 16 * MiB, WS_WM = 18 * MiB, WS_WL = 20 * MiB, WS_BT = 20 * MiB + 512 * 1024;
constexpr size_t WS_MEMN = 21 * MiB, WS_MKV = 25 * MiB, WS_TW = 29 * MiB, WS_XN = 34 * MiB, WS_H = 67 * MiB, WS_F = 100 * MiB, WS_P = 149 * MiB, WS_END = 271 * MiB;
constexpr int CW_TMO = 0, CW_BAR = 4096;

constexpr int RING_OFF = 0, RING_BYTES = 161792;
constexpr int LDSCTL_OFF = RING_BYTES, MISC_OFF = LDSCTL_OFF + 320;
constexpr int LDS_BYTES = 163840;

#define GAS __attribute__((address_space(1)))
#define LAS __attribute__((address_space(3)))
typedef unsigned short bf16;
typedef unsigned v4u __attribute__((ext_vector_type(4)));
typedef unsigned v2u __attribute__((ext_vector_type(2)));
typedef float f32x4 __attribute__((ext_vector_type(4)));
typedef GAS unsigned gu32;
#define RLX_AGENT __ATOMIC_RELAXED, __HIP_MEMORY_SCOPE_AGENT
#define LDS_WAIT() asm volatile("s_waitcnt lgkmcnt(0)" ::: "memory")
#define VM_WAIT() asm volatile("s_waitcnt vmcnt(0)" ::: "memory")
__device__ __forceinline__ unsigned f2bf(float f) { unsigned u = __builtin_bit_cast(unsigned, f); return (u + 0x7fffu + ((u >> 16) & 1u)) >> 16; }
__device__ __forceinline__ unsigned pk2(float lo, float hi) { return f2bf(lo) | (f2bf(hi) << 16); }
__device__ __forceinline__ float bflo(unsigned u) { return __builtin_bit_cast(float, u << 16); }
__device__ __forceinline__ float bfhi(unsigned u) { return __builtin_bit_cast(float, u & 0xffff0000u); }
__device__ __forceinline__ float bf2f(bf16 h) { return __builtin_bit_cast(float, (unsigned)h << 16); }

#define XB_TMO      128
#define XB_XCNT(j)  (256  + 64 * (j))
#define XB_XSUB(j)  (1280 + 64 * (j))
#define XB_XGEN(j)  (2304 + 64 * (j))
#define XB_TOP      3328
#define XB_TOPGEN   3392
#define XCD_BAR_WORDS 3456
#define XB_SPIN_CAP (1u << 20)
__device__ __forceinline__ unsigned xb_ld(unsigned* p)              { return __hip_atomic_load(p, __ATOMIC_RELAXED, __HIP_MEMORY_SCOPE_AGENT); }
__device__ __forceinline__ unsigned xb_add(unsigned* p, unsigned v) { return __hip_atomic_fetch_add(p, v, __ATOMIC_RELAXED, __HIP_MEMORY_SCOPE_AGENT); }
__device__ __forceinline__ unsigned xb_xcc_id() { return (unsigned)__builtin_amdgcn_s_getreg((3 << 11) | 20) & 0xFu; }
#define XB_SPIN(cond, bar) do { unsigned _sp = 0; while (cond) { __builtin_amdgcn_s_sleep(1); \
    if ((++_sp & 255u) == 0u) { if (xb_ld(&(bar)[XB_TMO])) break; if (_sp > XB_SPIN_CAP) { atomicAdd(&(bar)[XB_TMO], 1u); break; } } } } while (0)
struct XcdBarrier { unsigned* bar; unsigned x; volatile LAS unsigned* st; };
__device__ __forceinline__ XcdBarrier xcd_barrier_post(unsigned* bar, volatile LAS unsigned* st) {
    XcdBarrier b; b.bar = bar; b.x = xb_xcc_id(); b.st = st;
    if (threadIdx.x == 0) (void)xb_add(&bar[XB_XCNT(b.x)], 1u);
    return b;
}
__device__ __forceinline__ void xcd_barrier_complete(unsigned* bar, unsigned x, unsigned& nloc, unsigned& nx) {
    const unsigned G = gridDim.x * gridDim.y * gridDim.z;
    unsigned sum, cnt, mine, sp = 0u;
    for (;;) {
        sum = 0u; cnt = 0u; mine = 0u;
#pragma unroll
        for (unsigned j = 0; j < 16; ++j) { const unsigned c = xb_ld(&bar[XB_XCNT(j)]); sum += c; cnt += (c > 0u) ? 1u : 0u; mine = (j == x) ? c : mine; }
        if (sum == G) break;
        __builtin_amdgcn_s_sleep(1);
        if ((++sp & 255u) == 0u) { if (xb_ld(&bar[XB_TMO])) break; if (sp > XB_SPIN_CAP) { atomicAdd(&bar[XB_TMO], 1u); break; } }
    }
    nloc = mine > 0u ? mine : 1u; nx = cnt > 0u ? cnt : 1u;
}
__device__ __forceinline__ void xcd_barrier(const XcdBarrier& b) {
    asm volatile("s_waitcnt vmcnt(0)" ::: "memory");
    __syncthreads();
    if (threadIdx.x == 0) {
        unsigned* bar = b.bar;
        __builtin_amdgcn_s_waitcnt(0);
        unsigned nloc = b.st[0], nx = b.st[1];
        if (nloc == 0u) { xcd_barrier_complete(bar, b.x, nloc, nx); b.st[0] = nloc; b.st[1] = nx; }
        const unsigned old = xb_add(&bar[XB_XSUB(b.x)], 1u);
        const unsigned gen = old / nloc;
        if (old + 1u == (gen + 1u) * nloc) {
            __builtin_amdgcn_fence(__ATOMIC_RELEASE, "agent");
            asm volatile("s_waitcnt vmcnt(0)" ::: "memory");
            const unsigned og = xb_add(&bar[XB_TOP], 1u);
            const unsigned tg = og / nx;
            if (og + 1u == (tg + 1u) * nx) xb_add(&bar[XB_TOPGEN], 1u);
            else XB_SPIN(xb_ld(&bar[XB_TOPGEN]) == tg, bar);
            __builtin_amdgcn_fence(__ATOMIC_ACQUIRE, "agent");
            xb_add(&bar[XB_XGEN(b.x)], 1u);
            asm volatile("s_waitcnt vmcnt(0)" ::: "memory");
        } else {
            XB_SPIN(xb_ld(&bar[XB_XGEN(b.x)]) == gen, bar);
            __builtin_amdgcn_fence(__ATOMIC_ACQUIRE, "agent");
            asm volatile("s_waitcnt vmcnt(0)" ::: "memory");
        }
    }
    __syncthreads();
}

struct Ctx { LAS unsigned char* lds; int tid, lane, wave, vcu, G, gw, NGW; };

__device__ __forceinline__ float wave_sum(float v) {
#pragma unroll
    for (int o = 1; o < 64; o <<= 1) v += __shfl_xor(v, o);
    return v;
}
__device__ __forceinline__ float wave_max(float v) {
#pragma unroll
    for (int o = 1; o < 64; o <<= 1) v = fmaxf(v, __shfl_xor(v, o));
    return v;
}
__device__ __forceinline__ float rdlane(float v, int l) { return __builtin_bit_cast(float, __builtin_amdgcn_readlane(__builtin_bit_cast(int, v), l)); }

__device__ __forceinline__ void p0_transpose_item(const float* W, int N, const float* gain, bf16* WT, int ldo, int col_off, int row_off, LAS float* scr, int item, int nblk, int lane) {
    const int kb = item / nblk, nb = item % nblk, k0 = 64 * kb, n0 = 32 * nb;
#pragma unroll 8
    for (int i = 0; i < 32; ++i) { const int kk = 2 * i + (lane >> 5); const float g = gain ? gain[k0 + kk] : 1.f; scr[kk * 33 + (lane & 31)] = W[(size_t)(k0 + kk) * N + n0 + (lane & 31)] * g; }
    LDS_WAIT(); asm volatile("" ::: "memory");
    const int c = lane & 7;
#pragma unroll
    for (int j = 0; j < 4; ++j) { const int n = (lane >> 3) + 8 * j; const LAS float* s = scr + (8 * c) * 33 + n;
        v4u o; o.x = pk2(s[0 * 33], s[1 * 33]); o.y = pk2(s[2 * 33], s[3 * 33]); o.z = pk2(s[4 * 33], s[5 * 33]); o.w = pk2(s[6 * 33], s[7 * 33]);
        *(GAS v4u*)(WT + (size_t)(row_off + n0 + n) * ldo + col_off + k0 + 8 * c) = o; }
    LDS_WAIT(); asm volatile("" ::: "memory");
}
__device__ __forceinline__ void rms_row_to_bf16(const float* xrow, bf16* orow, int lane) {
    const GAS f32x4* xr = (const GAS f32x4*)xrow + lane;
    f32x4 v[4]; float s = 0.f;
#pragma unroll
    for (int j = 0; j < 4; ++j) { v[j] = xr[64 * j]; s += (v[j].x * v[j].x + v[j].y * v[j].y) + (v[j].z * v[j].z + v[j].w * v[j].w); }
    const float r = 1.f / sqrtf(wave_sum(s) * (1.f / DM) + RMS_EPS);
    GAS unsigned long long* o8 = (GAS unsigned long long*)orow + lane;
#pragma unroll
    for (int j = 0; j < 4; ++j) o8[64 * j] = (unsigned long long)pk2(v[j].x * r, v[j].y * r) | ((unsigned long long)pk2(v[j].z * r, v[j].w * r) << 32);
}
__device__ __forceinline__ int t5_bucket(int dist) {
    if (dist < 16) return dist;
    const double x = log((double)dist / 16.0) / log(128.0) * 16.0;
    int large = 16 + (int)x; return large < 31 ? large : 31;
}

__device__ __forceinline__ void ldq64(const bf16* p, float (&q)[64]) {
#pragma unroll
    for (int i = 0; i < 8; ++i) { const v4u u = *(const GAS v4u*)(p + 8 * i);
        q[8 * i + 0] = bflo(u.x); q[8 * i + 1] = bfhi(u.x); q[8 * i + 2] = bflo(u.y); q[8 * i + 3] = bfhi(u.y);
        q[8 * i + 4] = bflo(u.z); q[8 * i + 5] = bfhi(u.z); q[8 * i + 6] = bflo(u.w); q[8 * i + 7] = bfhi(u.w); }
}
__device__ __forceinline__ float dot64_bf(const float (&q)[64], const bf16* p) {
    float s0 = 0.f, s1 = 0.f;
#pragma unroll
    for (int i = 0; i < 8; ++i) { const v4u u = *(const GAS v4u*)(p + 8 * i);
        s0 += q[8 * i + 0] * bflo(u.x); s1 += q[8 * i + 1] * bfhi(u.x); s0 += q[8 * i + 2] * bflo(u.y); s1 += q[8 * i + 3] * bfhi(u.y);
        s0 += q[8 * i + 4] * bflo(u.z); s1 += q[8 * i + 5] * bfhi(u.z); s0 += q[8 * i + 6] * bflo(u.w); s1 += q[8 * i + 7] * bfhi(u.w); }
    return s0 + s1;
}
__device__ __forceinline__ float dot64_f32(const float (&q)[64], const float* p) {
    float s0 = 0.f, s1 = 0.f;
#pragma unroll
    for (int i = 0; i < 16; ++i) { const f32x4 u = *(const GAS f32x4*)(p + 4 * i);
        s0 += q[4 * i + 0] * u.x; s1 += q[4 * i + 1] * u.y; s0 += q[4 * i + 2] * u.z; s1 += q[4 * i + 3] * u.w; }
    return s0 + s1;
}
__device__ __forceinline__ float silu(float x) { return x / (1.f + __expf(-x)); }

__device__ __forceinline__ float cross_attn_task(const bf16* MKV, const float* c_mem, const bf16* qptr, int m, int hh, int layer, int lane) {
    float q[64]; ldq64(qptr, q);
    const bool samp = m >= TP;
    float l[4]; float mx = -3.0e38f, o = 0.f, s = 0.f;
    if (!samp) {
        const bf16* kb = MKV + (size_t)((m >> 11) * NMEM) * 1024 + layer * 512 + hh * 64;
#pragma unroll
        for (int r = 0; r < 4; ++r) { l[r] = dot64_bf(q, kb + (size_t)(r * 64 + lane) * 1024) * 0.125f; mx = fmaxf(mx, l[r]); }
        mx = wave_max(mx);
#pragma unroll
        for (int r = 0; r < 4; ++r) { l[r] = __expf(l[r] - mx); s += l[r]; }
        s = wave_sum(s);
#pragma unroll
        for (int r = 0; r < 4; ++r)
            for (int kk = 0; kk < 64; ++kk) o += rdlane(l[r], kk) * bf2f(kb[(size_t)(r * 64 + kk) * 1024 + 256 + lane]);
    } else {
        const float* kf = c_mem + ((size_t)(layer * SBATCH + ((m - TP) >> 2)) * NMEM) * 512 + hh * 64;
#pragma unroll
        for (int r = 0; r < 4; ++r) { l[r] = dot64_f32(q, kf + (size_t)(r * 64 + lane) * 512) * 0.125f; mx = fmaxf(mx, l[r]); }
        mx = wave_max(mx);
#pragma unroll
        for (int r = 0; r < 4; ++r) { l[r] = __expf(l[r] - mx); s += l[r]; }
        s = wave_sum(s);
#pragma unroll
        for (int r = 0; r < 4; ++r)
            for (int kk = 0; kk < 64; ++kk) o += rdlane(l[r], kk) * kf[(size_t)(r * 64 + kk) * 512 + 256 + lane];
    }
    return o / s;
}

template <int G>
__device__ __forceinline__ void attn_group(const bf16* P, const float* BT, const float* cw, int m, int hh, int lane, float& Mx, float& Ss, float& O) {
    constexpr int dil = G == 0 ? 1 : (G == 1 ? 4 : 16), Wg = G == 0 ? 128 : (G == 1 ? 512 : 2048), head0 = G * 4;
    const bool samp = m >= TP;
    const int b = m >> 11, t = m & 2047, sb = (m - TP) >> 2, st = (m - TP) & 3, head = head0 + hh;
    float q[64]; ldq64(P + (size_t)m * A_IN + head * 64, q);
    const float* bt = BT + (G * 4 + hh) * 132;
    float l[3]; float gm = -3.0e38f;
#pragma unroll
    for (int r = 0; r < 3; ++r) { const int kidx = r * 64 + lane; float lv = -3.0e38f;
        if (kidx < 129) {
            if (!samp) { const int tk = t - dil * kidx; if (tk >= 0) lv = dot64_bf(q, P + (size_t)((b << 11) + tk) * A_IN + RW + head * 64) * 0.125f + bt[kidx]; }
            else { const int idx = Wg + st - dil * kidx;
                if (idx >= Wg) lv = dot64_bf(q, P + (size_t)(TP + sb * 4 + idx - Wg) * A_IN + RW + head * 64) * 0.125f + bt[kidx];
                else lv = dot64_f32(q, cw + ((size_t)(sb * Wg + idx) * 2) * 256 + hh * 64) * 0.125f + bt[kidx]; }
        }
        l[r] = lv; gm = fmaxf(gm, lv); }
    gm = wave_max(gm);
    const float Mn = fmaxf(Mx, gm), sc = __expf(Mx - Mn);
    float ps = 0.f;
#pragma unroll
    for (int r = 0; r < 3; ++r) { l[r] = l[r] > -1.0e38f ? __expf(l[r] - Mn) : 0.f; ps += l[r]; }
    Ss = Ss * sc + wave_sum(ps); O *= sc; Mx = Mn;
#pragma unroll
    for (int r = 0; r < 3; ++r)
        for (int kk = 0; kk < 64; ++kk) { const int kidx = r * 64 + kk; if (kidx >= 129) break;
            const float p = rdlane(l[r], kk);
            if (p != 0.f) { float v;
                if (!samp) { const int tk = t - dil * kidx; v = bf2f(P[(size_t)((b << 11) + tk) * A_IN + 2 * RW + head * 64 + lane]); }
                else { const int idx = Wg + st - dil * kidx;
                    if (idx >= Wg) v = bf2f(P[(size_t)(TP + sb * 4 + idx - Wg) * A_IN + 2 * RW + head * 64 + lane]);
                    else v = cw[((size_t)(sb * Wg + idx) * 2 + 1) * 256 + hh * 64 + lane]; }
                O += p * v; } }
}

typedef short s16x4 __attribute__((ext_vector_type(4)));
typedef short bf16x8 __attribute__((ext_vector_type(8)));
constexpr int VROW = 160;
constexpr int VBUF = 32 * VROW;
constexpr float LOG2E = 1.4426950408889634f;
template <int OFF> __device__ __forceinline__ s16x4 tr_read(unsigned vb) {
    s16x4 r; asm volatile("ds_read_b64_tr_b16 %0, %1 offset:%2" : "=&v"(r) : "v"(vb), "i"(OFF) : "memory"); return r;
}
struct AttnSt { float m, s; f32x4 o[4]; };
__device__ __forceinline__ void attn_init(AttnSt& st) { st.m = -1.0e30f; st.s = 0.f;
#pragma unroll
    for (int i = 0; i < 4; ++i) st.o[i] = (f32x4){0.f, 0.f, 0.f, 0.f}; }
__device__ __forceinline__ unsigned cvt_pk_bf16f(float lo, float hi) { unsigned r; asm volatile("v_cvt_pk_bf16_f32 %0, %1, %2" : "=v"(r) : "v"(lo), "v"(hi)); return r; }

template <bool MASKED>
__device__ __forceinline__ void attn_pairs(const bf16* kbase, const bf16* vbase, int pitch, int tb, int dil, int qs, int tmax, int j0, int j1,
                                           const bf16x8 (&qf)[2], const LAS float* bias2, LAS unsigned char* vbuf, int lane, AttnSt& st) {
    const int n = lane & 15, quad = lane >> 4, vr8 = lane >> 3, vc8 = lane & 7;
    const unsigned vwr = (unsigned)(size_t)vbuf + (unsigned)(vr8 * VROW + vc8 * 16);
    const unsigned vrd = (unsigned)(size_t)vbuf + (unsigned)((4 * quad + (n >> 2)) * VROW + 8 * (n & 3));
    const float C2 = 0.125f * LOG2E;
#pragma unroll 1
    for (int jp = j0; jp < j1; ++jp) {
        bf16x8 ka[2][2]; v4u vr[4];
#pragma unroll
        for (int tt = 0; tt < 2; ++tt) { int tk = tb + dil * (32 * jp + 16 * tt + n); if (MASKED) tk = tk < 0 ? 0 : (tk > tmax ? tmax : tk);
            const bf16* kp = kbase + (size_t)tk * pitch + 8 * quad;
            ka[tt][0] = __builtin_bit_cast(bf16x8, *(const GAS v4u*)kp); ka[tt][1] = __builtin_bit_cast(bf16x8, *(const GAS v4u*)(kp + 32)); }
#pragma unroll
        for (int c = 0; c < 4; ++c) { int tk = tb + dil * (32 * jp + 8 * c + vr8); if (MASKED) tk = tk < 0 ? 0 : (tk > tmax ? tmax : tk);
            vr[c] = *(const GAS v4u*)(vbase + (size_t)tk * pitch + 8 * vc8); }
        f32x4 sA = {0.f, 0.f, 0.f, 0.f}, sB = {0.f, 0.f, 0.f, 0.f};
        sA = __builtin_amdgcn_mfma_f32_16x16x32_bf16(ka[0][0], qf[0], sA, 0, 0, 0); sA = __builtin_amdgcn_mfma_f32_16x16x32_bf16(ka[0][1], qf[1], sA, 0, 0, 0);
        sB = __builtin_amdgcn_mfma_f32_16x16x32_bf16(ka[1][0], qf[0], sB, 0, 0, 0); sB = __builtin_amdgcn_mfma_f32_16x16x32_bf16(ka[1][1], qf[1], sB, 0, 0, 0);
        float l[8]; bool ok[8]; float mloc = -1.0e30f;
#pragma unroll
        for (int e = 0; e < 8; ++e) { const int u = 32 * jp + (e >> 2) * 16 + 4 * quad + (e & 3); const float a = (e < 4 ? sA[e & 3] : sB[e & 3]) * C2;
            if (MASKED) { const int kidx = 128 + qs * n - u; ok[e] = (kidx >= 0) && (kidx <= 128) && (tb + dil * u >= 0);
                const int kc = kidx < 0 ? 0 : (kidx > 128 ? 128 : kidx); l[e] = ok[e] ? a + bias2[kc] : -1.0e30f; }
            else { ok[e] = true; l[e] = a; }
            mloc = fmaxf(mloc, l[e]); }
        mloc = fmaxf(mloc, __shfl_xor(mloc, 16)); mloc = fmaxf(mloc, __shfl_xor(mloc, 32));
        const float mn = fmaxf(st.m, mloc), alpha = __builtin_amdgcn_exp2f(st.m - mn);
        float ps = 0.f; float p[8];
#pragma unroll
        for (int e = 0; e < 8; ++e) { p[e] = ok[e] ? __builtin_amdgcn_exp2f(l[e] - mn) : 0.f; ps += p[e]; }
        st.s = st.s * alpha + ps; st.m = mn;
#pragma unroll
        for (int i = 0; i < 4; ++i) st.o[i] = st.o[i] * alpha;
        v4u pk; pk.x = cvt_pk_bf16f(p[0], p[1]); pk.y = cvt_pk_bf16f(p[2], p[3]); pk.z = cvt_pk_bf16f(p[4], p[5]); pk.w = cvt_pk_bf16f(p[6], p[7]);
        const bf16x8 pb = __builtin_bit_cast(bf16x8, pk);
#pragma unroll
        for (int c = 0; c < 4; ++c) *(LAS v4u*)(size_t)(vwr + c * 8 * VROW) = vr[c];
        asm volatile("s_waitcnt lgkmcnt(0)" ::: "memory");
        const s16x4 a0 = tr_read<0>(vrd), b0 = tr_read<16 * VROW>(vrd), a1 = tr_read<32>(vrd), b1 = tr_read<16 * VROW + 32>(vrd);
        const s16x4 a2 = tr_read<64>(vrd), b2 = tr_read<16 * VROW + 64>(vrd), a3 = tr_read<96>(vrd), b3 = tr_read<16 * VROW + 96>(vrd);
        asm volatile("s_waitcnt lgkmcnt(0)" ::: "memory"); __builtin_amdgcn_sched_barrier(0);
#define PKV(L, H) (bf16x8){L[0], L[1], L[2], L[3], H[0], H[1], H[2], H[3]}
        st.o[0] = __builtin_amdgcn_mfma_f32_16x16x32_bf16(PKV(a0, b0), pb, st.o[0], 0, 0, 0);
        st.o[1] = __builtin_amdgcn_mfma_f32_16x16x32_bf16(PKV(a1, b1), pb, st.o[1], 0, 0, 0);
        st.o[2] = __builtin_amdgcn_mfma_f32_16x16x32_bf16(PKV(a2, b2), pb, st.o[2], 0, 0, 0);
        st.o[3] = __builtin_amdgcn_mfma_f32_16x16x32_bf16(PKV(a3, b3), pb, st.o[3], 0, 0, 0);
#undef PKV
        __builtin_amdgcn_sched_barrier(0);
    }
}
__device__ __forceinline__ void attn_store(const AttnSt& st, const bf16* gate_row  , bf16* out_row, int lane) {
    const int quad = lane >> 4;
    float s = st.s; s += __shfl_xor(s, 16); s += __shfl_xor(s, 32);
    const float inv = 1.f / s;
#pragma unroll
    for (int mt = 0; mt < 4; ++mt) { const v2u g = *(const GAS v2u*)(gate_row + 16 * mt + 4 * quad);
        const float o0 = st.o[mt][0] * inv * silu(bflo(g.x)), o1 = st.o[mt][1] * inv * silu(bfhi(g.x)), o2 = st.o[mt][2] * inv * silu(bflo(g.y)), o3 = st.o[mt][3] * inv * silu(bfhi(g.y));
        *(GAS v2u*)(out_row + 16 * mt + 4 * quad) = (v2u){pk2(o0, o1), pk2(o2, o3)}; }
}
__device__ __forceinline__ void load_qf(const bf16* qrow, int lane, bf16x8 (&qf)[2]) {
    const int quad = lane >> 4;
    qf[0] = __builtin_bit_cast(bf16x8, *(const GAS v4u*)(qrow + 8 * quad)); qf[1] = __builtin_bit_cast(bf16x8, *(const GAS v4u*)(qrow + 32 + 8 * quad));
}
__device__ __forceinline__ void attn_a_unit(const Ctx& C, const bf16* P, const bf16* MKV, bf16* H, const float* BT, int unit) {
    const int b = unit >> 5, hh = (unit >> 3) & 3, t0 = (unit & 7) * 256;
    LAS float* bias2 = (LAS float*)(C.lds + RING_OFF);
    LAS unsigned char* vbuf = C.lds + RING_OFF + 4096 + C.wave * VBUF;
    __syncthreads();
    for (int i = C.tid; i < 3 * 132; i += NWAVES * 64) { const int g = i / 132, k = i % 132; bias2[i] = k < 129 ? BT[(g * 4 + hh) * 132 + k] * LOG2E : 0.f; }
    __syncthreads();
    const int n = C.lane & 15;
    const bf16* Pb = P + (size_t)(b << 11) * A_IN;
#pragma unroll 1
    for (int set = 0; set < 2; ++set) {
        const int r = 2 * C.wave + set, tq = t0 + r + 16 * n;
        const bf16* qrow = Pb + (size_t)tq * A_IN;
        AttnSt st; attn_init(st);
#pragma unroll 1
        for (int g = 0; g < 3; ++g) {
            const int dil = g == 0 ? 1 : (g == 1 ? 4 : 16), qs = 16 / dil, np = g == 0 ? 12 : (g == 1 ? 6 : 5), head = g * 4 + hh;
            const int tb = t0 + r - 128 * dil;
            int j0 = 0; if (tb < 0) { j0 = (-tb - 31 * dil + 32 * dil - 1) / (32 * dil); if (j0 < 0) j0 = 0; }
            bf16x8 qf[2]; load_qf(qrow + head * 64, C.lane, qf);
            attn_pairs<true>(Pb + RW + head * 64, Pb + 2 * RW + head * 64, A_IN, tb, dil, qs, SEQ - 1, j0, np, qf, bias2 + g * 132, vbuf, C.lane, st);
        }
        attn_store(st, qrow + 2560 + hh * 64, H + ((size_t)(b << 11) + tq) * 512 + hh * 64, C.lane);
        AttnSt sm; attn_init(sm);
        { bf16x8 qf[2]; load_qf(qrow + 2304 + hh * 64, C.lane, qf);
          const bf16* kb = MKV + (size_t)(b * NMEM) * 1024 + hh * 64;
          attn_pairs<false>(kb, kb + 256, 1024, 0, 1, 0, NMEM - 1, 0, 8, qf, nullptr, vbuf, C.lane, sm); }
        attn_store(sm, qrow + 2560 + 256 + hh * 64, H + ((size_t)(b << 11) + tq) * 512 + 256 + hh * 64, C.lane);
    }
}
__device__ __forceinline__ void attn_b_unit(const Ctx& C, const bf16* P, const bf16* MKV, bf16* H, int unit) {
    const int b = unit >> 5, hh = (unit >> 3) & 3, t0 = (unit & 7) * 256;
    LAS unsigned char* vbuf = C.lds + RING_OFF + 4096 + C.wave * VBUF;
    const int n = C.lane & 15;
#pragma unroll 1
    for (int set = 0; set < 2; ++set) {
        const int r = 2 * C.wave + set, tq = t0 + r + 16 * n;
        const bf16* qrow = P + ((size_t)(b << 11) + tq) * B_INP;
        AttnSt sm; attn_init(sm);
        bf16x8 qf[2]; load_qf(qrow + CSH + hh * 64, C.lane, qf);
        const bf16* kb = MKV + (size_t)(b * NMEM) * 1024 + 512 + hh * 64;
        attn_pairs<false>(kb, kb + 256, 1024, 0, 1, 0, NMEM - 1, 0, 8, qf, nullptr, vbuf, C.lane, sm);
        attn_store(sm, qrow + 2688 + RW + hh * 64, H + ((size_t)(b << 11) + tq) * 1024 + RW + hh * 64, C.lane);
    }
}

__device__ __forceinline__ void row_pass(const bf16* hp, const float* xin, float* xout, const float* gpost, bf16* xn, int lane) {
    const GAS v2u* h2 = (const GAS v2u*)hp + lane; const GAS f32x4* xr = (const GAS f32x4*)xin + lane; const GAS f32x4* gp = (const GAS f32x4*)gpost + lane;
    f32x4 h[4], x[4]; float s = 0.f;
#pragma unroll
    for (int j = 0; j < 4; ++j) { const v2u u = h2[64 * j]; h[j] = (f32x4){bflo(u.x), bfhi(u.x), bflo(u.y), bfhi(u.y)}; x[j] = xr[64 * j];
        s += (h[j].x * h[j].x + h[j].y * h[j].y) + (h[j].z * h[j].z + h[j].w * h[j].w); }
    const float r = 1.f / sqrtf(wave_sum(s) * (1.f / DM) + RMS_EPS);
    float s2 = 0.f;
#pragma unroll
    for (int j = 0; j < 4; ++j) { const f32x4 g = gp[64 * j]; x[j] = x[j] + h[j] * r * g; s2 += (x[j].x * x[j].x + x[j].y * x[j].y) + (x[j].z * x[j].z + x[j].w * x[j].w);
        *((GAS f32x4*)xout + lane + 64 * j) = x[j]; }
    if (xn) { const float r2 = 1.f / sqrtf(wave_sum(s2) * (1.f / DM) + RMS_EPS);
        GAS unsigned long long* o8 = (GAS unsigned long long*)xn + lane;
#pragma unroll
        for (int j = 0; j < 4; ++j) o8[64 * j] = (unsigned long long)pk2(x[j].x * r2, x[j].y * r2) | ((unsigned long long)pk2(x[j].z * r2, x[j].w * r2) << 32); }
}

struct ScanP { const bf16 *P, *LORA; bf16* H; float* out; const float *st_wkv, *st_shift, *mu, *w0, *a0, *k_k, *k_a, *r_k, *ln_w, *ln_b; };
__device__ __forceinline__ void scan_unit(const Ctx& C, const ScanP& sp, int u) {
    LAS float* L = (LAS float*)(C.lds + RING_OFF);
    LAS float *LA = L, *LB = L + 4096, *LW = L + 8192, *LK = L + 12288, *LRW = L + 16384, *LV = L + 20480, *LSC = L + 24576, *LY = L + 24576 + 256;
    const bool samp = u >= 96; const int seq = samp ? (u - 96) / 12 : u / 12, h = samp ? (u - 96) % 12 : u % 12;
    const int T = samp ? STOK : SEQ, row0 = samp ? TP + seq * 4 : seq * SEQ;
    int row = C.wave * 8 + (C.lane >> 3), p = C.lane & 7;
    asm volatile("" : "+v"(row), "+v"(p));
    float S[8];
#pragma unroll
    for (int j = 0; j < 8; ++j) S[j] = samp ? sp.st_wkv[((size_t)(seq * 12 + h) * 64 + row) * 64 + p * 8 + j] : 0.f;
#pragma unroll 1
    for (int c0 = 0; c0 < T; c0 += 64) {
        const int n = (T - c0) < 64 ? (T - c0) : 64;
        int tok = C.tid >> 3, part = C.tid & 7;
        asm volatile("" : "+v"(tok), "+v"(part));
        __syncthreads();
        if (tok < n) {
            const int t = c0 + tok, m = row0 + t;
            const bf16* cur = sp.P + (size_t)m * B_INP; const bf16* prv = cur - B_INP; const bf16* lo = sp.LORA + (size_t)m * 1536;
            float xr[8], xk[8], xv[8], kk[8], av[8], dv[8];
            float nrm = 0.f;
#pragma unroll
            for (int j = 0; j < 8; ++j) { const int c = h * 64 + part * 8 + j;
                const float cr = bf2f(cur[c]), ck = bf2f(cur[RW + c]), cv = bf2f(cur[2 * RW + c]);
                float pr = 0.f, pk = 0.f, pv = 0.f;
                if (t > 0) { pr = bf2f(prv[c]); pk = bf2f(prv[RW + c]); pv = bf2f(prv[2 * RW + c]); }
                else if (samp) { const float* ss = sp.st_shift + (size_t)seq * CSH; pr = ss[c]; pk = ss[RW + c]; pv = ss[2 * RW + c]; }
                xr[j] = cr + sp.mu[c] * (pr - cr); xk[j] = ck + sp.mu[RW + c] * (pk - ck); xv[j] = cv + sp.mu[2 * RW + c] * (pv - cv);
                const float dpre = sp.w0[c] + bf2f(lo[c]), apre = sp.a0[c] + bf2f(lo[RW + c]);
                const float z = -dpre, spl = fmaxf(z, 0.f) + log1pf(expf(-fabsf(z)));
                const float wlog = -spl - 0.5f; dv[j] = expf(-expf(wlog));
                av[j] = 1.f / (1.f + expf(-apre));
                kk[j] = xk[j] * sp.k_k[c]; nrm += kk[j] * kk[j]; }
            nrm += __shfl_xor(nrm, 1); nrm += __shfl_xor(nrm, 2); nrm += __shfl_xor(nrm, 4);
            const float inv = 1.f / fmaxf(sqrtf(nrm), 1e-12f);
            float br = 0.f, kr = 0.f, bon = 0.f;
#pragma unroll
            for (int j = 0; j < 8; ++j) { const int c = h * 64 + part * 8 + j, d = part * 8 + j;
                const float kn = kk[j] * inv, k2 = xk[j] * (1.f + (av[j] - 1.f) * sp.k_a[c]);
                const float bb = kn * av[j];
                LA[tok * 64 + d] = -kn; LB[tok * 64 + d] = bb; LW[tok * 64 + d] = dv[j]; LK[tok * 64 + d] = k2; LRW[tok * 64 + d] = xr[j] * dv[j]; LV[tok * 64 + d] = xv[j];
                br += bb * xr[j]; kr += k2 * xr[j]; bon += xr[j] * k2 * sp.r_k[c]; }
            br += __shfl_xor(br, 1); br += __shfl_xor(br, 2); br += __shfl_xor(br, 4);
            kr += __shfl_xor(kr, 1); kr += __shfl_xor(kr, 2); kr += __shfl_xor(kr, 4);
            bon += __shfl_xor(bon, 1); bon += __shfl_xor(bon, 2); bon += __shfl_xor(bon, 4);
            if (part == 0) { LSC[tok * 4 + 0] = br; LSC[tok * 4 + 1] = kr; LSC[tok * 4 + 2] = bon; }
        }
        __syncthreads();
#pragma unroll 1
        for (int i = 0; i < n; ++i) {
            const LAS f32x4* a4 = (const LAS f32x4*)(LA + i * 64 + p * 8); const LAS f32x4* r4 = (const LAS f32x4*)(LRW + i * 64 + p * 8);
            const LAS f32x4* w4 = (const LAS f32x4*)(LW + i * 64 + p * 8); const LAS f32x4* b4 = (const LAS f32x4*)(LB + i * 64 + p * 8); const LAS f32x4* k4 = (const LAS f32x4*)(LK + i * 64 + p * 8);
            const f32x4 a0 = a4[0], a1 = a4[1], r0 = r4[0], r1 = r4[1];
            float sa = (S[0] * a0.x + S[1] * a0.y) + (S[2] * a0.z + S[3] * a0.w) + (S[4] * a1.x + S[5] * a1.y) + (S[6] * a1.z + S[7] * a1.w);
            float yp = (S[0] * r0.x + S[1] * r0.y) + (S[2] * r0.z + S[3] * r0.w) + (S[4] * r1.x + S[5] * r1.y) + (S[6] * r1.z + S[7] * r1.w);
            sa += __shfl_xor(sa, 1); sa += __shfl_xor(sa, 2); sa += __shfl_xor(sa, 4);
            yp += __shfl_xor(yp, 1); yp += __shfl_xor(yp, 2); yp += __shfl_xor(yp, 4);
            const float v = LV[i * 64 + row], br = LSC[i * 4 + 0], kr = LSC[i * 4 + 1];
            const f32x4 w0 = w4[0], w1 = w4[1], b0 = b4[0], b1 = b4[1], k0 = k4[0], k1 = k4[1];
            S[0] = S[0] * w0.x + sa * b0.x + v * k0.x; S[1] = S[1] * w0.y + sa * b0.y + v * k0.y; S[2] = S[2] * w0.z + sa * b0.z + v * k0.z; S[3] = S[3] * w0.w + sa * b0.w + v * k0.w;
            S[4] = S[4] * w1.x + sa * b1.x + v * k1.x; S[5] = S[5] * w1.y + sa * b1.y + v * k1.y; S[6] = S[6] * w1.z + sa * b1.z + v * k1.z; S[7] = S[7] * w1.w + sa * b1.w + v * k1.w;
            if (p == 0) LY[i * 64 + row] = yp + sa * br + v * kr;
        }
        __syncthreads();
        asm volatile("" : "+v"(tok), "+v"(part));
        if (tok < n) {
            const int m = row0 + c0 + tok;
            float y[8]; float s = 0.f;
#pragma unroll
            for (int j = 0; j < 8; ++j) { y[j] = LY[tok * 64 + part * 8 + j]; s += y[j]; }
            s += __shfl_xor(s, 1); s += __shfl_xor(s, 2); s += __shfl_xor(s, 4);
            const float mean = s * (1.f / 64.f); float q = 0.f;
#pragma unroll
            for (int j = 0; j < 8; ++j) { y[j] -= mean; q += y[j] * y[j]; }
            q += __shfl_xor(q, 1); q += __shfl_xor(q, 2); q += __shfl_xor(q, 4);
            const float rstd = 1.f / sqrtf(q * (1.f / 64.f) + GN_EPS), bon = LSC[tok * 4 + 2];
            unsigned w[4];
#pragma unroll
            for (int j = 0; j < 8; j += 2) { float o2[2];
#pragma unroll
                for (int e = 0; e < 2; ++e) { const int c = h * 64 + part * 8 + j + e;
                    const float yy = y[j + e] * rstd * sp.ln_w[c] + sp.ln_b[c] + bon * LV[tok * 64 + part * 8 + j + e];
                    o2[e] = yy * silu(bf2f(sp.P[(size_t)m * B_INP + 2688 + c])); }
                w[j >> 1] = pk2(o2[0], o2[1]); }
            *(GAS v4u*)(sp.H + (size_t)m * 1024 + h * 64 + part * 8) = (v4u){w[0], w[1], w[2], w[3]};
        }
    }
    float* so = sp.out + (samp ? O_WKVS : O_WKVP) + ((size_t)(seq * 12 + h) * 64 + row) * 64 + p * 8;
    *(GAS f32x4*)so = (f32x4){S[0], S[1], S[2], S[3]}; *((GAS f32x4*)so + 1) = (f32x4){S[4], S[5], S[6], S[7]};
    __syncthreads();
}

constexpr int TS = 72;
constexpr int IMG = 64 * TS * 2;
constexpr int L_AT = 0, L_RT = IMG, L_BT = 2 * IMG, L_KT = 3 * IMG, L_VV = 4 * IMG, L_SB = 5 * IMG, L_Z = 6 * IMG, L_SA = 7 * IMG,
              L_NKA = 8 * IMG, L_NBR = 9 * IMG, L_NKR = 10 * IMG, L_TT = 11 * IMG, L_E = 12 * IMG, L_PC = L_E + 16384, L_BON = L_PC + 256, L_SEG = L_BON + 256, L_CH_END = L_SEG + 2048;
constexpr int NSLOT = 7, L_SLOT0 = 3 * IMG + 16384 + 256 + 256 + 2048;
static_assert(L_CH_END <= RING_BYTES && L_SLOT0 + NSLOT * 16384 <= RING_BYTES, "chunk-scan LDS map");
constexpr int LA_AT = 0, LA_BT = IMG, LA_E = 2 * IMG, LA_PC = LA_E + 16384, LA_BON = LA_PC + 256, LA_SEG = LA_BON + 256;

struct ChunkP { const bf16 *P, *LORA; const float *mu, *w0, *a0, *k_k, *k_a, *r_k; };
struct PrepR { float xr[8], xv[8], kn[8], as[8], k2[8], e[8], bon; };
struct PrepL { v4u cr4, ck4, cv4, pr4, pk4, pv4, lw4, la4, g4; };
__device__ __forceinline__ void prep_load(const ChunkP& cp, int m0, int t0tok, int h, int tok, int part, PrepL& L) {
    const int m = m0 + tok; const bool first = (t0tok + tok) == 0;
    const bf16* cur = cp.P + (size_t)m * B_INP + h * 64 + part * 8; const bf16* lo = cp.LORA + (size_t)m * 1536 + h * 64 + part * 8;
    L.cr4 = *(const GAS v4u*)cur; L.ck4 = *(const GAS v4u*)(cur + RW); L.cv4 = *(const GAS v4u*)(cur + 2 * RW);
    L.pr4 = (v4u){0u, 0u, 0u, 0u}; L.pk4 = L.pr4; L.pv4 = L.pr4;
    if (!first) { L.pr4 = *(const GAS v4u*)(cur - B_INP); L.pk4 = *(const GAS v4u*)(cur - B_INP + RW); L.pv4 = *(const GAS v4u*)(cur - B_INP + 2 * RW); }
    L.lw4 = *(const GAS v4u*)lo; L.la4 = *(const GAS v4u*)(lo + RW);
    L.g4 = *(const GAS v4u*)(cur + 2688);
}
__device__ __forceinline__ void prep_step1(const ChunkP& cp, const PrepL& L, int h, int tok, int part, LAS unsigned char* lds, int offE, PrepR& R) {
    float xk[8], kk[8]; float nrm = 0.f;
#pragma unroll
    for (int j = 0; j < 8; ++j) { const int c = h * 64 + part * 8 + j;
        const unsigned ur = L.cr4[j >> 1], uk = L.ck4[j >> 1], uv = L.cv4[j >> 1], upr = L.pr4[j >> 1], upk = L.pk4[j >> 1], upv = L.pv4[j >> 1], ulw = L.lw4[j >> 1], ula = L.la4[j >> 1];
        const float cr = (j & 1) ? bfhi(ur) : bflo(ur), ck = (j & 1) ? bfhi(uk) : bflo(uk), cv = (j & 1) ? bfhi(uv) : bflo(uv);
        const float pr = (j & 1) ? bfhi(upr) : bflo(upr), pk = (j & 1) ? bfhi(upk) : bflo(upk), pv = (j & 1) ? bfhi(upv) : bflo(upv);
        const float lw = (j & 1) ? bfhi(ulw) : bflo(ulw), la = (j & 1) ? bfhi(ula) : bflo(ula);
        R.xr[j] = cr + cp.mu[c] * (pr - cr); xk[j] = ck + cp.mu[RW + c] * (pk - ck); R.xv[j] = cv + cp.mu[2 * RW + c] * (pv - cv);
        const float dpre = cp.w0[c] + lw, apre = cp.a0[c] + la;
        R.e[j] = 0.6065306597f * __builtin_amdgcn_rcpf(1.f + __expf(-dpre));
        R.as[j] = __builtin_amdgcn_rcpf(1.f + __expf(-apre));
        kk[j] = xk[j] * cp.k_k[c]; nrm += kk[j] * kk[j]; }
    nrm += __shfl_xor(nrm, 1); nrm += __shfl_xor(nrm, 2); nrm += __shfl_xor(nrm, 4);
    const float inv = __builtin_amdgcn_rsqf(fmaxf(nrm, 1e-24f));
    float bon = 0.f;
#pragma unroll
    for (int j = 0; j < 8; ++j) { const int c = h * 64 + part * 8 + j; R.kn[j] = kk[j] * inv; R.k2[j] = xk[j] * (1.f + (R.as[j] - 1.f) * cp.k_a[c]); bon += R.xr[j] * R.k2[j] * cp.r_k[c]; }
    bon += __shfl_xor(bon, 1); bon += __shfl_xor(bon, 2); bon += __shfl_xor(bon, 4);
    R.bon = bon;
    LAS float* E = (LAS float*)(lds + offE) + tok * 64 + part * 8;
    *(LAS f32x4*)E = (f32x4){R.e[0], R.e[1], R.e[2], R.e[3]}; *((LAS f32x4*)E + 1) = (f32x4){R.e[4], R.e[5], R.e[6], R.e[7]};
}
__device__ __forceinline__ void prep_cumsum(int tid, LAS unsigned char* lds, int offE, int offSEG) {
    LAS float* E = (LAS float*)(lds + offE); LAS float* SEG = (LAS float*)(lds + offSEG);
    const int d = tid & 63, seg = tid >> 6;
    float v[8]; float run = 0.f;
#pragma unroll
    for (int j = 0; j < 8; ++j) { run += E[(seg * 8 + j) * 64 + d]; v[j] = run; }
    SEG[seg * 64 + d] = run;
    __syncthreads();
    float off = 0.f;
#pragma unroll
    for (int s = 0; s < 7; ++s) off += (s < seg) ? SEG[s * 64 + d] : 0.f;
#pragma unroll
    for (int j = 0; j < 8; ++j) E[(seg * 8 + j) * 64 + d] = v[j] + off;
}
__device__ __forceinline__ void st8bf(LAS unsigned char* lds, int off, int tok, int part, const float (&x)[8]) {
    *(LAS v4u*)(lds + off + (tok * TS + part * 8) * 2) = (v4u){pk2(x[0], x[1]), pk2(x[2], x[3]), pk2(x[4], x[5]), pk2(x[6], x[7])};
}
template <bool FULL>
__device__ __forceinline__ void prep_step3(int tok, int part, LAS unsigned char* lds, int offE, int offAT, int offBT, int offRT, int offKT, int offVV, int offPC, int offBON, const PrepR& R) {
    const LAS float* E = (const LAS float*)(lds + offE) + tok * 64 + part * 8;
    const f32x4 c0 = *(const LAS f32x4*)E, c1 = *((const LAS f32x4*)E + 1);
    float at[8], bt[8], rt[8], kt[8];
#pragma unroll
    for (int j = 0; j < 8; ++j) { const float cum = j < 4 ? c0[j & 3] : c1[j & 3];
        const float pm1 = __expf(R.e[j] - cum), ip = __expf(cum);
        at[j] = -R.kn[j] * pm1; bt[j] = R.kn[j] * R.as[j] * ip;
        if (FULL) { const float pt = __builtin_amdgcn_rcpf(ip); rt[j] = R.xr[j] * pt; kt[j] = R.k2[j] * ip;
            if (tok == 63) ((LAS float*)(lds + offPC))[part * 8 + j] = pt; } }
    st8bf(lds, offAT, tok, part, at); st8bf(lds, offBT, tok, part, bt);
    if (FULL) { st8bf(lds, offRT, tok, part, rt); st8bf(lds, offKT, tok, part, kt); st8bf(lds, offVV, tok, part, R.xv);
        if (part == 0) ((LAS float*)(lds + offBON))[tok] = R.bon; }
}
__device__ __forceinline__ bf16x8 frag_nat(const LAS unsigned char* img, int R0, int ks, int lane) {
    return __builtin_bit_cast(bf16x8, *(const LAS v4u*)(img + ((R0 + (lane & 15)) * TS + 32 * ks + 8 * (lane >> 4)) * 2));
}
__device__ __forceinline__ bf16x8 frag_tr(const LAS unsigned char* img, int I0, int ks, int lane) {
    const int i16 = lane & 15, quad = lane >> 4;
    const unsigned a = (unsigned)(size_t)img + (unsigned)(((32 * ks + 8 * quad + (i16 >> 2)) * TS + I0 + 4 * (i16 & 3)) * 2);
    const s16x4 lo = tr_read<0>(a), hi = tr_read<4 * TS * 2>(a);
    asm volatile("s_waitcnt lgkmcnt(0)" ::: "memory"); __builtin_amdgcn_sched_barrier(0);
    return (bf16x8){lo[0], lo[1], lo[2], lo[3], hi[0], hi[1], hi[2], hi[3]};
}
#define MFMA16(a, b, c) __builtin_amdgcn_mfma_f32_16x16x32_bf16((a), (b), (c), 0, 0, 0)
__device__ __forceinline__ void st_tile_T(LAS unsigned char* img, int C0, int R0, int lane, f32x4 v) {
    *(LAS v2u*)(img + ((C0 + (lane & 15)) * TS + R0 + 4 * (lane >> 4)) * 2) = (v2u){pk2(v[0], v[1]), pk2(v[2], v[3])};
}

__device__ __forceinline__ void scan_stage_a(const Ctx& C, const ChunkP& cp, bf16* TT, int task0, int ntask) {
    LAS unsigned char* lds = C.lds + RING_OFF;
    const int tok = C.tid >> 3, part = C.tid & 7, vs = C.wave & 3, rh = C.wave >> 2;
#pragma unroll 1
    for (int base = 0; base < ntask; base += NSLOT) {
        const int nr = (ntask - base) < NSLOT ? (ntask - base) : NSLOT;
#pragma unroll 1
        for (int s = 0; s < nr; ++s) {
            const int task = task0 + base + s, bh = task >> 5, c = task & 31, b = bh / 12, h = bh % 12;
            PrepR R; PrepL L; prep_load(cp, b * SEQ + c * 64, c * 64, h, tok, part, L);
            __syncthreads();
            prep_step1(cp, L, h, tok, part, lds, LA_E, R);
            __syncthreads();
            prep_cumsum(C.tid, lds, LA_E, LA_SEG);
            __syncthreads();
            prep_step3<false>(tok, part, lds, LA_E, LA_AT, LA_BT, 0, 0, 0, 0, 0, R);
            __syncthreads();
            LAS float* slot = (LAS float*)(lds + L_SLOT0 + s * 16384);
            const bf16x8 b0 = frag_nat(lds + LA_AT, 16 * vs, 0, C.lane), b1 = frag_nat(lds + LA_AT, 16 * vs, 1, C.lane);
#pragma unroll
            for (int q = 0; q < 2; ++q) { const int it = 2 * rh + q;
                f32x4 acc = {0.f, 0.f, 0.f, 0.f};
                acc = MFMA16(frag_nat(lds + LA_BT, 16 * it, 0, C.lane), b0, acc); acc = MFMA16(frag_nat(lds + LA_BT, 16 * it, 1, C.lane), b1, acc);
                const int t = 16 * vs + (C.lane & 15), i0 = 16 * it + 4 * (C.lane >> 4);
                f32x4 o; o[0] = (i0 + 0 < t) ? acc[0] : 0.f; o[1] = (i0 + 1 < t) ? acc[1] : 0.f; o[2] = (i0 + 2 < t) ? acc[2] : 0.f; o[3] = (i0 + 3 < t) ? acc[3] : 0.f;
                *(LAS f32x4*)(slot + t * 64 + i0) = o; }
        }
        __syncthreads();
        if (C.wave < nr) {
            const LAS float* Nl = (const LAS float*)(lds + L_SLOT0 + C.wave * 16384);
            float Tr[64];
#pragma unroll
            for (int t = 0; t < 64; ++t) { float acc = (C.lane == t) ? 1.f : 0.f;
#pragma unroll
                for (int i = 0; i < t; ++i) acc += Tr[i] * Nl[t * 64 + i];
                Tr[t] = acc; }
            bf16* o = TT + (size_t)(task0 + base + C.wave) * 4096 + C.lane;
#pragma unroll
            for (int t = 0; t < 64; ++t) o[t * 64] = (bf16)f2bf(Tr[t]);
        }
    }
    __syncthreads();
}

struct ScanBP { ChunkP cp; const bf16* TT; bf16* H; float* out; const float *ln_w, *ln_b; };
__device__ __forceinline__ void scan_stage_b(const Ctx& C, const ScanBP& sb, int bh) {
    LAS unsigned char* lds = C.lds + RING_OFF;
    const int b = bh / 12, h = bh % 12;
    const int tok = C.tid >> 3, part = C.tid & 7, vs = C.wave & 3, rh = C.wave >> 2, l15 = C.lane & 15, quad = C.lane >> 4;
    f32x4 St[2] = {{0.f, 0.f, 0.f, 0.f}, {0.f, 0.f, 0.f, 0.f}};
    __syncthreads();
    for (int i = C.tid; i < IMG / 4; i += NWAVES * 64) ((LAS unsigned*)(lds + L_SB))[i] = 0u;
    PrepL Ln; prep_load(sb.cp, b * SEQ, 0, h, tok, part, Ln);
#pragma unroll 1
    for (int c = 0; c < 32; ++c) {
        const int m0 = b * SEQ + c * 64;
        PrepR R; const v4u g4 = Ln.g4;
        __syncthreads();
        prep_step1(sb.cp, Ln, h, tok, part, lds, L_E, R);
        { const v4u tv = *((const GAS v4u*)(sb.TT + (size_t)(bh * 32 + c) * 4096) + C.tid);
          *(LAS v4u*)(lds + L_TT + ((C.tid >> 3) * TS + (C.tid & 7) * 8) * 2) = tv; }
        __syncthreads();
        prep_cumsum(C.tid, lds, L_E, L_SEG);
        __syncthreads();
        prep_step3<true>(tok, part, lds, L_E, L_AT, L_BT, L_RT, L_KT, L_VV, L_PC, L_BON, R);
        if (c < 31) prep_load(sb.cp, m0 + 64, c * 64 + 64, h, tok, part, Ln);
        __syncthreads();
        {   const bf16x8 a0 = frag_nat(lds + L_AT, 16 * vs, 0, C.lane), a1 = frag_nat(lds + L_AT, 16 * vs, 1, C.lane);
            const bf16x8 r0 = frag_nat(lds + L_RT, 16 * vs, 0, C.lane), r1 = frag_nat(lds + L_RT, 16 * vs, 1, C.lane);
#pragma unroll
            for (int q = 0; q < 2; ++q) { const int it = 2 * rh + q;
                const bf16x8 k0 = frag_nat(lds + L_KT, 16 * it, 0, C.lane), k1 = frag_nat(lds + L_KT, 16 * it, 1, C.lane);
                const bf16x8 bb0 = frag_nat(lds + L_BT, 16 * it, 0, C.lane), bb1 = frag_nat(lds + L_BT, 16 * it, 1, C.lane);
                f32x4 nka = {0.f, 0.f, 0.f, 0.f}, nbr = nka, nkr = nka;
                nka = MFMA16(k0, a0, nka); nka = MFMA16(k1, a1, nka);
                nbr = MFMA16(bb0, r0, nbr); nbr = MFMA16(bb1, r1, nbr);
                nkr = MFMA16(k0, r0, nkr); nkr = MFMA16(k1, r1, nkr);
                const int t = 16 * vs + l15, i0 = 16 * it + 4 * quad;
#pragma unroll
                for (int e = 0; e < 4; ++e) { if (!(i0 + e < t)) nka[e] = 0.f; if (!(i0 + e <= t)) { nbr[e] = 0.f; nkr[e] = 0.f; } }
                st_tile_T(lds + L_NKA, 16 * vs, 16 * it, C.lane, nka); st_tile_T(lds + L_NBR, 16 * vs, 16 * it, C.lane, nbr); st_tile_T(lds + L_NKR, 16 * vs, 16 * it, C.lane, nkr); }
        }
        __syncthreads();
        {   const bf16x8 s0 = frag_nat(lds + L_SB, 16 * vs, 0, C.lane), s1 = frag_nat(lds + L_SB, 16 * vs, 1, C.lane);
            const bf16x8 v0 = frag_tr(lds + L_VV, 16 * vs, 0, C.lane), v1 = frag_tr(lds + L_VV, 16 * vs, 1, C.lane);
#pragma unroll
            for (int q = 0; q < 2; ++q) { const int tt = 2 * rh + q; f32x4 z = {0.f, 0.f, 0.f, 0.f};
                z = MFMA16(frag_nat(lds + L_AT, 16 * tt, 0, C.lane), s0, z); z = MFMA16(frag_nat(lds + L_AT, 16 * tt, 1, C.lane), s1, z);
                z = MFMA16(frag_nat(lds + L_NKA, 16 * tt, 0, C.lane), v0, z); z = MFMA16(frag_nat(lds + L_NKA, 16 * tt, 1, C.lane), v1, z);
                st_tile_T(lds + L_Z, 16 * vs, 16 * tt, C.lane, z); }
        }
        __syncthreads();
        {   const bf16x8 z0 = frag_nat(lds + L_Z, 16 * vs, 0, C.lane), z1 = frag_nat(lds + L_Z, 16 * vs, 1, C.lane);
#pragma unroll
            for (int q = 0; q < 2; ++q) { const int tt = 2 * rh + q; f32x4 sa = {0.f, 0.f, 0.f, 0.f};
                sa = MFMA16(frag_nat(lds + L_TT, 16 * tt, 0, C.lane), z0, sa); sa = MFMA16(frag_nat(lds + L_TT, 16 * tt, 1, C.lane), z1, sa);
                st_tile_T(lds + L_SA, 16 * vs, 16 * tt, C.lane, sa); }
        }
        __syncthreads();
        {   const bf16x8 s0 = frag_nat(lds + L_SB, 16 * vs, 0, C.lane), s1 = frag_nat(lds + L_SB, 16 * vs, 1, C.lane);
            const bf16x8 sa0 = frag_nat(lds + L_SA, 16 * vs, 0, C.lane), sa1 = frag_nat(lds + L_SA, 16 * vs, 1, C.lane);
            const bf16x8 v0 = frag_tr(lds + L_VV, 16 * vs, 0, C.lane), v1 = frag_tr(lds + L_VV, 16 * vs, 1, C.lane);
            f32x4 y[2], d[2];
#pragma unroll
            for (int q = 0; q < 2; ++q) { const int tt = 2 * rh + q; f32x4 yy = {0.f, 0.f, 0.f, 0.f};
                yy = MFMA16(frag_nat(lds + L_RT, 16 * tt, 0, C.lane), s0, yy); yy = MFMA16(frag_nat(lds + L_RT, 16 * tt, 1, C.lane), s1, yy);
                yy = MFMA16(frag_nat(lds + L_NBR, 16 * tt, 0, C.lane), sa0, yy); yy = MFMA16(frag_nat(lds + L_NBR, 16 * tt, 1, C.lane), sa1, yy);
                yy = MFMA16(frag_nat(lds + L_NKR, 16 * tt, 0, C.lane), v0, yy); yy = MFMA16(frag_nat(lds + L_NKR, 16 * tt, 1, C.lane), v1, yy);
                y[q] = yy;
                f32x4 dd = {0.f, 0.f, 0.f, 0.f};
                dd = MFMA16(frag_tr(lds + L_BT, 16 * tt, 0, C.lane), sa0, dd); dd = MFMA16(frag_tr(lds + L_BT, 16 * tt, 1, C.lane), sa1, dd);
                dd = MFMA16(frag_tr(lds + L_KT, 16 * tt, 0, C.lane), v0, dd); dd = MFMA16(frag_tr(lds + L_KT, 16 * tt, 1, C.lane), v1, dd);
                d[q] = dd; }
            __syncthreads();
            LAS float* Y = (LAS float*)(lds + L_E);
#pragma unroll
            for (int q = 0; q < 2; ++q) { const int r0 = 16 * (2 * rh + q) + 4 * quad, v = 16 * vs + l15;
#pragma unroll
                for (int e = 0; e < 4; ++e) Y[(r0 + e) * 64 + v] = y[q][e];
                const f32x4 pc = *(const LAS f32x4*)(lds + L_PC + r0 * 4);
                St[q] = (St[q] + d[q]) * pc;
                st_tile_T(lds + L_SB, 16 * vs, 16 * (2 * rh + q), C.lane, St[q]); }
        }
        __syncthreads();
        {   const int m = m0 + tok; const LAS float* Y = (const LAS float*)(lds + L_E) + tok * 64 + part * 8;
            const f32x4 y0 = *(const LAS f32x4*)Y, y1 = *((const LAS f32x4*)Y + 1);
            float y[8] = {y0[0], y0[1], y0[2], y0[3], y1[0], y1[1], y1[2], y1[3]}; float s = 0.f;
#pragma unroll
            for (int j = 0; j < 8; ++j) s += y[j];
            s += __shfl_xor(s, 1); s += __shfl_xor(s, 2); s += __shfl_xor(s, 4);
            const float mean = s * (1.f / 64.f); float qq = 0.f;
#pragma unroll
            for (int j = 0; j < 8; ++j) { y[j] -= mean; qq += y[j] * y[j]; }
            qq += __shfl_xor(qq, 1); qq += __shfl_xor(qq, 2); qq += __shfl_xor(qq, 4);
            const float rstd = __builtin_amdgcn_rsqf(qq * (1.f / 64.f) + GN_EPS), bon = R.bon;
            float o[8];
#pragma unroll
            for (int j = 0; j < 8; ++j) { const int cc = h * 64 + part * 8 + j; const unsigned ug = g4[j >> 1]; const float g = (j & 1) ? bfhi(ug) : bflo(ug);
                o[j] = (y[j] * rstd * sb.ln_w[cc] + sb.ln_b[cc] + bon * R.xv[j]) * silu(g); }
            *(GAS v4u*)(sb.H + (size_t)m * 1024 + h * 64 + part * 8) = (v4u){pk2(o[0], o[1]), pk2(o[2], o[3]), pk2(o[4], o[5]), pk2(o[6], o[7])};
        }
    }
#pragma unroll
    for (int q = 0; q < 2; ++q) { float* so = sb.out + O_WKVP + ((size_t)bh * 64 + 16 * vs + l15) * 64 + 16 * (2 * rh + q) + 4 * quad; *(GAS f32x4*)so = St[q]; }
    __syncthreads();
}

constexpr int PTAB_OFF = LDSCTL_OFF + 512;
__device__ __forceinline__ const float* inptr(LAS unsigned char* ldsb, int i) {
    const LAS unsigned* p = (const LAS unsigned*)(ldsb + PTAB_OFF) + 2 * i;
    const unsigned lo = __builtin_amdgcn_readfirstlane(p[0]), hi = __builtin_amdgcn_readfirstlane(p[1]);
    return (const float*)(((unsigned long long)hi << 32) | lo);
}
struct Args { const float* in[28]; float* out; unsigned char* ws; int ph_lo, ph_hi; };
#define WSP(T, off) ((T*)(args.ws + (off)))
#define GEMM_BF16(Aptr, Bptr, Optr, Mv, Nv, Kv) do { pg8::Gemm g{Aptr, Bptr, Mv, Nv, Kv}; pg8::StaticOrder S; S.init(Mv, Nv, C.G, (int)blockIdx.x); \
        pg8::EpiBf16<0> E{Optr, Nv, nullptr, 0, 0, 1.f}; pg8::gemm_phase<pg8::EpiBf16<0>, pg8::StaticOrder, PG8_ALIGN, PG8_SP2>(C.lds + RING_OFF, g, S, E); } while (0)
__global__ void __launch_bounds__(NWAVES * 64, 2) hyb_fwd(Args args) {
    extern __shared__ __attribute__((aligned(16))) unsigned char lds[];
    LAS unsigned char* const ldsb = (LAS unsigned char*)lds;
    for (int u = threadIdx.x; u < (LDS_BYTES - LDSCTL_OFF) / 4; u += NWAVES * 64) ((LAS unsigned*)(ldsb + LDSCTL_OFF))[u] = 0u;
    __syncthreads();
    if (threadIdx.x < 28) ((LAS unsigned long long*)(ldsb + PTAB_OFF))[threadIdx.x] = (unsigned long long)args.in[threadIdx.x];
    __syncthreads();
#define INP(i) inptr(ldsb, (i))
#define MKCTX() Ctx C; { int t_ = threadIdx.x; asm volatile("" : "+v"(t_)); C.lds = ldsb; C.tid = t_; C.lane = t_ & 63; C.wave = __builtin_amdgcn_readfirstlane(t_ >> 6); \
        C.G = gridDim.x; const int bx_ = blockIdx.x; C.vcu = (C.G % 8 == 0) ? (bx_ % 8) * (C.G / 8) + bx_ / 8 : bx_; C.gw = C.vcu * NWAVES + C.wave; C.NGW = C.G * NWAVES; } \
        const int gt = C.gw * 64 + C.lane, NGT = C.NGW * 64; (void)gt; (void)NGT
    const int lo = args.ph_lo, hi = args.ph_hi;
    const bool fused = (hi - lo) > 1;
    XcdBarrier bar; bar.bar = WSP(unsigned, WS_CTL) + CW_BAR; bar.x = 0; bar.st = nullptr;
    if (fused) bar = xcd_barrier_post(WSP(unsigned, WS_CTL) + CW_BAR, (volatile LAS unsigned*)(ldsb + MISC_OFF) + 8);
#ifndef PROBE_PHASE
#define PROBE_PHASE -1
#endif
#define IN(k) (lo <= (k) && (k) < hi)
#define REP(k) for (int rep_ = 0; rep_ < ((k) == PROBE_PHASE ? 2 : 1); ++rep_)
#define SEAM(k) do { if (IN(k) && IN((k) + 1)) xcd_barrier(bar); } while (0)

    if (IN(0)) REP(0) { MKCTX();
        LAS float* scr = (LAS float*)(C.lds + RING_OFF + C.wave * 16384);
        constexpr int I0 = 16 * 96, I1 = 8 * 32, I2 = 16 * 116, I3 = 16 * 32, I4 = 16 * 16, I5 = 16 * 16, I6 = 24, I7 = 24;
        constexpr int NITEMS = I0 + I1 + I2 + I3 + I4 + I5 + I6 + I7;
        for (int it = C.gw; it < NITEMS; it += C.NGW) {
            int r = it;
            if (r < I0) { p0_transpose_item(INP(14), A_IN, INP(9), WSP(bf16, WS_WAIN), 1024, 0, 0, scr, r, 96, C.lane); continue; } r -= I0;
            if (r < I1) { p0_transpose_item(INP(15), 1024, nullptr, WSP(bf16, WS_WAOUT), 512, 0, 0, scr, r, 32, C.lane); continue; } r -= I1;
            if (r < I2) { p0_transpose_item(INP(16), B_IN, INP(9) + DM, WSP(bf16, WS_WBIN), 1024, 0, 0, scr, r, 116, C.lane); continue; } r -= I2;
            if (r < I3) { p0_transpose_item(INP(17), 1024, nullptr, WSP(bf16, WS_WBOUT), 1024, 0, 0, scr, r, 32, C.lane); continue; } r -= I3;
            if (r < I4) { p0_transpose_item(INP(12), 512, INP(11), WSP(bf16, WS_WM), 1024, 0, 0, scr, r, 16, C.lane); continue; } r -= I4;
            if (r < I5) { p0_transpose_item(INP(12) + 1024 * 512, 512, INP(11) + DM, WSP(bf16, WS_WM), 1024, 0, 512, scr, r, 16, C.lane); continue; } r -= I5;
            if (r < I6) { p0_transpose_item(INP(20), RW, nullptr, WSP(bf16, WS_WL), 128, 0, 0, scr, r, 24, C.lane); continue; } r -= I6;
            p0_transpose_item(INP(22), RW, nullptr, WSP(bf16, WS_WL), 128, 64, RW, scr, r, 24, C.lane);
        }
        const v4u z4 = {0u, 0u, 0u, 0u};
        for (int i = gt; i < 16384; i += NGT) *((GAS v4u*)(WSP(bf16, WS_WBIN) + (size_t)B_IN * 1024) + i) = z4;
        for (int i = gt; i < 1536 * 8; i += NGT) { const int n = i >> 3, c = i & 7; *(GAS v4u*)(WSP(bf16, WS_WL) + (size_t)n * 128 + (n < RW ? 64 : 0) + c * 8) = z4; }
        for (int i = gt; i < 128 * 128; i += NGT) *((GAS v4u*)(WSP(bf16, WS_XN) + (size_t)NREAL * 1024) + i) = z4;
        for (int i = gt; i < 3 * 4 * 129; i += NGT) { const int g = i / (4 * 129), r = i % (4 * 129), hh = r / 129, k = r % 129; const int dil = g == 0 ? 1 : (g == 1 ? 4 : 16);
            WSP(float, WS_BT)[(g * 4 + hh) * 132 + k] = INP(13)[t5_bucket(dil * k) * 12 + g * 4 + hh]; }
        for (int m = C.gw; m < NREAL + 2048; m += C.NGW) {
            if (m < TP) rms_row_to_bf16(INP(0) + (size_t)m * DM, WSP(bf16, WS_XN) + (size_t)m * DM, C.lane);
            else if (m < NREAL) rms_row_to_bf16(INP(1) + (size_t)(m - TP) * DM, WSP(bf16, WS_XN) + (size_t)m * DM, C.lane);
            else rms_row_to_bf16(INP(2) + (size_t)(m - NREAL) * DM, WSP(bf16, WS_MEMN) + (size_t)(m - NREAL) * DM, C.lane);
        }
    } SEAM(0);
    if (IN(1)) REP(1) { MKCTX();
        GEMM_BF16(WSP(bf16, WS_XN), WSP(bf16, WS_WAIN), WSP(bf16, WS_P), MROWS, A_IN, DM);
        GEMM_BF16(WSP(bf16, WS_MEMN), WSP(bf16, WS_WM), WSP(bf16, WS_MKV), 2048, 1024, DM);
    } SEAM(1);
    if (IN(2)) REP(2) { MKCTX();
        const bf16* P = WSP(bf16, WS_P); const bf16* MKV = WSP(bf16, WS_MKV); float* out = args.out;
        for (int i = gt; i < 2 * 2048 * 512; i += NGT) { const int l = i / (2048 * 512), r = (i / 512) % 2048, c = i % 512; out[O_MEM + i] = bf2f(MKV[(size_t)r * 1024 + l * 512 + c]); }
#pragma unroll
        for (int g = 0; g < 3; ++g) { const int Wg = g == 0 ? 128 : (g == 1 ? 512 : 2048); const size_t ob = g == 0 ? O_W0P : (g == 1 ? O_W1P : O_W2P);
            const int n = NBATCH * Wg * 512;
            for (int i = gt; i < n; i += NGT) { const int c = i % 512, ri = (i / 512) % Wg, b = i / (512 * Wg); const int t = SEQ - Wg + ri, kv = c >> 8, cc = c & 255;
                out[ob + i] = bf2f(P[(size_t)((b << 11) + t) * A_IN + RW + kv * RW + g * 256 + cc]); }
            const size_t os = g == 0 ? O_W0S : (g == 1 ? O_W1S : O_W2S);
            for (int i = gt; i < NSAMP * 512; i += NGT) { const int c = i % 512, r = i / 512, kv = c >> 8, cc = c & 255;
                out[os + i] = bf2f(P[(size_t)(TP + r) * A_IN + RW + kv * RW + g * 256 + cc]); } }
        bf16* H = WSP(bf16, WS_H); const float* BT = WSP(float, WS_BT);
        for (int unit = blockIdx.x; unit < 256; unit += C.G) attn_a_unit(C, P, MKV, H, BT, unit);
        for (int task = C.gw; task < NSAMP * 4; task += C.NGW) { const int m = TP + (task >> 2), hh = task & 3;
            float Mx = -3.0e38f, Ss = 0.f, O = 0.f;
            attn_group<0>(P, BT, INP(4), m, hh, C.lane, Mx, Ss, O);
            attn_group<1>(P, BT, INP(5), m, hh, C.lane, Mx, Ss, O);
            attn_group<2>(P, BT, INP(6), m, hh, C.lane, Mx, Ss, O);
            const bf16* prow = P + (size_t)m * A_IN;
            const float om = cross_attn_task(MKV, INP(3), prow + 2304 + hh * 64, m, hh, 0, C.lane);
            const float g0 = bf2f(prow[2560 + hh * 64 + C.lane]), g1 = bf2f(prow[2560 + 256 + hh * 64 + C.lane]);
            H[(size_t)m * 512 + hh * 64 + C.lane] = (bf16)f2bf((O / Ss) * silu(g0));
            H[(size_t)m * 512 + 256 + hh * 64 + C.lane] = (bf16)f2bf(om * silu(g1)); }
    } SEAM(2);
    if (IN(3)) REP(3) { MKCTX(); GEMM_BF16(WSP(bf16, WS_H), WSP(bf16, WS_WAOUT), WSP(bf16, WS_F), MROWS, DM, 512); } SEAM(3);
    if (IN(4)) REP(4) { MKCTX();
        for (int m = C.gw; m < NREAL; m += C.NGW) { const bool samp = m >= TP;
            row_pass(WSP(bf16, WS_F) + (size_t)m * DM, samp ? INP(1) + (size_t)(m - TP) * DM : INP(0) + (size_t)m * DM,
                     args.out + (samp ? O_YS + (size_t)(m - TP) * DM : O_YP + (size_t)m * DM), INP(10), WSP(bf16, WS_XN) + (size_t)m * DM, C.lane); }
    } SEAM(4);
    if (IN(5)) REP(5) { MKCTX(); GEMM_BF16(WSP(bf16, WS_XN), WSP(bf16, WS_WBIN), WSP(bf16, WS_P), MROWS, B_INP, DM); } SEAM(5);
    if (IN(6)) REP(6) { MKCTX();
        const bf16* P = WSP(bf16, WS_P); bf16* TW = WSP(bf16, WS_TW); const float* mu = INP(18); const float* stsh = INP(8);
        for (int m = C.gw; m < NREAL; m += C.NGW) {
            const bool samp = m >= TP; const int t = samp ? ((m - TP) & 3) : (m & 2047), sb = (m - TP) >> 2;
#pragma unroll
            for (int j = 0; j < 2; ++j) { const int c = 2304 + j * 64 + C.lane;
                const float cur = bf2f(P[(size_t)m * B_INP + c]);
                float prev = 0.f; if (t > 0) prev = bf2f(P[(size_t)(m - 1) * B_INP + c]); else if (samp) prev = stsh[(size_t)sb * CSH + c];
                const float xs = cur + mu[c] * (prev - cur);
                TW[(size_t)m * 128 + j * 64 + C.lane] = (bf16)f2bf(j == 0 ? tanhf(xs) : xs); }
        }
    } SEAM(6);
    if (IN(7)) REP(7) { MKCTX(); GEMM_BF16(WSP(bf16, WS_TW), WSP(bf16, WS_WL), WSP(bf16, WS_F), MROWS, 1536, 128); } SEAM(7);
    if (IN(8)) REP(8) { MKCTX();
        ChunkP cp{WSP(bf16, WS_P), WSP(bf16, WS_F), INP(18), INP(19), INP(21), INP(23), INP(24), INP(25)};
        const int per = (3072 + C.G - 1) / C.G, task0 = (int)blockIdx.x * per; int nt = 3072 - task0; if (nt > per) nt = per;
        if (nt > 0) scan_stage_a(C, cp, WSP(bf16, WS_XN), task0, nt);
    } SEAM(8);
    if (IN(9)) REP(9) { MKCTX();
        const bf16* P = WSP(bf16, WS_P); bf16* H = WSP(bf16, WS_H);
        const int GB = C.G > 96 ? 96 : C.G, vb = (int)blockIdx.x;
        if (vb < GB) {
            ScanBP sb{{WSP(bf16, WS_P), WSP(bf16, WS_F), INP(18), INP(19), INP(21), INP(23), INP(24), INP(25)}, WSP(bf16, WS_XN), WSP(bf16, WS_H), args.out, INP(26), INP(27)};
            for (int bh = vb; bh < 96; bh += GB) scan_stage_b(C, sb, bh);
        }
        const int GO = C.G > 96 ? C.G - 96 : C.G, ob = C.G > 96 ? vb - 96 : vb;
        if (ob >= 0) {
            for (int unit = ob; unit < 256; unit += GO) attn_b_unit(C, P, WSP(bf16, WS_MKV), H, unit);
            __syncthreads();
            { ScanP sp{WSP(bf16, WS_P), WSP(bf16, WS_F), WSP(bf16, WS_H), args.out, INP(7), INP(8), INP(18), INP(19), INP(21), INP(23), INP(24), INP(25), INP(26), INP(27)};
              for (int u = 96 + ob; u < 480; u += GO) scan_unit(C, sp, u); }
            const int ogw = ob * NWAVES + C.wave, ONGW = GO * NWAVES, ogt = ogw * 64 + C.lane, ONGT = ONGW * 64;
            for (int task = ogw; task < NSAMP * 4; task += ONGW) { const int m = TP + (task >> 2), hh = task & 3;
                const bf16* prow = P + (size_t)m * B_INP;
                const float om = cross_attn_task(WSP(bf16, WS_MKV), INP(3), prow + CSH + hh * 64, m, hh, 1, C.lane);
                H[(size_t)m * 1024 + RW + hh * 64 + C.lane] = (bf16)f2bf(om * silu(bf2f(prow[2688 + RW + hh * 64 + C.lane]))); }
            for (int i = ogt; i < NBATCH * CSH; i += ONGT) { const int b = i / CSH, c = i % CSH; args.out[O_SHP + i] = bf2f(P[(size_t)(b * SEQ + SEQ - 1) * B_INP + c]); }
            for (int i = ogt; i < SBATCH * CSH; i += ONGT) { const int sb = i / CSH, c = i % CSH; args.out[O_SHS + i] = bf2f(P[(size_t)(TP + sb * 4 + 3) * B_INP + c]); }
        }
    } SEAM(9);
    if (IN(10)) REP(10) { MKCTX(); GEMM_BF16(WSP(bf16, WS_H), WSP(bf16, WS_WBOUT), WSP(bf16, WS_F), MROWS, DM, DM); } SEAM(10);
    if (IN(11)) { MKCTX();
        for (int m = C.gw; m < NREAL; m += C.NGW) { const bool samp = m >= TP;
            float* xo = args.out + (samp ? O_YS + (size_t)(m - TP) * DM : O_YP + (size_t)m * DM);
            row_pass(WSP(bf16, WS_F) + (size_t)m * DM, xo, xo, INP(10) + DM, nullptr, C.lane); }
    }
#undef IN
#undef SEAM
}

extern "C" void kernel_launch(void* const* d_in, const int* in_sizes, int n_in, void* d_out, int out_size, void* d_ws, size_t ws_size, hipStream_t stream) {
    static int grid = 0;
    if (grid == 0) {
        if (n_in != 28 || in_sizes[0] != TP * DM || (size_t)out_size != O_END || ws_size < WS_END) {
            fprintf(stderr, "kernel_launch: unexpected shapes: n_in %d in0 %d out %d ws %zu (need >= %zu); nothing launched\n", n_in, n_in > 0 ? in_sizes[0] : -1, out_size, ws_size, (size_t)WS_END); grid = -1; return; }
        int dev = 0, cus = 0, per_cu = 0;
        if (hipGetDevice(&dev) != hipSuccess || hipDeviceGetAttribute(&cus, hipDeviceAttributeMultiprocessorCount, dev) != hipSuccess) { fprintf(stderr, "kernel_launch: device query failed\n"); grid = -1; return; }
        if (hipFuncSetAttribute((const void*)hyb_fwd, hipFuncAttributeMaxDynamicSharedMemorySize, LDS_BYTES) != hipSuccess) { fprintf(stderr, "kernel_launch: hipFuncSetAttribute failed\n"); grid = -1; return; }
        if (hipOccupancyMaxActiveBlocksPerMultiprocessor(&per_cu, (const void*)hyb_fwd, NWAVES * 64, LDS_BYTES) != hipSuccess || per_cu < 1) {
            fprintf(stderr, "kernel_launch: occupancy query reports %d workgroups per CU\n", per_cu); }
        (void)hipGetLastError();
        grid = cus;
    }
    if (grid < 0) return;
    if (hipMemsetAsync((char*)d_ws + WS_CTL, 0, CTL_ZERO_BYTES, stream) != hipSuccess) { fprintf(stderr, "kernel_launch: memset failed\n"); return; }
    Args a{};
    for (int i = 0; i < 28; ++i) a.in[i] = (const float*)d_in[i];
    a.out = (float*)d_out; a.ws = (unsigned char*)d_ws;
#if MK_N_LAUNCHES == 1
    a.ph_lo = 0; a.ph_hi = N_PHASES;
    hipLaunchKernelGGL(hyb_fwd, dim3(grid), dim3(NWAVES * 64), LDS_BYTES, stream, a);
#else
    for (int li = 0; li < N_PHASES; ++li) { a.ph_lo = li; a.ph_hi = li + 1;
        hipLaunchKernelGGL(hyb_fwd, dim3(grid), dim3(NWAVES * 64), LDS_BYTES, stream, a); }
#endif
    const hipError_t le = hipPeekAtLastError();
    if (le != hipSuccess) fprintf(stderr, "kernel_launch: launch failed: %s\n", hipGetErrorName(le));
}
```

```cpp
#include <hip/hip_runtime.h>
#include <cstdio>
#include <cstdint>
namespace pg8 {
#define PG8_LAS __attribute__((address_space(3)))
typedef unsigned short bf16_t;
typedef short bf16x8 __attribute__((ext_vector_type(8)));
typedef float f32x4 __attribute__((ext_vector_type(4)));
typedef unsigned u32x4 __attribute__((ext_vector_type(4)));
constexpr int BM = 256, BK = 64, HALF = 128, HTB = HALF * BK * 2  , STAGE_BYTES = 8 * HTB, NXCD = 8, WGM = 8;

__host__ __device__ __forceinline__ int lds_byte(int r, int c) { const int st = (r >> 4) * 2 + (c >> 5), rr = r & 15, cc = c & 31, ob = rr * 64 + cc * 2; return st * 1024 + (ob ^ (((ob >> 9) & 1) << 5)); }
__host__ __device__ __forceinline__ void stage_rc(int b, int& R, int& C) { const int st = b / 1024, sb = b % 1024, swz = sb ^ (((sb >> 9) & 1) << 5); R = (st >> 1) * 16 + swz / 64; C = (st & 1) * 32 + (swz % 64) / 2; }
__host__ __device__ __forceinline__ int perm32(int rho) { const int n = rho >> 4, i = rho & 15; return 8 * (i >> 2) + 4 * n + (i & 3); }

struct Unit { int pm, pn; };
struct Gemm { const bf16_t* A; const bf16_t* Bt; int M, N, K; };

struct StaticOrder {
    int nM, nN, nwg, G, c;
    __host__ __device__ void init(int M, int N, int G_, int c_) { nM = M / BM; nN = N / BM; nwg = nM * nN; G = G_; c = c_; }
    __host__ __device__ bool next(int i, Unit& u) const {
        const long L = (long)i * G + c; if (L >= nwg) return false;
        int wgid = (int)L; { const int q = nwg / NXCD, r = nwg % NXCD, xcd = wgid % NXCD, off = wgid / NXCD; wgid = (xcd < r ? xcd * (q + 1) : r * (q + 1) + (xcd - r) * q) + off; }
        const int nig = WGM * nN, gid = wgid / nig, fm = gid * WGM, gsz = (nM - fm) < WGM ? (nM - fm) : WGM;
        u.pm = fm + ((wgid % nig) % gsz); u.pn = (wgid % nig) / gsz; return true;
    }
    __device__ __forceinline__ void a_ready(const Unit&) const {}
    __device__ __forceinline__ void done(const Unit&) const {}
};

__device__ __forceinline__ unsigned cvt_pk_bf16(float lo, float hi) { unsigned r; asm volatile("v_cvt_pk_bf16_f32 %0, %1, %2" : "=v"(r) : "v"(lo), "v"(hi)); return r; }
typedef float f32x2 __attribute__((ext_vector_type(2)));
__device__ __forceinline__ f32x2 gelu_pk(f32x2 v) {
    const f32x2 av = __builtin_elementwise_abs(v), d = av * 0.2316418882f + 1.0f;
    f32x2 t; t.x = __builtin_amdgcn_rcpf(d.x); t.y = __builtin_amdgcn_rcpf(d.y);
    f32x2 q = t * 0.5307027145f + (-0.7265760135f); q = q * t + 0.7107068705f; q = q * t + (-0.142248368f); q = q * t + 0.127414796f; q = q * t;
    const f32x2 s = (v * v) * (-0.72134752044f);
    f32x2 e; e.x = __builtin_amdgcn_exp2f(s.x); e.y = __builtin_amdgcn_exp2f(s.y);
    const f32x2 m = v * (q * e), r = v - m;
    f32x2 o; o.x = v.x < 0.f ? m.x : r.x; o.y = v.y < 0.f ? m.y : r.y; return o;
}

template <int ACT  > struct EpiBf16 {
    static constexpr bool PERM = true, AFTER_DRAIN = false; static_assert(ACT == 0 || ACT == 1, "EpiBf16: ACT is 0 (none) or 1 (gelu_pk)");
    bf16_t* O; int ldc; const float* bias; int split_cols; size_t split_stride; float scale0;
    __device__ __forceinline__ void operator()(const f32x4 (&acc)[2][2][4][2], const Unit& u, int wr, int wc, int fr, int fq) const {
        const int row0 = u.pm * BM + wr * 64 + fr; int colt = u.pn * BM; bf16_t* base = O;
        float sc = 1.f; if (split_cols) { const int t = colt / split_cols; base += (size_t)t * split_stride; colt -= t * split_cols; if (t == 0) sc = scale0; }
        const int col0 = colt + wc * 32 + 8 * fq, bcol0 = u.pn * BM + wc * 32 + 8 * fq;
        f32x4 bv[2][2];
#pragma unroll
        for (int bj = 0; bj < 2; ++bj)
#pragma unroll
            for (int n = 0; n < 2; ++n) bv[bj][n] = bias ? *(const f32x4*)(bias + bcol0 + bj * HALF + 4 * n) : (f32x4){0.f, 0.f, 0.f, 0.f};
#pragma unroll
        for (int ai = 0; ai < 2; ++ai)
#pragma unroll
            for (int m = 0; m < 4; ++m) { bf16_t* rowp = base + (size_t)(row0 + ai * HALF + m * 16) * ldc + col0;
#pragma unroll
                for (int bj = 0; bj < 2; ++bj) { f32x4 v0 = acc[ai][bj][m][0] + bv[bj][0], v1 = acc[ai][bj][m][1] + bv[bj][1];
                    if (ACT == 1) { f32x2 a = gelu_pk((f32x2){v0[0], v0[1]}), b = gelu_pk((f32x2){v0[2], v0[3]}), c = gelu_pk((f32x2){v1[0], v1[1]}), d = gelu_pk((f32x2){v1[2], v1[3]});
                        v0 = (f32x4){a.x, a.y, b.x, b.y}; v1 = (f32x4){c.x, c.y, d.x, d.y}; }
                    v0 = v0 * sc; v1 = v1 * sc; u32x4 w; w.x = cvt_pk_bf16(v0[0], v0[1]); w.y = cvt_pk_bf16(v0[2], v0[3]); w.z = cvt_pk_bf16(v1[0], v1[1]); w.w = cvt_pk_bf16(v1[2], v1[3]);
                    *(u32x4*)(rowp + bj * HALF) = w; } }
    }
};
template <class Epi, class Sched, bool ALIGN_EPI = false, bool SP2 = false>
__device__ __forceinline__ void gemm_phase(PG8_LAS unsigned char* lds, const Gemm g, const Sched& S, const Epi& E) {
    const int tid = threadIdx.x, wid = __builtin_amdgcn_readfirstlane(tid >> 6), lane = tid & 63, wr = wid >> 2, wc = wid & 3, fr = lane & 15, fq = lane >> 4;
    const int K = g.K, nt = K / BK;
    unsigned voffA[2], voffB[2];
#pragma unroll
    for (int i = 0; i < 2; ++i) { int R, C; stage_rc(tid * 16 + i * 8192, R, C); const int Rb = Epi::PERM ? ((R & ~31) + perm32(R & 31)) : R;
        voffA[i] = (unsigned)(R * K + C) * 2u; voffB[i] = (unsigned)(Rb * K + C) * 2u; }
    const size_t kstep = (size_t)(BK * 2);
    const size_t hstep = (size_t)HALF * K * 2;
    const size_t tstep = 2 * hstep;
    const unsigned ldsw = (unsigned)wid * 1024u;
    const int aoff = lds_byte(wr * 64 + fr, fq * 8), boff = lds_byte(wc * 32 + fr, fq * 8);
#define PG8_SA(b, h) (((b) * 2 + (h)) * HTB)
#define PG8_SB(b, h) ((4 + (b) * 2 + (h)) * HTB)
#define PG8_STAGE(bufoff, gbase, voff) do { _Pragma("unroll") for (int _i = 0; _i < 2; ++_i) \
        __builtin_amdgcn_global_load_lds((const unsigned*)((const char*)(gbase) + (voff)[_i]), (PG8_LAS unsigned*)(lds + (bufoff) + ldsw + _i * 8192), 16, 0, 0); } while (0)
#define PG8_LDA(dst, b, h) do { _Pragma("unroll") for (int m = 0; m < 4; ++m) _Pragma("unroll") for (int k = 0; k < 2; ++k) dst[m][k] = *(const PG8_LAS bf16x8*)(lds + PG8_SA(b, h) + aoff + m * 2048 + k * 1024); } while (0)
#define PG8_LDB(dst, b, h) do { _Pragma("unroll") for (int n = 0; n < 2; ++n) _Pragma("unroll") for (int k = 0; k < 2; ++k) dst[n][k] = *(const PG8_LAS bf16x8*)(lds + PG8_SB(b, h) + boff + n * 2048 + k * 1024); } while (0)
#define PG8_MMA(ai, bj, At, Bt) do { __builtin_amdgcn_s_setprio(1); _Pragma("unroll") for (int m = 0; m < 4; ++m) _Pragma("unroll") for (int n = 0; n < 2; ++n) _Pragma("unroll") for (int k = 0; k < 2; ++k) \
        acc[ai][bj][m][n] = __builtin_amdgcn_mfma_f32_16x16x32_bf16(Bt[n][k], At[m][k], acc[ai][bj][m][n], 0, 0, 0); __builtin_amdgcn_s_setprio(0); } while (0)
#define PG8_WAIT_V(n) asm volatile("s_waitcnt vmcnt(" #n ")" ::: "memory")
#define PG8_WAIT_L(n) asm volatile("s_waitcnt lgkmcnt(" #n ")" ::: "memory")
#define PG8_BAR __builtin_amdgcn_s_barrier()
#define PG8_SCHED __builtin_amdgcn_sched_barrier(0)
    Unit cur, nxt; int ui = 0;
    if (!S.next(0, cur)) return;
    f32x4 acc[2][2][4][2];
#pragma unroll
    for (int a = 0; a < 2; ++a)
#pragma unroll
        for (int b = 0; b < 2; ++b)
#pragma unroll
            for (int m = 0; m < 4; ++m)
#pragma unroll
                for (int n = 0; n < 2; ++n) acc[a][b][m][n] = (f32x4){0.f, 0.f, 0.f, 0.f};
    bf16x8 At[4][2], B0[2][2], B1[2][2];
    const char* cA = (const char*)g.A + (size_t)cur.pm * tstep; const char* cB = (const char*)g.Bt + (size_t)cur.pn * tstep;
    S.a_ready(cur);
    if constexpr (SP2) {
        PG8_STAGE(PG8_SB(0, 0), cB, voffB); PG8_STAGE(PG8_SB(0, 1), cB + hstep, voffB); PG8_STAGE(PG8_SA(0, 0), cA, voffA); PG8_STAGE(PG8_SA(0, 1), cA + hstep, voffA);
        if (wr == 1) PG8_BAR;
        PG8_WAIT_V(2); PG8_BAR;
        PG8_STAGE(PG8_SB(1, 0), cB + kstep, voffB); PG8_STAGE(PG8_SA(1, 0), cA + kstep, voffA); PG8_STAGE(PG8_SB(1, 1), cB + hstep + kstep, voffB);
        PG8_WAIT_V(6); PG8_BAR;
    } else {
        PG8_STAGE(PG8_SB(0, 0), cB, voffB); PG8_STAGE(PG8_SA(0, 0), cA, voffA); PG8_STAGE(PG8_SB(0, 1), cB + hstep, voffB); PG8_STAGE(PG8_SA(0, 1), cA + hstep, voffA);
        if (wr == 1) PG8_BAR;
        PG8_WAIT_V(4); PG8_BAR;
        PG8_STAGE(PG8_SB(1, 0), cB + kstep, voffB); PG8_STAGE(PG8_SA(1, 0), cA + kstep, voffA); PG8_STAGE(PG8_SB(1, 1), cB + hstep + kstep, voffB);
        PG8_WAIT_V(6); PG8_BAR;
    }
    for (;;) {
        const bool has_next = S.next(ui + 1, nxt);
        const char* nA = has_next ? (const char*)g.A + (size_t)nxt.pm * tstep : cA; const char* nB = has_next ? (const char*)g.Bt + (size_t)nxt.pn * tstep : cB;
        for (int t = 0; t < nt; t += 2) {
            const bool last = (t == nt - 2);
            const char* a1 = cA + (size_t)(t + 1) * kstep;
            const char* a2 = last ? nA : cA + (size_t)(t + 2) * kstep; const char* b2 = last ? nB : cB + (size_t)(t + 2) * kstep;
            const char* a3 = a2 + kstep; const char* b3 = b2 + kstep;
            if (last && has_next) S.a_ready(nxt);
            if constexpr (SP2) {
            PG8_LDB(B0, 0, 0); PG8_LDB(B1, 0, 1); PG8_SCHED; PG8_LDA(At, 0, 0); PG8_STAGE(PG8_SA(1, 1), a1 + hstep, voffA);
            PG8_WAIT_V(8); PG8_WAIT_L(0); PG8_BAR; PG8_MMA(0, 0, At, B0); PG8_MMA(0, 1, At, B1); PG8_BAR; PG8_SCHED;
            PG8_LDA(At, 0, 1); PG8_STAGE(PG8_SB(0, 0), b2, voffB); PG8_STAGE(PG8_SB(0, 1), b2 + hstep, voffB); PG8_STAGE(PG8_SA(0, 0), a2, voffA);
            PG8_WAIT_V(8); PG8_WAIT_L(0); PG8_BAR; PG8_MMA(1, 0, At, B0); PG8_MMA(1, 1, At, B1); PG8_BAR; PG8_SCHED;
            PG8_LDB(B0, 1, 0); PG8_LDB(B1, 1, 1); PG8_SCHED; PG8_LDA(At, 1, 0); PG8_STAGE(PG8_SA(0, 1), a2 + hstep, voffA);
            PG8_WAIT_V(8); PG8_WAIT_L(0); PG8_BAR; PG8_MMA(0, 0, At, B0); PG8_MMA(0, 1, At, B1); PG8_BAR; PG8_SCHED;
            PG8_LDA(At, 1, 1); PG8_STAGE(PG8_SB(1, 0), b3, voffB); PG8_STAGE(PG8_SB(1, 1), b3 + hstep, voffB); PG8_STAGE(PG8_SA(1, 0), a3, voffA);
            PG8_WAIT_V(8); PG8_WAIT_L(0); PG8_BAR; PG8_MMA(1, 0, At, B0); PG8_MMA(1, 1, At, B1); PG8_BAR; PG8_SCHED;
            } else {
            PG8_LDB(B0, 0, 0); PG8_SCHED; PG8_LDA(At, 0, 0); PG8_STAGE(PG8_SA(1, 1), a1 + hstep, voffA);
            PG8_WAIT_L(8); PG8_BAR; PG8_WAIT_L(0); PG8_MMA(0, 0, At, B0); PG8_BAR; PG8_SCHED;
            PG8_LDB(B1, 0, 1); PG8_STAGE(PG8_SB(0, 0), b2, voffB);
            PG8_BAR; PG8_WAIT_L(0); PG8_MMA(0, 1, At, B1); PG8_BAR;
            PG8_LDA(At, 0, 1); PG8_STAGE(PG8_SA(0, 0), a2, voffA);
            PG8_BAR; PG8_WAIT_L(0); PG8_MMA(1, 0, At, B0); PG8_BAR; PG8_SCHED;
            PG8_STAGE(PG8_SB(0, 1), b2 + hstep, voffB);
            PG8_WAIT_V(6); PG8_BAR; PG8_MMA(1, 1, At, B1); PG8_BAR;
            PG8_LDB(B0, 1, 0); PG8_SCHED; PG8_LDA(At, 1, 0); PG8_STAGE(PG8_SA(0, 1), a2 + hstep, voffA);
            PG8_WAIT_L(8); PG8_BAR; PG8_WAIT_L(0); PG8_MMA(0, 0, At, B0); PG8_BAR; PG8_SCHED;
            PG8_LDB(B1, 1, 1); PG8_STAGE(PG8_SB(1, 0), b3, voffB);
            PG8_BAR; PG8_WAIT_L(0); PG8_MMA(0, 1, At, B1); PG8_BAR;
            PG8_LDA(At, 1, 1); PG8_STAGE(PG8_SA(1, 0), a3, voffA);
            PG8_BAR; PG8_WAIT_L(0); PG8_MMA(1, 0, At, B0); PG8_BAR; PG8_SCHED;
            PG8_STAGE(PG8_SB(1, 1), b3 + hstep, voffB);
            PG8_WAIT_V(6); PG8_BAR; PG8_MMA(1, 1, At, B1); PG8_BAR;
            }
        }
        if constexpr (ALIGN_EPI) { if (wr == 0) PG8_BAR; }
        if constexpr (!Epi::AFTER_DRAIN) { E(acc, cur, wr, wc, fr, fq); S.done(cur); }
        if (!has_next) break;
#pragma unroll
        for (int a = 0; a < 2; ++a)
#pragma unroll
            for (int b = 0; b < 2; ++b)
#pragma unroll
                for (int m = 0; m < 4; ++m)
#pragma unroll
                    for (int n = 0; n < 2; ++n) acc[a][b][m][n] = (f32x4){0.f, 0.f, 0.f, 0.f};
        cur = nxt; cA = nA; cB = nB; ++ui;
        if constexpr (ALIGN_EPI) { if (wr == 1) PG8_BAR; }
    }
    PG8_WAIT_V(0);
    if constexpr (!ALIGN_EPI) { if (wr == 0) PG8_BAR; }
    PG8_BAR;
    if constexpr (Epi::AFTER_DRAIN) { E.fused(acc, cur, wr, wc, fr, fq, lds, wid, lane); S.done(cur); }
#undef PG8_SA
#undef PG8_SB
#undef PG8_STAGE
#undef PG8_LDA
#undef PG8_LDB
#undef PG8_MMA
#undef PG8_WAIT_V
#undef PG8_WAIT_L
#undef PG8_BAR
#undef PG8_SCHED
}
}

#ifndef PG8_SP2
#define PG8_SP2 true
#endif
#ifndef PG8_ALIGN
#define PG8_ALIGN true
#endif

constexpr int NWAVES = 8;
#ifndef MK_N_LAUNCHES
#define MK_N_LAUNCHES 1
#endif
constexpr int N_PHASES = 12;
constexpr int TP = 16384, NSAMP = 128, NREAL = TP + NSAMP, MROWS = 16640, DM = 1024;
constexpr int SEQ = 2048, NBATCH = 8, SBATCH = 32, STOK = 4, NMEM = 256;
constexpr int A_IN = 3072, B_IN = 3712, B_INP = 3840, CSH = 2432, RW = 768;
constexpr float RMS_EPS = 1e-6f, GN_EPS = 64e-5f;
constexpr size_t O_YP = 0, O_YS = 16777216, O_MEM = 16908288, O_W0P = 19005440, O_W1P = 19529728, O_W2P = 21626880,
                 O_W0S = 30015488, O_W1S = 30081024, O_W2S = 30146560, O_WKVP = 30212096, O_WKVS = 30605312, O_SHP = 32178176, O_SHS = 32197632, O_END = 32275456;
constexpr size_t MiB = 1u << 20;
constexpr size_t WS_CTL = 0, CTL_ZERO_BYTES = 1 * MiB;
constexpr size_t WS_WAIN = 1 * MiB, WS_WAOUT = 7 * MiB, WS_WBIN = 8 * MiB, WS_WBOUT = 16 * MiB, WS_WM = 18 * MiB, WS_WL = 20 * MiB, WS_BT = 20 * MiB + 512 * 1024;
constexpr size_t WS_MEMN = 21 * MiB, WS_MKV = 25 * MiB, WS_TW = 29 * MiB, WS_XN = 34 * MiB, WS_H = 67 * MiB, WS_F = 100 * MiB, WS_P = 149 * MiB, WS_END = 271 * MiB;
constexpr int CW_TMO = 0, CW_BAR = 4096;

constexpr int RING_OFF = 0, RING_BYTES = 161792;
constexpr int LDSCTL_OFF = RING_BYTES, MISC_OFF = LDSCTL_OFF + 320;
constexpr int LDS_BYTES = 163840;

#define GAS __attribute__((address_space(1)))
#define LAS __attribute__((address_space(3)))
typedef unsigned short bf16;
typedef unsigned v4u __attribute__((ext_vector_type(4)));
typedef unsigned v2u __attribute__((ext_vector_type(2)));
typedef float f32x4 __attribute__((ext_vector_type(4)));
typedef GAS unsigned gu32;
#define RLX_AGENT __ATOMIC_RELAXED, __HIP_MEMORY_SCOPE_AGENT
#define LDS_WAIT() asm volatile("s_waitcnt lgkmcnt(0)" ::: "memory")
#define VM_WAIT() asm volatile("s_waitcnt vmcnt(0)" ::: "memory")
__device__ __forceinline__ unsigned f2bf(float f) { unsigned u = __builtin_bit_cast(unsigned, f); return (u + 0x7fffu + ((u >> 16) & 1u)) >> 16; }
__device__ __forceinline__ unsigned pk2(float lo, float hi) { return f2bf(lo) | (f2bf(hi) << 16); }
__device__ __forceinline__ float bflo(unsigned u) { return __builtin_bit_cast(float, u << 16); }
__device__ __forceinline__ float bfhi(unsigned u) { return __builtin_bit_cast(float, u & 0xffff0000u); }
__device__ __forceinline__ float bf2f(bf16 h) { return __builtin_bit_cast(float, (unsigned)h << 16); }

#define XB_TMO      128
#define XB_XCNT(j)  (256  + 64 * (j))
#define XB_XSUB(j)  (1280 + 64 * (j))
#define XB_XGEN(j)  (2304 + 64 * (j))
#define XB_TOP      3328
#define XB_TOPGEN   3392
#define XCD_BAR_WORDS 3456
#define XB_SPIN_CAP (1u << 20)
__device__ __forceinline__ unsigned xb_ld(unsigned* p)              { return __hip_atomic_load(p, __ATOMIC_RELAXED, __HIP_MEMORY_SCOPE_AGENT); }
__device__ __forceinline__ unsigned xb_add(unsigned* p, unsigned v) { return __hip_atomic_fetch_add(p, v, __ATOMIC_RELAXED, __HIP_MEMORY_SCOPE_AGENT); }
__device__ __forceinline__ unsigned xb_xcc_id() { return (unsigned)__builtin_amdgcn_s_getreg((3 << 11) | 20) & 0xFu; }
#define XB_SPIN(cond, bar) do { unsigned _sp = 0; while (cond) { __builtin_amdgcn_s_sleep(1); \
    if ((++_sp & 255u) == 0u) { if (xb_ld(&(bar)[XB_TMO])) break; if (_sp > XB_SPIN_CAP) { atomicAdd(&(bar)[XB_TMO], 1u); break; } } } } while (0)
struct XcdBarrier { unsigned* bar; unsigned x; volatile LAS unsigned* st; };
__device__ __forceinline__ XcdBarrier xcd_barrier_post(unsigned* bar, volatile LAS unsigned* st) {
    XcdBarrier b; b.bar = bar; b.x = xb_xcc_id(); b.st = st;
    if (threadIdx.x == 0) (void)xb_add(&bar[XB_XCNT(b.x)], 1u);
    return b;
}
__device__ __forceinline__ void xcd_barrier_complete(unsigned* bar, unsigned x, unsigned& nloc, unsigned& nx) {
    const unsigned G = gridDim.x * gridDim.y * gridDim.z;
    unsigned sum, cnt, mine, sp = 0u;
    for (;;) {
        sum = 0u; cnt = 0u; mine = 0u;
#pragma unroll
        for (unsigned j = 0; j < 16; ++j) { const unsigned c = xb_ld(&bar[XB_XCNT(j)]); sum += c; cnt += (c > 0u) ? 1u : 0u; mine = (j == x) ? c : mine; }
        if (sum == G) break;
        __builtin_amdgcn_s_sleep(1);
        if ((++sp & 255u) == 0u) { if (xb_ld(&bar[XB_TMO])) break; if (sp > XB_SPIN_CAP) { atomicAdd(&bar[XB_TMO], 1u); break; } }
    }
    nloc = mine > 0u ? mine : 1u; nx = cnt > 0u ? cnt : 1u;
}
__device__ __forceinline__ void xcd_barrier(const XcdBarrier& b) {
    asm volatile("s_waitcnt vmcnt(0)" ::: "memory");
    __syncthreads();
    if (threadIdx.x == 0) {
        unsigned* bar = b.bar;
        __builtin_amdgcn_s_waitcnt(0);
        unsigned nloc = b.st[0], nx = b.st[1];
        if (nloc == 0u) { xcd_barrier_complete(bar, b.x, nloc, nx); b.st[0] = nloc; b.st[1] = nx; }
        const unsigned old = xb_add(&bar[XB_XSUB(b.x)], 1u);
        const unsigned gen = old / nloc;
        if (old + 1u == (gen + 1u) * nloc) {
            __builtin_amdgcn_fence(__ATOMIC_RELEASE, "agent");
            asm volatile("s_waitcnt vmcnt(0)" ::: "memory");
            const unsigned og = xb_add(&bar[XB_TOP], 1u);
            const unsigned tg = og / nx;
            if (og + 1u == (tg + 1u) * nx) xb_add(&bar[XB_TOPGEN], 1u);
            else XB_SPIN(xb_ld(&bar[XB_TOPGEN]) == tg, bar);
            __builtin_amdgcn_fence(__ATOMIC_ACQUIRE, "agent");
            xb_add(&bar[XB_XGEN(b.x)], 1u);
            asm volatile("s_waitcnt vmcnt(0)" ::: "memory");
        } else {
            XB_SPIN(xb_ld(&bar[XB_XGEN(b.x)]) == gen, bar);
            __builtin_amdgcn_fence(__ATOMIC_ACQUIRE, "agent");
            asm volatile("s_waitcnt vmcnt(0)" ::: "memory");
        }
    }
    __syncthreads();
}

struct Ctx { LAS unsigned char* lds; int tid, lane, wave, vcu, G, gw, NGW; };

__device__ __forceinline__ float wave_sum(float v) {
#pragma unroll
    for (int o = 1; o < 64; o <<= 1) v += __shfl_xor(v, o);
    return v;
}
__device__ __forceinline__ float wave_max(float v) {
#pragma unroll
    for (int o = 1; o < 64; o <<= 1) v = fmaxf(v, __shfl_xor(v, o));
    return v;
}
__device__ __forceinline__ float rdlane(float v, int l) { return __builtin_bit_cast(float, __builtin_amdgcn_readlane(__builtin_bit_cast(int, v), l)); }

__device__ __forceinline__ void p0_transpose_item(const float* W, int N, const float* gain, bf16* WT, int ldo, int col_off, int row_off, LAS float* scr, int item, int nblk, int lane) {
    const int kb = item / nblk, nb = item % nblk, k0 = 64 * kb, n0 = 32 * nb;
#pragma unroll 8
    for (int i = 0; i < 32; ++i) { const int kk = 2 * i + (lane >> 5); const float g = gain ? gain[k0 + kk] : 1.f; scr[kk * 33 + (lane & 31)] = W[(size_t)(k0 + kk) * N + n0 + (lane & 31)] * g; }
    LDS_WAIT(); asm volatile("" ::: "memory");
    const int c = lane & 7;
#pragma unroll
    for (int j = 0; j < 4; ++j) { const int n = (lane >> 3) + 8 * j; const LAS float* s = scr + (8 * c) * 33 + n;
        v4u o; o.x = pk2(s[0 * 33], s[1 * 33]); o.y = pk2(s[2 * 33], s[3 * 33]); o.z = pk2(s[4 * 33], s[5 * 33]); o.w = pk2(s[6 * 33], s[7 * 33]);
        *(GAS v4u*)(WT + (size_t)(row_off + n0 + n) * ldo + col_off + k0 + 8 * c) = o; }
    LDS_WAIT(); asm volatile("" ::: "memory");
}
__device__ __forceinline__ void rms_row_to_bf16(const float* xrow, bf16* orow, int lane) {
    const GAS f32x4* xr = (const GAS f32x4*)xrow + lane;
    f32x4 v[4]; float s = 0.f;
#pragma unroll
    for (int j = 0; j < 4; ++j) { v[j] = xr[64 * j]; s += (v[j].x * v[j].x + v[j].y * v[j].y) + (v[j].z * v[j].z + v[j].w * v[j].w); }
    const float r = 1.f / sqrtf(wave_sum(s) * (1.f / DM) + RMS_EPS);
    GAS unsigned long long* o8 = (GAS unsigned long long*)orow + lane;
#pragma unroll
    for (int j = 0; j < 4; ++j) o8[64 * j] = (unsigned long long)pk2(v[j].x * r, v[j].y * r) | ((unsigned long long)pk2(v[j].z * r, v[j].w * r) << 32);
}
__device__ __forceinline__ int t5_bucket(int dist) {
    if (dist < 16) return dist;
    const double x = log((double)dist / 16.0) / log(128.0) * 16.0;
    int large = 16 + (int)x; return large < 31 ? large : 31;
}

__device__ __forceinline__ void ldq64(const bf16* p, float (&q)[64]) {
#pragma unroll
    for (int i = 0; i < 8; ++i) { const v4u u = *(const GAS v4u*)(p + 8 * i);
        q[8 * i + 0] = bflo(u.x); q[8 * i + 1] = bfhi(u.x); q[8 * i + 2] = bflo(u.y); q[8 * i + 3] = bfhi(u.y);
        q[8 * i + 4] = bflo(u.z); q[8 * i + 5] = bfhi(u.z); q[8 * i + 6] = bflo(u.w); q[8 * i + 7] = bfhi(u.w); }
}
__device__ __forceinline__ float dot64_bf(const float (&q)[64], const bf16* p) {
    float s0 = 0.f, s1 = 0.f;
#pragma unroll
    for (int i = 0; i < 8; ++i) { const v4u u = *(const GAS v4u*)(p + 8 * i);
        s0 += q[8 * i + 0] * bflo(u.x); s1 += q[8 * i + 1] * bfhi(u.x); s0 += q[8 * i + 2] * bflo(u.y); s1 += q[8 * i + 3] * bfhi(u.y);
        s0 += q[8 * i + 4] * bflo(u.z); s1 += q[8 * i + 5] * bfhi(u.z); s0 += q[8 * i + 6] * bflo(u.w); s1 += q[8 * i + 7] * bfhi(u.w); }
    return s0 + s1;
}
__device__ __forceinline__ float dot64_f32(const float (&q)[64], const float* p) {
    float s0 = 0.f, s1 = 0.f;
#pragma unroll
    for (int i = 0; i < 16; ++i) { const f32x4 u = *(const GAS f32x4*)(p + 4 * i);
        s0 += q[4 * i + 0] * u.x; s1 += q[4 * i + 1] * u.y; s0 += q[4 * i + 2] * u.z; s1 += q[4 * i + 3] * u.w; }
    return s0 + s1;
}
__device__ __forceinline__ float silu(float x) { return x / (1.f + __expf(-x)); }

__device__ __forceinline__ float cross_attn_task(const bf16* MKV, const float* c_mem, const bf16* qptr, int m, int hh, int layer, int lane) {
    float q[64]; ldq64(qptr, q);
    const bool samp = m >= TP;
    float l[4]; float mx = -3.0e38f, o = 0.f, s = 0.f;
    if (!samp) {
        const bf16* kb = MKV + (size_t)((m >> 11) * NMEM) * 1024 + layer * 512 + hh * 64;
#pragma unroll
        for (int r = 0; r < 4; ++r) { l[r] = dot64_bf(q, kb + (size_t)(r * 64 + lane) * 1024) * 0.125f; mx = fmaxf(mx, l[r]); }
        mx = wave_max(mx);
#pragma unroll
        for (int r = 0; r < 4; ++r) { l[r] = __expf(l[r] - mx); s += l[r]; }
        s = wave_sum(s);
#pragma unroll
        for (int r = 0; r < 4; ++r)
            for (int kk = 0; kk < 64; ++kk) o += rdlane(l[r], kk) * bf2f(kb[(size_t)(r * 64 + kk) * 1024 + 256 + lane]);
    } else {
        const float* kf = c_mem + ((size_t)(layer * SBATCH + ((m - TP) >> 2)) * NMEM) * 512 + hh * 64;
#pragma unroll
        for (int r = 0; r < 4; ++r) { l[r] = dot64_f32(q, kf + (size_t)(r * 64 + lane) * 512) * 0.125f; mx = fmaxf(mx, l[r]); }
        mx = wave_max(mx);
#pragma unroll
        for (int r = 0; r < 4; ++r) { l[r] = __expf(l[r] - mx); s += l[r]; }
        s = wave_sum(s);
#pragma unroll
        for (int r = 0; r < 4; ++r)
            for (int kk = 0; kk < 64; ++kk) o += rdlane(l[r], kk) * kf[(size_t)(r * 64 + kk) * 512 + 256 + lane];
    }
    return o / s;
}

template <int G>
__device__ __forceinline__ void attn_group(const bf16* P, const float* BT, const float* cw, int m, int hh, int lane, float& Mx, float& Ss, float& O) {
    constexpr int dil = G == 0 ? 1 : (G == 1 ? 4 : 16), Wg = G == 0 ? 128 : (G == 1 ? 512 : 2048), head0 = G * 4;
    const bool samp = m >= TP;
    const int b = m >> 11, t = m & 2047, sb = (m - TP) >> 2, st = (m - TP) & 3, head = head0 + hh;
    float q[64]; ldq64(P + (size_t)m * A_IN + head * 64, q);
    const float* bt = BT + (G * 4 + hh) * 132;
    float l[3]; float gm = -3.0e38f;
#pragma unroll
    for (int r = 0; r < 3; ++r) { const int kidx = r * 64 + lane; float lv = -3.0e38f;
        if (kidx < 129) {
            if (!samp) { const int tk = t - dil * kidx; if (tk >= 0) lv = dot64_bf(q, P + (size_t)((b << 11) + tk) * A_IN + RW + head * 64) * 0.125f + bt[kidx]; }
            else { const int idx = Wg + st - dil * kidx;
                if (idx >= Wg) lv = dot64_bf(q, P + (size_t)(TP + sb * 4 + idx - Wg) * A_IN + RW + head * 64) * 0.125f + bt[kidx];
                else lv = dot64_f32(q, cw + ((size_t)(sb * Wg + idx) * 2) * 256 + hh * 64) * 0.125f + bt[kidx]; }
        }
        l[r] = lv; gm = fmaxf(gm, lv); }
    gm = wave_max(gm);
    const float Mn = fmaxf(Mx, gm), sc = __expf(Mx - Mn);
    float ps = 0.f;
#pragma unroll
    for (int r = 0; r < 3; ++r) { l[r] = l[r] > -1.0e38f ? __expf(l[r] - Mn) : 0.f; ps += l[r]; }
    Ss = Ss * sc + wave_sum(ps); O *= sc; Mx = Mn;
#pragma unroll
    for (int r = 0; r < 3; ++r)
        for (int kk = 0; kk < 64; ++kk) { const int kidx = r * 64 + kk; if (kidx >= 129) break;
            const float p = rdlane(l[r], kk);
            if (p != 0.f) { float v;
                if (!samp) { const int tk = t - dil * kidx; v = bf2f(P[(size_t)((b << 11) + tk) * A_IN + 2 * RW + head * 64 + lane]); }
                else { const int idx = Wg + st - dil * kidx;
                    if (idx >= Wg) v = bf2f(P[(size_t)(TP + sb * 4 + idx - Wg) * A_IN + 2 * RW + head * 64 + lane]);
                    else v = cw[((size_t)(sb * Wg + idx) * 2 + 1) * 256 + hh * 64 + lane]; }
                O += p * v; } }
}


__device__ __forceinline__ void samp_dot_rounds3(const bf16* P, const float* cw, const float* bt, const float (&q)[64], int g, int sb, int st, int hh, int lane, float (&l)[3]) {
    const int dil = g == 0 ? 1 : (g == 1 ? 4 : 16), Wg = g == 0 ? 128 : (g == 1 ? 512 : 2048), head = g * 4 + hh;
#pragma unroll
    for (int r = 0; r < 3; ++r) { const int kidx = r * 64 + lane; float lv = -3.0e38f;
        if (kidx < 129) { const int idx = Wg + st - dil * kidx;
            if (idx >= Wg) lv = dot64_bf(q, P + (size_t)(TP + sb * 4 + idx - Wg) * A_IN + RW + head * 64) * 0.125f + bt[kidx];
            else lv = dot64_f32(q, cw + ((size_t)(sb * Wg + idx) * 2) * 256 + hh * 64) * 0.125f + bt[kidx]; }
        l[r] = lv; }
}
__device__ __forceinline__ void samp_part(const bf16* P, const float* BT, const float* cw, const bf16* MKVunused, const float* c_mem, int m, int hh, int part, int layer, const bf16* qmem, int lane, float& Mo, float& So, float& Oo) {
    const int sb = (m - TP) >> 2, st = (m - TP) & 3;
    float q[64];
    if (part < 3) {
        const int g = part, dil = g == 0 ? 1 : (g == 1 ? 4 : 16), Wg = g == 0 ? 128 : (g == 1 ? 512 : 2048), head = g * 4 + hh;
        ldq64(P + (size_t)m * A_IN + head * 64, q);
        float l[3]; samp_dot_rounds3(P, cw, BT + (g * 4 + hh) * 132, q, g, sb, st, hh, lane, l);
        float gm = wave_max(fmaxf(fmaxf(l[0], l[1]), l[2])); float ps = 0.f;
#pragma unroll
        for (int r = 0; r < 3; ++r) { l[r] = l[r] > -1.0e38f ? __expf(l[r] - gm) : 0.f; ps += l[r]; }
        const float S = wave_sum(ps); float O = 0.f;
#pragma unroll
        for (int r = 0; r < 3; ++r) {
#pragma unroll 1
            for (int k0 = 0; k0 < 64; k0 += 8) { if (r * 64 + k0 >= 129) break;
                float v[8];
#pragma unroll
                for (int e = 0; e < 8; ++e) { int kidx = r * 64 + k0 + e; if (kidx > 128) kidx = 128; const int idx = Wg + st - dil * kidx;
                    v[e] = (idx >= Wg) ? bf2f(P[(size_t)(TP + sb * 4 + idx - Wg) * A_IN + 2 * RW + head * 64 + lane]) : cw[((size_t)(sb * Wg + idx) * 2 + 1) * 256 + hh * 64 + lane]; }
#pragma unroll
                for (int e = 0; e < 8; ++e) O += rdlane(l[r], k0 + e) * v[e]; } }
        Mo = gm; So = S; Oo = O;
    } else {
        ldq64(qmem, q);
        const float* kf = c_mem + ((size_t)(layer * SBATCH + sb) * NMEM) * 512 + hh * 64;
        float l[4]; float mx = -3.0e38f, s = 0.f, o = 0.f;
#pragma unroll
        for (int r = 0; r < 4; ++r) { l[r] = dot64_f32(q, kf + (size_t)(r * 64 + lane) * 512) * 0.125f; mx = fmaxf(mx, l[r]); }
        mx = wave_max(mx);
#pragma unroll
        for (int r = 0; r < 4; ++r) { l[r] = __expf(l[r] - mx); s += l[r]; }
        s = wave_sum(s);
#pragma unroll
        for (int r = 0; r < 4; ++r) {
#pragma unroll 1
            for (int k0 = 0; k0 < 64; k0 += 8) { float v[8];
#pragma unroll
                for (int e = 0; e < 8; ++e) v[e] = kf[(size_t)(r * 64 + k0 + e) * 512 + 256 + lane];
#pragma unroll
                for (int e = 0; e < 8; ++e) o += rdlane(l[r], k0 + e) * v[e]; } }
        Mo = mx; So = s; Oo = o;
    }
}

typedef short s16x4 __attribute__((ext_vector_type(4)));
typedef short bf16x8 __attribute__((ext_vector_type(8)));
constexpr int VROW = 160;
constexpr int VBUF = 32 * VROW;
constexpr float LOG2E = 1.4426950408889634f;
template <int OFF> __device__ __forceinline__ s16x4 tr_read(unsigned vb) {
    s16x4 r; asm volatile("ds_read_b64_tr_b16 %0, %1 offset:%2" : "=&v"(r) : "v"(vb), "i"(OFF) : "memory"); return r;
}
struct AttnSt { float m, s; f32x4 o[4]; };
__device__ __forceinline__ void attn_init(AttnSt& st) { st.m = -1.0e30f; st.s = 0.f;
#pragma unroll
    for (int i = 0; i < 4; ++i) st.o[i] = (f32x4){0.f, 0.f, 0.f, 0.f}; }
__device__ __forceinline__ unsigned cvt_pk_bf16f(float lo, float hi) { unsigned r; asm volatile("v_cvt_pk_bf16_f32 %0, %1, %2" : "=v"(r) : "v"(lo), "v"(hi)); return r; }

template <bool MASKED>
__device__ __forceinline__ void attn_pairs(const bf16* kbase, const bf16* vbase, int pitch, int tb, int dil, int qs, int tmax, int j0, int j1,
                                           const bf16x8 (&qf)[2], const LAS float* bias2, LAS unsigned char* vbuf, int lane, AttnSt& st) {
    const int n = lane & 15, quad = lane >> 4, vr8 = lane >> 3, vc8 = lane & 7;
    const unsigned vwr = (unsigned)(size_t)vbuf + (unsigned)(vr8 * VROW + vc8 * 16);
    const unsigned vrd = (unsigned)(size_t)vbuf + (unsigned)((4 * quad + (n >> 2)) * VROW + 8 * (n & 3));
    const float C2 = 0.125f * LOG2E;
    bf16x8 ka[2][2]; v4u vr[4];
#define ATT_LOAD(JP, KA, VR) do { _Pragma("unroll") for (int tt = 0; tt < 2; ++tt) { int tk = tb + dil * (32 * (JP) + 16 * tt + n); if (MASKED) tk = tk < 0 ? 0 : (tk > tmax ? tmax : tk); \
            const bf16* kp = kbase + (size_t)tk * pitch + 8 * quad; \
            KA[tt][0] = __builtin_bit_cast(bf16x8, *(const GAS v4u*)kp); KA[tt][1] = __builtin_bit_cast(bf16x8, *(const GAS v4u*)(kp + 32)); } \
        _Pragma("unroll") for (int c = 0; c < 4; ++c) { int tk = tb + dil * (32 * (JP) + 8 * c + vr8); if (MASKED) tk = tk < 0 ? 0 : (tk > tmax ? tmax : tk); \
            VR[c] = *(const GAS v4u*)(vbase + (size_t)tk * pitch + 8 * vc8); } } while (0)
    if (j0 < j1) ATT_LOAD(j0, ka, vr);
#pragma unroll 1
    for (int jp = j0; jp < j1; ++jp) {
        bf16x8 kn[2][2]; v4u vn[4];
        { const int jn = (jp + 1 < j1) ? jp + 1 : jp; ATT_LOAD(jn, kn, vn); }
        f32x4 sA = {0.f, 0.f, 0.f, 0.f}, sB = {0.f, 0.f, 0.f, 0.f};
        sA = __builtin_amdgcn_mfma_f32_16x16x32_bf16(ka[0][0], qf[0], sA, 0, 0, 0); sA = __builtin_amdgcn_mfma_f32_16x16x32_bf16(ka[0][1], qf[1], sA, 0, 0, 0);
        sB = __builtin_amdgcn_mfma_f32_16x16x32_bf16(ka[1][0], qf[0], sB, 0, 0, 0); sB = __builtin_amdgcn_mfma_f32_16x16x32_bf16(ka[1][1], qf[1], sB, 0, 0, 0);
        float l[8]; bool ok[8]; float mloc = -1.0e30f;
#pragma unroll
        for (int e = 0; e < 8; ++e) { const int u = 32 * jp + (e >> 2) * 16 + 4 * quad + (e & 3); const float a = (e < 4 ? sA[e & 3] : sB[e & 3]) * C2;
            if (MASKED) { const int kidx = 128 + qs * n - u; ok[e] = (kidx >= 0) && (kidx <= 128) && (tb + dil * u >= 0);
                const int kc = kidx < 0 ? 0 : (kidx > 128 ? 128 : kidx); l[e] = ok[e] ? a + bias2[kc] : -1.0e30f; }
            else { ok[e] = true; l[e] = a; }
            mloc = fmaxf(mloc, l[e]); }
        mloc = fmaxf(mloc, __shfl_xor(mloc, 16)); mloc = fmaxf(mloc, __shfl_xor(mloc, 32));
        const float mn = fmaxf(st.m, mloc), alpha = __builtin_amdgcn_exp2f(st.m - mn);
        float ps = 0.f; float p[8];
#pragma unroll
        for (int e = 0; e < 8; ++e) { p[e] = ok[e] ? __builtin_amdgcn_exp2f(l[e] - mn) : 0.f; ps += p[e]; }
        st.s = st.s * alpha + ps; st.m = mn;
#pragma unroll
        for (int i = 0; i < 4; ++i) st.o[i] = st.o[i] * alpha;
        v4u pk; pk.x = cvt_pk_bf16f(p[0], p[1]); pk.y = cvt_pk_bf16f(p[2], p[3]); pk.z = cvt_pk_bf16f(p[4], p[5]); pk.w = cvt_pk_bf16f(p[6], p[7]);
        const bf16x8 pb = __builtin_bit_cast(bf16x8, pk);
#pragma unroll
        for (int c = 0; c < 4; ++c) *(LAS v4u*)(size_t)(vwr + c * 8 * VROW) = vr[c];
        asm volatile("s_waitcnt lgkmcnt(0)" ::: "memory");
        const s16x4 a0 = tr_read<0>(vrd), b0 = tr_read<16 * VROW>(vrd), a1 = tr_read<32>(vrd), b1 = tr_read<16 * VROW + 32>(vrd);
        const s16x4 a2 = tr_read<64>(vrd), b2 = tr_read<16 * VROW + 64>(vrd), a3 = tr_read<96>(vrd), b3 = tr_read<16 * VROW + 96>(vrd);
        asm volatile("s_waitcnt lgkmcnt(0)" ::: "memory"); __builtin_amdgcn_sched_barrier(0);
#define PKV(L, H) (bf16x8){L[0], L[1], L[2], L[3], H[0], H[1], H[2], H[3]}
        st.o[0] = __builtin_amdgcn_mfma_f32_16x16x32_bf16(PKV(a0, b0), pb, st.o[0], 0, 0, 0);
        st.o[1] = __builtin_amdgcn_mfma_f32_16x16x32_bf16(PKV(a1, b1), pb, st.o[1], 0, 0, 0);
        st.o[2] = __builtin_amdgcn_mfma_f32_16x16x32_bf16(PKV(a2, b2), pb, st.o[2], 0, 0, 0);
        st.o[3] = __builtin_amdgcn_mfma_f32_16x16x32_bf16(PKV(a3, b3), pb, st.o[3], 0, 0, 0);
#undef PKV
        __builtin_amdgcn_sched_barrier(0);
#pragma unroll
        for (int tt = 0; tt < 2; ++tt) { ka[tt][0] = kn[tt][0]; ka[tt][1] = kn[tt][1]; }
#pragma unroll
        for (int c = 0; c < 4; ++c) vr[c] = vn[c];
    }
#undef ATT_LOAD
}
__device__ __forceinline__ void attn_store(const AttnSt& st, const bf16* gate_row  , bf16* out_row, int lane) {
    const int quad = lane >> 4;
    float s = st.s; s += __shfl_xor(s, 16); s += __shfl_xor(s, 32);
    const float inv = 1.f / s;
#pragma unroll
    for (int mt = 0; mt < 4; ++mt) { const v2u g = *(const GAS v2u*)(gate_row + 16 * mt + 4 * quad);
        const float o0 = st.o[mt][0] * inv * silu(bflo(g.x)), o1 = st.o[mt][1] * inv * silu(bfhi(g.x)), o2 = st.o[mt][2] * inv * silu(bflo(g.y)), o3 = st.o[mt][3] * inv * silu(bfhi(g.y));
        *(GAS v2u*)(out_row + 16 * mt + 4 * quad) = (v2u){pk2(o0, o1), pk2(o2, o3)}; }
}
__device__ __forceinline__ void load_qf(const bf16* qrow, int lane, bf16x8 (&qf)[2]) {
    const int quad = lane >> 4;
    qf[0] = __builtin_bit_cast(bf16x8, *(const GAS v4u*)(qrow + 8 * quad)); qf[1] = __builtin_bit_cast(bf16x8, *(const GAS v4u*)(qrow + 32 + 8 * quad));
}
__device__ __forceinline__ void attn_a_unit(const Ctx& C, const bf16* P, const bf16* MKV, bf16* H, const float* BT, int unit) {
    const int b = unit >> 5, hh = (unit >> 3) & 3, t0 = (unit & 7) * 256;
    LAS float* bias2 = (LAS float*)(C.lds + RING_OFF);
    LAS unsigned char* vbuf = C.lds + RING_OFF + 4096 + C.wave * VBUF;
    __syncthreads();
    for (int i = C.tid; i < 3 * 132; i += NWAVES * 64) { const int g = i / 132, k = i % 132; bias2[i] = k < 129 ? BT[(g * 4 + hh) * 132 + k] * LOG2E : 0.f; }
    __syncthreads();
    const int n = C.lane & 15;
    const bf16* Pb = P + (size_t)(b << 11) * A_IN;
#pragma unroll 1
    for (int set = 0; set < 2; ++set) {
        const int r = 2 * C.wave + set, tq = t0 + r + 16 * n;
        const bf16* qrow = Pb + (size_t)tq * A_IN;
        AttnSt st; attn_init(st);
#pragma unroll 1
        for (int g = 0; g < 3; ++g) {
            const int dil = g == 0 ? 1 : (g == 1 ? 4 : 16), qs = 16 / dil, np = g == 0 ? 12 : (g == 1 ? 6 : 5), head = g * 4 + hh;
            const int tb = t0 + r - 128 * dil;
            int j0 = 0; if (tb < 0) { j0 = (-tb - 31 * dil + 32 * dil - 1) / (32 * dil); if (j0 < 0) j0 = 0; }
            bf16x8 qf[2]; load_qf(qrow + head * 64, C.lane, qf);
            attn_pairs<true>(Pb + RW + head * 64, Pb + 2 * RW + head * 64, A_IN, tb, dil, qs, SEQ - 1, j0, np, qf, bias2 + g * 132, vbuf, C.lane, st);
        }
        attn_store(st, qrow + 2560 + hh * 64, H + ((size_t)(b << 11) + tq) * 512 + hh * 64, C.lane);
        AttnSt sm; attn_init(sm);
        { bf16x8 qf[2]; load_qf(qrow + 2304 + hh * 64, C.lane, qf);
          const bf16* kb = MKV + (size_t)(b * NMEM) * 1024 + hh * 64;
          attn_pairs<false>(kb, kb + 256, 1024, 0, 1, 0, NMEM - 1, 0, 8, qf, nullptr, vbuf, C.lane, sm); }
        attn_store(sm, qrow + 2560 + 256 + hh * 64, H + ((size_t)(b << 11) + tq) * 512 + 256 + hh * 64, C.lane);
    }
}
__device__ __forceinline__ void attn_b_unit(const Ctx& C, const bf16* P, const bf16* MKV, bf16* H, int unit) {
    const int b = unit >> 5, hh = (unit >> 3) & 3, t0 = (unit & 7) * 256;
    LAS unsigned char* vbuf = C.lds + RING_OFF + 4096 + C.wave * VBUF;
    const int n = C.lane & 15;
#pragma unroll 1
    for (int set = 0; set < 2; ++set) {
        const int r = 2 * C.wave + set, tq = t0 + r + 16 * n;
        const bf16* qrow = P + ((size_t)(b << 11) + tq) * B_INP;
        AttnSt sm; attn_init(sm);
        bf16x8 qf[2]; load_qf(qrow + CSH + hh * 64, C.lane, qf);
        const bf16* kb = MKV + (size_t)(b * NMEM) * 1024 + 512 + hh * 64;
        attn_pairs<false>(kb, kb + 256, 1024, 0, 1, 0, NMEM - 1, 0, 8, qf, nullptr, vbuf, C.lane, sm);
        attn_store(sm, qrow + 2688 + RW + hh * 64, H + ((size_t)(b << 11) + tq) * 1024 + RW + hh * 64, C.lane);
    }
}

__device__ __forceinline__ void row_pass(const bf16* hp, const float* xin, float* xout, const float* gpost, bf16* xn, int lane) {
    const GAS v2u* h2 = (const GAS v2u*)hp + lane; const GAS f32x4* xr = (const GAS f32x4*)xin + lane; const GAS f32x4* gp = (const GAS f32x4*)gpost + lane;
    f32x4 h[4], x[4]; float s = 0.f;
#pragma unroll
    for (int j = 0; j < 4; ++j) { const v2u u = h2[64 * j]; h[j] = (f32x4){bflo(u.x), bfhi(u.x), bflo(u.y), bfhi(u.y)}; x[j] = xr[64 * j];
        s += (h[j].x * h[j].x + h[j].y * h[j].y) + (h[j].z * h[j].z + h[j].w * h[j].w); }
    const float r = 1.f / sqrtf(wave_sum(s) * (1.f / DM) + RMS_EPS);
    float s2 = 0.f;
#pragma unroll
    for (int j = 0; j < 4; ++j) { const f32x4 g = gp[64 * j]; x[j] = x[j] + h[j] * r * g; s2 += (x[j].x * x[j].x + x[j].y * x[j].y) + (x[j].z * x[j].z + x[j].w * x[j].w);
        *((GAS f32x4*)xout + lane + 64 * j) = x[j]; }
    if (xn) { const float r2 = 1.f / sqrtf(wave_sum(s2) * (1.f / DM) + RMS_EPS);
        GAS unsigned long long* o8 = (GAS unsigned long long*)xn + lane;
#pragma unroll
        for (int j = 0; j < 4; ++j) o8[64 * j] = (unsigned long long)pk2(x[j].x * r2, x[j].y * r2) | ((unsigned long long)pk2(x[j].z * r2, x[j].w * r2) << 32); }
}

struct ScanP { const bf16 *P, *LORA; bf16* H; float* out; const float *st_wkv, *st_shift, *mu, *w0, *a0, *k_k, *k_a, *r_k, *ln_w, *ln_b; };
__device__ __forceinline__ void scan_unit(const Ctx& C, const ScanP& sp, int u) {
    LAS float* L = (LAS float*)(C.lds + RING_OFF);
    LAS float *LA = L, *LB = L + 4096, *LW = L + 8192, *LK = L + 12288, *LRW = L + 16384, *LV = L + 20480, *LSC = L + 24576, *LY = L + 24576 + 256;
    const bool samp = u >= 96; const int seq = samp ? (u - 96) / 12 : u / 12, h = samp ? (u - 96) % 12 : u % 12;
    const int T = samp ? STOK : SEQ, row0 = samp ? TP + seq * 4 : seq * SEQ;
    int row = C.wave * 8 + (C.lane >> 3), p = C.lane & 7;
    asm volatile("" : "+v"(row), "+v"(p));
    float S[8];
#pragma unroll
    for (int j = 0; j < 8; ++j) S[j] = samp ? sp.st_wkv[((size_t)(seq * 12 + h) * 64 + row) * 64 + p * 8 + j] : 0.f;
#pragma unroll 1
    for (int c0 = 0; c0 < T; c0 += 64) {
        const int n = (T - c0) < 64 ? (T - c0) : 64;
        int tok = C.tid >> 3, part = C.tid & 7;
        asm volatile("" : "+v"(tok), "+v"(part));
        __syncthreads();
        if (tok < n) {
            const int t = c0 + tok, m = row0 + t;
            const bf16* cur = sp.P + (size_t)m * B_INP; const bf16* prv = cur - B_INP; const bf16* lo = sp.LORA + (size_t)m * 1536;
            float xr[8], xk[8], xv[8], kk[8], av[8], dv[8];
            float nrm = 0.f;
#pragma unroll
            for (int j = 0; j < 8; ++j) { const int c = h * 64 + part * 8 + j;
                const float cr = bf2f(cur[c]), ck = bf2f(cur[RW + c]), cv = bf2f(cur[2 * RW + c]);
                float pr = 0.f, pk = 0.f, pv = 0.f;
                if (t > 0) { pr = bf2f(prv[c]); pk = bf2f(prv[RW + c]); pv = bf2f(prv[2 * RW + c]); }
                else if (samp) { const float* ss = sp.st_shift + (size_t)seq * CSH; pr = ss[c]; pk = ss[RW + c]; pv = ss[2 * RW + c]; }
                xr[j] = cr + sp.mu[c] * (pr - cr); xk[j] = ck + sp.mu[RW + c] * (pk - ck); xv[j] = cv + sp.mu[2 * RW + c] * (pv - cv);
                const float dpre = sp.w0[c] + bf2f(lo[c]), apre = sp.a0[c] + bf2f(lo[RW + c]);
                dv[j] = __expf(-0.6065306597f * __builtin_amdgcn_rcpf(1.f + __expf(-dpre)));
                av[j] = __builtin_amdgcn_rcpf(1.f + __expf(-apre));
                kk[j] = xk[j] * sp.k_k[c]; nrm += kk[j] * kk[j]; }
            nrm += __shfl_xor(nrm, 1); nrm += __shfl_xor(nrm, 2); nrm += __shfl_xor(nrm, 4);
            const float inv = 1.f / fmaxf(sqrtf(nrm), 1e-12f);
            float br = 0.f, kr = 0.f, bon = 0.f;
#pragma unroll
            for (int j = 0; j < 8; ++j) { const int c = h * 64 + part * 8 + j, d = part * 8 + j;
                const float kn = kk[j] * inv, k2 = xk[j] * (1.f + (av[j] - 1.f) * sp.k_a[c]);
                const float bb = kn * av[j];
                LA[tok * 64 + d] = -kn; LB[tok * 64 + d] = bb; LW[tok * 64 + d] = dv[j]; LK[tok * 64 + d] = k2; LRW[tok * 64 + d] = xr[j] * dv[j]; LV[tok * 64 + d] = xv[j];
                br += bb * xr[j]; kr += k2 * xr[j]; bon += xr[j] * k2 * sp.r_k[c]; }
            br += __shfl_xor(br, 1); br += __shfl_xor(br, 2); br += __shfl_xor(br, 4);
            kr += __shfl_xor(kr, 1); kr += __shfl_xor(kr, 2); kr += __shfl_xor(kr, 4);
            bon += __shfl_xor(bon, 1); bon += __shfl_xor(bon, 2); bon += __shfl_xor(bon, 4);
            if (part == 0) { LSC[tok * 4 + 0] = br; LSC[tok * 4 + 1] = kr; LSC[tok * 4 + 2] = bon; }
        }
        __syncthreads();
#pragma unroll 1
        for (int i = 0; i < n; ++i) {
            const LAS f32x4* a4 = (const LAS f32x4*)(LA + i * 64 + p * 8); const LAS f32x4* r4 = (const LAS f32x4*)(LRW + i * 64 + p * 8);
            const LAS f32x4* w4 = (const LAS f32x4*)(LW + i * 64 + p * 8); const LAS f32x4* b4 = (const LAS f32x4*)(LB + i * 64 + p * 8); const LAS f32x4* k4 = (const LAS f32x4*)(LK + i * 64 + p * 8);
            const f32x4 a0 = a4[0], a1 = a4[1], r0 = r4[0], r1 = r4[1];
            float sa = (S[0] * a0.x + S[1] * a0.y) + (S[2] * a0.z + S[3] * a0.w) + (S[4] * a1.x + S[5] * a1.y) + (S[6] * a1.z + S[7] * a1.w);
            float yp = (S[0] * r0.x + S[1] * r0.y) + (S[2] * r0.z + S[3] * r0.w) + (S[4] * r1.x + S[5] * r1.y) + (S[6] * r1.z + S[7] * r1.w);
            sa += __shfl_xor(sa, 1); sa += __shfl_xor(sa, 2); sa += __shfl_xor(sa, 4);
            yp += __shfl_xor(yp, 1); yp += __shfl_xor(yp, 2); yp += __shfl_xor(yp, 4);
            const float v = LV[i * 64 + row], br = LSC[i * 4 + 0], kr = LSC[i * 4 + 1];
            const f32x4 w0 = w4[0], w1 = w4[1], b0 = b4[0], b1 = b4[1], k0 = k4[0], k1 = k4[1];
            S[0] = S[0] * w0.x + sa * b0.x + v * k0.x; S[1] = S[1] * w0.y + sa * b0.y + v * k0.y; S[2] = S[2] * w0.z + sa * b0.z + v * k0.z; S[3] = S[3] * w0.w + sa * b0.w + v * k0.w;
            S[4] = S[4] * w1.x + sa * b1.x + v * k1.x; S[5] = S[5] * w1.y + sa * b1.y + v * k1.y; S[6] = S[6] * w1.z + sa * b1.z + v * k1.z; S[7] = S[7] * w1.w + sa * b1.w + v * k1.w;
            if (p == 0) LY[i * 64 + row] = yp + sa * br + v * kr;
        }
        __syncthreads();
        asm volatile("" : "+v"(tok), "+v"(part));
        if (tok < n) {
            const int m = row0 + c0 + tok;
            float y[8]; float s = 0.f;
#pragma unroll
            for (int j = 0; j < 8; ++j) { y[j] = LY[tok * 64 + part * 8 + j]; s += y[j]; }
            s += __shfl_xor(s, 1); s += __shfl_xor(s, 2); s += __shfl_xor(s, 4);
            const float mean = s * (1.f / 64.f); float q = 0.f;
#pragma unroll
            for (int j = 0; j < 8; ++j) { y[j] -= mean; q += y[j] * y[j]; }
            q += __shfl_xor(q, 1); q += __shfl_xor(q, 2); q += __shfl_xor(q, 4);
            const float rstd = 1.f / sqrtf(q * (1.f / 64.f) + GN_EPS), bon = LSC[tok * 4 + 2];
            unsigned w[4];
#pragma unroll
            for (int j = 0; j < 8; j += 2) { float o2[2];
#pragma unroll
                for (int e = 0; e < 2; ++e) { const int c = h * 64 + part * 8 + j + e;
                    const float yy = y[j + e] * rstd * sp.ln_w[c] + sp.ln_b[c] + bon * LV[tok * 64 + part * 8 + j + e];
                    o2[e] = yy * silu(bf2f(sp.P[(size_t)m * B_INP + 2688 + c])); }
                w[j >> 1] = pk2(o2[0], o2[1]); }
            *(GAS v4u*)(sp.H + (size_t)m * 1024 + h * 64 + part * 8) = (v4u){w[0], w[1], w[2], w[3]};
        }
    }
    float* so = sp.out + (samp ? O_WKVS : O_WKVP) + ((size_t)(seq * 12 + h) * 64 + row) * 64 + p * 8;
    *(GAS f32x4*)so = (f32x4){S[0], S[1], S[2], S[3]}; *((GAS f32x4*)so + 1) = (f32x4){S[4], S[5], S[6], S[7]};
    __syncthreads();
}

constexpr int TS = 72;
constexpr int IMG = 64 * TS * 2;
constexpr int L_AT = 0, L_RT = IMG, L_BT = 2 * IMG, L_KT = 3 * IMG, L_VV = 4 * IMG, L_SB = 5 * IMG, L_Z = 6 * IMG, L_SA = 7 * IMG,
              L_NKA = 8 * IMG, L_NBR = 9 * IMG, L_NKR = 10 * IMG, L_TT = 11 * IMG, L_E = 12 * IMG, L_PC = L_E + 16384, L_BON = L_PC + 256, L_SEG = L_BON + 256, L_CH_END = L_SEG + 2048;
constexpr int NSLOT = 7, L_SLOT0 = 3 * IMG + 16384 + 256 + 256 + 2048;
static_assert(L_CH_END <= RING_BYTES && L_SLOT0 + NSLOT * 16384 <= RING_BYTES, "chunk-scan LDS map");
constexpr int LA_AT = 0, LA_BT = IMG, LA_E = 2 * IMG, LA_PC = LA_E + 16384, LA_BON = LA_PC + 256, LA_SEG = LA_BON + 256;

struct ChunkP { const bf16 *P, *LORA; const float *mu, *w0, *a0, *k_k, *k_a, *r_k; };
struct PrepR { float xr[8], xv[8], kn[8], as[8], k2[8], e[8], bon; };
struct PrepL { v4u cr4, ck4, cv4, pr4, pk4, pv4, lw4, la4, g4; };
__device__ __forceinline__ void prep_load(const ChunkP& cp, int m0, int t0tok, int h, int tok, int part, PrepL& L) {
    const int m = m0 + tok; const bool first = (t0tok + tok) == 0;
    const bf16* cur = cp.P + (size_t)m * B_INP + h * 64 + part * 8; const bf16* lo = cp.LORA + (size_t)m * 1536 + h * 64 + part * 8;
    L.cr4 = *(const GAS v4u*)cur; L.ck4 = *(const GAS v4u*)(cur + RW); L.cv4 = *(const GAS v4u*)(cur + 2 * RW);
    L.pr4 = (v4u){0u, 0u, 0u, 0u}; L.pk4 = L.pr4; L.pv4 = L.pr4;
    if (!first) { L.pr4 = *(const GAS v4u*)(cur - B_INP); L.pk4 = *(const GAS v4u*)(cur - B_INP + RW); L.pv4 = *(const GAS v4u*)(cur - B_INP + 2 * RW); }
    L.lw4 = *(const GAS v4u*)lo; L.la4 = *(const GAS v4u*)(lo + RW);
    L.g4 = *(const GAS v4u*)(cur + 2688);
}
__device__ __forceinline__ void prep_step1(const ChunkP& cp, const PrepL& L, int h, int tok, int part, LAS unsigned char* lds, int offE, PrepR& R) {
    float xk[8], kk[8]; float nrm = 0.f;
#pragma unroll
    for (int j = 0; j < 8; ++j) { const int c = h * 64 + part * 8 + j;
        const unsigned ur = L.cr4[j >> 1], uk = L.ck4[j >> 1], uv = L.cv4[j >> 1], upr = L.pr4[j >> 1], upk = L.pk4[j >> 1], upv = L.pv4[j >> 1], ulw = L.lw4[j >> 1], ula = L.la4[j >> 1];
        const float cr = (j & 1) ? bfhi(ur) : bflo(ur), ck = (j & 1) ? bfhi(uk) : bflo(uk), cv = (j & 1) ? bfhi(uv) : bflo(uv);
        const float pr = (j & 1) ? bfhi(upr) : bflo(upr), pk = (j & 1) ? bfhi(upk) : bflo(upk), pv = (j & 1) ? bfhi(upv) : bflo(upv);
        const float lw = (j & 1) ? bfhi(ulw) : bflo(ulw), la = (j & 1) ? bfhi(ula) : bflo(ula);
        R.xr[j] = cr + cp.mu[c] * (pr - cr); xk[j] = ck + cp.mu[RW + c] * (pk - ck); R.xv[j] = cv + cp.mu[2 * RW + c] * (pv - cv);
        const float dpre = cp.w0[c] + lw, apre = cp.a0[c] + la;
        R.e[j] = 0.6065306597f * __builtin_amdgcn_rcpf(1.f + __expf(-dpre));
        R.as[j] = __builtin_amdgcn_rcpf(1.f + __expf(-apre));
        kk[j] = xk[j] * cp.k_k[c]; nrm += kk[j] * kk[j]; }
    nrm += __shfl_xor(nrm, 1); nrm += __shfl_xor(nrm, 2); nrm += __shfl_xor(nrm, 4);
    const float inv = __builtin_amdgcn_rsqf(fmaxf(nrm, 1e-24f));
    float bon = 0.f;
#pragma unroll
    for (int j = 0; j < 8; ++j) { const int c = h * 64 + part * 8 + j; R.kn[j] = kk[j] * inv; R.k2[j] = xk[j] * (1.f + (R.as[j] - 1.f) * cp.k_a[c]); bon += R.xr[j] * R.k2[j] * cp.r_k[c]; }
    bon += __shfl_xor(bon, 1); bon += __shfl_xor(bon, 2); bon += __shfl_xor(bon, 4);
    R.bon = bon;
    LAS float* E = (LAS float*)(lds + offE) + tok * 64 + part * 8;
    *(LAS f32x4*)E = (f32x4){R.e[0], R.e[1], R.e[2], R.e[3]}; *((LAS f32x4*)E + 1) = (f32x4){R.e[4], R.e[5], R.e[6], R.e[7]};
}
__device__ __forceinline__ void prep_cumsum(int tid, LAS unsigned char* lds, int offE, int offSEG) {
    LAS float* E = (LAS float*)(lds + offE); LAS float* SEG = (LAS float*)(lds + offSEG);
    const int d = tid & 63, seg = tid >> 6;
    float v[8]; float run = 0.f;
#pragma unroll
    for (int j = 0; j < 8; ++j) { run += E[(seg * 8 + j) * 64 + d]; v[j] = run; }
    SEG[seg * 64 + d] = run;
    __syncthreads();
    float off = 0.f;
#pragma unroll
    for (int s = 0; s < 7; ++s) off += (s < seg) ? SEG[s * 64 + d] : 0.f;
#pragma unroll
    for (int j = 0; j < 8; ++j) E[(seg * 8 + j) * 64 + d] = v[j] + off;
}
__device__ __forceinline__ void st8bf(LAS unsigned char* lds, int off, int tok, int part, const float (&x)[8]) {
    *(LAS v4u*)(lds + off + (tok * TS + part * 8) * 2) = (v4u){pk2(x[0], x[1]), pk2(x[2], x[3]), pk2(x[4], x[5]), pk2(x[6], x[7])};
}
template <bool FULL>
__device__ __forceinline__ void prep_step3(int tok, int part, LAS unsigned char* lds, int offE, int offAT, int offBT, int offRT, int offKT, int offVV, int offPC, int offBON, const PrepR& R) {
    const LAS float* E = (const LAS float*)(lds + offE) + tok * 64 + part * 8;
    const f32x4 c0 = *(const LAS f32x4*)E, c1 = *((const LAS f32x4*)E + 1);
    float at[8], bt[8], rt[8], kt[8];
#pragma unroll
    for (int j = 0; j < 8; ++j) { const float cum = j < 4 ? c0[j & 3] : c1[j & 3];
        const float pm1 = __expf(R.e[j] - cum), ip = __expf(cum);
        at[j] = -R.kn[j] * pm1; bt[j] = R.kn[j] * R.as[j] * ip;
        if (FULL) { const float pt = __builtin_amdgcn_rcpf(ip); rt[j] = R.xr[j] * pt; kt[j] = R.k2[j] * ip;
            if (tok == 63) ((LAS float*)(lds + offPC))[part * 8 + j] = pt; } }
    st8bf(lds, offAT, tok, part, at); st8bf(lds, offBT, tok, part, bt);
    if (FULL) { st8bf(lds, offRT, tok, part, rt); st8bf(lds, offKT, tok, part, kt); st8bf(lds, offVV, tok, part, R.xv);
        if (part == 0) ((LAS float*)(lds + offBON))[tok] = R.bon; }
}
__device__ __forceinline__ bf16x8 frag_nat(const LAS unsigned char* img, int R0, int ks, int lane) {
    return __builtin_bit_cast(bf16x8, *(const LAS v4u*)(img + ((R0 + (lane & 15)) * TS + 32 * ks + 8 * (lane >> 4)) * 2));
}
__device__ __forceinline__ bf16x8 frag_tr(const LAS unsigned char* img, int I0, int ks, int lane) {
    const int i16 = lane & 15, quad = lane >> 4;
    const unsigned a = (unsigned)(size_t)img + (unsigned)(((32 * ks + 8 * quad + (i16 >> 2)) * TS + I0 + 4 * (i16 & 3)) * 2);
    const s16x4 lo = tr_read<0>(a), hi = tr_read<4 * TS * 2>(a);
    asm volatile("s_waitcnt lgkmcnt(0)" ::: "memory"); __builtin_amdgcn_sched_barrier(0);
    return (bf16x8){lo[0], lo[1], lo[2], lo[3], hi[0], hi[1], hi[2], hi[3]};
}
#define MFMA16(a, b, c) __builtin_amdgcn_mfma_f32_16x16x32_bf16((a), (b), (c), 0, 0, 0)
__device__ __forceinline__ void st_tile_T(LAS unsigned char* img, int C0, int R0, int lane, f32x4 v) {
    *(LAS v2u*)(img + ((C0 + (lane & 15)) * TS + R0 + 4 * (lane >> 4)) * 2) = (v2u){pk2(v[0], v[1]), pk2(v[2], v[3])};
}

__device__ __forceinline__ void scan_stage_a(const Ctx& C, const ChunkP& cp, bf16* TT, int task0, int ntask) {
    LAS unsigned char* lds = C.lds + RING_OFF;
    const int tok = C.tid >> 3, part = C.tid & 7, vs = C.wave & 3, rh = C.wave >> 2;
#pragma unroll 1
    for (int base = 0; base < ntask; base += NSLOT) {
        const int nr = (ntask - base) < NSLOT ? (ntask - base) : NSLOT;
#pragma unroll 1
        for (int s = 0; s < nr; ++s) {
            const int task = task0 + base + s, bh = task >> 5, c = task & 31, b = bh / 12, h = bh % 12;
            PrepR R; PrepL L; prep_load(cp, b * SEQ + c * 64, c * 64, h, tok, part, L);
            __syncthreads();
            prep_step1(cp, L, h, tok, part, lds, LA_E, R);
            __syncthreads();
            prep_cumsum(C.tid, lds, LA_E, LA_SEG);
            __syncthreads();
            prep_step3<false>(tok, part, lds, LA_E, LA_AT, LA_BT, 0, 0, 0, 0, 0, R);
            __syncthreads();
            LAS float* slot = (LAS float*)(lds + L_SLOT0 + s * 16384);
            const bf16x8 b0 = frag_nat(lds + LA_AT, 16 * vs, 0, C.lane), b1 = frag_nat(lds + LA_AT, 16 * vs, 1, C.lane);
#pragma unroll
            for (int q = 0; q < 2; ++q) { const int it = 2 * rh + q;
                f32x4 acc = {0.f, 0.f, 0.f, 0.f};
                acc = MFMA16(frag_nat(lds + LA_BT, 16 * it, 0, C.lane), b0, acc); acc = MFMA16(frag_nat(lds + LA_BT, 16 * it, 1, C.lane), b1, acc);
                const int t = 16 * vs + (C.lane & 15), i0 = 16 * it + 4 * (C.lane >> 4);
                f32x4 o; o[0] = (i0 + 0 < t) ? acc[0] : 0.f; o[1] = (i0 + 1 < t) ? acc[1] : 0.f; o[2] = (i0 + 2 < t) ? acc[2] : 0.f; o[3] = (i0 + 3 < t) ? acc[3] : 0.f;
                *(LAS f32x4*)(slot + t * 64 + i0) = o; }
        }
        __syncthreads();
        if (C.wave < nr) {
            const LAS float* Nl = (const LAS float*)(lds + L_SLOT0 + C.wave * 16384);
            float Tr[64];
#pragma unroll
            for (int t = 0; t < 64; ++t) { float acc = (C.lane == t) ? 1.f : 0.f;
#pragma unroll
                for (int i = 0; i < t; ++i) acc += Tr[i] * Nl[t * 64 + i];
                Tr[t] = acc; }
            bf16* o = TT + (size_t)(task0 + base + C.wave) * 4096 + C.lane;
#pragma unroll
            for (int t = 0; t < 64; ++t) o[t * 64] = (bf16)f2bf(Tr[t]);
        }
    }
    __syncthreads();
}

struct ScanBP { ChunkP cp; const bf16* TT; bf16* H; float* out; const float *ln_w, *ln_b; };
__device__ __forceinline__ void scan_stage_b(const Ctx& C, const ScanBP& sb, int bh) {
    LAS unsigned char* lds = C.lds + RING_OFF;
    const int b = bh / 12, h = bh % 12;
    const int tok = C.tid >> 3, part = C.tid & 7, vs = C.wave & 3, rh = C.wave >> 2, l15 = C.lane & 15, quad = C.lane >> 4;
    f32x4 St[2] = {{0.f, 0.f, 0.f, 0.f}, {0.f, 0.f, 0.f, 0.f}};
    __syncthreads();
    for (int i = C.tid; i < IMG / 4; i += NWAVES * 64) ((LAS unsigned*)(lds + L_SB))[i] = 0u;
    PrepL Ln; prep_load(sb.cp, b * SEQ, 0, h, tok, part, Ln);
#pragma unroll 1
    for (int c = 0; c < 32; ++c) {
        const int m0 = b * SEQ + c * 64;
        PrepR R; const v4u g4 = Ln.g4;
        __syncthreads();
        prep_step1(sb.cp, Ln, h, tok, part, lds, L_E, R);
        { const v4u tv = *((const GAS v4u*)(sb.TT + (size_t)(bh * 32 + c) * 4096) + C.tid);
          *(LAS v4u*)(lds + L_TT + ((C.tid >> 3) * TS + (C.tid & 7) * 8) * 2) = tv; }
        __syncthreads();
        prep_cumsum(C.tid, lds, L_E, L_SEG);
        __syncthreads();
        prep_step3<true>(tok, part, lds, L_E, L_AT, L_BT, L_RT, L_KT, L_VV, L_PC, L_BON, R);
        if (c < 31) prep_load(sb.cp, m0 + 64, c * 64 + 64, h, tok, part, Ln);
        __syncthreads();
        {   const bf16x8 a0 = frag_nat(lds + L_AT, 16 * vs, 0, C.lane), a1 = frag_nat(lds + L_AT, 16 * vs, 1, C.lane);
            const bf16x8 r0 = frag_nat(lds + L_RT, 16 * vs, 0, C.lane), r1 = frag_nat(lds + L_RT, 16 * vs, 1, C.lane);
#pragma unroll
            for (int q = 0; q < 2; ++q) { const int it = 2 * rh + q;
                const bf16x8 k0 = frag_nat(lds + L_KT, 16 * it, 0, C.lane), k1 = frag_nat(lds + L_KT, 16 * it, 1, C.lane);
                const bf16x8 bb0 = frag_nat(lds + L_BT, 16 * it, 0, C.lane), bb1 = frag_nat(lds + L_BT, 16 * it, 1, C.lane);
                f32x4 nka = {0.f, 0.f, 0.f, 0.f}, nbr = nka, nkr = nka;
                nka = MFMA16(k0, a0, nka); nka = MFMA16(k1, a1, nka);
                nbr = MFMA16(bb0, r0, nbr); nbr = MFMA16(bb1, r1, nbr);
                nkr = MFMA16(k0, r0, nkr); nkr = MFMA16(k1, r1, nkr);
                const int t = 16 * vs + l15, i0 = 16 * it + 4 * quad;
#pragma unroll
                for (int e = 0; e < 4; ++e) { if (!(i0 + e < t)) nka[e] = 0.f; if (!(i0 + e <= t)) { nbr[e] = 0.f; nkr[e] = 0.f; } }
                st_tile_T(lds + L_NKA, 16 * vs, 16 * it, C.lane, nka); st_tile_T(lds + L_NBR, 16 * vs, 16 * it, C.lane, nbr); st_tile_T(lds + L_NKR, 16 * vs, 16 * it, C.lane, nkr); }
        }
        __syncthreads();
        {   const bf16x8 s0 = frag_nat(lds + L_SB, 16 * vs, 0, C.lane), s1 = frag_nat(lds + L_SB, 16 * vs, 1, C.lane);
            const bf16x8 v0 = frag_tr(lds + L_VV, 16 * vs, 0, C.lane), v1 = frag_tr(lds + L_VV, 16 * vs, 1, C.lane);
#pragma unroll
            for (int q = 0; q < 2; ++q) { const int tt = 2 * rh + q; f32x4 z = {0.f, 0.f, 0.f, 0.f};
                z = MFMA16(frag_nat(lds + L_AT, 16 * tt, 0, C.lane), s0, z); z = MFMA16(frag_nat(lds + L_AT, 16 * tt, 1, C.lane), s1, z);
                z = MFMA16(frag_nat(lds + L_NKA, 16 * tt, 0, C.lane), v0, z); z = MFMA16(frag_nat(lds + L_NKA, 16 * tt, 1, C.lane), v1, z);
                st_tile_T(lds + L_Z, 16 * vs, 16 * tt, C.lane, z); }
        }
        __syncthreads();
        {   const bf16x8 z0 = frag_nat(lds + L_Z, 16 * vs, 0, C.lane), z1 = frag_nat(lds + L_Z, 16 * vs, 1, C.lane);
#pragma unroll
            for (int q = 0; q < 2; ++q) { const int tt = 2 * rh + q; f32x4 sa = {0.f, 0.f, 0.f, 0.f};
                sa = MFMA16(frag_nat(lds + L_TT, 16 * tt, 0, C.lane), z0, sa); sa = MFMA16(frag_nat(lds + L_TT, 16 * tt, 1, C.lane), z1, sa);
                st_tile_T(lds + L_SA, 16 * vs, 16 * tt, C.lane, sa); }
        }
        __syncthreads();
        {   const bf16x8 s0 = frag_nat(lds + L_SB, 16 * vs, 0, C.lane), s1 = frag_nat(lds + L_SB, 16 * vs, 1, C.lane);
            const bf16x8 sa0 = frag_nat(lds + L_SA, 16 * vs, 0, C.lane), sa1 = frag_nat(lds + L_SA, 16 * vs, 1, C.lane);
            const bf16x8 v0 = frag_tr(lds + L_VV, 16 * vs, 0, C.lane), v1 = frag_tr(lds + L_VV, 16 * vs, 1, C.lane);
            f32x4 y[2], d[2];
#pragma unroll
            for (int q = 0; q < 2; ++q) { const int tt = 2 * rh + q; f32x4 yy = {0.f, 0.f, 0.f, 0.f};
                yy = MFMA16(frag_nat(lds + L_RT, 16 * tt, 0, C.lane), s0, yy); yy = MFMA16(frag_nat(lds + L_RT, 16 * tt, 1, C.lane), s1, yy);
                yy = MFMA16(frag_nat(lds + L_NBR, 16 * tt, 0, C.lane), sa0, yy); yy = MFMA16(frag_nat(lds + L_NBR, 16 * tt, 1, C.lane), sa1, yy);
                yy = MFMA16(frag_nat(lds + L_NKR, 16 * tt, 0, C.lane), v0, yy); yy = MFMA16(frag_nat(lds + L_NKR, 16 * tt, 1, C.lane), v1, yy);
                y[q] = yy;
                f32x4 dd = {0.f, 0.f, 0.f, 0.f};
                dd = MFMA16(frag_tr(lds + L_BT, 16 * tt, 0, C.lane), sa0, dd); dd = MFMA16(frag_tr(lds + L_BT, 16 * tt, 1, C.lane), sa1, dd);
                dd = MFMA16(frag_tr(lds + L_KT, 16 * tt, 0, C.lane), v0, dd); dd = MFMA16(frag_tr(lds + L_KT, 16 * tt, 1, C.lane), v1, dd);
                d[q] = dd; }
            __syncthreads();
            LAS float* Y = (LAS float*)(lds + L_E);
#pragma unroll
            for (int q = 0; q < 2; ++q) { const int r0 = 16 * (2 * rh + q) + 4 * quad, v = 16 * vs + l15;
#pragma unroll
                for (int e = 0; e < 4; ++e) Y[(r0 + e) * 64 + v] = y[q][e];
                const f32x4 pc = *(const LAS f32x4*)(lds + L_PC + r0 * 4);
                St[q] = (St[q] + d[q]) * pc;
                st_tile_T(lds + L_SB, 16 * vs, 16 * (2 * rh + q), C.lane, St[q]); }
        }
        __syncthreads();
        {   const int m = m0 + tok; const LAS float* Y = (const LAS float*)(lds + L_E) + tok * 64 + part * 8;
            const f32x4 y0 = *(const LAS f32x4*)Y, y1 = *((const LAS f32x4*)Y + 1);
            float y[8] = {y0[0], y0[1], y0[2], y0[3], y1[0], y1[1], y1[2], y1[3]}; float s = 0.f;
#pragma unroll
            for (int j = 0; j < 8; ++j) s += y[j];
            s += __shfl_xor(s, 1); s += __shfl_xor(s, 2); s += __shfl_xor(s, 4);
            const float mean = s * (1.f / 64.f); float qq = 0.f;
#pragma unroll
            for (int j = 0; j < 8; ++j) { y[j] -= mean; qq += y[j] * y[j]; }
            qq += __shfl_xor(qq, 1); qq += __shfl_xor(qq, 2); qq += __shfl_xor(qq, 4);
            const float rstd = __builtin_amdgcn_rsqf(qq * (1.f / 64.f) + GN_EPS), bon = R.bon;
            float o[8];
#pragma unroll
            for (int j = 0; j < 8; ++j) { const int cc = h * 64 + part * 8 + j; const unsigned ug = g4[j >> 1]; const float g = (j & 1) ? bfhi(ug) : bflo(ug);
                o[j] = (y[j] * rstd * sb.ln_w[cc] + sb.ln_b[cc] + bon * R.xv[j]) * silu(g); }
            *(GAS v4u*)(sb.H + (size_t)m * 1024 + h * 64 + part * 8) = (v4u){pk2(o[0], o[1]), pk2(o[2], o[3]), pk2(o[4], o[5]), pk2(o[6], o[7])};
        }
    }
#pragma unroll
    for (int q = 0; q < 2; ++q) { float* so = sb.out + O_WKVP + ((size_t)bh * 64 + 16 * vs + l15) * 64 + 16 * (2 * rh + q) + 4 * quad; *(GAS f32x4*)so = St[q]; }
    __syncthreads();
}

constexpr int PTAB_OFF = LDSCTL_OFF + 512;
__device__ __forceinline__ const float* inptr(LAS unsigned char* ldsb, int i) {
    const LAS unsigned* p = (const LAS unsigned*)(ldsb + PTAB_OFF) + 2 * i;
    const unsigned lo = __builtin_amdgcn_readfirstlane(p[0]), hi = __builtin_amdgcn_readfirstlane(p[1]);
    return (const float*)(((unsigned long long)hi << 32) | lo);
}
struct Args { const float* in[28]; float* out; unsigned char* ws; int ph_lo, ph_hi; };
#define WSP(T, off) ((T*)(args.ws + (off)))
#define GEMM_BF16(Aptr, Bptr, Optr, Mv, Nv, Kv) do { pg8::Gemm g{Aptr, Bptr, Mv, Nv, Kv}; pg8::StaticOrder S; S.init(Mv, Nv, C.G, (int)blockIdx.x); \
        pg8::EpiBf16<0> E{Optr, Nv, nullptr, 0, 0, 1.f}; pg8::gemm_phase<pg8::EpiBf16<0>, pg8::StaticOrder, PG8_ALIGN, PG8_SP2>(C.lds + RING_OFF, g, S, E); } while (0)
__global__ void __launch_bounds__(NWAVES * 64, 2) hyb_fwd(Args args) {
    extern __shared__ __attribute__((aligned(16))) unsigned char lds[];
    LAS unsigned char* const ldsb = (LAS unsigned char*)lds;
    for (int u = threadIdx.x; u < (LDS_BYTES - LDSCTL_OFF) / 4; u += NWAVES * 64) ((LAS unsigned*)(ldsb + LDSCTL_OFF))[u] = 0u;
    __syncthreads();
    if (threadIdx.x < 28) ((LAS unsigned long long*)(ldsb + PTAB_OFF))[threadIdx.x] = (unsigned long long)args.in[threadIdx.x];
    __syncthreads();
#define INP(i) inptr(ldsb, (i))
#define MKCTX() Ctx C; { int t_ = threadIdx.x; asm volatile("" : "+v"(t_)); C.lds = ldsb; C.tid = t_; C.lane = t_ & 63; C.wave = __builtin_amdgcn_readfirstlane(t_ >> 6); \
        C.G = gridDim.x; const int bx_ = blockIdx.x; C.vcu = (C.G % 8 == 0) ? (bx_ % 8) * (C.G / 8) + bx_ / 8 : bx_; C.gw = C.vcu * NWAVES + C.wave; C.NGW = C.G * NWAVES; } \
        const int gt = C.gw * 64 + C.lane, NGT = C.NGW * 64; (void)gt; (void)NGT
    const int lo = args.ph_lo, hi = args.ph_hi;
    const bool fused = (hi - lo) > 1;
    XcdBarrier bar; bar.bar = WSP(unsigned, WS_CTL) + CW_BAR; bar.x = 0; bar.st = nullptr;
    if (fused) bar = xcd_barrier_post(WSP(unsigned, WS_CTL) + CW_BAR, (volatile LAS unsigned*)(ldsb + MISC_OFF) + 8);
#ifndef PROBE_PHASE
#define PROBE_PHASE -1
#endif
#ifndef PROBE_SUB
#define PROBE_SUB 0
#endif
#define IN(k) (lo <= (k) && (k) < hi)
#define REP(k) for (int rep_ = 0; rep_ < ((k) == PROBE_PHASE ? 2 : 1); ++rep_)
#define SEAM(k) do { if (IN(k) && IN((k) + 1)) xcd_barrier(bar); } while (0)

    if (IN(0)) REP(0) { MKCTX();
        LAS float* scr = (LAS float*)(C.lds + RING_OFF + C.wave * 16384);
        constexpr int I0 = 16 * 96, I1 = 8 * 32, I2 = 16 * 116, I3 = 16 * 32, I4 = 16 * 16, I5 = 16 * 16, I6 = 24, I7 = 24;
        constexpr int NITEMS = I0 + I1 + I2 + I3 + I4 + I5 + I6 + I7;
        for (int it = C.gw; it < NITEMS; it += C.NGW) {
            int r = it;
            if (r < I0) { p0_transpose_item(INP(14), A_IN, INP(9), WSP(bf16, WS_WAIN), 1024, 0, 0, scr, r, 96, C.lane); continue; } r -= I0;
            if (r < I1) { p0_transpose_item(INP(15), 1024, nullptr, WSP(bf16, WS_WAOUT), 512, 0, 0, scr, r, 32, C.lane); continue; } r -= I1;
            if (r < I2) { p0_transpose_item(INP(16), B_IN, INP(9) + DM, WSP(bf16, WS_WBIN), 1024, 0, 0, scr, r, 116, C.lane); continue; } r -= I2;
            if (r < I3) { p0_transpose_item(INP(17), 1024, nullptr, WSP(bf16, WS_WBOUT), 1024, 0, 0, scr, r, 32, C.lane); continue; } r -= I3;
            if (r < I4) { p0_transpose_item(INP(12), 512, INP(11), WSP(bf16, WS_WM), 1024, 0, 0, scr, r, 16, C.lane); continue; } r -= I4;
            if (r < I5) { p0_transpose_item(INP(12) + 1024 * 512, 512, INP(11) + DM, WSP(bf16, WS_WM), 1024, 0, 512, scr, r, 16, C.lane); continue; } r -= I5;
            if (r < I6) { p0_transpose_item(INP(20), RW, nullptr, WSP(bf16, WS_WL), 128, 0, 0, scr, r, 24, C.lane); continue; } r -= I6;
            p0_transpose_item(INP(22), RW, nullptr, WSP(bf16, WS_WL), 128, 64, RW, scr, r, 24, C.lane);
        }
        const v4u z4 = {0u, 0u, 0u, 0u};
        for (int i = gt; i < 16384; i += NGT) *((GAS v4u*)(WSP(bf16, WS_WBIN) + (size_t)B_IN * 1024) + i) = z4;
        for (int i = gt; i < 1536 * 8; i += NGT) { const int n = i >> 3, c = i & 7; *(GAS v4u*)(WSP(bf16, WS_WL) + (size_t)n * 128 + (n < RW ? 64 : 0) + c * 8) = z4; }
        for (int i = gt; i < 128 * 128; i += NGT) *((GAS v4u*)(WSP(bf16, WS_XN) + (size_t)NREAL * 1024) + i) = z4;
        for (int i = gt; i < 3 * 4 * 129; i += NGT) { const int g = i / (4 * 129), r = i % (4 * 129), hh = r / 129, k = r % 129; const int dil = g == 0 ? 1 : (g == 1 ? 4 : 16);
            WSP(float, WS_BT)[(g * 4 + hh) * 132 + k] = INP(13)[t5_bucket(dil * k) * 12 + g * 4 + hh]; }
        for (int m = C.gw; m < NREAL + 2048; m += C.NGW) {
            if (m < TP) rms_row_to_bf16(INP(0) + (size_t)m * DM, WSP(bf16, WS_XN) + (size_t)m * DM, C.lane);
            else if (m < NREAL) rms_row_to_bf16(INP(1) + (size_t)(m - TP) * DM, WSP(bf16, WS_XN) + (size_t)m * DM, C.lane);
            else rms_row_to_bf16(INP(2) + (size_t)(m - NREAL) * DM, WSP(bf16, WS_MEMN) + (size_t)(m - NREAL) * DM, C.lane);
        }
    } SEAM(0);
    if (IN(1)) REP(1) { MKCTX();
        GEMM_BF16(WSP(bf16, WS_XN), WSP(bf16, WS_WAIN), WSP(bf16, WS_P), MROWS, A_IN, DM);
        GEMM_BF16(WSP(bf16, WS_MEMN), WSP(bf16, WS_WM), WSP(bf16, WS_MKV), 2048, 1024, DM);
    } SEAM(1);
    if (IN(2)) REP(2) { MKCTX();
        const bf16* P = WSP(bf16, WS_P); const bf16* MKV = WSP(bf16, WS_MKV); float* out = args.out;
        for (int i = gt; i < 2 * 2048 * 512; i += NGT) { const int l = i / (2048 * 512), r = (i / 512) % 2048, c = i % 512; out[O_MEM + i] = bf2f(MKV[(size_t)r * 1024 + l * 512 + c]); }
#pragma unroll
        for (int g = 0; g < 3; ++g) { const int Wg = g == 0 ? 128 : (g == 1 ? 512 : 2048); const size_t ob = g == 0 ? O_W0P : (g == 1 ? O_W1P : O_W2P);
            const int n = NBATCH * Wg * 512;
            for (int i = gt; i < n; i += NGT) { const int c = i % 512, ri = (i / 512) % Wg, b = i / (512 * Wg); const int t = SEQ - Wg + ri, kv = c >> 8, cc = c & 255;
                out[ob + i] = bf2f(P[(size_t)((b << 11) + t) * A_IN + RW + kv * RW + g * 256 + cc]); }
            const size_t os = g == 0 ? O_W0S : (g == 1 ? O_W1S : O_W2S);
            for (int i = gt; i < NSAMP * 512; i += NGT) { const int c = i % 512, r = i / 512, kv = c >> 8, cc = c & 255;
                out[os + i] = bf2f(P[(size_t)(TP + r) * A_IN + RW + kv * RW + g * 256 + cc]); } }
        bf16* H = WSP(bf16, WS_H); const float* BT = WSP(float, WS_BT);
        for (int unit = blockIdx.x; unit < 256; unit += C.G) attn_a_unit(C, P, MKV, H, BT, unit);
        { LAS float* mg = (LAS float*)(C.lds + RING_OFF + 65536);
          for (int base = 0; base < NSAMP * 16; base += C.NGW) { const int task = base + C.gw; const bool on = task < NSAMP * 16;
            const int tq = task >> 2, part = task & 3, m = TP + (tq >> 2), hh = tq & 3;
            float Mo = 0.f, So = 1.f, Oo = 0.f;
            if (on) samp_part(P, BT, part == 0 ? INP(4) : (part == 1 ? INP(5) : INP(6)), MKV, INP(3), m, hh, part, 0, P + (size_t)m * A_IN + 2304 + hh * 64, C.lane, Mo, So, Oo);
            __syncthreads();
            mg[C.wave * 66 + C.lane] = Oo; if (C.lane == 0) { mg[C.wave * 66 + 64] = Mo; mg[C.wave * 66 + 65] = So; }
            __syncthreads();
            if (on && (part == 0 || part == 3)) { const bf16* prow = P + (size_t)m * A_IN; float o;
                if (part == 0) { const LAS float* w0 = mg + C.wave * 66; const float M0 = w0[64], M1 = w0[66 + 64], M2 = w0[132 + 64];
                    const float M = fmaxf(fmaxf(M0, M1), M2), e0 = __expf(M0 - M), e1 = __expf(M1 - M), e2 = __expf(M2 - M);
                    const float S = w0[65] * e0 + w0[66 + 65] * e1 + w0[132 + 65] * e2;
                    o = (w0[C.lane] * e0 + w0[66 + C.lane] * e1 + w0[132 + C.lane] * e2) / S;
                    H[(size_t)m * 512 + hh * 64 + C.lane] = (bf16)f2bf(o * silu(bf2f(prow[2560 + hh * 64 + C.lane]))); }
                else { o = Oo / So; H[(size_t)m * 512 + 256 + hh * 64 + C.lane] = (bf16)f2bf(o * silu(bf2f(prow[2560 + 256 + hh * 64 + C.lane]))); } }
          } }
    } SEAM(2);
    if (IN(3)) REP(3) { MKCTX(); GEMM_BF16(WSP(bf16, WS_H), WSP(bf16, WS_WAOUT), WSP(bf16, WS_F), MROWS, DM, 512); } SEAM(3);
    if (IN(4)) REP(4) { MKCTX();
        for (int m = C.gw; m < NREAL; m += C.NGW) { const bool samp = m >= TP;
            row_pass(WSP(bf16, WS_F) + (size_t)m * DM, samp ? INP(1) + (size_t)(m - TP) * DM : INP(0) + (size_t)m * DM,
                     args.out + (samp ? O_YS + (size_t)(m - TP) * DM : O_YP + (size_t)m * DM), INP(10), WSP(bf16, WS_XN) + (size_t)m * DM, C.lane); }
    } SEAM(4);
    if (IN(5)) REP(5) { MKCTX(); GEMM_BF16(WSP(bf16, WS_XN), WSP(bf16, WS_WBIN), WSP(bf16, WS_P), MROWS, B_INP, DM); } SEAM(5);
    if (IN(6)) REP(6) { MKCTX();
        const bf16* P = WSP(bf16, WS_P); bf16* TW = WSP(bf16, WS_TW); const float* mu = INP(18); const float* stsh = INP(8);
        for (int m = C.gw; m < NREAL; m += C.NGW) {
            const bool samp = m >= TP; const int t = samp ? ((m - TP) & 3) : (m & 2047), sb = (m - TP) >> 2;
#pragma unroll
            for (int j = 0; j < 2; ++j) { const int c = 2304 + j * 64 + C.lane;
                const float cur = bf2f(P[(size_t)m * B_INP + c]);
                float prev = 0.f; if (t > 0) prev = bf2f(P[(size_t)(m - 1) * B_INP + c]); else if (samp) prev = stsh[(size_t)sb * CSH + c];
                const float xs = cur + mu[c] * (prev - cur);
                TW[(size_t)m * 128 + j * 64 + C.lane] = (bf16)f2bf(j == 0 ? tanhf(xs) : xs); }
        }
    } SEAM(6);
    if (IN(7)) REP(7) { MKCTX(); GEMM_BF16(WSP(bf16, WS_TW), WSP(bf16, WS_WL), WSP(bf16, WS_F), MROWS, 1536, 128); } SEAM(7);
    if (IN(8)) REP(8) { MKCTX();
        ChunkP cp{WSP(bf16, WS_P), WSP(bf16, WS_F), INP(18), INP(19), INP(21), INP(23), INP(24), INP(25)};
        const int per = (3072 + C.G - 1) / C.G, task0 = (int)blockIdx.x * per; int nt = 3072 - task0; if (nt > per) nt = per;
        if (nt > 0) scan_stage_a(C, cp, WSP(bf16, WS_XN), task0, nt);
    } SEAM(8);
    if (IN(9)) REP(9) { MKCTX();
        const bf16* P = WSP(bf16, WS_P); bf16* H = WSP(bf16, WS_H);
        const int GB = C.G > 96 ? 96 : C.G, vb = (int)blockIdx.x;
        if (vb < GB) {
            ScanBP sb{{WSP(bf16, WS_P), WSP(bf16, WS_F), INP(18), INP(19), INP(21), INP(23), INP(24), INP(25)}, WSP(bf16, WS_XN), WSP(bf16, WS_H), args.out, INP(26), INP(27)};
            for (int rp = 0; rp < (PROBE_SUB == 1 ? 2 : 1); ++rp)
            for (int bh = vb; bh < 96; bh += GB) scan_stage_b(C, sb, bh);
        }
        const int GO = C.G > 96 ? C.G - 96 : C.G, ob = C.G > 96 ? vb - 96 : vb;
        if (ob >= 0) for (int rp = 0; rp < (PROBE_SUB == 2 ? 2 : 1); ++rp) {
            for (int unit = ob; unit < 256; unit += GO) attn_b_unit(C, P, WSP(bf16, WS_MKV), H, unit);
            __syncthreads();
            { ScanP sp{WSP(bf16, WS_P), WSP(bf16, WS_F), WSP(bf16, WS_H), args.out, INP(7), INP(8), INP(18), INP(19), INP(21), INP(23), INP(24), INP(25), INP(26), INP(27)};
              for (int u = 96 + ob; u < 480; u += GO) scan_unit(C, sp, u); }
            const int ogw = ob * NWAVES + C.wave, ONGW = GO * NWAVES, ogt = ogw * 64 + C.lane, ONGT = ONGW * 64;
            for (int task = ogw; task < NSAMP * 4; task += ONGW) { const int m = TP + (task >> 2), hh = task & 3;
                const bf16* prow = P + (size_t)m * B_INP;
                float Mo, So, Oo; samp_part(P, nullptr, nullptr, nullptr, INP(3), m, hh, 3, 1, prow + CSH + hh * 64, C.lane, Mo, So, Oo); const float om = Oo / So;
                H[(size_t)m * 1024 + RW + hh * 64 + C.lane] = (bf16)f2bf(om * silu(bf2f(prow[2688 + RW + hh * 64 + C.lane]))); }
            for (int i = ogt; i < NBATCH * CSH; i += ONGT) { const int b = i / CSH, c = i % CSH; args.out[O_SHP + i] = bf2f(P[(size_t)(b * SEQ + SEQ - 1) * B_INP + c]); }
            for (int i = ogt; i < SBATCH * CSH; i += ONGT) { const int sb = i / CSH, c = i % CSH; args.out[O_SHS + i] = bf2f(P[(size_t)(TP + sb * 4 + 3) * B_INP + c]); }
        }
    } SEAM(9);
    if (IN(10)) REP(10) { MKCTX(); GEMM_BF16(WSP(bf16, WS_H), WSP(bf16, WS_WBOUT), WSP(bf16, WS_F), MROWS, DM, DM); } SEAM(10);
    if (IN(11)) { MKCTX();
        for (int m = C.gw; m < NREAL; m += C.NGW) { const bool samp = m >= TP;
            float* xo = args.out + (samp ? O_YS + (size_t)(m - TP) * DM : O_YP + (size_t)m * DM);
            row_pass(WSP(bf16, WS_F) + (size_t)m * DM, xo, xo, INP(10) + DM, nullptr, C.lane); }
    }
#undef IN
#undef SEAM
}

extern "C" void kernel_launch(void* const* d_in, const int* in_sizes, int n_in, void* d_out, int out_size, void* d_ws, size_t ws_size, hipStream_t stream) {
    static int grid = 0;
    if (grid == 0) {
        if (n_in != 28 || in_sizes[0] != TP * DM || (size_t)out_size != O_END || ws_size < WS_END) {
            fprintf(stderr, "kernel_launch: unexpected shapes: n_in %d in0 %d out %d ws %zu (need >= %zu); nothing launched\n", n_in, n_in > 0 ? in_sizes[0] : -1, out_size, ws_size, (size_t)WS_END); grid = -1; return; }
        int dev = 0, cus = 0, per_cu = 0;
        if (hipGetDevice(&dev) != hipSuccess || hipDeviceGetAttribute(&cus, hipDeviceAttributeMultiprocessorCount, dev) != hipSuccess) { fprintf(stderr, "kernel_launch: device query failed\n"); grid = -1; return; }
        if (hipFuncSetAttribute((const void*)hyb_fwd, hipFuncAttributeMaxDynamicSharedMemorySize, LDS_BYTES) != hipSuccess) { fprintf(stderr, "kernel_launch: hipFuncSetAttribute failed\n"); grid = -1; return; }
        if (hipOccupancyMaxActiveBlocksPerMultiprocessor(&per_cu, (const void*)hyb_fwd, NWAVES * 64, LDS_BYTES) != hipSuccess || per_cu < 1) {
            fprintf(stderr, "kernel_launch: occupancy query reports %d workgroups per CU\n", per_cu); }
        (void)hipGetLastError();
        grid = cus;
    }
    if (grid < 0) return;
    if (hipMemsetAsync((char*)d_ws + WS_CTL, 0, CTL_ZERO_BYTES, stream) != hipSuccess) { fprintf(stderr, "kernel_launch: memset failed\n"); return; }
    Args a{};
    for (int i = 0; i < 28; ++i) a.in[i] = (const float*)d_in[i];
    a.out = (float*)d_out; a.ws = (unsigned char*)d_ws;
#if MK_N_LAUNCHES == 1
    a.ph_lo = 0; a.ph_hi = N_PHASES;
    hipLaunchKernelGGL(hyb_fwd, dim3(grid), dim3(NWAVES * 64), LDS_BYTES, stream, a);
#else
    for (int li = 0; li < N_PHASES; ++li) { a.ph_lo = li; a.ph_hi = li + 1;
        hipLaunchKernelGGL(hyb_fwd, dim3(grid), dim3(NWAVES * 64), LDS_BYTES, stream, a); }
#endif
    const hipError_t le = hipPeekAtLastError();
    if (le != hipSuccess) fprintf(stderr, "kernel_launch: launch failed: %s\n", hipGetErrorName(le));
}
```

```cpp
#include <hip/hip_runtime.h>
#include <cstdio>
#include <cstdint>
namespace pg8 {
#define PG8_LAS __attribute__((address_space(3)))
typedef unsigned short bf16_t;
typedef short bf16x8 __attribute__((ext_vector_type(8)));
typedef float f32x4 __attribute__((ext_vector_type(4)));
typedef unsigned u32x4 __attribute__((ext_vector_type(4)));
constexpr int BM = 256, BK = 64, HALF = 128, HTB = HALF * BK * 2  , STAGE_BYTES = 8 * HTB, NXCD = 8, WGM = 8;

__host__ __device__ __forceinline__ int lds_byte(int r, int c) { const int st = (r >> 4) * 2 + (c >> 5), rr = r & 15, cc = c & 31, ob = rr * 64 + cc * 2; return st * 1024 + (ob ^ (((ob >> 9) & 1) << 5)); }
__host__ __device__ __forceinline__ void stage_rc(int b, int& R, int& C) { const int st = b / 1024, sb = b % 1024, swz = sb ^ (((sb >> 9) & 1) << 5); R = (st >> 1) * 16 + swz / 64; C = (st & 1) * 32 + (swz % 64) / 2; }
__host__ __device__ __forceinline__ int perm32(int rho) { const int n = rho >> 4, i = rho & 15; return 8 * (i >> 2) + 4 * n + (i & 3); }

struct Unit { int pm, pn; };
struct Gemm { const bf16_t* A; const bf16_t* Bt; int M, N, K; };

struct StaticOrder {
    int nM, nN, nwg, G, c;
    __host__ __device__ void init(int M, int N, int G_, int c_) { nM = M / BM; nN = N / BM; nwg = nM * nN; G = G_; c = c_; }
    __host__ __device__ bool next(int i, Unit& u) const {
        const long L = (long)i * G + c; if (L >= nwg) return false;
        int wgid = (int)L; { const int q = nwg / NXCD, r = nwg % NXCD, xcd = wgid % NXCD, off = wgid / NXCD; wgid = (xcd < r ? xcd * (q + 1) : r * (q + 1) + (xcd - r) * q) + off; }
        const int nig = WGM * nN, gid = wgid / nig, fm = gid * WGM, gsz = (nM - fm) < WGM ? (nM - fm) : WGM;
        u.pm = fm + ((wgid % nig) % gsz); u.pn = (wgid % nig) / gsz; return true;
    }
    __device__ __forceinline__ void a_ready(const Unit&) const {}
    __device__ __forceinline__ void done(const Unit&) const {}
};

__device__ __forceinline__ unsigned cvt_pk_bf16(float lo, float hi) { unsigned r; asm volatile("v_cvt_pk_bf16_f32 %0, %1, %2" : "=v"(r) : "v"(lo), "v"(hi)); return r; }
typedef float f32x2 __attribute__((ext_vector_type(2)));
__device__ __forceinline__ f32x2 gelu_pk(f32x2 v) {
    const f32x2 av = __builtin_elementwise_abs(v), d = av * 0.2316418882f + 1.0f;
    f32x2 t; t.x = __builtin_amdgcn_rcpf(d.x); t.y = __builtin_amdgcn_rcpf(d.y);
    f32x2 q = t * 0.5307027145f + (-0.7265760135f); q = q * t + 0.7107068705f; q = q * t + (-0.142248368f); q = q * t + 0.127414796f; q = q * t;
    const f32x2 s = (v * v) * (-0.72134752044f);
    f32x2 e; e.x = __builtin_amdgcn_exp2f(s.x); e.y = __builtin_amdgcn_exp2f(s.y);
    const f32x2 m = v * (q * e), r = v - m;
    f32x2 o; o.x = v.x < 0.f ? m.x : r.x; o.y = v.y < 0.f ? m.y : r.y; return o;
}

template <int ACT  > struct EpiBf16 {
    static constexpr bool PERM = true, AFTER_DRAIN = false; static_assert(ACT == 0 || ACT == 1, "EpiBf16: ACT is 0 (none) or 1 (gelu_pk)");
    bf16_t* O; int ldc; const float* bias; int split_cols; size_t split_stride; float scale0;
    __device__ __forceinline__ void operator()(const f32x4 (&acc)[2][2][4][2], const Unit& u, int wr, int wc, int fr, int fq) const {
        const int row0 = u.pm * BM + wr * 64 + fr; int colt = u.pn * BM; bf16_t* base = O;
        float sc = 1.f; if (split_cols) { const int t = colt / split_cols; base += (size_t)t * split_stride; colt -= t * split_cols; if (t == 0) sc = scale0; }
        const int col0 = colt + wc * 32 + 8 * fq, bcol0 = u.pn * BM + wc * 32 + 8 * fq;
        f32x4 bv[2][2];
#pragma unroll
        for (int bj = 0; bj < 2; ++bj)
#pragma unroll
            for (int n = 0; n < 2; ++n) bv[bj][n] = bias ? *(const f32x4*)(bias + bcol0 + bj * HALF + 4 * n) : (f32x4){0.f, 0.f, 0.f, 0.f};
#pragma unroll
        for (int ai = 0; ai < 2; ++ai)
#pragma unroll
            for (int m = 0; m < 4; ++m) { bf16_t* rowp = base + (size_t)(row0 + ai * HALF + m * 16) * ldc + col0;
#pragma unroll
                for (int bj = 0; bj < 2; ++bj) { f32x4 v0 = acc[ai][bj][m][0] + bv[bj][0], v1 = acc[ai][bj][m][1] + bv[bj][1];
                    if (ACT == 1) { f32x2 a = gelu_pk((f32x2){v0[0], v0[1]}), b = gelu_pk((f32x2){v0[2], v0[3]}), c = gelu_pk((f32x2){v1[0], v1[1]}), d = gelu_pk((f32x2){v1[2], v1[3]});
                        v0 = (f32x4){a.x, a.y, b.x, b.y}; v1 = (f32x4){c.x, c.y, d.x, d.y}; }
                    v0 = v0 * sc; v1 = v1 * sc; u32x4 w; w.x = cvt_pk_bf16(v0[0], v0[1]); w.y = cvt_pk_bf16(v0[2], v0[3]); w.z = cvt_pk_bf16(v1[0], v1[1]); w.w = cvt_pk_bf16(v1[2], v1[3]);
                    *(u32x4*)(rowp + bj * HALF) = w; } }
    }
};
template <class Epi, class Sched, bool ALIGN_EPI = false, bool SP2 = false>
__device__ __forceinline__ void gemm_phase(PG8_LAS unsigned char* lds, const Gemm g, const Sched& S, const Epi& E) {
    const int tid = threadIdx.x, wid = __builtin_amdgcn_readfirstlane(tid >> 6), lane = tid & 63, wr = wid >> 2, wc = wid & 3, fr = lane & 15, fq = lane >> 4;
    const int K = g.K, nt = K / BK;
    unsigned voffA[2], voffB[2];
#pragma unroll
    for (int i = 0; i < 2; ++i) { int R, C; stage_rc(tid * 16 + i * 8192, R, C); const int Rb = Epi::PERM ? ((R & ~31) + perm32(R & 31)) : R;
        voffA[i] = (unsigned)(R * K + C) * 2u; voffB[i] = (unsigned)(Rb * K + C) * 2u; }
    const size_t kstep = (size_t)(BK * 2);
    const size_t hstep = (size_t)HALF * K * 2;
    const size_t tstep = 2 * hstep;
    const unsigned ldsw = (unsigned)wid * 1024u;
    const int aoff = lds_byte(wr * 64 + fr, fq * 8), boff = lds_byte(wc * 32 + fr, fq * 8);
#define PG8_SA(b, h) (((b) * 2 + (h)) * HTB)
#define PG8_SB(b, h) ((4 + (b) * 2 + (h)) * HTB)
#define PG8_STAGE(bufoff, gbase, voff) do { _Pragma("unroll") for (int _i = 0; _i < 2; ++_i) \
        __builtin_amdgcn_global_load_lds((const unsigned*)((const char*)(gbase) + (voff)[_i]), (PG8_LAS unsigned*)(lds + (bufoff) + ldsw + _i * 8192), 16, 0, 0); } while (0)
#define PG8_LDA(dst, b, h) do { _Pragma("unroll") for (int m = 0; m < 4; ++m) _Pragma("unroll") for (int k = 0; k < 2; ++k) dst[m][k] = *(const PG8_LAS bf16x8*)(lds + PG8_SA(b, h) + aoff + m * 2048 + k * 1024); } while (0)
#define PG8_LDB(dst, b, h) do { _Pragma("unroll") for (int n = 0; n < 2; ++n) _Pragma("unroll") for (int k = 0; k < 2; ++k) dst[n][k] = *(const PG8_LAS bf16x8*)(lds + PG8_SB(b, h) + boff + n * 2048 + k * 1024); } while (0)
#define PG8_MMA(ai, bj, At, Bt) do { __builtin_amdgcn_s_setprio(1); _Pragma("unroll") for (int m = 0; m < 4; ++m) _Pragma("unroll") for (int n = 0; n < 2; ++n) _Pragma("unroll") for (int k = 0; k < 2; ++k) \
        acc[ai][bj][m][n] = __builtin_amdgcn_mfma_f32_16x16x32_bf16(Bt[n][k], At[m][k], acc[ai][bj][m][n], 0, 0, 0); __builtin_amdgcn_s_setprio(0); } while (0)
#define PG8_WAIT_V(n) asm volatile("s_waitcnt vmcnt(" #n ")" ::: "memory")
#define PG8_WAIT_L(n) asm volatile("s_waitcnt lgkmcnt(" #n ")" ::: "memory")
#define PG8_BAR __builtin_amdgcn_s_barrier()
#define PG8_SCHED __builtin_amdgcn_sched_barrier(0)
    Unit cur, nxt; int ui = 0;
    if (!S.next(0, cur)) return;
    f32x4 acc[2][2][4][2];
#pragma unroll
    for (int a = 0; a < 2; ++a)
#pragma unroll
        for (int b = 0; b < 2; ++b)
#pragma unroll
            for (int m = 0; m < 4; ++m)
#pragma unroll
                for (int n = 0; n < 2; ++n) acc[a][b][m][n] = (f32x4){0.f, 0.f, 0.f, 0.f};
    bf16x8 At[4][2], B0[2][2], B1[2][2];
    const char* cA = (const char*)g.A + (size_t)cur.pm * tstep; const char* cB = (const char*)g.Bt + (size_t)cur.pn * tstep;
    S.a_ready(cur);
    if constexpr (SP2) {
        PG8_STAGE(PG8_SB(0, 0), cB, voffB); PG8_STAGE(PG8_SB(0, 1), cB + hstep, voffB); PG8_STAGE(PG8_SA(0, 0), cA, voffA); PG8_STAGE(PG8_SA(0, 1), cA + hstep, voffA);
        if (wr == 1) PG8_BAR;
        PG8_WAIT_V(2); PG8_BAR;
        PG8_STAGE(PG8_SB(1, 0), cB + kstep, voffB); PG8_STAGE(PG8_SA(1, 0), cA + kstep, voffA); PG8_STAGE(PG8_SB(1, 1), cB + hstep + kstep, voffB);
        PG8_WAIT_V(6); PG8_BAR;
    } else {
        PG8_STAGE(PG8_SB(0, 0), cB, voffB); PG8_STAGE(PG8_SA(0, 0), cA, voffA); PG8_STAGE(PG8_SB(0, 1), cB + hstep, voffB); PG8_STAGE(PG8_SA(0, 1), cA + hstep, voffA);
        if (wr == 1) PG8_BAR;
        PG8_WAIT_V(4); PG8_BAR;
        PG8_STAGE(PG8_SB(1, 0), cB + kstep, voffB); PG8_STAGE(PG8_SA(1, 0), cA + kstep, voffA); PG8_STAGE(PG8_SB(1, 1), cB + hstep + kstep, voffB);
        PG8_WAIT_V(6); PG8_BAR;
    }
    for (;;) {
        const bool has_next = S.next(ui + 1, nxt);
        const char* nA = has_next ? (const char*)g.A + (size_t)nxt.pm * tstep : cA; const char* nB = has_next ? (const char*)g.Bt + (size_t)nxt.pn * tstep : cB;
        for (int t = 0; t < nt; t += 2) {
            const bool last = (t == nt - 2);
            const char* a1 = cA + (size_t)(t + 1) * kstep;
            const char* a2 = last ? nA : cA + (size_t)(t + 2) * kstep; const char* b2 = last ? nB : cB + (size_t)(t + 2) * kstep;
            const char* a3 = a2 + kstep; const char* b3 = b2 + kstep;
            if (last && has_next) S.a_ready(nxt);
            if constexpr (SP2) {
            PG8_LDB(B0, 0, 0); PG8_LDB(B1, 0, 1); PG8_SCHED; PG8_LDA(At, 0, 0); PG8_STAGE(PG8_SA(1, 1), a1 + hstep, voffA);
            PG8_WAIT_V(8); PG8_WAIT_L(0); PG8_BAR; PG8_MMA(0, 0, At, B0); PG8_MMA(0, 1, At, B1); PG8_BAR; PG8_SCHED;
            PG8_LDA(At, 0, 1); PG8_STAGE(PG8_SB(0, 0), b2, voffB); PG8_STAGE(PG8_SB(0, 1), b2 + hstep, voffB); PG8_STAGE(PG8_SA(0, 0), a2, voffA);
            PG8_WAIT_V(8); PG8_WAIT_L(0); PG8_BAR; PG8_MMA(1, 0, At, B0); PG8_MMA(1, 1, At, B1); PG8_BAR; PG8_SCHED;
            PG8_LDB(B0, 1, 0); PG8_LDB(B1, 1, 1); PG8_SCHED; PG8_LDA(At, 1, 0); PG8_STAGE(PG8_SA(0, 1), a2 + hstep, voffA);
            PG8_WAIT_V(8); PG8_WAIT_L(0); PG8_BAR; PG8_MMA(0, 0, At, B0); PG8_MMA(0, 1, At, B1); PG8_BAR; PG8_SCHED;
            PG8_LDA(At, 1, 1); PG8_STAGE(PG8_SB(1, 0), b3, voffB); PG8_STAGE(PG8_SB(1, 1), b3 + hstep, voffB); PG8_STAGE(PG8_SA(1, 0), a3, voffA);
            PG8_WAIT_V(8); PG8_WAIT_L(0); PG8_BAR; PG8_MMA(1, 0, At, B0); PG8_MMA(1, 1, At, B1); PG8_BAR; PG8_SCHED;
            } else {
            PG8_LDB(B0, 0, 0); PG8_SCHED; PG8_LDA(At, 0, 0); PG8_STAGE(PG8_SA(1, 1), a1 + hstep, voffA);
            PG8_WAIT_L(8); PG8_BAR; PG8_WAIT_L(0); PG8_MMA(0, 0, At, B0); PG8_BAR; PG8_SCHED;
            PG8_LDB(B1, 0, 1); PG8_STAGE(PG8_SB(0, 0), b2, voffB);
            PG8_BAR; PG8_WAIT_L(0); PG8_MMA(0, 1, At, B1); PG8_BAR;
            PG8_LDA(At, 0, 1); PG8_STAGE(PG8_SA(0, 0), a2, voffA);
            PG8_BAR; PG8_WAIT_L(0); PG8_MMA(1, 0, At, B0); PG8_BAR; PG8_SCHED;
            PG8_STAGE(PG8_SB(0, 1), b2 + hstep, voffB);
            PG8_WAIT_V(6); PG8_BAR; PG8_MMA(1, 1, At, B1); PG8_BAR;
            PG8_LDB(B0, 1, 0); PG8_SCHED; PG8_LDA(At, 1, 0); PG8_STAGE(PG8_SA(0, 1), a2 + hstep, voffA);
            PG8_WAIT_L(8); PG8_BAR; PG8_WAIT_L(0); PG8_MMA(0, 0, At, B0); PG8_BAR; PG8_SCHED;
            PG8_LDB(B1, 1, 1); PG8_STAGE(PG8_SB(1, 0), b3, voffB);
            PG8_BAR; PG8_WAIT_L(0); PG8_MMA(0, 1, At, B1); PG8_BAR;
            PG8_LDA(At, 1, 1); PG8_STAGE(PG8_SA(1, 0), a3, voffA);
            PG8_BAR; PG8_WAIT_L(0); PG8_MMA(1, 0, At, B0); PG8_BAR; PG8_SCHED;
            PG8_STAGE(PG8_SB(1, 1), b3 + hstep, voffB);
            PG8_WAIT_V(6); PG8_BAR; PG8_MMA(1, 1, At, B1); PG8_BAR;
            }
        }
        if constexpr (ALIGN_EPI) { if (wr == 0) PG8_BAR; }
        if constexpr (!Epi::AFTER_DRAIN) { E(acc, cur, wr, wc, fr, fq); S.done(cur); }
        if (!has_next) break;
#pragma unroll
        for (int a = 0; a < 2; ++a)
#pragma unroll
            for (int b = 0; b < 2; ++b)
#pragma unroll
                for (int m = 0; m < 4; ++m)
#pragma unroll
                    for (int n = 0; n < 2; ++n) acc[a][b][m][n] = (f32x4){0.f, 0.f, 0.f, 0.f};
        cur = nxt; cA = nA; cB = nB; ++ui;
        if constexpr (ALIGN_EPI) { if (wr == 1) PG8_BAR; }
    }
    PG8_WAIT_V(0);
    if constexpr (!ALIGN_EPI) { if (wr == 0) PG8_BAR; }
    PG8_BAR;
    if constexpr (Epi::AFTER_DRAIN) { E.fused(acc, cur, wr, wc, fr, fq, lds, wid, lane); S.done(cur); }
#undef PG8_SA
#undef PG8_SB
#undef PG8_STAGE
#undef PG8_LDA
#undef PG8_LDB
#undef PG8_MMA
#undef PG8_WAIT_V
#undef PG8_WAIT_L
#undef PG8_BAR
#undef PG8_SCHED
}
}

#ifndef PG8_SP2
#define PG8_SP2 true
#endif
#ifndef PG8_ALIGN
#define PG8_ALIGN true
#endif

constexpr int NWAVES = 8;
#ifndef MK_N_LAUNCHES
#define MK_N_LAUNCHES 1
#endif
constexpr int N_PHASES = 12;
constexpr int TP = 16384, NSAMP = 128, NREAL = TP + NSAMP, MROWS = 16640, DM = 1024;
constexpr int SEQ = 2048, NBATCH = 8, SBATCH = 32, STOK = 4, NMEM = 256;
constexpr int A_IN = 3072, B_IN = 3712, B_INP = 3840, CSH = 2432, RW = 768;
constexpr float RMS_EPS = 1e-6f, GN_EPS = 64e-5f;
constexpr size_t O_YP = 0, O_YS = 16777216, O_MEM = 16908288, O_W0P = 19005440, O_W1P = 19529728, O_W2P = 21626880,
                 O_W0S = 30015488, O_W1S = 30081024, O_W2S = 30146560, O_WKVP = 30212096, O_WKVS = 30605312, O_SHP = 32178176, O_SHS = 32197632, O_END = 32275456;
constexpr size_t MiB = 1u << 20;
constexpr size_t WS_CTL = 0, CTL_ZERO_BYTES = 1 * MiB;
constexpr size_t WS_WAIN = 1 * MiB, WS_WAOUT = 7 * MiB, WS_WBIN = 8 * MiB, WS_WBOUT = 16 * MiB, WS_WM = 18 * MiB, WS_WL = 20 * MiB, WS_BT = 20 * MiB + 512 * 1024;
constexpr size_t WS_MEMN = 21 * MiB, WS_MKV = 25 * MiB, WS_TW = 29 * MiB, WS_XN = 34 * MiB, WS_H = 67 * MiB, WS_F = 100 * MiB, WS_P = 149 * MiB, WS_END = 271 * MiB;
constexpr int CW_TMO = 0, CW_BAR = 4096;

constexpr int RING_OFF = 0, RING_BYTES = 161792;
constexpr int LDSCTL_OFF = RING_BYTES, MISC_OFF = LDSCTL_OFF + 320;
constexpr int LDS_BYTES = 163840;

#define GAS __attribute__((address_space(1)))
#define LAS __attribute__((address_space(3)))
typedef unsigned short bf16;
typedef unsigned v4u __attribute__((ext_vector_type(4)));
typedef unsigned v2u __attribute__((ext_vector_type(2)));
typedef float f32x4 __attribute__((ext_vector_type(4)));
typedef GAS unsigned gu32;
#define RLX_AGENT __ATOMIC_RELAXED, __HIP_MEMORY_SCOPE_AGENT
#define LDS_WAIT() asm volatile("s_waitcnt lgkmcnt(0)" ::: "memory")
#define VM_WAIT() asm volatile("s_waitcnt vmcnt(0)" ::: "memory")
__device__ __forceinline__ unsigned f2bf(float f) { unsigned u = __builtin_bit_cast(unsigned, f); return (u + 0x7fffu + ((u >> 16) & 1u)) >> 16; }
__device__ __forceinline__ unsigned pk2(float lo, float hi) { return f2bf(lo) | (f2bf(hi) << 16); }
__device__ __forceinline__ float bflo(unsigned u) { return __builtin_bit_cast(float, u << 16); }
__device__ __forceinline__ float bfhi(unsigned u) { return __builtin_bit_cast(float, u & 0xffff0000u); }
__device__ __forceinline__ float bf2f(bf16 h) { return __builtin_bit_cast(float, (unsigned)h << 16); }

#define XB_TMO      128
#define XB_XCNT(j)  (256  + 64 * (j))
#define XB_XSUB(j)  (1280 + 64 * (j))
#define XB_XGEN(j)  (2304 + 64 * (j))
#define XB_TOP      3328
#define XB_TOPGEN   3392
#define XCD_BAR_WORDS 3456
#define XB_SPIN_CAP (1u << 20)
__device__ __forceinline__ unsigned xb_ld(unsigned* p)              { return __hip_atomic_load(p, __ATOMIC_RELAXED, __HIP_MEMORY_SCOPE_AGENT); }
__device__ __forceinline__ unsigned xb_add(unsigned* p, unsigned v) { return __hip_atomic_fetch_add(p, v, __ATOMIC_RELAXED, __HIP_MEMORY_SCOPE_AGENT); }
__device__ __forceinline__ unsigned xb_xcc_id() { return (unsigned)__builtin_amdgcn_s_getreg((3 << 11) | 20) & 0xFu; }
#define XB_SPIN(cond, bar) do { unsigned _sp = 0; while (cond) { __builtin_amdgcn_s_sleep(1); \
    if ((++_sp & 255u) == 0u) { if (xb_ld(&(bar)[XB_TMO])) break; if (_sp > XB_SPIN_CAP) { atomicAdd(&(bar)[XB_TMO], 1u); break; } } } } while (0)
struct XcdBarrier { unsigned* bar; unsigned x; volatile LAS unsigned* st; };
__device__ __forceinline__ XcdBarrier xcd_barrier_post(unsigned* bar, volatile LAS unsigned* st) {
    XcdBarrier b; b.bar = bar; b.x = xb_xcc_id(); b.st = st;
    if (threadIdx.x == 0) (void)xb_add(&bar[XB_XCNT(b.x)], 1u);
    return b;
}
__device__ __forceinline__ void xcd_barrier_complete(unsigned* bar, unsigned x, unsigned& nloc, unsigned& nx) {
    const unsigned G = gridDim.x * gridDim.y * gridDim.z;
    unsigned sum, cnt, mine, sp = 0u;
    for (;;) {
        sum = 0u; cnt = 0u; mine = 0u;
#pragma unroll
        for (unsigned j = 0; j < 16; ++j) { const unsigned c = xb_ld(&bar[XB_XCNT(j)]); sum += c; cnt += (c > 0u) ? 1u : 0u; mine = (j == x) ? c : mine; }
        if (sum == G) break;
        __builtin_amdgcn_s_sleep(1);
        if ((++sp & 255u) == 0u) { if (xb_ld(&bar[XB_TMO])) break; if (sp > XB_SPIN_CAP) { atomicAdd(&bar[XB_TMO], 1u); break; } }
    }
    nloc = mine > 0u ? mine : 1u; nx = cnt > 0u ? cnt : 1u;
}
__device__ __forceinline__ void xcd_barrier(const XcdBarrier& b) {
    asm volatile("s_waitcnt vmcnt(0)" ::: "memory");
    __syncthreads();
    if (threadIdx.x == 0) {
        unsigned* bar = b.bar;
        __builtin_amdgcn_s_waitcnt(0);
        unsigned nloc = b.st[0], nx = b.st[1];
        if (nloc == 0u) { xcd_barrier_complete(bar, b.x, nloc, nx); b.st[0] = nloc; b.st[1] = nx; }
        const unsigned old = xb_add(&bar[XB_XSUB(b.x)], 1u);
        const unsigned gen = old / nloc;
        if (old + 1u == (gen + 1u) * nloc) {
            __builtin_amdgcn_fence(__ATOMIC_RELEASE, "agent");
            asm volatile("s_waitcnt vmcnt(0)" ::: "memory");
            const unsigned og = xb_add(&bar[XB_TOP], 1u);
            const unsigned tg = og / nx;
            if (og + 1u == (tg + 1u) * nx) xb_add(&bar[XB_TOPGEN], 1u);
            else XB_SPIN(xb_ld(&bar[XB_TOPGEN]) == tg, bar);
            __builtin_amdgcn_fence(__ATOMIC_ACQUIRE, "agent");
            xb_add(&bar[XB_XGEN(b.x)], 1u);
            asm volatile("s_waitcnt vmcnt(0)" ::: "memory");
        } else {
            XB_SPIN(xb_ld(&bar[XB_XGEN(b.x)]) == gen, bar);
            __builtin_amdgcn_fence(__ATOMIC_ACQUIRE, "agent");
            asm volatile("s_waitcnt vmcnt(0)" ::: "memory");
        }
    }
    __syncthreads();
}

struct Ctx { LAS unsigned char* lds; int tid, lane, wave, vcu, G, gw, NGW; };

__device__ __forceinline__ float wave_sum(float v) {
#pragma unroll
    for (int o = 1; o < 64; o <<= 1) v += __shfl_xor(v, o);
    return v;
}
__device__ __forceinline__ float wave_max(float v) {
#pragma unroll
    for (int o = 1; o < 64; o <<= 1) v = fmaxf(v, __shfl_xor(v, o));
    return v;
}
__device__ __forceinline__ float rdlane(float v, int l) { return __builtin_bit_cast(float, __builtin_amdgcn_readlane(__builtin_bit_cast(int, v), l)); }

__device__ __forceinline__ void p0_transpose_item(const float* W, int N, const float* gain, bf16* WT, int ldo, int col_off, int row_off, LAS float* scr, int item, int nblk, int lane) {
    const int kb = item / nblk, nb = item % nblk, k0 = 64 * kb, n0 = 32 * nb;
#pragma unroll 8
    for (int i = 0; i < 32; ++i) { const int kk = 2 * i + (lane >> 5); const float g = gain ? gain[k0 + kk] : 1.f; scr[kk * 33 + (lane & 31)] = W[(size_t)(k0 + kk) * N + n0 + (lane & 31)] * g; }
    LDS_WAIT(); asm volatile("" ::: "memory");
    const int c = lane & 7;
#pragma unroll
    for (int j = 0; j < 4; ++j) { const int n = (lane >> 3) + 8 * j; const LAS float* s = scr + (8 * c) * 33 + n;
        v4u o; o.x = pk2(s[0 * 33], s[1 * 33]); o.y = pk2(s[2 * 33], s[3 * 33]); o.z = pk2(s[4 * 33], s[5 * 33]); o.w = pk2(s[6 * 33], s[7 * 33]);
        *(GAS v4u*)(WT + (size_t)(row_off + n0 + n) * ldo + col_off + k0 + 8 * c) = o; }
    LDS_WAIT(); asm volatile("" ::: "memory");
}
__device__ __forceinline__ void rms_row_to_bf16(const float* xrow, bf16* orow, int lane) {
    const GAS f32x4* xr = (const GAS f32x4*)xrow + lane;
    f32x4 v[4]; float s = 0.f;
#pragma unroll
    for (int j = 0; j < 4; ++j) { v[j] = xr[64 * j]; s += (v[j].x * v[j].x + v[j].y * v[j].y) + (v[j].z * v[j].z + v[j].w * v[j].w); }
    const float r = 1.f / sqrtf(wave_sum(s) * (1.f / DM) + RMS_EPS);
    GAS unsigned long long* o8 = (GAS unsigned long long*)orow + lane;
#pragma unroll
    for (int j = 0; j < 4; ++j) o8[64 * j] = (unsigned long long)pk2(v[j].x * r, v[j].y * r) | ((unsigned long long)pk2(v[j].z * r, v[j].w * r) << 32);
}
__device__ __forceinline__ int t5_bucket(int dist) {
    if (dist < 16) return dist;
    const double x = log((double)dist / 16.0) / log(128.0) * 16.0;
    int large = 16 + (int)x; return large < 31 ? large : 31;
}

__device__ __forceinline__ void ldq64(const bf16* p, float (&q)[64]) {
#pragma unroll
    for (int i = 0; i < 8; ++i) { const v4u u = *(const GAS v4u*)(p + 8 * i);
        q[8 * i + 0] = bflo(u.x); q[8 * i + 1] = bfhi(u.x); q[8 * i + 2] = bflo(u.y); q[8 * i + 3] = bfhi(u.y);
        q[8 * i + 4] = bflo(u.z); q[8 * i + 5] = bfhi(u.z); q[8 * i + 6] = bflo(u.w); q[8 * i + 7] = bfhi(u.w); }
}
__device__ __forceinline__ float dot64_bf(const float (&q)[64], const bf16* p) {
    float s0 = 0.f, s1 = 0.f;
#pragma unroll
    for (int i = 0; i < 8; ++i) { const v4u u = *(const GAS v4u*)(p + 8 * i);
        s0 += q[8 * i + 0] * bflo(u.x); s1 += q[8 * i + 1] * bfhi(u.x); s0 += q[8 * i + 2] * bflo(u.y); s1 += q[8 * i + 3] * bfhi(u.y);
        s0 += q[8 * i + 4] * bflo(u.z); s1 += q[8 * i + 5] * bfhi(u.z); s0 += q[8 * i + 6] * bflo(u.w); s1 += q[8 * i + 7] * bfhi(u.w); }
    return s0 + s1;
}
__device__ __forceinline__ float dot64_f32(const float (&q)[64], const float* p) {
    float s0 = 0.f, s1 = 0.f;
#pragma unroll
    for (int i = 0; i < 16; ++i) { const f32x4 u = *(const GAS f32x4*)(p + 4 * i);
        s0 += q[4 * i + 0] * u.x; s1 += q[4 * i + 1] * u.y; s0 += q[4 * i + 2] * u.z; s1 += q[4 * i + 3] * u.w; }
    return s0 + s1;
}
__device__ __forceinline__ float silu(float x) { return x / (1.f + __expf(-x)); }

__device__ __forceinline__ float cross_attn_task(const bf16* MKV, const float* c_mem, const bf16* qptr, int m, int hh, int layer, int lane) {
    float q[64]; ldq64(qptr, q);
    const bool samp = m >= TP;
    float l[4]; float mx = -3.0e38f, o = 0.f, s = 0.f;
    if (!samp) {
        const bf16* kb = MKV + (size_t)((m >> 11) * NMEM) * 1024 + layer * 512 + hh * 64;
#pragma unroll
        for (int r = 0; r < 4; ++r) { l[r] = dot64_bf(q, kb + (size_t)(r * 64 + lane) * 1024) * 0.125f; mx = fmaxf(mx, l[r]); }
        mx = wave_max(mx);
#pragma unroll
        for (int r = 0; r < 4; ++r) { l[r] = __expf(l[r] - mx); s += l[r]; }
        s = wave_sum(s);
#pragma unroll
        for (int r = 0; r < 4; ++r)
            for (int kk = 0; kk < 64; ++kk) o += rdlane(l[r], kk) * bf2f(kb[(size_t)(r * 64 + kk) * 1024 + 256 + lane]);
    } else {
        const float* kf = c_mem + ((size_t)(layer * SBATCH + ((m - TP) >> 2)) * NMEM) * 512 + hh * 64;
#pragma unroll
        for (int r = 0; r < 4; ++r) { l[r] = dot64_f32(q, kf + (size_t)(r * 64 + lane) * 512) * 0.125f; mx = fmaxf(mx, l[r]); }
        mx = wave_max(mx);
#pragma unroll
        for (int r = 0; r < 4; ++r) { l[r] = __expf(l[r] - mx); s += l[r]; }
        s = wave_sum(s);
#pragma unroll
        for (int r = 0; r < 4; ++r)
            for (int kk = 0; kk < 64; ++kk) o += rdlane(l[r], kk) * kf[(size_t)(r * 64 + kk) * 512 + 256 + lane];
    }
    return o / s;
}

template <int G>
__device__ __forceinline__ void attn_group(const bf16* P, const float* BT, const float* cw, int m, int hh, int lane, float& Mx, float& Ss, float& O) {
    constexpr int dil = G == 0 ? 1 : (G == 1 ? 4 : 16), Wg = G == 0 ? 128 : (G == 1 ? 512 : 2048), head0 = G * 4;
    const bool samp = m >= TP;
    const int b = m >> 11, t = m & 2047, sb = (m - TP) >> 2, st = (m - TP) & 3, head = head0 + hh;
    float q[64]; ldq64(P + (size_t)m * A_IN + head * 64, q);
    const float* bt = BT + (G * 4 + hh) * 132;
    float l[3]; float gm = -3.0e38f;
#pragma unroll
    for (int r = 0; r < 3; ++r) { const int kidx = r * 64 + lane; float lv = -3.0e38f;
        if (kidx < 129) {
            if (!samp) { const int tk = t - dil * kidx; if (tk >= 0) lv = dot64_bf(q, P + (size_t)((b << 11) + tk) * A_IN + RW + head * 64) * 0.125f + bt[kidx]; }
            else { const int idx = Wg + st - dil * kidx;
                if (idx >= Wg) lv = dot64_bf(q, P + (size_t)(TP + sb * 4 + idx - Wg) * A_IN + RW + head * 64) * 0.125f + bt[kidx];
                else lv = dot64_f32(q, cw + ((size_t)(sb * Wg + idx) * 2) * 256 + hh * 64) * 0.125f + bt[kidx]; }
        }
        l[r] = lv; gm = fmaxf(gm, lv); }
    gm = wave_max(gm);
    const float Mn = fmaxf(Mx, gm), sc = __expf(Mx - Mn);
    float ps = 0.f;
#pragma unroll
    for (int r = 0; r < 3; ++r) { l[r] = l[r] > -1.0e38f ? __expf(l[r] - Mn) : 0.f; ps += l[r]; }
    Ss = Ss * sc + wave_sum(ps); O *= sc; Mx = Mn;
#pragma unroll
    for (int r = 0; r < 3; ++r)
        for (int kk = 0; kk < 64; ++kk) { const int kidx = r * 64 + kk; if (kidx >= 129) break;
            const float p = rdlane(l[r], kk);
            if (p != 0.f) { float v;
                if (!samp) { const int tk = t - dil * kidx; v = bf2f(P[(size_t)((b << 11) + tk) * A_IN + 2 * RW + head * 64 + lane]); }
                else { const int idx = Wg + st - dil * kidx;
                    if (idx >= Wg) v = bf2f(P[(size_t)(TP + sb * 4 + idx - Wg) * A_IN + 2 * RW + head * 64 + lane]);
                    else v = cw[((size_t)(sb * Wg + idx) * 2 + 1) * 256 + hh * 64 + lane]; }
                O += p * v; } }
}


__device__ __forceinline__ void samp_dot_rounds3(const bf16* P, const float* cw, const float* bt, const float (&q)[64], int g, int sb, int st, int hh, int lane, float (&l)[3]) {
    const int dil = g == 0 ? 1 : (g == 1 ? 4 : 16), Wg = g == 0 ? 128 : (g == 1 ? 512 : 2048), head = g * 4 + hh;
#pragma unroll
    for (int r = 0; r < 3; ++r) { const int kidx = r * 64 + lane; float lv = -3.0e38f;
        if (kidx < 129) { const int idx = Wg + st - dil * kidx;
            if (idx >= Wg) lv = dot64_bf(q, P + (size_t)(TP + sb * 4 + idx - Wg) * A_IN + RW + head * 64) * 0.125f + bt[kidx];
            else lv = dot64_f32(q, cw + ((size_t)(sb * Wg + idx) * 2) * 256 + hh * 64) * 0.125f + bt[kidx]; }
        l[r] = lv; }
}
__device__ __forceinline__ void samp_part(const bf16* P, const float* BT, const float* cw, const bf16* MKVunused, const float* c_mem, int m, int hh, int part, int layer, const bf16* qmem, int lane, float& Mo, float& So, float& Oo) {
    const int sb = (m - TP) >> 2, st = (m - TP) & 3;
    float q[64];
    if (part < 3) {
        const int g = part, dil = g == 0 ? 1 : (g == 1 ? 4 : 16), Wg = g == 0 ? 128 : (g == 1 ? 512 : 2048), head = g * 4 + hh;
        ldq64(P + (size_t)m * A_IN + head * 64, q);
        float l[3]; samp_dot_rounds3(P, cw, BT + (g * 4 + hh) * 132, q, g, sb, st, hh, lane, l);
        float gm = wave_max(fmaxf(fmaxf(l[0], l[1]), l[2])); float ps = 0.f;
#pragma unroll
        for (int r = 0; r < 3; ++r) { l[r] = l[r] > -1.0e38f ? __expf(l[r] - gm) : 0.f; ps += l[r]; }
        const float S = wave_sum(ps); float O = 0.f;
#pragma unroll
        for (int r = 0; r < 3; ++r) {
#pragma unroll 1
            for (int k0 = 0; k0 < 64; k0 += 8) { if (r * 64 + k0 >= 129) break;
                float v[8];
#pragma unroll
                for (int e = 0; e < 8; ++e) { int kidx = r * 64 + k0 + e; if (kidx > 128) kidx = 128; const int idx = Wg + st - dil * kidx;
                    v[e] = (idx >= Wg) ? bf2f(P[(size_t)(TP + sb * 4 + idx - Wg) * A_IN + 2 * RW + head * 64 + lane]) : cw[((size_t)(sb * Wg + idx) * 2 + 1) * 256 + hh * 64 + lane]; }
#pragma unroll
                for (int e = 0; e < 8; ++e) O += rdlane(l[r], k0 + e) * v[e]; } }
        Mo = gm; So = S; Oo = O;
    } else {
        ldq64(qmem, q);
        const float* kf = c_mem + ((size_t)(layer * SBATCH + sb) * NMEM) * 512 + hh * 64;
        float l[4]; float mx = -3.0e38f, s = 0.f, o = 0.f;
#pragma unroll
        for (int r = 0; r < 4; ++r) { l[r] = dot64_f32(q, kf + (size_t)(r * 64 + lane) * 512) * 0.125f; mx = fmaxf(mx, l[r]); }
        mx = wave_max(mx);
#pragma unroll
        for (int r = 0; r < 4; ++r) { l[r] = __expf(l[r] - mx); s += l[r]; }
        s = wave_sum(s);
#pragma unroll
        for (int r = 0; r < 4; ++r) {
#pragma unroll 1
            for (int k0 = 0; k0 < 64; k0 += 8) { float v[8];
#pragma unroll
                for (int e = 0; e < 8; ++e) v[e] = kf[(size_t)(r * 64 + k0 + e) * 512 + 256 + lane];
#pragma unroll
                for (int e = 0; e < 8; ++e) o += rdlane(l[r], k0 + e) * v[e]; } }
        Mo = mx; So = s; Oo = o;
    }
}

typedef short s16x4 __attribute__((ext_vector_type(4)));
typedef short bf16x8 __attribute__((ext_vector_type(8)));
constexpr int VROW = 160;
constexpr int VBUF = 32 * VROW;
constexpr float LOG2E = 1.4426950408889634f;
template <int OFF> __device__ __forceinline__ s16x4 tr_read(unsigned vb) {
    s16x4 r; asm volatile("ds_read_b64_tr_b16 %0, %1 offset:%2" : "=&v"(r) : "v"(vb), "i"(OFF) : "memory"); return r;
}
struct AttnSt { float m, s; f32x4 o[4]; };
__device__ __forceinline__ void attn_init(AttnSt& st) { st.m = -1.0e30f; st.s = 0.f;
#pragma unroll
    for (int i = 0; i < 4; ++i) st.o[i] = (f32x4){0.f, 0.f, 0.f, 0.f}; }
__device__ __forceinline__ unsigned cvt_pk_bf16f(float lo, float hi) { unsigned r; asm volatile("v_cvt_pk_bf16_f32 %0, %1, %2" : "=v"(r) : "v"(lo), "v"(hi)); return r; }

template <bool MASKED>
__device__ __forceinline__ void attn_pairs(const bf16* kbase, const bf16* vbase, int pitch, int tb, int dil, int qs, int tmax, int j0, int j1,
                                           const bf16x8 (&qf)[2], const LAS float* bias2, LAS unsigned char* vbuf, int lane, AttnSt& st) {
    const int n = lane & 15, quad = lane >> 4, vr8 = lane >> 3, vc8 = lane & 7;
    const unsigned vwr = (unsigned)(size_t)vbuf + (unsigned)(vr8 * VROW + vc8 * 16);
    const unsigned vrd = (unsigned)(size_t)vbuf + (unsigned)((4 * quad + (n >> 2)) * VROW + 8 * (n & 3));
    const float C2 = 0.125f * LOG2E;
    bf16x8 ka[2][2]; v4u vr[4];
#define ATT_LOAD(JP, KA, VR) do { _Pragma("unroll") for (int tt = 0; tt < 2; ++tt) { int tk = tb + dil * (32 * (JP) + 16 * tt + n); if (MASKED) tk = tk < 0 ? 0 : (tk > tmax ? tmax : tk); \
            const bf16* kp = kbase + (size_t)tk * pitch + 8 * quad; \
            KA[tt][0] = __builtin_bit_cast(bf16x8, *(const GAS v4u*)kp); KA[tt][1] = __builtin_bit_cast(bf16x8, *(const GAS v4u*)(kp + 32)); } \
        _Pragma("unroll") for (int c = 0; c < 4; ++c) { int tk = tb + dil * (32 * (JP) + 8 * c + vr8); if (MASKED) tk = tk < 0 ? 0 : (tk > tmax ? tmax : tk); \
            VR[c] = *(const GAS v4u*)(vbase + (size_t)tk * pitch + 8 * vc8); } } while (0)
    if (j0 < j1) ATT_LOAD(j0, ka, vr);
#pragma unroll 1
    for (int jp = j0; jp < j1; ++jp) {
        bf16x8 kn[2][2]; v4u vn[4];
        { const int jn = (jp + 1 < j1) ? jp + 1 : jp; ATT_LOAD(jn, kn, vn); }
        f32x4 sA = {0.f, 0.f, 0.f, 0.f}, sB = {0.f, 0.f, 0.f, 0.f};
        sA = __builtin_amdgcn_mfma_f32_16x16x32_bf16(ka[0][0], qf[0], sA, 0, 0, 0); sA = __builtin_amdgcn_mfma_f32_16x16x32_bf16(ka[0][1], qf[1], sA, 0, 0, 0);
        sB = __builtin_amdgcn_mfma_f32_16x16x32_bf16(ka[1][0], qf[0], sB, 0, 0, 0); sB = __builtin_amdgcn_mfma_f32_16x16x32_bf16(ka[1][1], qf[1], sB, 0, 0, 0);
        float l[8]; bool ok[8]; float mloc = -1.0e30f;
#pragma unroll
        for (int e = 0; e < 8; ++e) { const int u = 32 * jp + (e >> 2) * 16 + 4 * quad + (e & 3); const float a = (e < 4 ? sA[e & 3] : sB[e & 3]) * C2;
            if (MASKED) { const int kidx = 128 + qs * n - u; ok[e] = (kidx >= 0) && (kidx <= 128) && (tb + dil * u >= 0);
                const int kc = kidx < 0 ? 0 : (kidx > 128 ? 128 : kidx); l[e] = ok[e] ? a + bias2[kc] : -1.0e30f; }
            else { ok[e] = true; l[e] = a; }
            mloc = fmaxf(mloc, l[e]); }
        mloc = fmaxf(mloc, __shfl_xor(mloc, 16)); mloc = fmaxf(mloc, __shfl_xor(mloc, 32));
        const float mn = fmaxf(st.m, mloc), alpha = __builtin_amdgcn_exp2f(st.m - mn);
        float ps = 0.f; float p[8];
#pragma unroll
        for (int e = 0; e < 8; ++e) { p[e] = ok[e] ? __builtin_amdgcn_exp2f(l[e] - mn) : 0.f; ps += p[e]; }
        st.s = st.s * alpha + ps; st.m = mn;
#pragma unroll
        for (int i = 0; i < 4; ++i) st.o[i] = st.o[i] * alpha;
        v4u pk; pk.x = cvt_pk_bf16f(p[0], p[1]); pk.y = cvt_pk_bf16f(p[2], p[3]); pk.z = cvt_pk_bf16f(p[4], p[5]); pk.w = cvt_pk_bf16f(p[6], p[7]);
        const bf16x8 pb = __builtin_bit_cast(bf16x8, pk);
#pragma unroll
        for (int c = 0; c < 4; ++c) *(LAS v4u*)(size_t)(vwr + c * 8 * VROW) = vr[c];
        asm volatile("s_waitcnt lgkmcnt(0)" ::: "memory");
        const s16x4 a0 = tr_read<0>(vrd), b0 = tr_read<16 * VROW>(vrd), a1 = tr_read<32>(vrd), b1 = tr_read<16 * VROW + 32>(vrd);
        const s16x4 a2 = tr_read<64>(vrd), b2 = tr_read<16 * VROW + 64>(vrd), a3 = tr_read<96>(vrd), b3 = tr_read<16 * VROW + 96>(vrd);
        asm volatile("s_waitcnt lgkmcnt(0)" ::: "memory"); __builtin_amdgcn_sched_barrier(0);
#define PKV(L, H) (bf16x8){L[0], L[1], L[2], L[3], H[0], H[1], H[2], H[3]}
        st.o[0] = __builtin_amdgcn_mfma_f32_16x16x32_bf16(PKV(a0, b0), pb, st.o[0], 0, 0, 0);
        st.o[1] = __builtin_amdgcn_mfma_f32_16x16x32_bf16(PKV(a1, b1), pb, st.o[1], 0, 0, 0);
        st.o[2] = __builtin_amdgcn_mfma_f32_16x16x32_bf16(PKV(a2, b2), pb, st.o[2], 0, 0, 0);
        st.o[3] = __builtin_amdgcn_mfma_f32_16x16x32_bf16(PKV(a3, b3), pb, st.o[3], 0, 0, 0);
#undef PKV
        __builtin_amdgcn_sched_barrier(0);
#pragma unroll
        for (int tt = 0; tt < 2; ++tt) { ka[tt][0] = kn[tt][0]; ka[tt][1] = kn[tt][1]; }
#pragma unroll
        for (int c = 0; c < 4; ++c) vr[c] = vn[c];
    }
#undef ATT_LOAD
}
__device__ __forceinline__ void attn_store(const AttnSt& st, const bf16* gate_row  , bf16* out_row, int lane) {
    const int quad = lane >> 4;
    float s = st.s; s += __shfl_xor(s, 16); s += __shfl_xor(s, 32);
    const float inv = 1.f / s;
#pragma unroll
    for (int mt = 0; mt < 4; ++mt) { const v2u g = *(const GAS v2u*)(gate_row + 16 * mt + 4 * quad);
        const float o0 = st.o[mt][0] * inv * silu(bflo(g.x)), o1 = st.o[mt][1] * inv * silu(bfhi(g.x)), o2 = st.o[mt][2] * inv * silu(bflo(g.y)), o3 = st.o[mt][3] * inv * silu(bfhi(g.y));
        *(GAS v2u*)(out_row + 16 * mt + 4 * quad) = (v2u){pk2(o0, o1), pk2(o2, o3)}; }
}
__device__ __forceinline__ void load_qf(const bf16* qrow, int lane, bf16x8 (&qf)[2]) {
    const int quad = lane >> 4;
    qf[0] = __builtin_bit_cast(bf16x8, *(const GAS v4u*)(qrow + 8 * quad)); qf[1] = __builtin_bit_cast(bf16x8, *(const GAS v4u*)(qrow + 32 + 8 * quad));
}
__device__ __forceinline__ void attn_a_unit(const Ctx& C, const bf16* P, const bf16* MKV, bf16* H, const float* BT, int unit) {
    const int b = unit >> 5, hh = (unit >> 3) & 3, t0 = (unit & 7) * 256;
    LAS float* bias2 = (LAS float*)(C.lds + RING_OFF);
    LAS unsigned char* vbuf = C.lds + RING_OFF + 4096 + C.wave * VBUF;
    __syncthreads();
    for (int i = C.tid; i < 3 * 132; i += NWAVES * 64) { const int g = i / 132, k = i % 132; bias2[i] = k < 129 ? BT[(g * 4 + hh) * 132 + k] * LOG2E : 0.f; }
    __syncthreads();
    const int n = C.lane & 15;
    const bf16* Pb = P + (size_t)(b << 11) * A_IN;
#pragma unroll 1
    for (int set = 0; set < 2; ++set) {
        const int r = 2 * C.wave + set, tq = t0 + r + 16 * n;
        const bf16* qrow = Pb + (size_t)tq * A_IN;
        AttnSt st; attn_init(st);
#pragma unroll 1
        for (int g = 0; g < 3; ++g) {
            const int dil = g == 0 ? 1 : (g == 1 ? 4 : 16), qs = 16 / dil, np = g == 0 ? 12 : (g == 1 ? 6 : 5), head = g * 4 + hh;
            const int tb = t0 + r - 128 * dil;
            int j0 = 0; if (tb < 0) { j0 = (-tb - 31 * dil + 32 * dil - 1) / (32 * dil); if (j0 < 0) j0 = 0; }
            bf16x8 qf[2]; load_qf(qrow + head * 64, C.lane, qf);
            attn_pairs<true>(Pb + RW + head * 64, Pb + 2 * RW + head * 64, A_IN, tb, dil, qs, SEQ - 1, j0, np, qf, bias2 + g * 132, vbuf, C.lane, st);
        }
        attn_store(st, qrow + 2560 + hh * 64, H + ((size_t)(b << 11) + tq) * 512 + hh * 64, C.lane);
        AttnSt sm; attn_init(sm);
        { bf16x8 qf[2]; load_qf(qrow + 2304 + hh * 64, C.lane, qf);
          const bf16* kb = MKV + (size_t)(b * NMEM) * 1024 + hh * 64;
          attn_pairs<false>(kb, kb + 256, 1024, 0, 1, 0, NMEM - 1, 0, 8, qf, nullptr, vbuf, C.lane, sm); }
        attn_store(sm, qrow + 2560 + 256 + hh * 64, H + ((size_t)(b << 11) + tq) * 512 + 256 + hh * 64, C.lane);
    }
}
__device__ __forceinline__ void attn_b_unit(const Ctx& C, const bf16* P, const bf16* MKV, bf16* H, int unit) {
    const int b = unit >> 5, hh = (unit >> 3) & 3, t0 = (unit & 7) * 256;
    LAS unsigned char* vbuf = C.lds + RING_OFF + 4096 + C.wave * VBUF;
    const int n = C.lane & 15;
#pragma unroll 1
    for (int set = 0; set < 2; ++set) {
        const int r = 2 * C.wave + set, tq = t0 + r + 16 * n;
        const bf16* qrow = P + ((size_t)(b << 11) + tq) * B_INP;
        AttnSt sm; attn_init(sm);
        bf16x8 qf[2]; load_qf(qrow + CSH + hh * 64, C.lane, qf);
        const bf16* kb = MKV + (size_t)(b * NMEM) * 1024 + 512 + hh * 64;
        attn_pairs<false>(kb, kb + 256, 1024, 0, 1, 0, NMEM - 1, 0, 8, qf, nullptr, vbuf, C.lane, sm);
        attn_store(sm, qrow + 2688 + RW + hh * 64, H + ((size_t)(b << 11) + tq) * 1024 + RW + hh * 64, C.lane);
    }
}

__device__ __forceinline__ void row_pass(const bf16* hp, const float* xin, float* xout, const float* gpost, bf16* xn, int lane) {
    const GAS v2u* h2 = (const GAS v2u*)hp + lane; const GAS f32x4* xr = (const GAS f32x4*)xin + lane; const GAS f32x4* gp = (const GAS f32x4*)gpost + lane;
    f32x4 h[4], x[4]; float s = 0.f;
#pragma unroll
    for (int j = 0; j < 4; ++j) { const v2u u = h2[64 * j]; h[j] = (f32x4){bflo(u.x), bfhi(u.x), bflo(u.y), bfhi(u.y)}; x[j] = xr[64 * j];
        s += (h[j].x * h[j].x + h[j].y * h[j].y) + (h[j].z * h[j].z + h[j].w * h[j].w); }
    const float r = 1.f / sqrtf(wave_sum(s) * (1.f / DM) + RMS_EPS);
    float s2 = 0.f;
#pragma unroll
    for (int j = 0; j < 4; ++j) { const f32x4 g = gp[64 * j]; x[j] = x[j] + h[j] * r * g; s2 += (x[j].x * x[j].x + x[j].y * x[j].y) + (x[j].z * x[j].z + x[j].w * x[j].w);
        *((GAS f32x4*)xout + lane + 64 * j) = x[j]; }
    if (xn) { const float r2 = 1.f / sqrtf(wave_sum(s2) * (1.f / DM) + RMS_EPS);
        GAS unsigned long long* o8 = (GAS unsigned long long*)xn + lane;
#pragma unroll
        for (int j = 0; j < 4; ++j) o8[64 * j] = (unsigned long long)pk2(x[j].x * r2, x[j].y * r2) | ((unsigned long long)pk2(x[j].z * r2, x[j].w * r2) << 32); }
}

struct ScanP { const bf16 *P, *LORA; bf16* H; float* out; const float *st_wkv, *st_shift, *mu, *w0, *a0, *k_k, *k_a, *r_k, *ln_w, *ln_b; };
__device__ __forceinline__ void scan_unit(const Ctx& C, const ScanP& sp, int u) {
    LAS float* L = (LAS float*)(C.lds + RING_OFF);
    LAS float *LA = L, *LB = L + 4096, *LW = L + 8192, *LK = L + 12288, *LRW = L + 16384, *LV = L + 20480, *LSC = L + 24576, *LY = L + 24576 + 256;
    const bool samp = u >= 96; const int seq = samp ? (u - 96) / 12 : u / 12, h = samp ? (u - 96) % 12 : u % 12;
    const int T = samp ? STOK : SEQ, row0 = samp ? TP + seq * 4 : seq * SEQ;
    int row = C.wave * 8 + (C.lane >> 3), p = C.lane & 7;
    asm volatile("" : "+v"(row), "+v"(p));
    float S[8];
#pragma unroll
    for (int j = 0; j < 8; ++j) S[j] = samp ? sp.st_wkv[((size_t)(seq * 12 + h) * 64 + row) * 64 + p * 8 + j] : 0.f;
#pragma unroll 1
    for (int c0 = 0; c0 < T; c0 += 64) {
        const int n = (T - c0) < 64 ? (T - c0) : 64;
        int tok = C.tid >> 3, part = C.tid & 7;
        asm volatile("" : "+v"(tok), "+v"(part));
        __syncthreads();
        if (tok < n) {
            const int t = c0 + tok, m = row0 + t;
            const bf16* cur = sp.P + (size_t)m * B_INP; const bf16* prv = cur - B_INP; const bf16* lo = sp.LORA + (size_t)m * 1536;
            float xr[8], xk[8], xv[8], kk[8], av[8], dv[8];
            float nrm = 0.f;
#pragma unroll
            for (int j = 0; j < 8; ++j) { const int c = h * 64 + part * 8 + j;
                const float cr = bf2f(cur[c]), ck = bf2f(cur[RW + c]), cv = bf2f(cur[2 * RW + c]);
                float pr = 0.f, pk = 0.f, pv = 0.f;
                if (t > 0) { pr = bf2f(prv[c]); pk = bf2f(prv[RW + c]); pv = bf2f(prv[2 * RW + c]); }
                else if (samp) { const float* ss = sp.st_shift + (size_t)seq * CSH; pr = ss[c]; pk = ss[RW + c]; pv = ss[2 * RW + c]; }
                xr[j] = cr + sp.mu[c] * (pr - cr); xk[j] = ck + sp.mu[RW + c] * (pk - ck); xv[j] = cv + sp.mu[2 * RW + c] * (pv - cv);
                const float dpre = sp.w0[c] + bf2f(lo[c]), apre = sp.a0[c] + bf2f(lo[RW + c]);
                dv[j] = __expf(-0.6065306597f * __builtin_amdgcn_rcpf(1.f + __expf(-dpre)));
                av[j] = __builtin_amdgcn_rcpf(1.f + __expf(-apre));
                kk[j] = xk[j] * sp.k_k[c]; nrm += kk[j] * kk[j]; }
            nrm += __shfl_xor(nrm, 1); nrm += __shfl_xor(nrm, 2); nrm += __shfl_xor(nrm, 4);
            const float inv = 1.f / fmaxf(sqrtf(nrm), 1e-12f);
            float br = 0.f, kr = 0.f, bon = 0.f;
#pragma unroll
            for (int j = 0; j < 8; ++j) { const int c = h * 64 + part * 8 + j, d = part * 8 + j;
                const float kn = kk[j] * inv, k2 = xk[j] * (1.f + (av[j] - 1.f) * sp.k_a[c]);
                const float bb = kn * av[j];
                LA[tok * 64 + d] = -kn; LB[tok * 64 + d] = bb; LW[tok * 64 + d] = dv[j]; LK[tok * 64 + d] = k2; LRW[tok * 64 + d] = xr[j] * dv[j]; LV[tok * 64 + d] = xv[j];
                br += bb * xr[j]; kr += k2 * xr[j]; bon += xr[j] * k2 * sp.r_k[c]; }
            br += __shfl_xor(br, 1); br += __shfl_xor(br, 2); br += __shfl_xor(br, 4);
            kr += __shfl_xor(kr, 1); kr += __shfl_xor(kr, 2); kr += __shfl_xor(kr, 4);
            bon += __shfl_xor(bon, 1); bon += __shfl_xor(bon, 2); bon += __shfl_xor(bon, 4);
            if (part == 0) { LSC[tok * 4 + 0] = br; LSC[tok * 4 + 1] = kr; LSC[tok * 4 + 2] = bon; }
        }
        __syncthreads();
#pragma unroll 1
        for (int i = 0; i < n; ++i) {
            const LAS f32x4* a4 = (const LAS f32x4*)(LA + i * 64 + p * 8); const LAS f32x4* r4 = (const LAS f32x4*)(LRW + i * 64 + p * 8);
            const LAS f32x4* w4 = (const LAS f32x4*)(LW + i * 64 + p * 8); const LAS f32x4* b4 = (const LAS f32x4*)(LB + i * 64 + p * 8); const LAS f32x4* k4 = (const LAS f32x4*)(LK + i * 64 + p * 8);
            const f32x4 a0 = a4[0], a1 = a4[1], r0 = r4[0], r1 = r4[1];
            float sa = (S[0] * a0.x + S[1] * a0.y) + (S[2] * a0.z + S[3] * a0.w) + (S[4] * a1.x + S[5] * a1.y) + (S[6] * a1.z + S[7] * a1.w);
            float yp = (S[0] * r0.x + S[1] * r0.y) + (S[2] * r0.z + S[3] * r0.w) + (S[4] * r1.x + S[5] * r1.y) + (S[6] * r1.z + S[7] * r1.w);
            sa += __shfl_xor(sa, 1); sa += __shfl_xor(sa, 2); sa += __shfl_xor(sa, 4);
            yp += __shfl_xor(yp, 1); yp += __shfl_xor(yp, 2); yp += __shfl_xor(yp, 4);
            const float v = LV[i * 64 + row], br = LSC[i * 4 + 0], kr = LSC[i * 4 + 1];
            const f32x4 w0 = w4[0], w1 = w4[1], b0 = b4[0], b1 = b4[1], k0 = k4[0], k1 = k4[1];
            S[0] = S[0] * w0.x + sa * b0.x + v * k0.x; S[1] = S[1] * w0.y + sa * b0.y + v * k0.y; S[2] = S[2] * w0.z + sa * b0.z + v * k0.z; S[3] = S[3] * w0.w + sa * b0.w + v * k0.w;
            S[4] = S[4] * w1.x + sa * b1.x + v * k1.x; S[5] = S[5] * w1.y + sa * b1.y + v * k1.y; S[6] = S[6] * w1.z + sa * b1.z + v * k1.z; S[7] = S[7] * w1.w + sa * b1.w + v * k1.w;
            if (p == 0) LY[i * 64 + row] = yp + sa * br + v * kr;
        }
        __syncthreads();
        asm volatile("" : "+v"(tok), "+v"(part));
        if (tok < n) {
            const int m = row0 + c0 + tok;
            float y[8]; float s = 0.f;
#pragma unroll
            for (int j = 0; j < 8; ++j) { y[j] = LY[tok * 64 + part * 8 + j]; s += y[j]; }
            s += __shfl_xor(s, 1); s += __shfl_xor(s, 2); s += __shfl_xor(s, 4);
            const float mean = s * (1.f / 64.f); float q = 0.f;
#pragma unroll
            for (int j = 0; j < 8; ++j) { y[j] -= mean; q += y[j] * y[j]; }
            q += __shfl_xor(q, 1); q += __shfl_xor(q, 2); q += __shfl_xor(q, 4);
            const float rstd = 1.f / sqrtf(q * (1.f / 64.f) + GN_EPS), bon = LSC[tok * 4 + 2];
            unsigned w[4];
#pragma unroll
            for (int j = 0; j < 8; j += 2) { float o2[2];
#pragma unroll
                for (int e = 0; e < 2; ++e) { const int c = h * 64 + part * 8 + j + e;
                    const float yy = y[j + e] * rstd * sp.ln_w[c] + sp.ln_b[c] + bon * LV[tok * 64 + part * 8 + j + e];
                    o2[e] = yy * silu(bf2f(sp.P[(size_t)m * B_INP + 2688 + c])); }
                w[j >> 1] = pk2(o2[0], o2[1]); }
            *(GAS v4u*)(sp.H + (size_t)m * 1024 + h * 64 + part * 8) = (v4u){w[0], w[1], w[2], w[3]};
        }
    }
    float* so = sp.out + (samp ? O_WKVS : O_WKVP) + ((size_t)(seq * 12 + h) * 64 + row) * 64 + p * 8;
    *(GAS f32x4*)so = (f32x4){S[0], S[1], S[2], S[3]}; *((GAS f32x4*)so + 1) = (f32x4){S[4], S[5], S[6], S[7]};
    __syncthreads();
}

constexpr int TS = 72;
constexpr int IMG = 64 * TS * 2;
constexpr int L_AT = 0, L_RT = IMG, L_BT = 2 * IMG, L_KT = 3 * IMG, L_VV = 4 * IMG, L_SB = 5 * IMG, L_Z = 6 * IMG, L_SA = 7 * IMG,
              L_NKA = 8 * IMG, L_NBR = 9 * IMG, L_NKR = 10 * IMG, L_TT = 11 * IMG, L_E = 12 * IMG, L_PC = L_E + 16384, L_BON = L_PC + 256, L_SEG = L_BON + 256, L_CH_END = L_SEG + 2048;
constexpr int NSLOT = 7, L_SLOT0 = 3 * IMG + 16384 + 256 + 256 + 2048;
static_assert(L_CH_END <= RING_BYTES && L_SLOT0 + NSLOT * 16384 <= RING_BYTES, "chunk-scan LDS map");
constexpr int LA_AT = 0, LA_BT = IMG, LA_E = 2 * IMG, LA_PC = LA_E + 16384, LA_BON = LA_PC + 256, LA_SEG = LA_BON + 256;

struct ChunkP { const bf16 *P, *LORA; const float *mu, *w0, *a0, *k_k, *k_a, *r_k; };
struct PrepR { float xr[8], xv[8], kn[8], as[8], k2[8], e[8], bon; };
struct PrepL { v4u cr4, ck4, cv4, pr4, pk4, pv4, lw4, la4, g4; };
__device__ __forceinline__ void prep_load(const ChunkP& cp, int m0, int t0tok, int h, int tok, int part, PrepL& L) {
    const int m = m0 + tok; const bool first = (t0tok + tok) == 0;
    const bf16* cur = cp.P + (size_t)m * B_INP + h * 64 + part * 8; const bf16* lo = cp.LORA + (size_t)m * 1536 + h * 64 + part * 8;
    L.cr4 = *(const GAS v4u*)cur; L.ck4 = *(const GAS v4u*)(cur + RW); L.cv4 = *(const GAS v4u*)(cur + 2 * RW);
    L.pr4 = (v4u){0u, 0u, 0u, 0u}; L.pk4 = L.pr4; L.pv4 = L.pr4;
    if (!first) { L.pr4 = *(const GAS v4u*)(cur - B_INP); L.pk4 = *(const GAS v4u*)(cur - B_INP + RW); L.pv4 = *(const GAS v4u*)(cur - B_INP + 2 * RW); }
    L.lw4 = *(const GAS v4u*)lo; L.la4 = *(const GAS v4u*)(lo + RW);
    L.g4 = *(const GAS v4u*)(cur + 2688);
}
__device__ __forceinline__ void prep_step1(const ChunkP& cp, const PrepL& L, int h, int tok, int part, LAS unsigned char* lds, int offE, PrepR& R) {
    float xk[8], kk[8]; float nrm = 0.f;
#pragma unroll
    for (int j = 0; j < 8; ++j) { const int c = h * 64 + part * 8 + j;
        const unsigned ur = L.cr4[j >> 1], uk = L.ck4[j >> 1], uv = L.cv4[j >> 1], upr = L.pr4[j >> 1], upk = L.pk4[j >> 1], upv = L.pv4[j >> 1], ulw = L.lw4[j >> 1], ula = L.la4[j >> 1];
        const float cr = (j & 1) ? bfhi(ur) : bflo(ur), ck = (j & 1) ? bfhi(uk) : bflo(uk), cv = (j & 1) ? bfhi(uv) : bflo(uv);
        const float pr = (j & 1) ? bfhi(upr) : bflo(upr), pk = (j & 1) ? bfhi(upk) : bflo(upk), pv = (j & 1) ? bfhi(upv) : bflo(upv);
        const float lw = (j & 1) ? bfhi(ulw) : bflo(ulw), la = (j & 1) ? bfhi(ula) : bflo(ula);
        R.xr[j] = cr + cp.mu[c] * (pr - cr); xk[j] = ck + cp.mu[RW + c] * (pk - ck); R.xv[j] = cv + cp.mu[2 * RW + c] * (pv - cv);
        const float dpre = cp.w0[c] + lw, apre = cp.a0[c] + la;
        R.e[j] = 0.6065306597f * __builtin_amdgcn_rcpf(1.f + __expf(-dpre));
        R.as[j] = __builtin_amdgcn_rcpf(1.f + __expf(-apre));
        kk[j] = xk[j] * cp.k_k[c]; nrm += kk[j] * kk[j]; }
    nrm += __shfl_xor(nrm, 1); nrm += __shfl_xor(nrm, 2); nrm += __shfl_xor(nrm, 4);
    const float inv = __builtin_amdgcn_rsqf(fmaxf(nrm, 1e-24f));
    float bon = 0.f;
#pragma unroll
    for (int j = 0; j < 8; ++j) { const int c = h * 64 + part * 8 + j; R.kn[j] = kk[j] * inv; R.k2[j] = xk[j] * (1.f + (R.as[j] - 1.f) * cp.k_a[c]); bon += R.xr[j] * R.k2[j] * cp.r_k[c]; }
    bon += __shfl_xor(bon, 1); bon += __shfl_xor(bon, 2); bon += __shfl_xor(bon, 4);
    R.bon = bon;
    LAS float* E = (LAS float*)(lds + offE) + tok * 64 + part * 8;
    *(LAS f32x4*)E = (f32x4){R.e[0], R.e[1], R.e[2], R.e[3]}; *((LAS f32x4*)E + 1) = (f32x4){R.e[4], R.e[5], R.e[6], R.e[7]};
}
__device__ __forceinline__ void prep_cumsum(int tid, LAS unsigned char* lds, int offE, int offSEG) {
    LAS float* E = (LAS float*)(lds + offE); LAS float* SEG = (LAS float*)(lds + offSEG);
    const int d = tid & 63, seg = tid >> 6;
    float v[8]; float run = 0.f;
#pragma unroll
    for (int j = 0; j < 8; ++j) { run += E[(seg * 8 + j) * 64 + d]; v[j] = run; }
    SEG[seg * 64 + d] = run;
    __syncthreads();
    float off = 0.f;
#pragma unroll
    for (int s = 0; s < 7; ++s) off += (s < seg) ? SEG[s * 64 + d] : 0.f;
#pragma unroll
    for (int j = 0; j < 8; ++j) E[(seg * 8 + j) * 64 + d] = v[j] + off;
}
__device__ __forceinline__ void st8bf(LAS unsigned char* lds, int off, int tok, int part, const float (&x)[8]) {
    *(LAS v4u*)(lds + off + (tok * TS + part * 8) * 2) = (v4u){pk2(x[0], x[1]), pk2(x[2], x[3]), pk2(x[4], x[5]), pk2(x[6], x[7])};
}
template <bool FULL>
__device__ __forceinline__ void prep_step3(int tok, int part, LAS unsigned char* lds, int offE, int offAT, int offBT, int offRT, int offKT, int offVV, int offPC, int offBON, const PrepR& R) {
    const LAS float* E = (const LAS float*)(lds + offE) + tok * 64 + part * 8;
    const f32x4 c0 = *(const LAS f32x4*)E, c1 = *((const LAS f32x4*)E + 1);
    float at[8], bt[8], rt[8], kt[8];
#pragma unroll
    for (int j = 0; j < 8; ++j) { const float cum = j < 4 ? c0[j & 3] : c1[j & 3];
        const float pm1 = __expf(R.e[j] - cum), ip = __expf(cum);
        at[j] = -R.kn[j] * pm1; bt[j] = R.kn[j] * R.as[j] * ip;
        if (FULL) { const float pt = __builtin_amdgcn_rcpf(ip); rt[j] = R.xr[j] * pt; kt[j] = R.k2[j] * ip;
            if (tok == 63) ((LAS float*)(lds + offPC))[part * 8 + j] = pt; } }
    st8bf(lds, offAT, tok, part, at); st8bf(lds, offBT, tok, part, bt);
    if (FULL) { st8bf(lds, offRT, tok, part, rt); st8bf(lds, offKT, tok, part, kt); st8bf(lds, offVV, tok, part, R.xv);
        if (part == 0) ((LAS float*)(lds + offBON))[tok] = R.bon; }
}
__device__ __forceinline__ bf16x8 frag_nat(const LAS unsigned char* img, int R0, int ks, int lane) {
    return __builtin_bit_cast(bf16x8, *(const LAS v4u*)(img + ((R0 + (lane & 15)) * TS + 32 * ks + 8 * (lane >> 4)) * 2));
}
__device__ __forceinline__ bf16x8 frag_tr(const LAS unsigned char* img, int I0, int ks, int lane) {
    const int i16 = lane & 15, quad = lane >> 4;
    const unsigned a = (unsigned)(size_t)img + (unsigned)(((32 * ks + 8 * quad + (i16 >> 2)) * TS + I0 + 4 * (i16 & 3)) * 2);
    const s16x4 lo = tr_read<0>(a), hi = tr_read<4 * TS * 2>(a);
    asm volatile("s_waitcnt lgkmcnt(0)" ::: "memory"); __builtin_amdgcn_sched_barrier(0);
    return (bf16x8){lo[0], lo[1], lo[2], lo[3], hi[0], hi[1], hi[2], hi[3]};
}
#define MFMA16(a, b, c) __builtin_amdgcn_mfma_f32_16x16x32_bf16((a), (b), (c), 0, 0, 0)
__device__ __forceinline__ void st_tile_T(LAS unsigned char* img, int C0, int R0, int lane, f32x4 v) {
    *(LAS v2u*)(img + ((C0 + (lane & 15)) * TS + R0 + 4 * (lane >> 4)) * 2) = (v2u){pk2(v[0], v[1]), pk2(v[2], v[3])};
}

__device__ __forceinline__ void scan_stage_a(const Ctx& C, const ChunkP& cp, bf16* TT, int task0, int ntask) {
    LAS unsigned char* lds = C.lds + RING_OFF;
    const int tok = C.tid >> 3, part = C.tid & 7, vs = C.wave & 3, rh = C.wave >> 2;
#pragma unroll 1
    for (int base = 0; base < ntask; base += NSLOT) {
        const int nr = (ntask - base) < NSLOT ? (ntask - base) : NSLOT;
#pragma unroll 1
        for (int s = 0; s < nr; ++s) {
            const int task = task0 + base + s, bh = task >> 5, c = task & 31, b = bh / 12, h = bh % 12;
            PrepR R; PrepL L; prep_load(cp, b * SEQ + c * 64, c * 64, h, tok, part, L);
            __syncthreads();
            prep_step1(cp, L, h, tok, part, lds, LA_E, R);
            __syncthreads();
            prep_cumsum(C.tid, lds, LA_E, LA_SEG);
            __syncthreads();
            prep_step3<false>(tok, part, lds, LA_E, LA_AT, LA_BT, 0, 0, 0, 0, 0, R);
            __syncthreads();
            LAS float* slot = (LAS float*)(lds + L_SLOT0 + s * 16384);
            const bf16x8 b0 = frag_nat(lds + LA_AT, 16 * vs, 0, C.lane), b1 = frag_nat(lds + LA_AT, 16 * vs, 1, C.lane);
#pragma unroll
            for (int q = 0; q < 2; ++q) { const int it = 2 * rh + q;
                f32x4 acc = {0.f, 0.f, 0.f, 0.f};
                acc = MFMA16(frag_nat(lds + LA_BT, 16 * it, 0, C.lane), b0, acc); acc = MFMA16(frag_nat(lds + LA_BT, 16 * it, 1, C.lane), b1, acc);
                const int t = 16 * vs + (C.lane & 15), i0 = 16 * it + 4 * (C.lane >> 4);
                f32x4 o; o[0] = (i0 + 0 < t) ? acc[0] : 0.f; o[1] = (i0 + 1 < t) ? acc[1] : 0.f; o[2] = (i0 + 2 < t) ? acc[2] : 0.f; o[3] = (i0 + 3 < t) ? acc[3] : 0.f;
                *(LAS f32x4*)(slot + t * 64 + i0) = o; }
        }
        __syncthreads();
        if (C.wave < nr) {
            const LAS float* Nl = (const LAS float*)(lds + L_SLOT0 + C.wave * 16384);
            float Tr[64];
#pragma unroll
            for (int t = 0; t < 64; ++t) { float acc = (C.lane == t) ? 1.f : 0.f;
#pragma unroll
                for (int i = 0; i < t; ++i) acc += Tr[i] * Nl[t * 64 + i];
                Tr[t] = acc; }
            bf16* o = TT + (size_t)(task0 + base + C.wave) * 4096 + C.lane;
#pragma unroll
            for (int t = 0; t < 64; ++t) o[t * 64] = (bf16)f2bf(Tr[t]);
        }
    }
    __syncthreads();
}

struct ScanBP { ChunkP cp; const bf16* TT; bf16* H; float* out; const float *ln_w, *ln_b; };
constexpr int L_Y = L_E, L_SB2 = L_CH_END, L_PRM = L_SB2 + IMG, L_B_END = L_PRM + 2560;
static_assert(L_B_END <= RING_BYTES, "stage B LDS map");
__device__ __forceinline__ void ld8(const LAS float* p, float (&x)[8]) { const f32x4 a = *(const LAS f32x4*)p, b = *((const LAS f32x4*)p + 1);
    x[0] = a[0]; x[1] = a[1]; x[2] = a[2]; x[3] = a[3]; x[4] = b[0]; x[5] = b[1]; x[6] = b[2]; x[7] = b[3]; }
__device__ __forceinline__ void scan_stage_b(const Ctx& C, const ScanBP& sb, int bh) {
    LAS unsigned char* lds = C.lds + RING_OFF;
    const int b = bh / 12, h = bh % 12;
    const int tok = C.tid >> 3, part = C.tid & 7, tl = C.lane >> 3, vs = C.wave & 3, rh = C.wave >> 2, l15 = C.lane & 15, quad = C.lane >> 4;
    f32x4 St[2] = {{0.f, 0.f, 0.f, 0.f}, {0.f, 0.f, 0.f, 0.f}};
    __syncthreads();
    for (int i = C.tid; i < IMG / 4; i += NWAVES * 64) ((LAS unsigned*)(lds + L_SB))[i] = 0u;
    { LAS float* prm = (LAS float*)(lds + L_PRM);
      for (int i = C.tid; i < 640; i += NWAVES * 64) { const int a = i >> 6, d = i & 63, c = h * 64 + d;
          const float* src = a == 0 ? sb.cp.mu + c : a == 1 ? sb.cp.mu + RW + c : a == 2 ? sb.cp.mu + 2 * RW + c : a == 3 ? sb.cp.w0 + c : a == 4 ? sb.cp.a0 + c : a == 5 ? sb.cp.k_k + c :
                             a == 6 ? sb.cp.k_a + c : a == 7 ? sb.cp.r_k + c : a == 8 ? sb.ln_w + c : sb.ln_b + c;
          prm[i] = *src; } }
    PrepL Ln; prep_load(sb.cp, b * SEQ, 0, h, tok, part, Ln);
    v4u ttn = *((const GAS v4u*)(sb.TT + (size_t)(bh * 32) * 4096) + C.tid);
    float xvp[8] = {0.f, 0.f, 0.f, 0.f, 0.f, 0.f, 0.f, 0.f}; float bonp = 0.f; v4u g4p = {0u, 0u, 0u, 0u};
    __syncthreads();
    const LAS float* prm = (const LAS float*)(lds + L_PRM) + part * 8;
#pragma unroll 1
    for (int c = 0; c <= 32; ++c) {
        const int m0 = b * SEQ + c * 64;
        if (c > 0) { const int m = m0 - 64 + tok; float y[8]; ld8((const LAS float*)(lds + L_Y) + tok * 64 + part * 8, y); float s = 0.f;
#pragma unroll
            for (int j = 0; j < 8; ++j) s += y[j];
            s += __shfl_xor(s, 1); s += __shfl_xor(s, 2); s += __shfl_xor(s, 4);
            const float mean = s * (1.f / 64.f); float qq = 0.f;
#pragma unroll
            for (int j = 0; j < 8; ++j) { y[j] -= mean; qq += y[j] * y[j]; }
            qq += __shfl_xor(qq, 1); qq += __shfl_xor(qq, 2); qq += __shfl_xor(qq, 4);
            const float rstd = __builtin_amdgcn_rsqf(qq * (1.f / 64.f) + GN_EPS);
            float lw[8], lb[8]; ld8(prm + 8 * 64, lw); ld8(prm + 9 * 64, lb);
            float o[8];
#pragma unroll
            for (int j = 0; j < 8; ++j) { const unsigned ug = g4p[j >> 1]; const float g = (j & 1) ? bfhi(ug) : bflo(ug);
                o[j] = (y[j] * rstd * lw[j] + lb[j] + bonp * xvp[j]) * silu(g); }
            *(GAS v4u*)(sb.H + (size_t)m * 1024 + h * 64 + part * 8) = (v4u){pk2(o[0], o[1]), pk2(o[2], o[3]), pk2(o[4], o[5]), pk2(o[6], o[7])};
        }
        if (c == 32) break;
        float xr[8], xk[8], xv[8], kn[8], as[8], k2[8], e[8], cum[8]; float bon;
        {   float mr[8], mk[8], mv[8], w0[8], a0[8], kkp[8], kap[8], rkp[8];
            ld8(prm, mr); ld8(prm + 64, mk); ld8(prm + 128, mv); ld8(prm + 192, w0); ld8(prm + 256, a0); ld8(prm + 320, kkp); ld8(prm + 384, kap); ld8(prm + 448, rkp);
            float kk[8]; float nrm = 0.f;
#pragma unroll
            for (int j = 0; j < 8; ++j) {
                const unsigned ur = Ln.cr4[j >> 1], uk = Ln.ck4[j >> 1], uv = Ln.cv4[j >> 1], upr = Ln.pr4[j >> 1], upk = Ln.pk4[j >> 1], upv = Ln.pv4[j >> 1], ulw = Ln.lw4[j >> 1], ula = Ln.la4[j >> 1];
                const float cr = (j & 1) ? bfhi(ur) : bflo(ur), ck = (j & 1) ? bfhi(uk) : bflo(uk), cv = (j & 1) ? bfhi(uv) : bflo(uv);
                const float pr = (j & 1) ? bfhi(upr) : bflo(upr), pk = (j & 1) ? bfhi(upk) : bflo(upk), pv = (j & 1) ? bfhi(upv) : bflo(upv);
                const float lw = (j & 1) ? bfhi(ulw) : bflo(ulw), la = (j & 1) ? bfhi(ula) : bflo(ula);
                xr[j] = cr + mr[j] * (pr - cr); xk[j] = ck + mk[j] * (pk - ck); xv[j] = cv + mv[j] * (pv - cv);
                e[j] = 0.6065306597f * __builtin_amdgcn_rcpf(1.f + __expf(-(w0[j] + lw)));
                as[j] = __builtin_amdgcn_rcpf(1.f + __expf(-(a0[j] + la)));
                kk[j] = xk[j] * kkp[j]; nrm += kk[j] * kk[j]; }
            nrm += __shfl_xor(nrm, 1); nrm += __shfl_xor(nrm, 2); nrm += __shfl_xor(nrm, 4);
            const float inv = __builtin_amdgcn_rsqf(fmaxf(nrm, 1e-24f));
            bon = 0.f;
#pragma unroll
            for (int j = 0; j < 8; ++j) { kn[j] = kk[j] * inv; k2[j] = xk[j] * (1.f + (as[j] - 1.f) * kap[j]); bon += xr[j] * k2[j] * rkp[j]; }
            bon += __shfl_xor(bon, 1); bon += __shfl_xor(bon, 2); bon += __shfl_xor(bon, 4);
#pragma unroll
            for (int j = 0; j < 8; ++j) { float x = e[j]; float y = __shfl_up(x, 8); if (tl >= 1) x += y; y = __shfl_up(x, 16); if (tl >= 2) x += y; y = __shfl_up(x, 32); if (tl >= 4) x += y; cum[j] = x; }
            if (tl == 7) { LAS float* sg = (LAS float*)(lds + L_SEG) + C.wave * 64 + part * 8;
                *(LAS f32x4*)sg = (f32x4){cum[0], cum[1], cum[2], cum[3]}; *((LAS f32x4*)sg + 1) = (f32x4){cum[4], cum[5], cum[6], cum[7]}; }
        }
        const v4u g4 = Ln.g4;
        *(LAS v4u*)(lds + L_TT + ((C.tid >> 3) * TS + (C.tid & 7) * 8) * 2) = ttn;
        __syncthreads();
        {   float off[8] = {0.f, 0.f, 0.f, 0.f, 0.f, 0.f, 0.f, 0.f};
            for (int w = 0; w < C.wave; ++w) { float t8[8]; ld8((const LAS float*)(lds + L_SEG) + w * 64 + part * 8, t8);
#pragma unroll
                for (int j = 0; j < 8; ++j) off[j] += t8[j]; }
            float at[8], bt[8], rt[8], kt[8];
#pragma unroll
            for (int j = 0; j < 8; ++j) { const float cm = cum[j] + off[j]; const float pm1 = __expf(e[j] - cm), ip = __expf(cm), pt = __builtin_amdgcn_rcpf(ip);
                at[j] = -kn[j] * pm1; bt[j] = kn[j] * as[j] * ip; rt[j] = xr[j] * pt; kt[j] = k2[j] * ip;
                if (tok == 63) ((LAS float*)(lds + L_PC))[part * 8 + j] = pt; }
            st8bf(lds, L_AT, tok, part, at); st8bf(lds, L_BT, tok, part, bt); st8bf(lds, L_RT, tok, part, rt); st8bf(lds, L_KT, tok, part, kt); st8bf(lds, L_VV, tok, part, xv);
        }
        if (c < 31) { prep_load(sb.cp, m0 + 64, c * 64 + 64, h, tok, part, Ln); ttn = *((const GAS v4u*)(sb.TT + (size_t)(bh * 32 + c + 1) * 4096) + C.tid); }
        __syncthreads();
        {   const bf16x8 a0 = frag_nat(lds + L_AT, 16 * vs, 0, C.lane), a1 = frag_nat(lds + L_AT, 16 * vs, 1, C.lane);
            const bf16x8 r0 = frag_nat(lds + L_RT, 16 * vs, 0, C.lane), r1 = frag_nat(lds + L_RT, 16 * vs, 1, C.lane);
#pragma unroll
            for (int q = 0; q < 2; ++q) { const int it = 2 * rh + q;
                const bf16x8 k0 = frag_nat(lds + L_KT, 16 * it, 0, C.lane), k1 = frag_nat(lds + L_KT, 16 * it, 1, C.lane);
                const bf16x8 bb0 = frag_nat(lds + L_BT, 16 * it, 0, C.lane), bb1 = frag_nat(lds + L_BT, 16 * it, 1, C.lane);
                f32x4 nka = {0.f, 0.f, 0.f, 0.f}, nbr = nka, nkr = nka;
                nka = MFMA16(k0, a0, nka); nka = MFMA16(k1, a1, nka);
                nbr = MFMA16(bb0, r0, nbr); nbr = MFMA16(bb1, r1, nbr);
                nkr = MFMA16(k0, r0, nkr); nkr = MFMA16(k1, r1, nkr);
                const int t = 16 * vs + l15, i0 = 16 * it + 4 * quad;
#pragma unroll
                for (int ee = 0; ee < 4; ++ee) { if (!(i0 + ee < t)) nka[ee] = 0.f; if (!(i0 + ee <= t)) { nbr[ee] = 0.f; nkr[ee] = 0.f; } }
                st_tile_T(lds + L_NKA, 16 * vs, 16 * it, C.lane, nka); st_tile_T(lds + L_NBR, 16 * vs, 16 * it, C.lane, nbr); st_tile_T(lds + L_NKR, 16 * vs, 16 * it, C.lane, nkr); }
        }
        __syncthreads();
        const int sbc = (c & 1) ? L_SB2 : L_SB, sbn = (c & 1) ? L_SB : L_SB2;
        bf16x8 v0, v1;
        {   const unsigned av = (unsigned)(size_t)(lds + L_VV) + (unsigned)(((8 * quad + (l15 >> 2)) * TS + 16 * vs + 4 * (l15 & 3)) * 2);
            const s16x4 p0 = tr_read<0>(av), p1 = tr_read<4 * TS * 2>(av), p2 = tr_read<32 * TS * 2>(av), p3 = tr_read<36 * TS * 2>(av);
            asm volatile("s_waitcnt lgkmcnt(0)" ::: "memory"); __builtin_amdgcn_sched_barrier(0);
            v0 = (bf16x8){p0[0], p0[1], p0[2], p0[3], p1[0], p1[1], p1[2], p1[3]}; v1 = (bf16x8){p2[0], p2[1], p2[2], p2[3], p3[0], p3[1], p3[2], p3[3]}; }
        {   const bf16x8 s0 = frag_nat(lds + sbc, 16 * vs, 0, C.lane), s1 = frag_nat(lds + sbc, 16 * vs, 1, C.lane);
#pragma unroll
            for (int q = 0; q < 2; ++q) { const int tt = 2 * rh + q; f32x4 z = {0.f, 0.f, 0.f, 0.f};
                z = MFMA16(frag_nat(lds + L_AT, 16 * tt, 0, C.lane), s0, z); z = MFMA16(frag_nat(lds + L_AT, 16 * tt, 1, C.lane), s1, z);
                z = MFMA16(frag_nat(lds + L_NKA, 16 * tt, 0, C.lane), v0, z); z = MFMA16(frag_nat(lds + L_NKA, 16 * tt, 1, C.lane), v1, z);
                st_tile_T(lds + L_Z, 16 * vs, 16 * tt, C.lane, z); }
        }
        __syncthreads();
        {   const bf16x8 z0 = frag_nat(lds + L_Z, 16 * vs, 0, C.lane), z1 = frag_nat(lds + L_Z, 16 * vs, 1, C.lane);
#pragma unroll
            for (int q = 0; q < 2; ++q) { const int tt = 2 * rh + q; f32x4 sa = {0.f, 0.f, 0.f, 0.f};
                sa = MFMA16(frag_nat(lds + L_TT, 16 * tt, 0, C.lane), z0, sa); sa = MFMA16(frag_nat(lds + L_TT, 16 * tt, 1, C.lane), z1, sa);
                st_tile_T(lds + L_SA, 16 * vs, 16 * tt, C.lane, sa); }
        }
        bf16x8 tb[2][2], tk[2][2];
        {   s16x4 pb[2][2][2], pk[2][2][2];
#pragma unroll
            for (int q = 0; q < 2; ++q) { const int kt0 = 16 * (2 * rh + q);
                const unsigned ab = (unsigned)(size_t)(lds + L_BT) + (unsigned)(((8 * quad + (l15 >> 2)) * TS + kt0 + 4 * (l15 & 3)) * 2);
                const unsigned ak = (unsigned)(size_t)(lds + L_KT) + (unsigned)(((8 * quad + (l15 >> 2)) * TS + kt0 + 4 * (l15 & 3)) * 2);
                pb[q][0][0] = tr_read<0>(ab); pb[q][0][1] = tr_read<4 * TS * 2>(ab); pb[q][1][0] = tr_read<32 * TS * 2>(ab); pb[q][1][1] = tr_read<36 * TS * 2>(ab);
                pk[q][0][0] = tr_read<0>(ak); pk[q][0][1] = tr_read<4 * TS * 2>(ak); pk[q][1][0] = tr_read<32 * TS * 2>(ak); pk[q][1][1] = tr_read<36 * TS * 2>(ak); }
            asm volatile("s_waitcnt lgkmcnt(0)" ::: "memory"); __builtin_amdgcn_sched_barrier(0);
#pragma unroll
            for (int q = 0; q < 2; ++q)
#pragma unroll
                for (int ks = 0; ks < 2; ++ks) {
                    tb[q][ks] = (bf16x8){pb[q][ks][0][0], pb[q][ks][0][1], pb[q][ks][0][2], pb[q][ks][0][3], pb[q][ks][1][0], pb[q][ks][1][1], pb[q][ks][1][2], pb[q][ks][1][3]};
                    tk[q][ks] = (bf16x8){pk[q][ks][0][0], pk[q][ks][0][1], pk[q][ks][0][2], pk[q][ks][0][3], pk[q][ks][1][0], pk[q][ks][1][1], pk[q][ks][1][2], pk[q][ks][1][3]}; }
        }
        __syncthreads();
        {   const bf16x8 s0 = frag_nat(lds + sbc, 16 * vs, 0, C.lane), s1 = frag_nat(lds + sbc, 16 * vs, 1, C.lane);
            const bf16x8 sa0 = frag_nat(lds + L_SA, 16 * vs, 0, C.lane), sa1 = frag_nat(lds + L_SA, 16 * vs, 1, C.lane);
            LAS float* Y = (LAS float*)(lds + L_Y);
#pragma unroll
            for (int q = 0; q < 2; ++q) { const int tt = 2 * rh + q; f32x4 yy = {0.f, 0.f, 0.f, 0.f};
                yy = MFMA16(frag_nat(lds + L_RT, 16 * tt, 0, C.lane), s0, yy); yy = MFMA16(frag_nat(lds + L_RT, 16 * tt, 1, C.lane), s1, yy);
                yy = MFMA16(frag_nat(lds + L_NBR, 16 * tt, 0, C.lane), sa0, yy); yy = MFMA16(frag_nat(lds + L_NBR, 16 * tt, 1, C.lane), sa1, yy);
                yy = MFMA16(frag_nat(lds + L_NKR, 16 * tt, 0, C.lane), v0, yy); yy = MFMA16(frag_nat(lds + L_NKR, 16 * tt, 1, C.lane), v1, yy);
                f32x4 dd = {0.f, 0.f, 0.f, 0.f};
                dd = MFMA16(tb[q][0], sa0, dd); dd = MFMA16(tb[q][1], sa1, dd); dd = MFMA16(tk[q][0], v0, dd); dd = MFMA16(tk[q][1], v1, dd);
                const int r0 = 16 * tt + 4 * quad, v = 16 * vs + l15;
#pragma unroll
                for (int ee = 0; ee < 4; ++ee) Y[(r0 + ee) * 64 + v] = yy[ee];
                const f32x4 pc = *(const LAS f32x4*)(lds + L_PC + r0 * 4);
                St[q] = (St[q] + dd) * pc;
                st_tile_T(lds + sbn, 16 * vs, 16 * tt, C.lane, St[q]); }
        }
#pragma unroll
        for (int j = 0; j < 8; ++j) xvp[j] = xv[j];
        bonp = bon; g4p = g4;
        __syncthreads();
    }
#pragma unroll
    for (int q = 0; q < 2; ++q) { float* so = sb.out + O_WKVP + ((size_t)bh * 64 + 16 * vs + l15) * 64 + 16 * (2 * rh + q) + 4 * quad; *(GAS f32x4*)so = St[q]; }
    __syncthreads();
}

constexpr int PTAB_OFF = LDSCTL_OFF + 512;
__device__ __forceinline__ const float* inptr(LAS unsigned char* ldsb, int i) {
    const LAS unsigned* p = (const LAS unsigned*)(ldsb + PTAB_OFF) + 2 * i;
    const unsigned lo = __builtin_amdgcn_readfirstlane(p[0]), hi = __builtin_amdgcn_readfirstlane(p[1]);
    return (const float*)(((unsigned long long)hi << 32) | lo);
}
struct Args { const float* in[28]; float* out; unsigned char* ws; int ph_lo, ph_hi; };
#define WSP(T, off) ((T*)(args.ws + (off)))
#define GEMM_BF16(Aptr, Bptr, Optr, Mv, Nv, Kv) do { pg8::Gemm g{Aptr, Bptr, Mv, Nv, Kv}; pg8::StaticOrder S; S.init(Mv, Nv, C.G, (int)blockIdx.x); \
        pg8::EpiBf16<0> E{Optr, Nv, nullptr, 0, 0, 1.f}; pg8::gemm_phase<pg8::EpiBf16<0>, pg8::StaticOrder, PG8_ALIGN, PG8_SP2>(C.lds + RING_OFF, g, S, E); } while (0)
__global__ void __launch_bounds__(NWAVES * 64, 2) hyb_fwd(Args args) {
    extern __shared__ __attribute__((aligned(16))) unsigned char lds[];
    LAS unsigned char* const ldsb = (LAS unsigned char*)lds;
    for (int u = threadIdx.x; u < (LDS_BYTES - LDSCTL_OFF) / 4; u += NWAVES * 64) ((LAS unsigned*)(ldsb + LDSCTL_OFF))[u] = 0u;
    __syncthreads();
    if (threadIdx.x < 28) ((LAS unsigned long long*)(ldsb + PTAB_OFF))[threadIdx.x] = (unsigned long long)args.in[threadIdx.x];
    __syncthreads();
#define INP(i) inptr(ldsb, (i))
#define MKCTX() Ctx C; { int t_ = threadIdx.x; asm volatile("" : "+v"(t_)); C.lds = ldsb; C.tid = t_; C.lane = t_ & 63; C.wave = __builtin_amdgcn_readfirstlane(t_ >> 6); \
        C.G = gridDim.x; const int bx_ = blockIdx.x; C.vcu = (C.G % 8 == 0) ? (bx_ % 8) * (C.G / 8) + bx_ / 8 : bx_; C.gw = C.vcu * NWAVES + C.wave; C.NGW = C.G * NWAVES; } \
        const int gt = C.gw * 64 + C.lane, NGT = C.NGW * 64; (void)gt; (void)NGT
    const int lo = args.ph_lo, hi = args.ph_hi;
    const bool fused = (hi - lo) > 1;
    XcdBarrier bar; bar.bar = WSP(unsigned, WS_CTL) + CW_BAR; bar.x = 0; bar.st = nullptr;
    if (fused) bar = xcd_barrier_post(WSP(unsigned, WS_CTL) + CW_BAR, (volatile LAS unsigned*)(ldsb + MISC_OFF) + 8);
#ifndef PROBE_PHASE
#define PROBE_PHASE -1
#endif
#ifndef PROBE_SUB
#define PROBE_SUB 0
#endif
#define IN(k) (lo <= (k) && (k) < hi)
#define REP(k) for (int rep_ = 0; rep_ < ((k) == PROBE_PHASE ? 2 : 1); ++rep_)
#define SEAM(k) do { if (IN(k) && IN((k) + 1)) xcd_barrier(bar); } while (0)

    if (IN(0)) REP(0) { MKCTX();
        LAS float* scr = (LAS float*)(C.lds + RING_OFF + C.wave * 16384);
        constexpr int I0 = 16 * 96, I1 = 8 * 32, I2 = 16 * 116, I3 = 16 * 32, I4 = 16 * 16, I5 = 16 * 16, I6 = 24, I7 = 24;
        constexpr int NITEMS = I0 + I1 + I2 + I3 + I4 + I5 + I6 + I7;
        for (int it = C.gw; it < NITEMS; it += C.NGW) {
            int r = it;
            if (r < I0) { p0_transpose_item(INP(14), A_IN, INP(9), WSP(bf16, WS_WAIN), 1024, 0, 0, scr, r, 96, C.lane); continue; } r -= I0;
            if (r < I1) { p0_transpose_item(INP(15), 1024, nullptr, WSP(bf16, WS_WAOUT), 512, 0, 0, scr, r, 32, C.lane); continue; } r -= I1;
            if (r < I2) { p0_transpose_item(INP(16), B_IN, INP(9) + DM, WSP(bf16, WS_WBIN), 1024, 0, 0, scr, r, 116, C.lane); continue; } r -= I2;
            if (r < I3) { p0_transpose_item(INP(17), 1024, nullptr, WSP(bf16, WS_WBOUT), 1024, 0, 0, scr, r, 32, C.lane); continue; } r -= I3;
            if (r < I4) { p0_transpose_item(INP(12), 512, INP(11), WSP(bf16, WS_WM), 1024, 0, 0, scr, r, 16, C.lane); continue; } r -= I4;
            if (r < I5) { p0_transpose_item(INP(12) + 1024 * 512, 512, INP(11) + DM, WSP(bf16, WS_WM), 1024, 0, 512, scr, r, 16, C.lane); continue; } r -= I5;
            if (r < I6) { p0_transpose_item(INP(20), RW, nullptr, WSP(bf16, WS_WL), 128, 0, 0, scr, r, 24, C.lane); continue; } r -= I6;
            p0_transpose_item(INP(22), RW, nullptr, WSP(bf16, WS_WL), 128, 64, RW, scr, r, 24, C.lane);
        }
        const v4u z4 = {0u, 0u, 0u, 0u};
        for (int i = gt; i < 16384; i += NGT) *((GAS v4u*)(WSP(bf16, WS_WBIN) + (size_t)B_IN * 1024) + i) = z4;
        for (int i = gt; i < 1536 * 8; i += NGT) { const int n = i >> 3, c = i & 7; *(GAS v4u*)(WSP(bf16, WS_WL) + (size_t)n * 128 + (n < RW ? 64 : 0) + c * 8) = z4; }
        for (int i = gt; i < 128 * 128; i += NGT) *((GAS v4u*)(WSP(bf16, WS_XN) + (size_t)NREAL * 1024) + i) = z4;
        for (int i = gt; i < 3 * 4 * 129; i += NGT) { const int g = i / (4 * 129), r = i % (4 * 129), hh = r / 129, k = r % 129; const int dil = g == 0 ? 1 : (g == 1 ? 4 : 16);
            WSP(float, WS_BT)[(g * 4 + hh) * 132 + k] = INP(13)[t5_bucket(dil * k) * 12 + g * 4 + hh]; }
        for (int m = C.gw; m < NREAL + 2048; m += C.NGW) {
            if (m < TP) rms_row_to_bf16(INP(0) + (size_t)m * DM, WSP(bf16, WS_XN) + (size_t)m * DM, C.lane);
            else if (m < NREAL) rms_row_to_bf16(INP(1) + (size_t)(m - TP) * DM, WSP(bf16, WS_XN) + (size_t)m * DM, C.lane);
            else rms_row_to_bf16(INP(2) + (size_t)(m - NREAL) * DM, WSP(bf16, WS_MEMN) + (size_t)(m - NREAL) * DM, C.lane);
        }
    } SEAM(0);
    if (IN(1)) REP(1) { MKCTX();
        GEMM_BF16(WSP(bf16, WS_XN), WSP(bf16, WS_WAIN), WSP(bf16, WS_P), MROWS, A_IN, DM);
        GEMM_BF16(WSP(bf16, WS_MEMN), WSP(bf16, WS_WM), WSP(bf16, WS_MKV), 2048, 1024, DM);
    } SEAM(1);
    if (IN(2)) REP(2) { MKCTX();
        const bf16* P = WSP(bf16, WS_P); const bf16* MKV = WSP(bf16, WS_MKV); float* out = args.out;
        for (int rp_ = 0; rp_ < (PROBE_SUB == 23 ? 2 : 1); ++rp_) {
        for (int i = gt; i < 2 * 2048 * 512; i += NGT) { const int l = i / (2048 * 512), r = (i / 512) % 2048, c = i % 512; out[O_MEM + i] = bf2f(MKV[(size_t)r * 1024 + l * 512 + c]); }
#pragma unroll
        for (int g = 0; g < 3; ++g) { const int Wg = g == 0 ? 128 : (g == 1 ? 512 : 2048); const size_t ob = g == 0 ? O_W0P : (g == 1 ? O_W1P : O_W2P);
            const int n = NBATCH * Wg * 512;
            for (int i = gt; i < n; i += NGT) { const int c = i % 512, ri = (i / 512) % Wg, b = i / (512 * Wg); const int t = SEQ - Wg + ri, kv = c >> 8, cc = c & 255;
                out[ob + i] = bf2f(P[(size_t)((b << 11) + t) * A_IN + RW + kv * RW + g * 256 + cc]); }
            const size_t os = g == 0 ? O_W0S : (g == 1 ? O_W1S : O_W2S);
            for (int i = gt; i < NSAMP * 512; i += NGT) { const int c = i % 512, r = i / 512, kv = c >> 8, cc = c & 255;
                out[os + i] = bf2f(P[(size_t)(TP + r) * A_IN + RW + kv * RW + g * 256 + cc]); } }
        }
        bf16* H = WSP(bf16, WS_H); const float* BT = WSP(float, WS_BT);
        for (int rp_ = 0; rp_ < (PROBE_SUB == 21 ? 2 : 1); ++rp_)
        for (int unit = blockIdx.x; unit < 256; unit += C.G) attn_a_unit(C, P, MKV, H, BT, unit);
        { LAS float* mg = (LAS float*)(C.lds + RING_OFF + 65536);
          for (int rp_ = 0; rp_ < (PROBE_SUB == 22 ? 2 : 1); ++rp_)
          for (int base = 0; base < NSAMP * 16; base += C.NGW) { const int task = base + C.gw; const bool on = task < NSAMP * 16;
            const int tq = task >> 2, part = task & 3, m = TP + (tq >> 2), hh = tq & 3;
            float Mo = 0.f, So = 1.f, Oo = 0.f;
            if (on) samp_part(P, BT, part == 0 ? INP(4) : (part == 1 ? INP(5) : INP(6)), MKV, INP(3), m, hh, part, 0, P + (size_t)m * A_IN + 2304 + hh * 64, C.lane, Mo, So, Oo);
            __syncthreads();
            mg[C.wave * 66 + C.lane] = Oo; if (C.lane == 0) { mg[C.wave * 66 + 64] = Mo; mg[C.wave * 66 + 65] = So; }
            __syncthreads();
            if (on && (part == 0 || part == 3)) { const bf16* prow = P + (size_t)m * A_IN; float o;
                if (part == 0) { const LAS float* w0 = mg + C.wave * 66; const float M0 = w0[64], M1 = w0[66 + 64], M2 = w0[132 + 64];
                    const float M = fmaxf(fmaxf(M0, M1), M2), e0 = __expf(M0 - M), e1 = __expf(M1 - M), e2 = __expf(M2 - M);
                    const float S = w0[65] * e0 + w0[66 + 65] * e1 + w0[132 + 65] * e2;
                    o = (w0[C.lane] * e0 + w0[66 + C.lane] * e1 + w0[132 + C.lane] * e2) / S;
                    H[(size_t)m * 512 + hh * 64 + C.lane] = (bf16)f2bf(o * silu(bf2f(prow[2560 + hh * 64 + C.lane]))); }
                else { o = Oo / So; H[(size_t)m * 512 + 256 + hh * 64 + C.lane] = (bf16)f2bf(o * silu(bf2f(prow[2560 + 256 + hh * 64 + C.lane]))); } }
          } }
    } SEAM(2);
    if (IN(3)) REP(3) { MKCTX(); GEMM_BF16(WSP(bf16, WS_H), WSP(bf16, WS_WAOUT), WSP(bf16, WS_F), MROWS, DM, 512); } SEAM(3);
    if (IN(4)) REP(4) { MKCTX();
        for (int m = C.gw; m < NREAL; m += C.NGW) { const bool samp = m >= TP;
            row_pass(WSP(bf16, WS_F) + (size_t)m * DM, samp ? INP(1) + (size_t)(m - TP) * DM : INP(0) + (size_t)m * DM,
                     args.out + (samp ? O_YS + (size_t)(m - TP) * DM : O_YP + (size_t)m * DM), INP(10), WSP(bf16, WS_XN) + (size_t)m * DM, C.lane); }
    } SEAM(4);
    if (IN(5)) REP(5) { MKCTX(); GEMM_BF16(WSP(bf16, WS_XN), WSP(bf16, WS_WBIN), WSP(bf16, WS_P), MROWS, B_INP, DM); } SEAM(5);
    if (IN(6)) REP(6) { MKCTX();
        const bf16* P = WSP(bf16, WS_P); bf16* TW = WSP(bf16, WS_TW); const float* mu = INP(18); const float* stsh = INP(8);
        for (int m = C.gw; m < NREAL; m += C.NGW) {
            const bool samp = m >= TP; const int t = samp ? ((m - TP) & 3) : (m & 2047), sb = (m - TP) >> 2;
#pragma unroll
            for (int j = 0; j < 2; ++j) { const int c = 2304 + j * 64 + C.lane;
                const float cur = bf2f(P[(size_t)m * B_INP + c]);
                float prev = 0.f; if (t > 0) prev = bf2f(P[(size_t)(m - 1) * B_INP + c]); else if (samp) prev = stsh[(size_t)sb * CSH + c];
                const float xs = cur + mu[c] * (prev - cur);
                TW[(size_t)m * 128 + j * 64 + C.lane] = (bf16)f2bf(j == 0 ? tanhf(xs) : xs); }
        }
    } SEAM(6);
    if (IN(7)) REP(7) { MKCTX(); GEMM_BF16(WSP(bf16, WS_TW), WSP(bf16, WS_WL), WSP(bf16, WS_F), MROWS, 1536, 128); } SEAM(7);
    if (IN(8)) REP(8) { MKCTX();
        ChunkP cp{WSP(bf16, WS_P), WSP(bf16, WS_F), INP(18), INP(19), INP(21), INP(23), INP(24), INP(25)};
        const int per = (3072 + C.G - 1) / C.G, task0 = (int)blockIdx.x * per; int nt = 3072 - task0; if (nt > per) nt = per;
        if (nt > 0) scan_stage_a(C, cp, WSP(bf16, WS_XN), task0, nt);
    } SEAM(8);
    if (IN(9)) REP(9) { MKCTX();
        const bf16* P = WSP(bf16, WS_P); bf16* H = WSP(bf16, WS_H);
        const int GB = C.G > 96 ? 96 : C.G, vb = (int)blockIdx.x;
        if (vb < GB) {
            ScanBP sb{{WSP(bf16, WS_P), WSP(bf16, WS_F), INP(18), INP(19), INP(21), INP(23), INP(24), INP(25)}, WSP(bf16, WS_XN), WSP(bf16, WS_H), args.out, INP(26), INP(27)};
            for (int rp = 0; rp < (PROBE_SUB == 1 ? 2 : 1); ++rp)
            for (int bh = vb; bh < 96; bh += GB) scan_stage_b(C, sb, bh);
        }
        const int GO = C.G > 96 ? C.G - 96 : C.G, ob = C.G > 96 ? vb - 96 : vb;
        if (ob >= 0) for (int rp = 0; rp < (PROBE_SUB == 2 ? 2 : 1); ++rp) {
            for (int unit = ob; unit < 256; unit += GO) attn_b_unit(C, P, WSP(bf16, WS_MKV), H, unit);
            __syncthreads();
            { ScanP sp{WSP(bf16, WS_P), WSP(bf16, WS_F), WSP(bf16, WS_H), args.out, INP(7), INP(8), INP(18), INP(19), INP(21), INP(23), INP(24), INP(25), INP(26), INP(27)};
              for (int u = 96 + ob; u < 480; u += GO) scan_unit(C, sp, u); }
            const int ogw = ob * NWAVES + C.wave, ONGW = GO * NWAVES, ogt = ogw * 64 + C.lane, ONGT = ONGW * 64;
            for (int task = ogw; task < NSAMP * 4; task += ONGW) { const int m = TP + (task >> 2), hh = task & 3;
                const bf16* prow = P + (size_t)m * B_INP;
                float Mo, So, Oo; samp_part(P, nullptr, nullptr, nullptr, INP(3), m, hh, 3, 1, prow + CSH + hh * 64, C.lane, Mo, So, Oo); const float om = Oo / So;
                H[(size_t)m * 1024 + RW + hh * 64 + C.lane] = (bf16)f2bf(om * silu(bf2f(prow[2688 + RW + hh * 64 + C.lane]))); }
            for (int i = ogt; i < NBATCH * CSH; i += ONGT) { const int b = i / CSH, c = i % CSH; args.out[O_SHP + i] = bf2f(P[(size_t)(b * SEQ + SEQ - 1) * B_INP + c]); }
            for (int i = ogt; i < SBATCH * CSH; i += ONGT) { const int sb = i / CSH, c = i % CSH; args.out[O_SHS + i] = bf2f(P[(size_t)(TP + sb * 4 + 3) * B_INP + c]); }
        }
    } SEAM(9);
    if (IN(10)) REP(10) { MKCTX(); GEMM_BF16(WSP(bf16, WS_H), WSP(bf16, WS_WBOUT), WSP(bf16, WS_F), MROWS, DM, DM); } SEAM(10);
    if (IN(11)) { MKCTX();
        for (int m = C.gw; m < NREAL; m += C.NGW) { const bool samp = m >= TP;
            float* xo = args.out + (samp ? O_YS + (size_t)(m - TP) * DM : O_YP + (size_t)m * DM);
            row_pass(WSP(bf16, WS_F) + (size_t)m * DM, xo, xo, INP(10) + DM, nullptr, C.lane); }
    }
#undef IN
#undef SEAM
}

extern "C" void kernel_launch(void* const* d_in, const int* in_sizes, int n_in, void* d_out, int out_size, void* d_ws, size_t ws_size, hipStream_t stream) {
    static int grid = 0;
    if (grid == 0) {
        if (n_in != 28 || in_sizes[0] != TP * DM || (size_t)out_size != O_END || ws_size < WS_END) {
            fprintf(stderr, "kernel_launch: unexpected shapes: n_in %d in0 %d out %d ws %zu (need >= %zu); nothing launched\n", n_in, n_in > 0 ? in_sizes[0] : -1, out_size, ws_size, (size_t)WS_END); grid = -1; return; }
        int dev = 0, cus = 0, per_cu = 0;
        if (hipGetDevice(&dev) != hipSuccess || hipDeviceGetAttribute(&cus, hipDeviceAttributeMultiprocessorCount, dev) != hipSuccess) { fprintf(stderr, "kernel_launch: device query failed\n"); grid = -1; return; }
        if (hipFuncSetAttribute((const void*)hyb_fwd, hipFuncAttributeMaxDynamicSharedMemorySize, LDS_BYTES) != hipSuccess) { fprintf(stderr, "kernel_launch: hipFuncSetAttribute failed\n"); grid = -1; return; }
        if (hipOccupancyMaxActiveBlocksPerMultiprocessor(&per_cu, (const void*)hyb_fwd, NWAVES * 64, LDS_BYTES) != hipSuccess || per_cu < 1) {
            fprintf(stderr, "kernel_launch: occupancy query reports %d workgroups per CU\n", per_cu); }
        (void)hipGetLastError();
        grid = cus;
    }
    if (grid < 0) return;
    if (hipMemsetAsync((char*)d_ws + WS_CTL, 0, CTL_ZERO_BYTES, stream) != hipSuccess) { fprintf(stderr, "kernel_launch: memset failed\n"); return; }
    Args a{};
    for (int i = 0; i < 28; ++i) a.in[i] = (const float*)d_in[i];
    a.out = (float*)d_out; a.ws = (unsigned char*)d_ws;
#if MK_N_LAUNCHES == 1
    a.ph_lo = 0; a.ph_hi = N_PHASES;
    hipLaunchKernelGGL(hyb_fwd, dim3(grid), dim3(NWAVES * 64), LDS_BYTES, stream, a);
#else
    for (int li = 0; li < N_PHASES; ++li) { a.ph_lo = li; a.ph_hi = li + 1;
        hipLaunchKernelGGL(hyb_fwd, dim3(grid), dim3(NWAVES * 64), LDS_BYTES, stream, a); }
#endif
    const hipError_t le = hipPeekAtLastError();
    if (le != hipSuccess) fprintf(stderr, "kernel_launch: launch failed: %s\n", hipGetErrorName(le));
}
```

```cpp
#include <hip/hip_runtime.h>
#include <cstdio>
#include <cstdint>
namespace pg8 {
#define PG8_LAS __attribute__((address_space(3)))
typedef unsigned short bf16_t;
typedef short bf16x8 __attribute__((ext_vector_type(8)));
typedef float f32x4 __attribute__((ext_vector_type(4)));
typedef unsigned u32x4 __attribute__((ext_vector_type(4)));
constexpr int BM = 256, BK = 64, HALF = 128, HTB = HALF * BK * 2  , STAGE_BYTES = 8 * HTB, NXCD = 8, WGM = 8;

__host__ __device__ __forceinline__ int lds_byte(int r, int c) { const int st = (r >> 4) * 2 + (c >> 5), rr = r & 15, cc = c & 31, ob = rr * 64 + cc * 2; return st * 1024 + (ob ^ (((ob >> 9) & 1) << 5)); }
__host__ __device__ __forceinline__ void stage_rc(int b, int& R, int& C) { const int st = b / 1024, sb = b % 1024, swz = sb ^ (((sb >> 9) & 1) << 5); R = (st >> 1) * 16 + swz / 64; C = (st & 1) * 32 + (swz % 64) / 2; }
__host__ __device__ __forceinline__ int perm32(int rho) { const int n = rho >> 4, i = rho & 15; return 8 * (i >> 2) + 4 * n + (i & 3); }

struct Unit { int pm, pn; };
struct Gemm { const bf16_t* A; const bf16_t* Bt; int M, N, K; };

struct StaticOrder {
    int nM, nN, nwg, G, c;
    __host__ __device__ void init(int M, int N, int G_, int c_) { nM = M / BM; nN = N / BM; nwg = nM * nN; G = G_; c = c_; }
    __host__ __device__ bool next(int i, Unit& u) const {
        const long L = (long)i * G + c; if (L >= nwg) return false;
        int wgid = (int)L; { const int q = nwg / NXCD, r = nwg % NXCD, xcd = wgid % NXCD, off = wgid / NXCD; wgid = (xcd < r ? xcd * (q + 1) : r * (q + 1) + (xcd - r) * q) + off; }
        const int nig = WGM * nN, gid = wgid / nig, fm = gid * WGM, gsz = (nM - fm) < WGM ? (nM - fm) : WGM;
        u.pm = fm + ((wgid % nig) % gsz); u.pn = (wgid % nig) / gsz; return true;
    }
    __device__ __forceinline__ void a_ready(const Unit&) const {}
    __device__ __forceinline__ void done(const Unit&) const {}
};

__device__ __forceinline__ unsigned cvt_pk_bf16(float lo, float hi) { unsigned r; asm volatile("v_cvt_pk_bf16_f32 %0, %1, %2" : "=v"(r) : "v"(lo), "v"(hi)); return r; }
typedef float f32x2 __attribute__((ext_vector_type(2)));
__device__ __forceinline__ f32x2 gelu_pk(f32x2 v) {
    const f32x2 av = __builtin_elementwise_abs(v), d = av * 0.2316418882f + 1.0f;
    f32x2 t; t.x = __builtin_amdgcn_rcpf(d.x); t.y = __builtin_amdgcn_rcpf(d.y);
    f32x2 q = t * 0.5307027145f + (-0.7265760135f); q = q * t + 0.7107068705f; q = q * t + (-0.142248368f); q = q * t + 0.127414796f; q = q * t;
    const f32x2 s = (v * v) * (-0.72134752044f);
    f32x2 e; e.x = __builtin_amdgcn_exp2f(s.x); e.y = __builtin_amdgcn_exp2f(s.y);
    const f32x2 m = v * (q * e), r = v - m;
    f32x2 o; o.x = v.x < 0.f ? m.x : r.x; o.y = v.y < 0.f ? m.y : r.y; return o;
}

template <int ACT  > struct EpiBf16 {
    static constexpr bool PERM = true, AFTER_DRAIN = false; static_assert(ACT == 0 || ACT == 1, "EpiBf16: ACT is 0 (none) or 1 (gelu_pk)");
    bf16_t* O; int ldc; const float* bias; int split_cols; size_t split_stride; float scale0;
    __device__ __forceinline__ void operator()(const f32x4 (&acc)[2][2][4][2], const Unit& u, int wr, int wc, int fr, int fq) const {
        const int row0 = u.pm * BM + wr * 64 + fr; int colt = u.pn * BM; bf16_t* base = O;
        float sc = 1.f; if (split_cols) { const int t = colt / split_cols; base += (size_t)t * split_stride; colt -= t * split_cols; if (t == 0) sc = scale0; }
        const int col0 = colt + wc * 32 + 8 * fq, bcol0 = u.pn * BM + wc * 32 + 8 * fq;
        f32x4 bv[2][2];
#pragma unroll
        for (int bj = 0; bj < 2; ++bj)
#pragma unroll
            for (int n = 0; n < 2; ++n) bv[bj][n] = bias ? *(const f32x4*)(bias + bcol0 + bj * HALF + 4 * n) : (f32x4){0.f, 0.f, 0.f, 0.f};
#pragma unroll
        for (int ai = 0; ai < 2; ++ai)
#pragma unroll
            for (int m = 0; m < 4; ++m) { bf16_t* rowp = base + (size_t)(row0 + ai * HALF + m * 16) * ldc + col0;
#pragma unroll
                for (int bj = 0; bj < 2; ++bj) { f32x4 v0 = acc[ai][bj][m][0] + bv[bj][0], v1 = acc[ai][bj][m][1] + bv[bj][1];
                    if (ACT == 1) { f32x2 a = gelu_pk((f32x2){v0[0], v0[1]}), b = gelu_pk((f32x2){v0[2], v0[3]}), c = gelu_pk((f32x2){v1[0], v1[1]}), d = gelu_pk((f32x2){v1[2], v1[3]});
                        v0 = (f32x4){a.x, a.y, b.x, b.y}; v1 = (f32x4){c.x, c.y, d.x, d.y}; }
                    v0 = v0 * sc; v1 = v1 * sc; u32x4 w; w.x = cvt_pk_bf16(v0[0], v0[1]); w.y = cvt_pk_bf16(v0[2], v0[3]); w.z = cvt_pk_bf16(v1[0], v1[1]); w.w = cvt_pk_bf16(v1[2], v1[3]);
                    *(u32x4*)(rowp + bj * HALF) = w; } }
    }
};
template <class Epi, class Sched, bool ALIGN_EPI = false, bool SP2 = false>
__device__ __forceinline__ void gemm_phase(PG8_LAS unsigned char* lds, const Gemm g, const Sched& S, const Epi& E) {
    const int tid = threadIdx.x, wid = __builtin_amdgcn_readfirstlane(tid >> 6), lane = tid & 63, wr = wid >> 2, wc = wid & 3, fr = lane & 15, fq = lane >> 4;
    const int K = g.K, nt = K / BK;
    unsigned voffA[2], voffB[2];
#pragma unroll
    for (int i = 0; i < 2; ++i) { int R, C; stage_rc(tid * 16 + i * 8192, R, C); const int Rb = Epi::PERM ? ((R & ~31) + perm32(R & 31)) : R;
        voffA[i] = (unsigned)(R * K + C) * 2u; voffB[i] = (unsigned)(Rb * K + C) * 2u; }
    const size_t kstep = (size_t)(BK * 2);
    const size_t hstep = (size_t)HALF * K * 2;
    const size_t tstep = 2 * hstep;
    const unsigned ldsw = (unsigned)wid * 1024u;
    const int aoff = lds_byte(wr * 64 + fr, fq * 8), boff = lds_byte(wc * 32 + fr, fq * 8);
#define PG8_SA(b, h) (((b) * 2 + (h)) * HTB)
#define PG8_SB(b, h) ((4 + (b) * 2 + (h)) * HTB)
#define PG8_STAGE(bufoff, gbase, voff) do { _Pragma("unroll") for (int _i = 0; _i < 2; ++_i) \
        __builtin_amdgcn_global_load_lds((const unsigned*)((const char*)(gbase) + (voff)[_i]), (PG8_LAS unsigned*)(lds + (bufoff) + ldsw + _i * 8192), 16, 0, 0); } while (0)
#define PG8_LDA(dst, b, h) do { _Pragma("unroll") for (int m = 0; m < 4; ++m) _Pragma("unroll") for (int k = 0; k < 2; ++k) dst[m][k] = *(const PG8_LAS bf16x8*)(lds + PG8_SA(b, h) + aoff + m * 2048 + k * 1024); } while (0)
#define PG8_LDB(dst, b, h) do { _Pragma("unroll") for (int n = 0; n < 2; ++n) _Pragma("unroll") for (int k = 0; k < 2; ++k) dst[n][k] = *(const PG8_LAS bf16x8*)(lds + PG8_SB(b, h) + boff + n * 2048 + k * 1024); } while (0)
#define PG8_MMA(ai, bj, At, Bt) do { __builtin_amdgcn_s_setprio(1); _Pragma("unroll") for (int m = 0; m < 4; ++m) _Pragma("unroll") for (int n = 0; n < 2; ++n) _Pragma("unroll") for (int k = 0; k < 2; ++k) \
        acc[ai][bj][m][n] = __builtin_amdgcn_mfma_f32_16x16x32_bf16(Bt[n][k], At[m][k], acc[ai][bj][m][n], 0, 0, 0); __builtin_amdgcn_s_setprio(0); } while (0)
#define PG8_WAIT_V(n) asm volatile("s_waitcnt vmcnt(" #n ")" ::: "memory")
#define PG8_WAIT_L(n) asm volatile("s_waitcnt lgkmcnt(" #n ")" ::: "memory")
#define PG8_BAR __builtin_amdgcn_s_barrier()
#define PG8_SCHED __builtin_amdgcn_sched_barrier(0)
    Unit cur, nxt; int ui = 0;
    if (!S.next(0, cur)) return;
    f32x4 acc[2][2][4][2];
#pragma unroll
    for (int a = 0; a < 2; ++a)
#pragma unroll
        for (int b = 0; b < 2; ++b)
#pragma unroll
            for (int m = 0; m < 4; ++m)
#pragma unroll
                for (int n = 0; n < 2; ++n) acc[a][b][m][n] = (f32x4){0.f, 0.f, 0.f, 0.f};
    bf16x8 At[4][2], B0[2][2], B1[2][2];
    const char* cA = (const char*)g.A + (size_t)cur.pm * tstep; const char* cB = (const char*)g.Bt + (size_t)cur.pn * tstep;
    S.a_ready(cur);
    if constexpr (SP2) {
        PG8_STAGE(PG8_SB(0, 0), cB, voffB); PG8_STAGE(PG8_SB(0, 1), cB + hstep, voffB); PG8_STAGE(PG8_SA(0, 0), cA, voffA); PG8_STAGE(PG8_SA(0, 1), cA + hstep, voffA);
        if (wr == 1) PG8_BAR;
        PG8_WAIT_V(2); PG8_BAR;
        PG8_STAGE(PG8_SB(1, 0), cB + kstep, voffB); PG8_STAGE(PG8_SA(1, 0), cA + kstep, voffA); PG8_STAGE(PG8_SB(1, 1), cB + hstep + kstep, voffB);
        PG8_WAIT_V(6); PG8_BAR;
    } else {
        PG8_STAGE(PG8_SB(0, 0), cB, voffB); PG8_STAGE(PG8_SA(0, 0), cA, voffA); PG8_STAGE(PG8_SB(0, 1), cB + hstep, voffB); PG8_STAGE(PG8_SA(0, 1), cA + hstep, voffA);
        if (wr == 1) PG8_BAR;
        PG8_WAIT_V(4); PG8_BAR;
        PG8_STAGE(PG8_SB(1, 0), cB + kstep, voffB); PG8_STAGE(PG8_SA(1, 0), cA + kstep, voffA); PG8_STAGE(PG8_SB(1, 1), cB + hstep + kstep, voffB);
        PG8_WAIT_V(6); PG8_BAR;
    }
    for (;;) {
        const bool has_next = S.next(ui + 1, nxt);
        const char* nA = has_next ? (const char*)g.A + (size_t)nxt.pm * tstep : cA; const char* nB = has_next ? (const char*)g.Bt + (size_t)nxt.pn * tstep : cB;
        for (int t = 0; t < nt; t += 2) {
            const bool last = (t == nt - 2);
            const char* a1 = cA + (size_t)(t + 1) * kstep;
            const char* a2 = last ? nA : cA + (size_t)(t + 2) * kstep; const char* b2 = last ? nB : cB + (size_t)(t + 2) * kstep;
            const char* a3 = a2 + kstep; const char* b3 = b2 + kstep;
            if (last && has_next) S.a_ready(nxt);
            if constexpr (SP2) {
            PG8_LDB(B0, 0, 0); PG8_LDB(B1, 0, 1); PG8_SCHED; PG8_LDA(At, 0, 0); PG8_STAGE(PG8_SA(1, 1), a1 + hstep, voffA);
            PG8_WAIT_V(8); PG8_WAIT_L(0); PG8_BAR; PG8_MMA(0, 0, At, B0); PG8_MMA(0, 1, At, B1); PG8_BAR; PG8_SCHED;
            PG8_LDA(At, 0, 1); PG8_STAGE(PG8_SB(0, 0), b2, voffB); PG8_STAGE(PG8_SB(0, 1), b2 + hstep, voffB); PG8_STAGE(PG8_SA(0, 0), a2, voffA);
            PG8_WAIT_V(8); PG8_WAIT_L(0); PG8_BAR; PG8_MMA(1, 0, At, B0); PG8_MMA(1, 1, At, B1); PG8_BAR; PG8_SCHED;
            PG8_LDB(B0, 1, 0); PG8_LDB(B1, 1, 1); PG8_SCHED; PG8_LDA(At, 1, 0); PG8_STAGE(PG8_SA(0, 1), a2 + hstep, voffA);
            PG8_WAIT_V(8); PG8_WAIT_L(0); PG8_BAR; PG8_MMA(0, 0, At, B0); PG8_MMA(0, 1, At, B1); PG8_BAR; PG8_SCHED;
            PG8_LDA(At, 1, 1); PG8_STAGE(PG8_SB(1, 0), b3, voffB); PG8_STAGE(PG8_SB(1, 1), b3 + hstep, voffB); PG8_STAGE(PG8_SA(1, 0), a3, voffA);
            PG8_WAIT_V(8); PG8_WAIT_L(0); PG8_BAR; PG8_MMA(1, 0, At, B0); PG8_MMA(1, 1, At, B1); PG8_BAR; PG8_SCHED;
            } else {
            PG8_LDB(B0, 0, 0); PG8_SCHED; PG8_LDA(At, 0, 0); PG8_STAGE(PG8_SA(1, 1), a1 + hstep, voffA);
            PG8_WAIT_L(8); PG8_BAR; PG8_WAIT_L(0); PG8_MMA(0, 0, At, B0); PG8_BAR; PG8_SCHED;
            PG8_LDB(B1, 0, 1); PG8_STAGE(PG8_SB(0, 0), b2, voffB);
            PG8_BAR; PG8_WAIT_L(0); PG8_MMA(0, 1, At, B1); PG8_BAR;
            PG8_LDA(At, 0, 1); PG8_STAGE(PG8_SA(0, 0), a2, voffA);
            PG8_BAR; PG8_WAIT_L(0); PG8_MMA(1, 0, At, B0); PG8_BAR; PG8_SCHED;
            PG8_STAGE(PG8_SB(0, 1), b2 + hstep, voffB);
            PG8_WAIT_V(6); PG8_BAR; PG8_MMA(1, 1, At, B1); PG8_BAR;
            PG8_LDB(B0, 1, 0); PG8_SCHED; PG8_LDA(At, 1, 0); PG8_STAGE(PG8_SA(0, 1), a2 + hstep, voffA);
            PG8_WAIT_L(8); PG8_BAR; PG8_WAIT_L(0); PG8_MMA(0, 0, At, B0); PG8_BAR; PG8_SCHED;
            PG8_LDB(B1, 1, 1); PG8_STAGE(PG8_SB(1, 0), b3, voffB);
            PG8_BAR; PG8_WAIT_L(0); PG8_MMA(0, 1, At, B1); PG8_BAR;
            PG8_LDA(At, 1, 1); PG8_STAGE(PG8_SA(1, 0), a3, voffA);
            PG8_BAR; PG8_WAIT_L(0); PG8_MMA(1, 0, At, B0); PG8_BAR; PG8_SCHED;
            PG8_STAGE(PG8_SB(1, 1), b3 + hstep, voffB);
            PG8_WAIT_V(6); PG8_BAR; PG8_MMA(1, 1, At, B1); PG8_BAR;
            }
        }
        if constexpr (ALIGN_EPI) { if (wr == 0) PG8_BAR; }
        if constexpr (!Epi::AFTER_DRAIN) { E(acc, cur, wr, wc, fr, fq); S.done(cur); }
        if (!has_next) break;
#pragma unroll
        for (int a = 0; a < 2; ++a)
#pragma unroll
            for (int b = 0; b < 2; ++b)
#pragma unroll
                for (int m = 0; m < 4; ++m)
#pragma unroll
                    for (int n = 0; n < 2; ++n) acc[a][b][m][n] = (f32x4){0.f, 0.f, 0.f, 0.f};
        cur = nxt; cA = nA; cB = nB; ++ui;
        if constexpr (ALIGN_EPI) { if (wr == 1) PG8_BAR; }
    }
    PG8_WAIT_V(0);
    if constexpr (!ALIGN_EPI) { if (wr == 0) PG8_BAR; }
    PG8_BAR;
    if constexpr (Epi::AFTER_DRAIN) { E.fused(acc, cur, wr, wc, fr, fq, lds, wid, lane); S.done(cur); }
#undef PG8_SA
#undef PG8_SB
#undef PG8_STAGE
#undef PG8_LDA
#undef PG8_LDB
#undef PG8_MMA
#undef PG8_WAIT_V
#undef PG8_WAIT_L
#undef PG8_BAR
#undef PG8_SCHED
}
}

#ifndef PG8_SP2
#define PG8_SP2 true
#endif
#ifndef PG8_ALIGN
#define PG8_ALIGN true
#endif

constexpr int NWAVES = 8;
#ifndef MK_N_LAUNCHES
#define MK_N_LAUNCHES 1
#endif
constexpr int N_PHASES = 12;
constexpr int TP = 16384, NSAMP = 128, NREAL = TP + NSAMP, MROWS = 16640, DM = 1024;
constexpr int SEQ = 2048, NBATCH = 8, SBATCH = 32, STOK = 4, NMEM = 256;
constexpr int A_IN = 3072, B_IN = 3712, B_INP = 3840, CSH = 2432, RW = 768;
constexpr float RMS_EPS = 1e-6f, GN_EPS = 64e-5f;
constexpr size_t O_YP = 0, O_YS = 16777216, O_MEM = 16908288, O_W0P = 19005440, O_W1P = 19529728, O_W2P = 21626880,
                 O_W0S = 30015488, O_W1S = 30081024, O_W2S = 30146560, O_WKVP = 30212096, O_WKVS = 30605312, O_SHP = 32178176, O_SHS = 32197632, O_END = 32275456;
constexpr size_t MiB = 1u << 20;
constexpr size_t WS_CTL = 0, CTL_ZERO_BYTES = 1 * MiB;
constexpr size_t WS_WAIN = 1 * MiB, WS_WAOUT = 7 * MiB, WS_WBIN = 8 * MiB, WS_WBOUT = 16 * MiB, WS_WM = 18 * MiB, WS_WL = 20 * MiB, WS_BT = 20 * MiB + 512 * 1024;
constexpr size_t WS_MEMN = 21 * MiB, WS_MKV = 25 * MiB, WS_TW = 29 * MiB, WS_XN = 34 * MiB, WS_H = 67 * MiB, WS_F = 100 * MiB, WS_P = 149 * MiB, WS_END = 271 * MiB;
constexpr int CW_TMO = 0, CW_BAR = 4096;

constexpr int RING_OFF = 0, RING_BYTES = 161792;
constexpr int LDSCTL_OFF = RING_BYTES, MISC_OFF = LDSCTL_OFF + 320;
constexpr int LDS_BYTES = 163840;

#define GAS __attribute__((address_space(1)))
#define LAS __attribute__((address_space(3)))
typedef unsigned short bf16;
typedef unsigned v4u __attribute__((ext_vector_type(4)));
typedef unsigned v2u __attribute__((ext_vector_type(2)));
typedef float f32x4 __attribute__((ext_vector_type(4)));
typedef GAS unsigned gu32;
#define RLX_AGENT __ATOMIC_RELAXED, __HIP_MEMORY_SCOPE_AGENT
#define LDS_WAIT() asm volatile("s_waitcnt lgkmcnt(0)" ::: "memory")
#define VM_WAIT() asm volatile("s_waitcnt vmcnt(0)" ::: "memory")
__device__ __forceinline__ unsigned f2bf(float f) { unsigned u = __builtin_bit_cast(unsigned, f); return (u + 0x7fffu + ((u >> 16) & 1u)) >> 16; }
typedef float f32x2_t __attribute__((ext_vector_type(2))); typedef __bf16 bf16x2_t __attribute__((ext_vector_type(2)));
__device__ __forceinline__ unsigned pk2(float lo, float hi) { const f32x2_t v = {lo, hi}; const bf16x2_t b = __builtin_convertvector(v, bf16x2_t); return __builtin_bit_cast(unsigned, b); }
__device__ __forceinline__ float bflo(unsigned u) { return __builtin_bit_cast(float, u << 16); }
__device__ __forceinline__ float bfhi(unsigned u) { return __builtin_bit_cast(float, u & 0xffff0000u); }
__device__ __forceinline__ float bf2f(bf16 h) { return __builtin_bit_cast(float, (unsigned)h << 16); }

#define XB_TMO      128
#define XB_XCNT(j)  (256  + 64 * (j))
#define XB_XSUB(j)  (1280 + 64 * (j))
#define XB_XGEN(j)  (2304 + 64 * (j))
#define XB_TOP      3328
#define XB_TOPGEN   3392
#define XCD_BAR_WORDS 3456
#define XB_SPIN_CAP (1u << 20)
__device__ __forceinline__ unsigned xb_ld(unsigned* p)              { return __hip_atomic_load(p, __ATOMIC_RELAXED, __HIP_MEMORY_SCOPE_AGENT); }
__device__ __forceinline__ unsigned xb_add(unsigned* p, unsigned v) { return __hip_atomic_fetch_add(p, v, __ATOMIC_RELAXED, __HIP_MEMORY_SCOPE_AGENT); }
__device__ __forceinline__ unsigned xb_xcc_id() { return (unsigned)__builtin_amdgcn_s_getreg((3 << 11) | 20) & 0xFu; }
#define XB_SPIN(cond, bar) do { unsigned _sp = 0; while (cond) { __builtin_amdgcn_s_sleep(1); \
    if ((++_sp & 255u) == 0u) { if (xb_ld(&(bar)[XB_TMO])) break; if (_sp > XB_SPIN_CAP) { atomicAdd(&(bar)[XB_TMO], 1u); break; } } } } while (0)
struct XcdBarrier { unsigned* bar; unsigned x; volatile LAS unsigned* st; };
__device__ __forceinline__ XcdBarrier xcd_barrier_post(unsigned* bar, volatile LAS unsigned* st) {
    XcdBarrier b; b.bar = bar; b.x = xb_xcc_id(); b.st = st;
    if (threadIdx.x == 0) (void)xb_add(&bar[XB_XCNT(b.x)], 1u);
    return b;
}
__device__ __forceinline__ void xcd_barrier_complete(unsigned* bar, unsigned x, unsigned& nloc, unsigned& nx) {
    const unsigned G = gridDim.x * gridDim.y * gridDim.z;
    unsigned sum, cnt, mine, sp = 0u;
    for (;;) {
        sum = 0u; cnt = 0u; mine = 0u;
#pragma unroll
        for (unsigned j = 0; j < 16; ++j) { const unsigned c = xb_ld(&bar[XB_XCNT(j)]); sum += c; cnt += (c > 0u) ? 1u : 0u; mine = (j == x) ? c : mine; }
        if (sum == G) break;
        __builtin_amdgcn_s_sleep(1);
        if ((++sp & 255u) == 0u) { if (xb_ld(&bar[XB_TMO])) break; if (sp > XB_SPIN_CAP) { atomicAdd(&bar[XB_TMO], 1u); break; } }
    }
    nloc = mine > 0u ? mine : 1u; nx = cnt > 0u ? cnt : 1u;
}
__device__ __forceinline__ void xcd_barrier(const XcdBarrier& b) {
    asm volatile("s_waitcnt vmcnt(0)" ::: "memory");
    __syncthreads();
    if (threadIdx.x == 0) {
        unsigned* bar = b.bar;
        __builtin_amdgcn_s_waitcnt(0);
        unsigned nloc = b.st[0], nx = b.st[1];
        if (nloc == 0u) { xcd_barrier_complete(bar, b.x, nloc, nx); b.st[0] = nloc; b.st[1] = nx; }
        const unsigned old = xb_add(&bar[XB_XSUB(b.x)], 1u);
        const unsigned gen = old / nloc;
        if (old + 1u == (gen + 1u) * nloc) {
            __builtin_amdgcn_fence(__ATOMIC_RELEASE, "agent");
            asm volatile("s_waitcnt vmcnt(0)" ::: "memory");
            const unsigned og = xb_add(&bar[XB_TOP], 1u);
            const unsigned tg = og / nx;
            if (og + 1u == (tg + 1u) * nx) xb_add(&bar[XB_TOPGEN], 1u);
            else XB_SPIN(xb_ld(&bar[XB_TOPGEN]) == tg, bar);
            __builtin_amdgcn_fence(__ATOMIC_ACQUIRE, "agent");
            xb_add(&bar[XB_XGEN(b.x)], 1u);
            asm volatile("s_waitcnt vmcnt(0)" ::: "memory");
        } else {
            XB_SPIN(xb_ld(&bar[XB_XGEN(b.x)]) == gen, bar);
            __builtin_amdgcn_fence(__ATOMIC_ACQUIRE, "agent");
            asm volatile("s_waitcnt vmcnt(0)" ::: "memory");
        }
    }
    __syncthreads();
}

struct Ctx { LAS unsigned char* lds; int tid, lane, wave, vcu, G, gw, NGW; };

__device__ __forceinline__ float wave_sum(float v) {
#pragma unroll
    for (int o = 1; o < 64; o <<= 1) v += __shfl_xor(v, o);
    return v;
}
__device__ __forceinline__ float wave_max(float v) {
#pragma unroll
    for (int o = 1; o < 64; o <<= 1) v = fmaxf(v, __shfl_xor(v, o));
    return v;
}
__device__ __forceinline__ float rdlane(float v, int l) { return __builtin_bit_cast(float, __builtin_amdgcn_readlane(__builtin_bit_cast(int, v), l)); }

__device__ __forceinline__ void p0_transpose_item(const float* W, int N, const float* gain, bf16* WT, int ldo, int col_off, int row_off, LAS float* scr, int item, int nblk, int lane) {
    const int kb = item / nblk, nb = item % nblk, k0 = 64 * kb, n0 = 32 * nb;
#pragma unroll 8
    for (int i = 0; i < 32; ++i) { const int kk = 2 * i + (lane >> 5); const float g = gain ? gain[k0 + kk] : 1.f; scr[kk * 33 + (lane & 31)] = W[(size_t)(k0 + kk) * N + n0 + (lane & 31)] * g; }
    LDS_WAIT(); asm volatile("" ::: "memory");
    const int c = lane & 7;
#pragma unroll
    for (int j = 0; j < 4; ++j) { const int n = (lane >> 3) + 8 * j; const LAS float* s = scr + (8 * c) * 33 + n;
        v4u o; o.x = pk2(s[0 * 33], s[1 * 33]); o.y = pk2(s[2 * 33], s[3 * 33]); o.z = pk2(s[4 * 33], s[5 * 33]); o.w = pk2(s[6 * 33], s[7 * 33]);
        *(GAS v4u*)(WT + (size_t)(row_off + n0 + n) * ldo + col_off + k0 + 8 * c) = o; }
    LDS_WAIT(); asm volatile("" ::: "memory");
}
__device__ __forceinline__ void rms_row_to_bf16(const float* xrow, bf16* orow, int lane) {
    const GAS f32x4* xr = (const GAS f32x4*)xrow + lane;
    f32x4 v[4]; float s = 0.f;
#pragma unroll
    for (int j = 0; j < 4; ++j) { v[j] = xr[64 * j]; s += (v[j].x * v[j].x + v[j].y * v[j].y) + (v[j].z * v[j].z + v[j].w * v[j].w); }
    const float r = 1.f / sqrtf(wave_sum(s) * (1.f / DM) + RMS_EPS);
    GAS unsigned long long* o8 = (GAS unsigned long long*)orow + lane;
#pragma unroll
    for (int j = 0; j < 4; ++j) o8[64 * j] = (unsigned long long)pk2(v[j].x * r, v[j].y * r) | ((unsigned long long)pk2(v[j].z * r, v[j].w * r) << 32);
}
__device__ __forceinline__ int t5_bucket(int dist) {
    if (dist < 16) return dist;
    const double x = log((double)dist / 16.0) / log(128.0) * 16.0;
    int large = 16 + (int)x; return large < 31 ? large : 31;
}

__device__ __forceinline__ void ldq64(const bf16* p, float (&q)[64]) {
#pragma unroll
    for (int i = 0; i < 8; ++i) { const v4u u = *(const GAS v4u*)(p + 8 * i);
        q[8 * i + 0] = bflo(u.x); q[8 * i + 1] = bfhi(u.x); q[8 * i + 2] = bflo(u.y); q[8 * i + 3] = bfhi(u.y);
        q[8 * i + 4] = bflo(u.z); q[8 * i + 5] = bfhi(u.z); q[8 * i + 6] = bflo(u.w); q[8 * i + 7] = bfhi(u.w); }
}
__device__ __forceinline__ float dot64_bf(const float (&q)[64], const bf16* p) {
    float s0 = 0.f, s1 = 0.f;
#pragma unroll
    for (int i = 0; i < 8; ++i) { const v4u u = *(const GAS v4u*)(p + 8 * i);
        s0 += q[8 * i + 0] * bflo(u.x); s1 += q[8 * i + 1] * bfhi(u.x); s0 += q[8 * i + 2] * bflo(u.y); s1 += q[8 * i + 3] * bfhi(u.y);
        s0 += q[8 * i + 4] * bflo(u.z); s1 += q[8 * i + 5] * bfhi(u.z); s0 += q[8 * i + 6] * bflo(u.w); s1 += q[8 * i + 7] * bfhi(u.w); }
    return s0 + s1;
}
__device__ __forceinline__ float dot64_f32(const float (&q)[64], const float* p) {
    float s0 = 0.f, s1 = 0.f;
#pragma unroll
    for (int i = 0; i < 16; ++i) { const f32x4 u = *(const GAS f32x4*)(p + 4 * i);
        s0 += q[4 * i + 0] * u.x; s1 += q[4 * i + 1] * u.y; s0 += q[4 * i + 2] * u.z; s1 += q[4 * i + 3] * u.w; }
    return s0 + s1;
}
__device__ __forceinline__ float silu(float x) { return x / (1.f + __expf(-x)); }

__device__ __forceinline__ float cross_attn_task(const bf16* MKV, const float* c_mem, const bf16* qptr, int m, int hh, int layer, int lane) {
    float q[64]; ldq64(qptr, q);
    const bool samp = m >= TP;
    float l[4]; float mx = -3.0e38f, o = 0.f, s = 0.f;
    if (!samp) {
        const bf16* kb = MKV + (size_t)((m >> 11) * NMEM) * 1024 + layer * 512 + hh * 64;
#pragma unroll
        for (int r = 0; r < 4; ++r) { l[r] = dot64_bf(q, kb + (size_t)(r * 64 + lane) * 1024) * 0.125f; mx = fmaxf(mx, l[r]); }
        mx = wave_max(mx);
#pragma unroll
        for (int r = 0; r < 4; ++r) { l[r] = __expf(l[r] - mx); s += l[r]; }
        s = wave_sum(s);
#pragma unroll
        for (int r = 0; r < 4; ++r)
            for (int kk = 0; kk < 64; ++kk) o += rdlane(l[r], kk) * bf2f(kb[(size_t)(r * 64 + kk) * 1024 + 256 + lane]);
    } else {
        const float* kf = c_mem + ((size_t)(layer * SBATCH + ((m - TP) >> 2)) * NMEM) * 512 + hh * 64;
#pragma unroll
        for (int r = 0; r < 4; ++r) { l[r] = dot64_f32(q, kf + (size_t)(r * 64 + lane) * 512) * 0.125f; mx = fmaxf(mx, l[r]); }
        mx = wave_max(mx);
#pragma unroll
        for (int r = 0; r < 4; ++r) { l[r] = __expf(l[r] - mx); s += l[r]; }
        s = wave_sum(s);
#pragma unroll
        for (int r = 0; r < 4; ++r)
            for (int kk = 0; kk < 64; ++kk) o += rdlane(l[r], kk) * kf[(size_t)(r * 64 + kk) * 512 + 256 + lane];
    }
    return o / s;
}

template <int G>
__device__ __forceinline__ void attn_group(const bf16* P, const float* BT, const float* cw, int m, int hh, int lane, float& Mx, float& Ss, float& O) {
    constexpr int dil = G == 0 ? 1 : (G == 1 ? 4 : 16), Wg = G == 0 ? 128 : (G == 1 ? 512 : 2048), head0 = G * 4;
    const bool samp = m >= TP;
    const int b = m >> 11, t = m & 2047, sb = (m - TP) >> 2, st = (m - TP) & 3, head = head0 + hh;
    float q[64]; ldq64(P + (size_t)m * A_IN + head * 64, q);
    const float* bt = BT + (G * 4 + hh) * 132;
    float l[3]; float gm = -3.0e38f;
#pragma unroll
    for (int r = 0; r < 3; ++r) { const int kidx = r * 64 + lane; float lv = -3.0e38f;
        if (kidx < 129) {
            if (!samp) { const int tk = t - dil * kidx; if (tk >= 0) lv = dot64_bf(q, P + (size_t)((b << 11) + tk) * A_IN + RW + head * 64) * 0.125f + bt[kidx]; }
            else { const int idx = Wg + st - dil * kidx;
                if (idx >= Wg) lv = dot64_bf(q, P + (size_t)(TP + sb * 4 + idx - Wg) * A_IN + RW + head * 64) * 0.125f + bt[kidx];
                else lv = dot64_f32(q, cw + ((size_t)(sb * Wg + idx) * 2) * 256 + hh * 64) * 0.125f + bt[kidx]; }
        }
        l[r] = lv; gm = fmaxf(gm, lv); }
    gm = wave_max(gm);
    const float Mn = fmaxf(Mx, gm), sc = __expf(Mx - Mn);
    float ps = 0.f;
#pragma unroll
    for (int r = 0; r < 3; ++r) { l[r] = l[r] > -1.0e38f ? __expf(l[r] - Mn) : 0.f; ps += l[r]; }
    Ss = Ss * sc + wave_sum(ps); O *= sc; Mx = Mn;
#pragma unroll
    for (int r = 0; r < 3; ++r)
        for (int kk = 0; kk < 64; ++kk) { const int kidx = r * 64 + kk; if (kidx >= 129) break;
            const float p = rdlane(l[r], kk);
            if (p != 0.f) { float v;
                if (!samp) { const int tk = t - dil * kidx; v = bf2f(P[(size_t)((b << 11) + tk) * A_IN + 2 * RW + head * 64 + lane]); }
                else { const int idx = Wg + st - dil * kidx;
                    if (idx >= Wg) v = bf2f(P[(size_t)(TP + sb * 4 + idx - Wg) * A_IN + 2 * RW + head * 64 + lane]);
                    else v = cw[((size_t)(sb * Wg + idx) * 2 + 1) * 256 + hh * 64 + lane]; }
                O += p * v; } }
}


__device__ __forceinline__ void samp_dot_rounds3(const bf16* P, const float* cw, const float* bt, const float (&q)[64], int g, int sb, int st, int hh, int lane, float (&l)[3]) {
    const int dil = g == 0 ? 1 : (g == 1 ? 4 : 16), Wg = g == 0 ? 128 : (g == 1 ? 512 : 2048), head = g * 4 + hh;
#pragma unroll
    for (int r = 0; r < 3; ++r) { const int kidx = r * 64 + lane; float lv = -3.0e38f;
        if (kidx < 129) { const int idx = Wg + st - dil * kidx;
            if (idx >= Wg) lv = dot64_bf(q, P + (size_t)(TP + sb * 4 + idx - Wg) * A_IN + RW + head * 64) * 0.125f + bt[kidx];
            else lv = dot64_f32(q, cw + ((size_t)(sb * Wg + idx) * 2) * 256 + hh * 64) * 0.125f + bt[kidx]; }
        l[r] = lv; }
}
__device__ __forceinline__ void samp_part(const bf16* P, const float* BT, const float* cw, const bf16* MKVunused, const float* c_mem, int m, int hh, int part, int layer, const bf16* qmem, int lane, float& Mo, float& So, float& Oo) {
    const int sb = (m - TP) >> 2, st = (m - TP) & 3;
    float q[64];
    if (part < 3) {
        const int g = part, dil = g == 0 ? 1 : (g == 1 ? 4 : 16), Wg = g == 0 ? 128 : (g == 1 ? 512 : 2048), head = g * 4 + hh;
        ldq64(P + (size_t)m * A_IN + head * 64, q);
        float l[3]; samp_dot_rounds3(P, cw, BT + (g * 4 + hh) * 132, q, g, sb, st, hh, lane, l);
        float gm = wave_max(fmaxf(fmaxf(l[0], l[1]), l[2])); float ps = 0.f;
#pragma unroll
        for (int r = 0; r < 3; ++r) { l[r] = l[r] > -1.0e38f ? __expf(l[r] - gm) : 0.f; ps += l[r]; }
        const float S = wave_sum(ps); float O = 0.f;
#pragma unroll
        for (int r = 0; r < 3; ++r) {
#pragma unroll 1
            for (int k0 = 0; k0 < 64; k0 += 8) { if (r * 64 + k0 >= 129) break;
                float v[8];
#pragma unroll
                for (int e = 0; e < 8; ++e) { int kidx = r * 64 + k0 + e; if (kidx > 128) kidx = 128; const int idx = Wg + st - dil * kidx;
                    v[e] = (idx >= Wg) ? bf2f(P[(size_t)(TP + sb * 4 + idx - Wg) * A_IN + 2 * RW + head * 64 + lane]) : cw[((size_t)(sb * Wg + idx) * 2 + 1) * 256 + hh * 64 + lane]; }
#pragma unroll
                for (int e = 0; e < 8; ++e) O += rdlane(l[r], k0 + e) * v[e]; } }
        Mo = gm; So = S; Oo = O;
    } else {
        ldq64(qmem, q);
        const float* kf = c_mem + ((size_t)(layer * SBATCH + sb) * NMEM) * 512 + hh * 64;
        float l[4]; float mx = -3.0e38f, s = 0.f, o = 0.f;
#pragma unroll
        for (int r = 0; r < 4; ++r) { l[r] = dot64_f32(q, kf + (size_t)(r * 64 + lane) * 512) * 0.125f; mx = fmaxf(mx, l[r]); }
        mx = wave_max(mx);
#pragma unroll
        for (int r = 0; r < 4; ++r) { l[r] = __expf(l[r] - mx); s += l[r]; }
        s = wave_sum(s);
#pragma unroll
        for (int r = 0; r < 4; ++r) {
#pragma unroll 1
            for (int k0 = 0; k0 < 64; k0 += 8) { float v[8];
#pragma unroll
                for (int e = 0; e < 8; ++e) v[e] = kf[(size_t)(r * 64 + k0 + e) * 512 + 256 + lane];
#pragma unroll
                for (int e = 0; e < 8; ++e) o += rdlane(l[r], k0 + e) * v[e]; } }
        Mo = mx; So = s; Oo = o;
    }
}

typedef short s16x4 __attribute__((ext_vector_type(4)));
typedef short bf16x8 __attribute__((ext_vector_type(8)));
constexpr int VROW = 160;
constexpr int VBUF = 32 * VROW;
constexpr float LOG2E = 1.4426950408889634f;
template <int OFF> __device__ __forceinline__ s16x4 tr_read(unsigned vb) {
    s16x4 r; asm volatile("ds_read_b64_tr_b16 %0, %1 offset:%2" : "=&v"(r) : "v"(vb), "i"(OFF) : "memory"); return r;
}
struct AttnSt { float m, s; f32x4 o[4]; };
__device__ __forceinline__ void attn_init(AttnSt& st) { st.m = -1.0e30f; st.s = 0.f;
#pragma unroll
    for (int i = 0; i < 4; ++i) st.o[i] = (f32x4){0.f, 0.f, 0.f, 0.f}; }
__device__ __forceinline__ unsigned cvt_pk_bf16f(float lo, float hi) { unsigned r; asm volatile("v_cvt_pk_bf16_f32 %0, %1, %2" : "=v"(r) : "v"(lo), "v"(hi)); return r; }

template <bool MASKED>
__device__ __forceinline__ void attn_pairs(const bf16* kbase, const bf16* vbase, int pitch, int tb, int dil, int qs, int tmax, int j0, int j1,
                                           const bf16x8 (&qf)[2], const LAS float* bias2, LAS unsigned char* vbuf, int lane, AttnSt& st) {
    const int n = lane & 15, quad = lane >> 4, vr8 = lane >> 3, vc8 = lane & 7;
    const unsigned vwr = (unsigned)(size_t)vbuf + (unsigned)(vr8 * VROW + vc8 * 16);
    const unsigned vrd = (unsigned)(size_t)vbuf + (unsigned)((4 * quad + (n >> 2)) * VROW + 8 * (n & 3));
    const float C2 = 0.125f * LOG2E;
    bf16x8 ka[2][2]; v4u vr[4];
#define ATT_LOAD(JP, KA, VR) do { _Pragma("unroll") for (int tt = 0; tt < 2; ++tt) { int tk = tb + dil * (32 * (JP) + 16 * tt + n); if (MASKED) tk = tk < 0 ? 0 : (tk > tmax ? tmax : tk); \
            const bf16* kp = kbase + (size_t)tk * pitch + 8 * quad; \
            KA[tt][0] = __builtin_bit_cast(bf16x8, *(const GAS v4u*)kp); KA[tt][1] = __builtin_bit_cast(bf16x8, *(const GAS v4u*)(kp + 32)); } \
        _Pragma("unroll") for (int c = 0; c < 4; ++c) { int tk = tb + dil * (32 * (JP) + 8 * c + vr8); if (MASKED) tk = tk < 0 ? 0 : (tk > tmax ? tmax : tk); \
            VR[c] = *(const GAS v4u*)(vbase + (size_t)tk * pitch + 8 * vc8); } } while (0)
    if (j0 < j1) ATT_LOAD(j0, ka, vr);
#pragma unroll 1
    for (int jp = j0; jp < j1; ++jp) {
        bf16x8 kn[2][2]; v4u vn[4];
        { const int jn = (jp + 1 < j1) ? jp + 1 : jp; ATT_LOAD(jn, kn, vn); }
        f32x4 sA = {0.f, 0.f, 0.f, 0.f}, sB = {0.f, 0.f, 0.f, 0.f};
        sA = __builtin_amdgcn_mfma_f32_16x16x32_bf16(ka[0][0], qf[0], sA, 0, 0, 0); sA = __builtin_amdgcn_mfma_f32_16x16x32_bf16(ka[0][1], qf[1], sA, 0, 0, 0);
        sB = __builtin_amdgcn_mfma_f32_16x16x32_bf16(ka[1][0], qf[0], sB, 0, 0, 0); sB = __builtin_amdgcn_mfma_f32_16x16x32_bf16(ka[1][1], qf[1], sB, 0, 0, 0);
        float l[8]; bool ok[8]; float mloc = -1.0e30f;
#pragma unroll
        for (int e = 0; e < 8; ++e) { const int u = 32 * jp + (e >> 2) * 16 + 4 * quad + (e & 3); const float a = (e < 4 ? sA[e & 3] : sB[e & 3]) * C2;
            if (MASKED) { const int kidx = 128 + qs * n - u; ok[e] = (kidx >= 0) && (kidx <= 128) && (tb + dil * u >= 0);
                const int kc = kidx < 0 ? 0 : (kidx > 128 ? 128 : kidx); l[e] = ok[e] ? a + bias2[kc] : -1.0e30f; }
            else { ok[e] = true; l[e] = a; }
            mloc = fmaxf(mloc, l[e]); }
        mloc = fmaxf(mloc, __shfl_xor(mloc, 16)); mloc = fmaxf(mloc, __shfl_xor(mloc, 32));
        const float mn = fmaxf(st.m, mloc), alpha = __builtin_amdgcn_exp2f(st.m - mn);
        float ps = 0.f; float p[8];
#pragma unroll
        for (int e = 0; e < 8; ++e) { p[e] = ok[e] ? __builtin_amdgcn_exp2f(l[e] - mn) : 0.f; ps += p[e]; }
        st.s = st.s * alpha + ps; st.m = mn;
#pragma unroll
        for (int i = 0; i < 4; ++i) st.o[i] = st.o[i] * alpha;
        v4u pk; pk.x = cvt_pk_bf16f(p[0], p[1]); pk.y = cvt_pk_bf16f(p[2], p[3]); pk.z = cvt_pk_bf16f(p[4], p[5]); pk.w = cvt_pk_bf16f(p[6], p[7]);
        const bf16x8 pb = __builtin_bit_cast(bf16x8, pk);
#pragma unroll
        for (int c = 0; c < 4; ++c) *(LAS v4u*)(size_t)(vwr + c * 8 * VROW) = vr[c];
        asm volatile("s_waitcnt lgkmcnt(0)" ::: "memory");
        const s16x4 a0 = tr_read<0>(vrd), b0 = tr_read<16 * VROW>(vrd), a1 = tr_read<32>(vrd), b1 = tr_read<16 * VROW + 32>(vrd);
        const s16x4 a2 = tr_read<64>(vrd), b2 = tr_read<16 * VROW + 64>(vrd), a3 = tr_read<96>(vrd), b3 = tr_read<16 * VROW + 96>(vrd);
        asm volatile("s_waitcnt lgkmcnt(0)" ::: "memory"); __builtin_amdgcn_sched_barrier(0);
#define PKV(L, H) (bf16x8){L[0], L[1], L[2], L[3], H[0], H[1], H[2], H[3]}
        st.o[0] = __builtin_amdgcn_mfma_f32_16x16x32_bf16(PKV(a0, b0), pb, st.o[0], 0, 0, 0);
        st.o[1] = __builtin_amdgcn_mfma_f32_16x16x32_bf16(PKV(a1, b1), pb, st.o[1], 0, 0, 0);
        st.o[2] = __builtin_amdgcn_mfma_f32_16x16x32_bf16(PKV(a2, b2), pb, st.o[2], 0, 0, 0);
        st.o[3] = __builtin_amdgcn_mfma_f32_16x16x32_bf16(PKV(a3, b3), pb, st.o[3], 0, 0, 0);
#undef PKV
        __builtin_amdgcn_sched_barrier(0);
#pragma unroll
        for (int tt = 0; tt < 2; ++tt) { ka[tt][0] = kn[tt][0]; ka[tt][1] = kn[tt][1]; }
#pragma unroll
        for (int c = 0; c < 4; ++c) vr[c] = vn[c];
    }
#undef ATT_LOAD
}
__device__ __forceinline__ void attn_store(const AttnSt& st, const bf16* gate_row  , bf16* out_row, int lane) {
    const int quad = lane >> 4;
    float s = st.s; s += __shfl_xor(s, 16); s += __shfl_xor(s, 32);
    const float inv = 1.f / s;
#pragma unroll
    for (int mt = 0; mt < 4; ++mt) { const v2u g = *(const GAS v2u*)(gate_row + 16 * mt + 4 * quad);
        const float o0 = st.o[mt][0] * inv * silu(bflo(g.x)), o1 = st.o[mt][1] * inv * silu(bfhi(g.x)), o2 = st.o[mt][2] * inv * silu(bflo(g.y)), o3 = st.o[mt][3] * inv * silu(bfhi(g.y));
        *(GAS v2u*)(out_row + 16 * mt + 4 * quad) = (v2u){pk2(o0, o1), pk2(o2, o3)}; }
}
__device__ __forceinline__ void load_qf(const bf16* qrow, int lane, bf16x8 (&qf)[2]) {
    const int quad = lane >> 4;
    qf[0] = __builtin_bit_cast(bf16x8, *(const GAS v4u*)(qrow + 8 * quad)); qf[1] = __builtin_bit_cast(bf16x8, *(const GAS v4u*)(qrow + 32 + 8 * quad));
}
__device__ __forceinline__ void attn_a_unit(const Ctx& C, const bf16* P, const bf16* MKV, bf16* H, const float* BT, int unit) {
    const int b = unit >> 5, hh = (unit >> 3) & 3, t0 = (unit & 7) * 256;
    LAS float* bias2 = (LAS float*)(C.lds + RING_OFF);
    LAS unsigned char* vbuf = C.lds + RING_OFF + 4096 + C.wave * VBUF;
    __syncthreads();
    for (int i = C.tid; i < 3 * 132; i += NWAVES * 64) { const int g = i / 132, k = i % 132; bias2[i] = k < 129 ? BT[(g * 4 + hh) * 132 + k] * LOG2E : 0.f; }
    __syncthreads();
    const int n = C.lane & 15;
    const bf16* Pb = P + (size_t)(b << 11) * A_IN;
#pragma unroll 1
    for (int set = 0; set < 2; ++set) {
        const int r = 2 * C.wave + set, tq = t0 + r + 16 * n;
        const bf16* qrow = Pb + (size_t)tq * A_IN;
        AttnSt st; attn_init(st);
#pragma unroll 1
        for (int g = 0; g < 3; ++g) {
            const int dil = g == 0 ? 1 : (g == 1 ? 4 : 16), qs = 16 / dil, np = g == 0 ? 12 : (g == 1 ? 6 : 5), head = g * 4 + hh;
            const int tb = t0 + r - 128 * dil;
            int j0 = 0; if (tb < 0) { j0 = (-tb - 31 * dil + 32 * dil - 1) / (32 * dil); if (j0 < 0) j0 = 0; }
            bf16x8 qf[2]; load_qf(qrow + head * 64, C.lane, qf);
            attn_pairs<true>(Pb + RW + head * 64, Pb + 2 * RW + head * 64, A_IN, tb, dil, qs, SEQ - 1, j0, np, qf, bias2 + g * 132, vbuf, C.lane, st);
        }
        attn_store(st, qrow + 2560 + hh * 64, H + ((size_t)(b << 11) + tq) * 512 + hh * 64, C.lane);
        AttnSt sm; attn_init(sm);
        { bf16x8 qf[2]; load_qf(qrow + 2304 + hh * 64, C.lane, qf);
          const bf16* kb = MKV + (size_t)(b * NMEM) * 1024 + hh * 64;
          attn_pairs<false>(kb, kb + 256, 1024, 0, 1, 0, NMEM - 1, 0, 8, qf, nullptr, vbuf, C.lane, sm); }
        attn_store(sm, qrow + 2560 + 256 + hh * 64, H + ((size_t)(b << 11) + tq) * 512 + 256 + hh * 64, C.lane);
    }
}
__device__ __forceinline__ void attn_b_unit(const Ctx& C, const bf16* P, const bf16* MKV, bf16* H, int unit) {
    const int b = unit >> 5, hh = (unit >> 3) & 3, t0 = (unit & 7) * 256;
    LAS unsigned char* vbuf = C.lds + RING_OFF + 4096 + C.wave * VBUF;
    const int n = C.lane & 15;
#pragma unroll 1
    for (int set = 0; set < 2; ++set) {
        const int r = 2 * C.wave + set, tq = t0 + r + 16 * n;
        const bf16* qrow = P + ((size_t)(b << 11) + tq) * B_INP;
        AttnSt sm; attn_init(sm);
        bf16x8 qf[2]; load_qf(qrow + CSH + hh * 64, C.lane, qf);
        const bf16* kb = MKV + (size_t)(b * NMEM) * 1024 + 512 + hh * 64;
        attn_pairs<false>(kb, kb + 256, 1024, 0, 1, 0, NMEM - 1, 0, 8, qf, nullptr, vbuf, C.lane, sm);
        attn_store(sm, qrow + 2688 + RW + hh * 64, H + ((size_t)(b << 11) + tq) * 1024 + RW + hh * 64, C.lane);
    }
}

__device__ __forceinline__ void row_pass(const bf16* hp, const float* xin, float* xout, const float* gpost, bf16* xn, int lane) {
    const GAS v2u* h2 = (const GAS v2u*)hp + lane; const GAS f32x4* xr = (const GAS f32x4*)xin + lane; const GAS f32x4* gp = (const GAS f32x4*)gpost + lane;
    f32x4 h[4], x[4]; float s = 0.f;
#pragma unroll
    for (int j = 0; j < 4; ++j) { const v2u u = h2[64 * j]; h[j] = (f32x4){bflo(u.x), bfhi(u.x), bflo(u.y), bfhi(u.y)}; x[j] = xr[64 * j];
        s += (h[j].x * h[j].x + h[j].y * h[j].y) + (h[j].z * h[j].z + h[j].w * h[j].w); }
    const float r = 1.f / sqrtf(wave_sum(s) * (1.f / DM) + RMS_EPS);
    float s2 = 0.f;
#pragma unroll
    for (int j = 0; j < 4; ++j) { const f32x4 g = gp[64 * j]; x[j] = x[j] + h[j] * r * g; s2 += (x[j].x * x[j].x + x[j].y * x[j].y) + (x[j].z * x[j].z + x[j].w * x[j].w);
        *((GAS f32x4*)xout + lane + 64 * j) = x[j]; }
    if (xn) { const float r2 = 1.f / sqrtf(wave_sum(s2) * (1.f / DM) + RMS_EPS);
        GAS unsigned long long* o8 = (GAS unsigned long long*)xn + lane;
#pragma unroll
        for (int j = 0; j < 4; ++j) o8[64 * j] = (unsigned long long)pk2(x[j].x * r2, x[j].y * r2) | ((unsigned long long)pk2(x[j].z * r2, x[j].w * r2) << 32); }
}

struct ScanP { const bf16 *P, *LORA; bf16* H; float* out; const float *st_wkv, *st_shift, *mu, *w0, *a0, *k_k, *k_a, *r_k, *ln_w, *ln_b; };
__device__ __forceinline__ void scan_unit(const Ctx& C, const ScanP& sp, int u) {
    LAS float* L = (LAS float*)(C.lds + RING_OFF);
    LAS float *LA = L, *LB = L + 4096, *LW = L + 8192, *LK = L + 12288, *LRW = L + 16384, *LV = L + 20480, *LSC = L + 24576, *LY = L + 24576 + 256;
    const bool samp = u >= 96; const int seq = samp ? (u - 96) / 12 : u / 12, h = samp ? (u - 96) % 12 : u % 12;
    const int T = samp ? STOK : SEQ, row0 = samp ? TP + seq * 4 : seq * SEQ;
    int row = C.wave * 8 + (C.lane >> 3), p = C.lane & 7;
    asm volatile("" : "+v"(row), "+v"(p));
    float S[8];
#pragma unroll
    for (int j = 0; j < 8; ++j) S[j] = samp ? sp.st_wkv[((size_t)(seq * 12 + h) * 64 + row) * 64 + p * 8 + j] : 0.f;
#pragma unroll 1
    for (int c0 = 0; c0 < T; c0 += 64) {
        const int n = (T - c0) < 64 ? (T - c0) : 64;
        int tok = C.tid >> 3, part = C.tid & 7;
        asm volatile("" : "+v"(tok), "+v"(part));
        __syncthreads();
        if (tok < n) {
            const int t = c0 + tok, m = row0 + t;
            const bf16* cur = sp.P + (size_t)m * B_INP; const bf16* prv = cur - B_INP; const bf16* lo = sp.LORA + (size_t)m * 1536;
            float xr[8], xk[8], xv[8], kk[8], av[8], dv[8];
            float nrm = 0.f;
#pragma unroll
            for (int j = 0; j < 8; ++j) { const int c = h * 64 + part * 8 + j;
                const float cr = bf2f(cur[c]), ck = bf2f(cur[RW + c]), cv = bf2f(cur[2 * RW + c]);
                float pr = 0.f, pk = 0.f, pv = 0.f;
                if (t > 0) { pr = bf2f(prv[c]); pk = bf2f(prv[RW + c]); pv = bf2f(prv[2 * RW + c]); }
                else if (samp) { const float* ss = sp.st_shift + (size_t)seq * CSH; pr = ss[c]; pk = ss[RW + c]; pv = ss[2 * RW + c]; }
                xr[j] = cr + sp.mu[c] * (pr - cr); xk[j] = ck + sp.mu[RW + c] * (pk - ck); xv[j] = cv + sp.mu[2 * RW + c] * (pv - cv);
                const float dpre = sp.w0[c] + bf2f(lo[c]), apre = sp.a0[c] + bf2f(lo[RW + c]);
                dv[j] = __expf(-0.6065306597f * __builtin_amdgcn_rcpf(1.f + __expf(-dpre)));
                av[j] = __builtin_amdgcn_rcpf(1.f + __expf(-apre));
                kk[j] = xk[j] * sp.k_k[c]; nrm += kk[j] * kk[j]; }
            nrm += __shfl_xor(nrm, 1); nrm += __shfl_xor(nrm, 2); nrm += __shfl_xor(nrm, 4);
            const float inv = 1.f / fmaxf(sqrtf(nrm), 1e-12f);
            float br = 0.f, kr = 0.f, bon = 0.f;
#pragma unroll
            for (int j = 0; j < 8; ++j) { const int c = h * 64 + part * 8 + j, d = part * 8 + j;
                const float kn = kk[j] * inv, k2 = xk[j] * (1.f + (av[j] - 1.f) * sp.k_a[c]);
                const float bb = kn * av[j];
                LA[tok * 64 + d] = -kn; LB[tok * 64 + d] = bb; LW[tok * 64 + d] = dv[j]; LK[tok * 64 + d] = k2; LRW[tok * 64 + d] = xr[j] * dv[j]; LV[tok * 64 + d] = xv[j];
                br += bb * xr[j]; kr += k2 * xr[j]; bon += xr[j] * k2 * sp.r_k[c]; }
            br += __shfl_xor(br, 1); br += __shfl_xor(br, 2); br += __shfl_xor(br, 4);
            kr += __shfl_xor(kr, 1); kr += __shfl_xor(kr, 2); kr += __shfl_xor(kr, 4);
            bon += __shfl_xor(bon, 1); bon += __shfl_xor(bon, 2); bon += __shfl_xor(bon, 4);
            if (part == 0) { LSC[tok * 4 + 0] = br; LSC[tok * 4 + 1] = kr; LSC[tok * 4 + 2] = bon; }
        }
        __syncthreads();
#pragma unroll 1
        for (int i = 0; i < n; ++i) {
            const LAS f32x4* a4 = (const LAS f32x4*)(LA + i * 64 + p * 8); const LAS f32x4* r4 = (const LAS f32x4*)(LRW + i * 64 + p * 8);
            const LAS f32x4* w4 = (const LAS f32x4*)(LW + i * 64 + p * 8); const LAS f32x4* b4 = (const LAS f32x4*)(LB + i * 64 + p * 8); const LAS f32x4* k4 = (const LAS f32x4*)(LK + i * 64 + p * 8);
            const f32x4 a0 = a4[0], a1 = a4[1], r0 = r4[0], r1 = r4[1];
            float sa = (S[0] * a0.x + S[1] * a0.y) + (S[2] * a0.z + S[3] * a0.w) + (S[4] * a1.x + S[5] * a1.y) + (S[6] * a1.z + S[7] * a1.w);
            float yp = (S[0] * r0.x + S[1] * r0.y) + (S[2] * r0.z + S[3] * r0.w) + (S[4] * r1.x + S[5] * r1.y) + (S[6] * r1.z + S[7] * r1.w);
            sa += __shfl_xor(sa, 1); sa += __shfl_xor(sa, 2); sa += __shfl_xor(sa, 4);
            yp += __shfl_xor(yp, 1); yp += __shfl_xor(yp, 2); yp += __shfl_xor(yp, 4);
            const float v = LV[i * 64 + row], br = LSC[i * 4 + 0], kr = LSC[i * 4 + 1];
            const f32x4 w0 = w4[0], w1 = w4[1], b0 = b4[0], b1 = b4[1], k0 = k4[0], k1 = k4[1];
            S[0] = S[0] * w0.x + sa * b0.x + v * k0.x; S[1] = S[1] * w0.y + sa * b0.y + v * k0.y; S[2] = S[2] * w0.z + sa * b0.z + v * k0.z; S[3] = S[3] * w0.w + sa * b0.w + v * k0.w;
            S[4] = S[4] * w1.x + sa * b1.x + v * k1.x; S[5] = S[5] * w1.y + sa * b1.y + v * k1.y; S[6] = S[6] * w1.z + sa * b1.z + v * k1.z; S[7] = S[7] * w1.w + sa * b1.w + v * k1.w;
            if (p == 0) LY[i * 64 + row] = yp + sa * br + v * kr;
        }
        __syncthreads();
        asm volatile("" : "+v"(tok), "+v"(part));
        if (tok < n) {
            const int m = row0 + c0 + tok;
            float y[8]; float s = 0.f;
#pragma unroll
            for (int j = 0; j < 8; ++j) { y[j] = LY[tok * 64 + part * 8 + j]; s += y[j]; }
            s += __shfl_xor(s, 1); s += __shfl_xor(s, 2); s += __shfl_xor(s, 4);
            const float mean = s * (1.f / 64.f); float q = 0.f;
#pragma unroll
            for (int j = 0; j < 8; ++j) { y[j] -= mean; q += y[j] * y[j]; }
            q += __shfl_xor(q, 1); q += __shfl_xor(q, 2); q += __shfl_xor(q, 4);
            const float rstd = 1.f / sqrtf(q * (1.f / 64.f) + GN_EPS), bon = LSC[tok * 4 + 2];
            unsigned w[4];
#pragma unroll
            for (int j = 0; j < 8; j += 2) { float o2[2];
#pragma unroll
                for (int e = 0; e < 2; ++e) { const int c = h * 64 + part * 8 + j + e;
                    const float yy = y[j + e] * rstd * sp.ln_w[c] + sp.ln_b[c] + bon * LV[tok * 64 + part * 8 + j + e];
                    o2[e] = yy * silu(bf2f(sp.P[(size_t)m * B_INP + 2688 + c])); }
                w[j >> 1] = pk2(o2[0], o2[1]); }
            *(GAS v4u*)(sp.H + (size_t)m * 1024 + h * 64 + part * 8) = (v4u){w[0], w[1], w[2], w[3]};
        }
    }
    float* so = sp.out + (samp ? O_WKVS : O_WKVP) + ((size_t)(seq * 12 + h) * 64 + row) * 64 + p * 8;
    *(GAS f32x4*)so = (f32x4){S[0], S[1], S[2], S[3]}; *((GAS f32x4*)so + 1) = (f32x4){S[4], S[5], S[6], S[7]};
    __syncthreads();
}

constexpr int TS = 72;
constexpr int IMG = 64 * TS * 2;
constexpr int L_AT = 0, L_RT = IMG, L_BT = 2 * IMG, L_KT = 3 * IMG, L_VV = 4 * IMG, L_SB = 5 * IMG, L_Z = 6 * IMG, L_SA = 7 * IMG,
              L_NKA = 8 * IMG, L_NBR = 9 * IMG, L_NKR = 10 * IMG, L_TT = 11 * IMG, L_E = 12 * IMG, L_PC = L_E + 16384, L_BON = L_PC + 256, L_SEG = L_BON + 256, L_CH_END = L_SEG + 2048;
constexpr int NSLOT = 7, L_SLOT0 = 3 * IMG + 16384 + 256 + 256 + 2048;
static_assert(L_CH_END <= RING_BYTES && L_SLOT0 + NSLOT * 16384 <= RING_BYTES, "chunk-scan LDS map");
constexpr int LA_AT = 0, LA_BT = IMG, LA_E = 2 * IMG, LA_PC = LA_E + 16384, LA_BON = LA_PC + 256, LA_SEG = LA_BON + 256;

struct ChunkP { const bf16 *P, *LORA; const float *mu, *w0, *a0, *k_k, *k_a, *r_k; };
struct PrepR { float xr[8], xv[8], kn[8], as[8], k2[8], e[8], bon; };
struct PrepL { v4u cr4, ck4, cv4, pr4, pk4, pv4, lw4, la4, g4; };
__device__ __forceinline__ void prep_load(const ChunkP& cp, int m0, int t0tok, int h, int tok, int part, PrepL& L) {
    const int m = m0 + tok; const bool first = (t0tok + tok) == 0;
    const bf16* cur = cp.P + (size_t)m * B_INP + h * 64 + part * 8; const bf16* lo = cp.LORA + (size_t)m * 1536 + h * 64 + part * 8;
    L.cr4 = *(const GAS v4u*)cur; L.ck4 = *(const GAS v4u*)(cur + RW); L.cv4 = *(const GAS v4u*)(cur + 2 * RW);
    L.pr4 = (v4u){0u, 0u, 0u, 0u}; L.pk4 = L.pr4; L.pv4 = L.pr4;
    if (!first) { L.pr4 = *(const GAS v4u*)(cur - B_INP); L.pk4 = *(const GAS v4u*)(cur - B_INP + RW); L.pv4 = *(const GAS v4u*)(cur - B_INP + 2 * RW); }
    L.lw4 = *(const GAS v4u*)lo; L.la4 = *(const GAS v4u*)(lo + RW);
    L.g4 = *(const GAS v4u*)(cur + 2688);
}
__device__ __forceinline__ void prep_step1(const ChunkP& cp, const PrepL& L, int h, int tok, int part, LAS unsigned char* lds, int offE, PrepR& R) {
    float xk[8], kk[8]; float nrm = 0.f;
#pragma unroll
    for (int j = 0; j < 8; ++j) { const int c = h * 64 + part * 8 + j;
        const unsigned ur = L.cr4[j >> 1], uk = L.ck4[j >> 1], uv = L.cv4[j >> 1], upr = L.pr4[j >> 1], upk = L.pk4[j >> 1], upv = L.pv4[j >> 1], ulw = L.lw4[j >> 1], ula = L.la4[j >> 1];
        const float cr = (j & 1) ? bfhi(ur) : bflo(ur), ck = (j & 1) ? bfhi(uk) : bflo(uk), cv = (j & 1) ? bfhi(uv) : bflo(uv);
        const float pr = (j & 1) ? bfhi(upr) : bflo(upr), pk = (j & 1) ? bfhi(upk) : bflo(upk), pv = (j & 1) ? bfhi(upv) : bflo(upv);
        const float lw = (j & 1) ? bfhi(ulw) : bflo(ulw), la = (j & 1) ? bfhi(ula) : bflo(ula);
        R.xr[j] = cr + cp.mu[c] * (pr - cr); xk[j] = ck + cp.mu[RW + c] * (pk - ck); R.xv[j] = cv + cp.mu[2 * RW + c] * (pv - cv);
        const float dpre = cp.w0[c] + lw, apre = cp.a0[c] + la;
        R.e[j] = 0.6065306597f * __builtin_amdgcn_rcpf(1.f + __expf(-dpre));
        R.as[j] = __builtin_amdgcn_rcpf(1.f + __expf(-apre));
        kk[j] = xk[j] * cp.k_k[c]; nrm += kk[j] * kk[j]; }
    nrm += __shfl_xor(nrm, 1); nrm += __shfl_xor(nrm, 2); nrm += __shfl_xor(nrm, 4);
    const float inv = __builtin_amdgcn_rsqf(fmaxf(nrm, 1e-24f));
    float bon = 0.f;
#pragma unroll
    for (int j = 0; j < 8; ++j) { const int c = h * 64 + part * 8 + j; R.kn[j] = kk[j] * inv; R.k2[j] = xk[j] * (1.f + (R.as[j] - 1.f) * cp.k_a[c]); bon += R.xr[j] * R.k2[j] * cp.r_k[c]; }
    bon += __shfl_xor(bon, 1); bon += __shfl_xor(bon, 2); bon += __shfl_xor(bon, 4);
    R.bon = bon;
    LAS float* E = (LAS float*)(lds + offE) + tok * 64 + part * 8;
    *(LAS f32x4*)E = (f32x4){R.e[0], R.e[1], R.e[2], R.e[3]}; *((LAS f32x4*)E + 1) = (f32x4){R.e[4], R.e[5], R.e[6], R.e[7]};
}
__device__ __forceinline__ void prep_cumsum(int tid, LAS unsigned char* lds, int offE, int offSEG) {
    LAS float* E = (LAS float*)(lds + offE); LAS float* SEG = (LAS float*)(lds + offSEG);
    const int d = tid & 63, seg = tid >> 6;
    float v[8]; float run = 0.f;
#pragma unroll
    for (int j = 0; j < 8; ++j) { run += E[(seg * 8 + j) * 64 + d]; v[j] = run; }
    SEG[seg * 64 + d] = run;
    __syncthreads();
    float off = 0.f;
#pragma unroll
    for (int s = 0; s < 7; ++s) off += (s < seg) ? SEG[s * 64 + d] : 0.f;
#pragma unroll
    for (int j = 0; j < 8; ++j) E[(seg * 8 + j) * 64 + d] = v[j] + off;
}
__device__ __forceinline__ void st8bf(LAS unsigned char* lds, int off, int tok, int part, const float (&x)[8]) {
    *(LAS v4u*)(lds + off + (tok * TS + part * 8) * 2) = (v4u){pk2(x[0], x[1]), pk2(x[2], x[3]), pk2(x[4], x[5]), pk2(x[6], x[7])};
}
template <bool FULL>
__device__ __forceinline__ void prep_step3(int tok, int part, LAS unsigned char* lds, int offE, int offAT, int offBT, int offRT, int offKT, int offVV, int offPC, int offBON, const PrepR& R) {
    const LAS float* E = (const LAS float*)(lds + offE) + tok * 64 + part * 8;
    const f32x4 c0 = *(const LAS f32x4*)E, c1 = *((const LAS f32x4*)E + 1);
    float at[8], bt[8], rt[8], kt[8];
#pragma unroll
    for (int j = 0; j < 8; ++j) { const float cum = j < 4 ? c0[j & 3] : c1[j & 3];
        const float pm1 = __expf(R.e[j] - cum), ip = __expf(cum);
        at[j] = -R.kn[j] * pm1; bt[j] = R.kn[j] * R.as[j] * ip;
        if (FULL) { const float pt = __builtin_amdgcn_rcpf(ip); rt[j] = R.xr[j] * pt; kt[j] = R.k2[j] * ip;
            if (tok == 63) ((LAS float*)(lds + offPC))[part * 8 + j] = pt; } }
    st8bf(lds, offAT, tok, part, at); st8bf(lds, offBT, tok, part, bt);
    if (FULL) { st8bf(lds, offRT, tok, part, rt); st8bf(lds, offKT, tok, part, kt); st8bf(lds, offVV, tok, part, R.xv);
        if (part == 0) ((LAS float*)(lds + offBON))[tok] = R.bon; }
}
__device__ __forceinline__ bf16x8 frag_nat(const LAS unsigned char* img, int R0, int ks, int lane) {
    return __builtin_bit_cast(bf16x8, *(const LAS v4u*)(img + ((R0 + (lane & 15)) * TS + 32 * ks + 8 * (lane >> 4)) * 2));
}
__device__ __forceinline__ bf16x8 frag_tr(const LAS unsigned char* img, int I0, int ks, int lane) {
    const int i16 = lane & 15, quad = lane >> 4;
    const unsigned a = (unsigned)(size_t)img + (unsigned)(((32 * ks + 8 * quad + (i16 >> 2)) * TS + I0 + 4 * (i16 & 3)) * 2);
    const s16x4 lo = tr_read<0>(a), hi = tr_read<4 * TS * 2>(a);
    asm volatile("s_waitcnt lgkmcnt(0)" ::: "memory"); __builtin_amdgcn_sched_barrier(0);
    return (bf16x8){lo[0], lo[1], lo[2], lo[3], hi[0], hi[1], hi[2], hi[3]};
}
#define MFMA16(a, b, c) __builtin_amdgcn_mfma_f32_16x16x32_bf16((a), (b), (c), 0, 0, 0)
__device__ __forceinline__ void st_tile_T(LAS unsigned char* img, int C0, int R0, int lane, f32x4 v) {
    *(LAS v2u*)(img + ((C0 + (lane & 15)) * TS + R0 + 4 * (lane >> 4)) * 2) = (v2u){pk2(v[0], v[1]), pk2(v[2], v[3])};
}

__device__ __forceinline__ void scan_stage_a(const Ctx& C, const ChunkP& cp, bf16* TT, int task0, int ntask) {
    LAS unsigned char* lds = C.lds + RING_OFF;
    const int tok = C.tid >> 3, part = C.tid & 7, vs = C.wave & 3, rh = C.wave >> 2;
#pragma unroll 1
    for (int base = 0; base < ntask; base += NSLOT) {
        const int nr = (ntask - base) < NSLOT ? (ntask - base) : NSLOT;
#pragma unroll 1
        for (int s = 0; s < nr; ++s) {
            const int task = task0 + base + s, bh = task >> 5, c = task & 31, b = bh / 12, h = bh % 12;
            PrepR R; PrepL L; prep_load(cp, b * SEQ + c * 64, c * 64, h, tok, part, L);
            __syncthreads();
            prep_step1(cp, L, h, tok, part, lds, LA_E, R);
            __syncthreads();
            prep_cumsum(C.tid, lds, LA_E, LA_SEG);
            __syncthreads();
            prep_step3<false>(tok, part, lds, LA_E, LA_AT, LA_BT, 0, 0, 0, 0, 0, R);
            __syncthreads();
            LAS float* slot = (LAS float*)(lds + L_SLOT0 + s * 16384);
            const bf16x8 b0 = frag_nat(lds + LA_AT, 16 * vs, 0, C.lane), b1 = frag_nat(lds + LA_AT, 16 * vs, 1, C.lane);
#pragma unroll
            for (int q = 0; q < 2; ++q) { const int it = 2 * rh + q;
                f32x4 acc = {0.f, 0.f, 0.f, 0.f};
                acc = MFMA16(frag_nat(lds + LA_BT, 16 * it, 0, C.lane), b0, acc); acc = MFMA16(frag_nat(lds + LA_BT, 16 * it, 1, C.lane), b1, acc);
                const int t = 16 * vs + (C.lane & 15), i0 = 16 * it + 4 * (C.lane >> 4);
                f32x4 o; o[0] = (i0 + 0 < t) ? acc[0] : 0.f; o[1] = (i0 + 1 < t) ? acc[1] : 0.f; o[2] = (i0 + 2 < t) ? acc[2] : 0.f; o[3] = (i0 + 3 < t) ? acc[3] : 0.f;
                *(LAS f32x4*)(slot + t * 64 + i0) = o; }
        }
        __syncthreads();
        if (C.wave < nr) {
            const LAS float* Nl = (const LAS float*)(lds + L_SLOT0 + C.wave * 16384);
            float Tr[64];
#pragma unroll
            for (int t = 0; t < 64; ++t) { float acc = (C.lane == t) ? 1.f : 0.f;
#pragma unroll
                for (int i = 0; i < t; ++i) acc += Tr[i] * Nl[t * 64 + i];
                Tr[t] = acc; }
            bf16* o = TT + (size_t)(task0 + base + C.wave) * 4096 + C.lane;
#pragma unroll
            for (int t = 0; t < 64; ++t) o[t * 64] = (bf16)f2bf(Tr[t]);
        }
    }
    __syncthreads();
}

struct ScanBP { ChunkP cp; const bf16* TT; bf16* H; float* out; const float *ln_w, *ln_b; };
constexpr int L_Y = L_E, L_SB2 = L_CH_END, L_PRM = L_SB2 + IMG, L_B_END = L_PRM + 2560;
static_assert(L_B_END <= RING_BYTES, "stage B LDS map");
__device__ __forceinline__ void ld8(const LAS float* p, float (&x)[8]) { const f32x4 a = *(const LAS f32x4*)p, b = *((const LAS f32x4*)p + 1);
    x[0] = a[0]; x[1] = a[1]; x[2] = a[2]; x[3] = a[3]; x[4] = b[0]; x[5] = b[1]; x[6] = b[2]; x[7] = b[3]; }
__device__ __forceinline__ void scan_stage_b(const Ctx& C, const ScanBP& sb, int bh) {
    LAS unsigned char* lds = C.lds + RING_OFF;
    const int b = bh / 12, h = bh % 12;
    const int tok = C.tid >> 3, part = C.tid & 7, tl = C.lane >> 3, vs = C.wave & 3, rh = C.wave >> 2, l15 = C.lane & 15, quad = C.lane >> 4;
    f32x4 St[2] = {{0.f, 0.f, 0.f, 0.f}, {0.f, 0.f, 0.f, 0.f}};
    __syncthreads();
    for (int i = C.tid; i < IMG / 4; i += NWAVES * 64) ((LAS unsigned*)(lds + L_SB))[i] = 0u;
    { LAS float* prm = (LAS float*)(lds + L_PRM);
      for (int i = C.tid; i < 640; i += NWAVES * 64) { const int a = i >> 6, d = i & 63, c = h * 64 + d;
          const float* src = a == 0 ? sb.cp.mu + c : a == 1 ? sb.cp.mu + RW + c : a == 2 ? sb.cp.mu + 2 * RW + c : a == 3 ? sb.cp.w0 + c : a == 4 ? sb.cp.a0 + c : a == 5 ? sb.cp.k_k + c :
                             a == 6 ? sb.cp.k_a + c : a == 7 ? sb.cp.r_k + c : a == 8 ? sb.ln_w + c : sb.ln_b + c;
          prm[i] = *src; } }
    PrepL Ln; prep_load(sb.cp, b * SEQ, 0, h, tok, part, Ln);
    v4u ttn = *((const GAS v4u*)(sb.TT + (size_t)(bh * 32) * 4096) + C.tid);
    float xvp[8] = {0.f, 0.f, 0.f, 0.f, 0.f, 0.f, 0.f, 0.f}; float bonp = 0.f; v4u g4p = {0u, 0u, 0u, 0u};
    __syncthreads();
    const LAS float* prm = (const LAS float*)(lds + L_PRM) + part * 8;
#pragma unroll 1
    for (int c = 0; c <= 32; ++c) {
        const int m0 = b * SEQ + c * 64;
        if (c > 0) { const int m = m0 - 64 + tok; float y[8]; ld8((const LAS float*)(lds + L_Y) + tok * 64 + part * 8, y); float s = 0.f;
#pragma unroll
            for (int j = 0; j < 8; ++j) s += y[j];
            s += __shfl_xor(s, 1); s += __shfl_xor(s, 2); s += __shfl_xor(s, 4);
            const float mean = s * (1.f / 64.f); float qq = 0.f;
#pragma unroll
            for (int j = 0; j < 8; ++j) { y[j] -= mean; qq += y[j] * y[j]; }
            qq += __shfl_xor(qq, 1); qq += __shfl_xor(qq, 2); qq += __shfl_xor(qq, 4);
            const float rstd = __builtin_amdgcn_rsqf(qq * (1.f / 64.f) + GN_EPS);
            float lw[8], lb[8]; ld8(prm + 8 * 64, lw); ld8(prm + 9 * 64, lb);
            float o[8];
#pragma unroll
            for (int j = 0; j < 8; ++j) { const unsigned ug = g4p[j >> 1]; const float g = (j & 1) ? bfhi(ug) : bflo(ug);
                o[j] = (y[j] * rstd * lw[j] + lb[j] + bonp * xvp[j]) * silu(g); }
            *(GAS v4u*)(sb.H + (size_t)m * 1024 + h * 64 + part * 8) = (v4u){pk2(o[0], o[1]), pk2(o[2], o[3]), pk2(o[4], o[5]), pk2(o[6], o[7])};
        }
        if (c == 32) break;
        float xr[8], xk[8], xv[8], kn[8], as[8], k2[8], e[8], cum[8]; float bon;
        {   float mr[8], mk[8], mv[8], w0[8], a0[8], kkp[8], kap[8], rkp[8];
            ld8(prm, mr); ld8(prm + 64, mk); ld8(prm + 128, mv); ld8(prm + 192, w0); ld8(prm + 256, a0); ld8(prm + 320, kkp); ld8(prm + 384, kap); ld8(prm + 448, rkp);
            float kk[8]; float nrm = 0.f;
#pragma unroll
            for (int j = 0; j < 8; ++j) {
                const unsigned ur = Ln.cr4[j >> 1], uk = Ln.ck4[j >> 1], uv = Ln.cv4[j >> 1], upr = Ln.pr4[j >> 1], upk = Ln.pk4[j >> 1], upv = Ln.pv4[j >> 1], ulw = Ln.lw4[j >> 1], ula = Ln.la4[j >> 1];
                const float cr = (j & 1) ? bfhi(ur) : bflo(ur), ck = (j & 1) ? bfhi(uk) : bflo(uk), cv = (j & 1) ? bfhi(uv) : bflo(uv);
                const float pr = (j & 1) ? bfhi(upr) : bflo(upr), pk = (j & 1) ? bfhi(upk) : bflo(upk), pv = (j & 1) ? bfhi(upv) : bflo(upv);
                const float lw = (j & 1) ? bfhi(ulw) : bflo(ulw), la = (j & 1) ? bfhi(ula) : bflo(ula);
                xr[j] = cr + mr[j] * (pr - cr); xk[j] = ck + mk[j] * (pk - ck); xv[j] = cv + mv[j] * (pv - cv);
                e[j] = 0.6065306597f * __builtin_amdgcn_rcpf(1.f + __expf(-(w0[j] + lw)));
                as[j] = __builtin_amdgcn_rcpf(1.f + __expf(-(a0[j] + la)));
                kk[j] = xk[j] * kkp[j]; nrm += kk[j] * kk[j]; }
            nrm += __shfl_xor(nrm, 1); nrm += __shfl_xor(nrm, 2); nrm += __shfl_xor(nrm, 4);
            const float inv = __builtin_amdgcn_rsqf(fmaxf(nrm, 1e-24f));
            bon = 0.f;
#pragma unroll
            for (int j = 0; j < 8; ++j) { kn[j] = kk[j] * inv; k2[j] = xk[j] * (1.f + (as[j] - 1.f) * kap[j]); bon += xr[j] * k2[j] * rkp[j]; }
            bon += __shfl_xor(bon, 1); bon += __shfl_xor(bon, 2); bon += __shfl_xor(bon, 4);
#pragma unroll
            for (int j = 0; j < 8; ++j) { float x = e[j]; float y = __shfl_up(x, 8); if (tl >= 1) x += y; y = __shfl_up(x, 16); if (tl >= 2) x += y; y = __shfl_up(x, 32); if (tl >= 4) x += y; cum[j] = x; }
            if (tl == 7) { LAS float* sg = (LAS float*)(lds + L_SEG) + C.wave * 64 + part * 8;
                *(LAS f32x4*)sg = (f32x4){cum[0], cum[1], cum[2], cum[3]}; *((LAS f32x4*)sg + 1) = (f32x4){cum[4], cum[5], cum[6], cum[7]}; }
        }
        const v4u g4 = Ln.g4;
        *(LAS v4u*)(lds + L_TT + ((C.tid >> 3) * TS + (C.tid & 7) * 8) * 2) = ttn;
        __syncthreads();
        {   float off[8] = {0.f, 0.f, 0.f, 0.f, 0.f, 0.f, 0.f, 0.f};
            for (int w = 0; w < C.wave; ++w) { float t8[8]; ld8((const LAS float*)(lds + L_SEG) + w * 64 + part * 8, t8);
#pragma unroll
                for (int j = 0; j < 8; ++j) off[j] += t8[j]; }
            float at[8], bt[8], rt[8], kt[8];
#pragma unroll
            for (int j = 0; j < 8; ++j) { const float cm = cum[j] + off[j]; const float pm1 = __expf(e[j] - cm), ip = __expf(cm), pt = __builtin_amdgcn_rcpf(ip);
                at[j] = -kn[j] * pm1; bt[j] = kn[j] * as[j] * ip; rt[j] = xr[j] * pt; kt[j] = k2[j] * ip;
                if (tok == 63) ((LAS float*)(lds + L_PC))[part * 8 + j] = pt; }
            st8bf(lds, L_AT, tok, part, at); st8bf(lds, L_BT, tok, part, bt); st8bf(lds, L_RT, tok, part, rt); st8bf(lds, L_KT, tok, part, kt); st8bf(lds, L_VV, tok, part, xv);
        }
        if (c < 31) { prep_load(sb.cp, m0 + 64, c * 64 + 64, h, tok, part, Ln); ttn = *((const GAS v4u*)(sb.TT + (size_t)(bh * 32 + c + 1) * 4096) + C.tid); }
        __syncthreads();
        {   const bf16x8 a0 = frag_nat(lds + L_AT, 16 * vs, 0, C.lane), a1 = frag_nat(lds + L_AT, 16 * vs, 1, C.lane);
            const bf16x8 r0 = frag_nat(lds + L_RT, 16 * vs, 0, C.lane), r1 = frag_nat(lds + L_RT, 16 * vs, 1, C.lane);
#pragma unroll
            for (int q = 0; q < 2; ++q) { const int it = 2 * rh + q;
                const bf16x8 k0 = frag_nat(lds + L_KT, 16 * it, 0, C.lane), k1 = frag_nat(lds + L_KT, 16 * it, 1, C.lane);
                const bf16x8 bb0 = frag_nat(lds + L_BT, 16 * it, 0, C.lane), bb1 = frag_nat(lds + L_BT, 16 * it, 1, C.lane);
                f32x4 nka = {0.f, 0.f, 0.f, 0.f}, nbr = nka, nkr = nka;
                nka = MFMA16(k0, a0, nka); nka = MFMA16(k1, a1, nka);
                nbr = MFMA16(bb0, r0, nbr); nbr = MFMA16(bb1, r1, nbr);
                nkr = MFMA16(k0, r0, nkr); nkr = MFMA16(k1, r1, nkr);
                const int t = 16 * vs + l15, i0 = 16 * it + 4 * quad;
#pragma unroll
                for (int ee = 0; ee < 4; ++ee) { if (!(i0 + ee < t)) nka[ee] = 0.f; if (!(i0 + ee <= t)) { nbr[ee] = 0.f; nkr[ee] = 0.f; } }
                st_tile_T(lds + L_NKA, 16 * vs, 16 * it, C.lane, nka); st_tile_T(lds + L_NBR, 16 * vs, 16 * it, C.lane, nbr); st_tile_T(lds + L_NKR, 16 * vs, 16 * it, C.lane, nkr); }
        }
        __syncthreads();
        const int sbc = (c & 1) ? L_SB2 : L_SB, sbn = (c & 1) ? L_SB : L_SB2;
        bf16x8 v0, v1;
        {   const unsigned av = (unsigned)(size_t)(lds + L_VV) + (unsigned)(((8 * quad + (l15 >> 2)) * TS + 16 * vs + 4 * (l15 & 3)) * 2);
            const s16x4 p0 = tr_read<0>(av), p1 = tr_read<4 * TS * 2>(av), p2 = tr_read<32 * TS * 2>(av), p3 = tr_read<36 * TS * 2>(av);
            asm volatile("s_waitcnt lgkmcnt(0)" ::: "memory"); __builtin_amdgcn_sched_barrier(0);
            v0 = (bf16x8){p0[0], p0[1], p0[2], p0[3], p1[0], p1[1], p1[2], p1[3]}; v1 = (bf16x8){p2[0], p2[1], p2[2], p2[3], p3[0], p3[1], p3[2], p3[3]}; }
        {   const bf16x8 s0 = frag_nat(lds + sbc, 16 * vs, 0, C.lane), s1 = frag_nat(lds + sbc, 16 * vs, 1, C.lane);
#pragma unroll
            for (int q = 0; q < 2; ++q) { const int tt = 2 * rh + q; f32x4 z = {0.f, 0.f, 0.f, 0.f};
                z = MFMA16(frag_nat(lds + L_AT, 16 * tt, 0, C.lane), s0, z); z = MFMA16(frag_nat(lds + L_AT, 16 * tt, 1, C.lane), s1, z);
                z = MFMA16(frag_nat(lds + L_NKA, 16 * tt, 0, C.lane), v0, z); z = MFMA16(frag_nat(lds + L_NKA, 16 * tt, 1, C.lane), v1, z);
                st_tile_T(lds + L_Z, 16 * vs, 16 * tt, C.lane, z); }
        }
        __syncthreads();
        {   const bf16x8 z0 = frag_nat(lds + L_Z, 16 * vs, 0, C.lane), z1 = frag_nat(lds + L_Z, 16 * vs, 1, C.lane);
#pragma unroll
            for (int q = 0; q < 2; ++q) { const int tt = 2 * rh + q; f32x4 sa = {0.f, 0.f, 0.f, 0.f};
                sa = MFMA16(frag_nat(lds + L_TT, 16 * tt, 0, C.lane), z0, sa); sa = MFMA16(frag_nat(lds + L_TT, 16 * tt, 1, C.lane), z1, sa);
                st_tile_T(lds + L_SA, 16 * vs, 16 * tt, C.lane, sa); }
        }
        bf16x8 tb[2][2], tk[2][2];
        {   s16x4 pb[2][2][2], pk[2][2][2];
#pragma unroll
            for (int q = 0; q < 2; ++q) { const int kt0 = 16 * (2 * rh + q);
                const unsigned ab = (unsigned)(size_t)(lds + L_BT) + (unsigned)(((8 * quad + (l15 >> 2)) * TS + kt0 + 4 * (l15 & 3)) * 2);
                const unsigned ak = (unsigned)(size_t)(lds + L_KT) + (unsigned)(((8 * quad + (l15 >> 2)) * TS + kt0 + 4 * (l15 & 3)) * 2);
                pb[q][0][0] = tr_read<0>(ab); pb[q][0][1] = tr_read<4 * TS * 2>(ab); pb[q][1][0] = tr_read<32 * TS * 2>(ab); pb[q][1][1] = tr_read<36 * TS * 2>(ab);
                pk[q][0][0] = tr_read<0>(ak); pk[q][0][1] = tr_read<4 * TS * 2>(ak); pk[q][1][0] = tr_read<32 * TS * 2>(ak); pk[q][1][1] = tr_read<36 * TS * 2>(ak); }
            asm volatile("s_waitcnt lgkmcnt(0)" ::: "memory"); __builtin_amdgcn_sched_barrier(0);
#pragma unroll
            for (int q = 0; q < 2; ++q)
#pragma unroll
                for (int ks = 0; ks < 2; ++ks) {
                    tb[q][ks] = (bf16x8){pb[q][ks][0][0], pb[q][ks][0][1], pb[q][ks][0][2], pb[q][ks][0][3], pb[q][ks][1][0], pb[q][ks][1][1], pb[q][ks][1][2], pb[q][ks][1][3]};
                    tk[q][ks] = (bf16x8){pk[q][ks][0][0], pk[q][ks][0][1], pk[q][ks][0][2], pk[q][ks][0][3], pk[q][ks][1][0], pk[q][ks][1][1], pk[q][ks][1][2], pk[q][ks][1][3]}; }
        }
        __syncthreads();
        {   const bf16x8 s0 = frag_nat(lds + sbc, 16 * vs, 0, C.lane), s1 = frag_nat(lds + sbc, 16 * vs, 1, C.lane);
            const bf16x8 sa0 = frag_nat(lds + L_SA, 16 * vs, 0, C.lane), sa1 = frag_nat(lds + L_SA, 16 * vs, 1, C.lane);
            LAS float* Y = (LAS float*)(lds + L_Y);
#pragma unroll
            for (int q = 0; q < 2; ++q) { const int tt = 2 * rh + q; f32x4 yy = {0.f, 0.f, 0.f, 0.f};
                yy = MFMA16(frag_nat(lds + L_RT, 16 * tt, 0, C.lane), s0, yy); yy = MFMA16(frag_nat(lds + L_RT, 16 * tt, 1, C.lane), s1, yy);
                yy = MFMA16(frag_nat(lds + L_NBR, 16 * tt, 0, C.lane), sa0, yy); yy = MFMA16(frag_nat(lds + L_NBR, 16 * tt, 1, C.lane), sa1, yy);
                yy = MFMA16(frag_nat(lds + L_NKR, 16 * tt, 0, C.lane), v0, yy); yy = MFMA16(frag_nat(lds + L_NKR, 16 * tt, 1, C.lane), v1, yy);
                f32x4 dd = {0.f, 0.f, 0.f, 0.f};
                dd = MFMA16(tb[q][0], sa0, dd); dd = MFMA16(tb[q][1], sa1, dd); dd = MFMA16(tk[q][0], v0, dd); dd = MFMA16(tk[q][1], v1, dd);
                const int r0 = 16 * tt + 4 * quad, v = 16 * vs + l15;
#pragma unroll
                for (int ee = 0; ee < 4; ++ee) Y[(r0 + ee) * 64 + v] = yy[ee];
                const f32x4 pc = *(const LAS f32x4*)(lds + L_PC + r0 * 4);
                St[q] = (St[q] + dd) * pc;
                st_tile_T(lds + sbn, 16 * vs, 16 * tt, C.lane, St[q]); }
        }
#pragma unroll
        for (int j = 0; j < 8; ++j) xvp[j] = xv[j];
        bonp = bon; g4p = g4;
        __syncthreads();
    }
#pragma unroll
    for (int q = 0; q < 2; ++q) { float* so = sb.out + O_WKVP + ((size_t)bh * 64 + 16 * vs + l15) * 64 + 16 * (2 * rh + q) + 4 * quad; *(GAS f32x4*)so = St[q]; }
    __syncthreads();
}

constexpr int PTAB_OFF = LDSCTL_OFF + 512;
__device__ __forceinline__ const float* inptr(LAS unsigned char* ldsb, int i) {
    const LAS unsigned* p = (const LAS unsigned*)(ldsb + PTAB_OFF) + 2 * i;
    const unsigned lo = __builtin_amdgcn_readfirstlane(p[0]), hi = __builtin_amdgcn_readfirstlane(p[1]);
    return (const float*)(((unsigned long long)hi << 32) | lo);
}
struct Args { const float* in[28]; float* out; unsigned char* ws; int ph_lo, ph_hi; };
#define WSP(T, off) ((T*)(args.ws + (off)))
#define GEMM_BF16(Aptr, Bptr, Optr, Mv, Nv, Kv) do { pg8::Gemm g{Aptr, Bptr, Mv, Nv, Kv}; pg8::StaticOrder S; S.init(Mv, Nv, C.G, (int)blockIdx.x); \
        pg8::EpiBf16<0> E{Optr, Nv, nullptr, 0, 0, 1.f}; pg8::gemm_phase<pg8::EpiBf16<0>, pg8::StaticOrder, PG8_ALIGN, PG8_SP2>(C.lds + RING_OFF, g, S, E); } while (0)
__global__ void __launch_bounds__(NWAVES * 64, 2) hyb_fwd(Args args) {
    extern __shared__ __attribute__((aligned(16))) unsigned char lds[];
    LAS unsigned char* const ldsb = (LAS unsigned char*)lds;
    for (int u = threadIdx.x; u < (LDS_BYTES - LDSCTL_OFF) / 4; u += NWAVES * 64) ((LAS unsigned*)(ldsb + LDSCTL_OFF))[u] = 0u;
    __syncthreads();
    if (threadIdx.x < 28) ((LAS unsigned long long*)(ldsb + PTAB_OFF))[threadIdx.x] = (unsigned long long)args.in[threadIdx.x];
    __syncthreads();
#define INP(i) inptr(ldsb, (i))
#define MKCTX() Ctx C; { int t_ = threadIdx.x; asm volatile("" : "+v"(t_)); C.lds = ldsb; C.tid = t_; C.lane = t_ & 63; C.wave = __builtin_amdgcn_readfirstlane(t_ >> 6); \
        C.G = gridDim.x; const int bx_ = blockIdx.x; C.vcu = (C.G % 8 == 0) ? (bx_ % 8) * (C.G / 8) + bx_ / 8 : bx_; C.gw = C.vcu * NWAVES + C.wave; C.NGW = C.G * NWAVES; } \
        const int gt = C.gw * 64 + C.lane, NGT = C.NGW * 64; (void)gt; (void)NGT
    const int lo = args.ph_lo, hi = args.ph_hi;
    const bool fused = (hi - lo) > 1;
    XcdBarrier bar; bar.bar = WSP(unsigned, WS_CTL) + CW_BAR; bar.x = 0; bar.st = nullptr;
    if (fused) bar = xcd_barrier_post(WSP(unsigned, WS_CTL) + CW_BAR, (volatile LAS unsigned*)(ldsb + MISC_OFF) + 8);
#ifndef PROBE_PHASE
#define PROBE_PHASE -1
#endif
#ifndef PROBE_SUB
#define PROBE_SUB 0
#endif
#define IN(k) (lo <= (k) && (k) < hi)
#define REP(k) for (int rep_ = 0; rep_ < ((k) == PROBE_PHASE ? 2 : 1); ++rep_)
#define SEAM(k) do { if (IN(k) && IN((k) + 1)) xcd_barrier(bar); } while (0)

    if (IN(0)) REP(0) { MKCTX();
        LAS float* scr = (LAS float*)(C.lds + RING_OFF + C.wave * 16384);
        constexpr int I0 = 16 * 96, I1 = 8 * 32, I2 = 16 * 116, I3 = 16 * 32, I4 = 16 * 16, I5 = 16 * 16, I6 = 24, I7 = 24;
        constexpr int NITEMS = I0 + I1 + I2 + I3 + I4 + I5 + I6 + I7;
        for (int it = C.gw; it < NITEMS; it += C.NGW) {
            int r = it;
            if (r < I0) { p0_transpose_item(INP(14), A_IN, INP(9), WSP(bf16, WS_WAIN), 1024, 0, 0, scr, r, 96, C.lane); continue; } r -= I0;
            if (r < I1) { p0_transpose_item(INP(15), 1024, nullptr, WSP(bf16, WS_WAOUT), 512, 0, 0, scr, r, 32, C.lane); continue; } r -= I1;
            if (r < I2) { p0_transpose_item(INP(16), B_IN, INP(9) + DM, WSP(bf16, WS_WBIN), 1024, 0, 0, scr, r, 116, C.lane); continue; } r -= I2;
            if (r < I3) { p0_transpose_item(INP(17), 1024, nullptr, WSP(bf16, WS_WBOUT), 1024, 0, 0, scr, r, 32, C.lane); continue; } r -= I3;
            if (r < I4) { p0_transpose_item(INP(12), 512, INP(11), WSP(bf16, WS_WM), 1024, 0, 0, scr, r, 16, C.lane); continue; } r -= I4;
            if (r < I5) { p0_transpose_item(INP(12) + 1024 * 512, 512, INP(11) + DM, WSP(bf16, WS_WM), 1024, 0, 512, scr, r, 16, C.lane); continue; } r -= I5;
            if (r < I6) { p0_transpose_item(INP(20), RW, nullptr, WSP(bf16, WS_WL), 128, 0, 0, scr, r, 24, C.lane); continue; } r -= I6;
            p0_transpose_item(INP(22), RW, nullptr, WSP(bf16, WS_WL), 128, 64, RW, scr, r, 24, C.lane);
        }
        const v4u z4 = {0u, 0u, 0u, 0u};
        for (int i = gt; i < 16384; i += NGT) *((GAS v4u*)(WSP(bf16, WS_WBIN) + (size_t)B_IN * 1024) + i) = z4;
        for (int i = gt; i < 1536 * 8; i += NGT) { const int n = i >> 3, c = i & 7; *(GAS v4u*)(WSP(bf16, WS_WL) + (size_t)n * 128 + (n < RW ? 64 : 0) + c * 8) = z4; }
        for (int i = gt; i < 128 * 128; i += NGT) *((GAS v4u*)(WSP(bf16, WS_XN) + (size_t)NREAL * 1024) + i) = z4;
        for (int i = gt; i < 3 * 4 * 129; i += NGT) { const int g = i / (4 * 129), r = i % (4 * 129), hh = r / 129, k = r % 129; const int dil = g == 0 ? 1 : (g == 1 ? 4 : 16);
            WSP(float, WS_BT)[(g * 4 + hh) * 132 + k] = INP(13)[t5_bucket(dil * k) * 12 + g * 4 + hh]; }
        for (int m = C.gw; m < NREAL + 2048; m += C.NGW) {
            if (m < TP) rms_row_to_bf16(INP(0) + (size_t)m * DM, WSP(bf16, WS_XN) + (size_t)m * DM, C.lane);
            else if (m < NREAL) rms_row_to_bf16(INP(1) + (size_t)(m - TP) * DM, WSP(bf16, WS_XN) + (size_t)m * DM, C.lane);
            else rms_row_to_bf16(INP(2) + (size_t)(m - NREAL) * DM, WSP(bf16, WS_MEMN) + (size_t)(m - NREAL) * DM, C.lane);
        }
    } SEAM(0);
    if (IN(1)) REP(1) { MKCTX();
        GEMM_BF16(WSP(bf16, WS_XN), WSP(bf16, WS_WAIN), WSP(bf16, WS_P), MROWS, A_IN, DM);
        GEMM_BF16(WSP(bf16, WS_MEMN), WSP(bf16, WS_WM), WSP(bf16, WS_MKV), 2048, 1024, DM);
    } SEAM(1);
    if (IN(2)) REP(2) { MKCTX();
        const bf16* P = WSP(bf16, WS_P); const bf16* MKV = WSP(bf16, WS_MKV); float* out = args.out;
        for (int rp_ = 0; rp_ < (PROBE_SUB == 23 ? 2 : 1); ++rp_) {
        for (int i = gt; i < 2 * 2048 * 512; i += NGT) { const int l = i / (2048 * 512), r = (i / 512) % 2048, c = i % 512; out[O_MEM + i] = bf2f(MKV[(size_t)r * 1024 + l * 512 + c]); }
#pragma unroll
        for (int g = 0; g < 3; ++g) { const int Wg = g == 0 ? 128 : (g == 1 ? 512 : 2048); const size_t ob = g == 0 ? O_W0P : (g == 1 ? O_W1P : O_W2P);
            const int n = NBATCH * Wg * 512;
            for (int i = gt; i < n; i += NGT) { const int c = i % 512, ri = (i / 512) % Wg, b = i / (512 * Wg); const int t = SEQ - Wg + ri, kv = c >> 8, cc = c & 255;
                out[ob + i] = bf2f(P[(size_t)((b << 11) + t) * A_IN + RW + kv * RW + g * 256 + cc]); }
            const size_t os = g == 0 ? O_W0S : (g == 1 ? O_W1S : O_W2S);
            for (int i = gt; i < NSAMP * 512; i += NGT) { const int c = i % 512, r = i / 512, kv = c >> 8, cc = c & 255;
                out[os + i] = bf2f(P[(size_t)(TP + r) * A_IN + RW + kv * RW + g * 256 + cc]); } }
        }
        bf16* H = WSP(bf16, WS_H); const float* BT = WSP(float, WS_BT);
        for (int rp_ = 0; rp_ < (PROBE_SUB == 21 ? 2 : 1); ++rp_)
        for (int unit = blockIdx.x; unit < 256; unit += C.G) attn_a_unit(C, P, MKV, H, BT, unit);
        { LAS float* mg = (LAS float*)(C.lds + RING_OFF + 65536);
          for (int rp_ = 0; rp_ < (PROBE_SUB == 22 ? 2 : 1); ++rp_)
          for (int base = 0; base < NSAMP * 16; base += C.NGW) { const int task = base + C.gw; const bool on = task < NSAMP * 16;
            const int tq = task >> 2, part = task & 3, m = TP + (tq >> 2), hh = tq & 3;
            float Mo = 0.f, So = 1.f, Oo = 0.f;
            if (on) samp_part(P, BT, part == 0 ? INP(4) : (part == 1 ? INP(5) : INP(6)), MKV, INP(3), m, hh, part, 0, P + (size_t)m * A_IN + 2304 + hh * 64, C.lane, Mo, So, Oo);
            __syncthreads();
            mg[C.wave * 66 + C.lane] = Oo; if (C.lane == 0) { mg[C.wave * 66 + 64] = Mo; mg[C.wave * 66 + 65] = So; }
            __syncthreads();
            if (on && (part == 0 || part == 3)) { const bf16* prow = P + (size_t)m * A_IN; float o;
                if (part == 0) { const LAS float* w0 = mg + C.wave * 66; const float M0 = w0[64], M1 = w0[66 + 64], M2 = w0[132 + 64];
                    const float M = fmaxf(fmaxf(M0, M1), M2), e0 = __expf(M0 - M), e1 = __expf(M1 - M), e2 = __expf(M2 - M);
                    const float S = w0[65] * e0 + w0[66 + 65] * e1 + w0[132 + 65] * e2;
                    o = (w0[C.lane] * e0 + w0[66 + C.lane] * e1 + w0[132 + C.lane] * e2) / S;
                    H[(size_t)m * 512 + hh * 64 + C.lane] = (bf16)f2bf(o * silu(bf2f(prow[2560 + hh * 64 + C.lane]))); }
                else { o = Oo / So; H[(size_t)m * 512 + 256 + hh * 64 + C.lane] = (bf16)f2bf(o * silu(bf2f(prow[2560 + 256 + hh * 64 + C.lane]))); } }
          } }
    } SEAM(2);
    if (IN(3)) REP(3) { MKCTX(); GEMM_BF16(WSP(bf16, WS_H), WSP(bf16, WS_WAOUT), WSP(bf16, WS_F), MROWS, DM, 512); } SEAM(3);
    if (IN(4)) REP(4) { MKCTX();
        for (int m = C.gw; m < NREAL; m += C.NGW) { const bool samp = m >= TP;
            row_pass(WSP(bf16, WS_F) + (size_t)m * DM, samp ? INP(1) + (size_t)(m - TP) * DM : INP(0) + (size_t)m * DM,
                     args.out + (samp ? O_YS + (size_t)(m - TP) * DM : O_YP + (size_t)m * DM), INP(10), WSP(bf16, WS_XN) + (size_t)m * DM, C.lane); }
    } SEAM(4);
    if (IN(5)) REP(5) { MKCTX(); GEMM_BF16(WSP(bf16, WS_XN), WSP(bf16, WS_WBIN), WSP(bf16, WS_P), MROWS, B_INP, DM); } SEAM(5);
    if (IN(6)) REP(6) { MKCTX();
        const bf16* P = WSP(bf16, WS_P); bf16* TW = WSP(bf16, WS_TW); const float* mu = INP(18); const float* stsh = INP(8);
        for (int m = C.gw; m < NREAL; m += C.NGW) {
            const bool samp = m >= TP; const int t = samp ? ((m - TP) & 3) : (m & 2047), sb = (m - TP) >> 2;
#pragma unroll
            for (int j = 0; j < 2; ++j) { const int c = 2304 + j * 64 + C.lane;
                const float cur = bf2f(P[(size_t)m * B_INP + c]);
                float prev = 0.f; if (t > 0) prev = bf2f(P[(size_t)(m - 1) * B_INP + c]); else if (samp) prev = stsh[(size_t)sb * CSH + c];
                const float xs = cur + mu[c] * (prev - cur);
                TW[(size_t)m * 128 + j * 64 + C.lane] = (bf16)f2bf(j == 0 ? tanhf(xs) : xs); }
        }
    } SEAM(6);
    if (IN(7)) REP(7) { MKCTX(); GEMM_BF16(WSP(bf16, WS_TW), WSP(bf16, WS_WL), WSP(bf16, WS_F), MROWS, 1536, 128); } SEAM(7);
    if (IN(8)) REP(8) { MKCTX();
        ChunkP cp{WSP(bf16, WS_P), WSP(bf16, WS_F), INP(18), INP(19), INP(21), INP(23), INP(24), INP(25)};
        const int per = (3072 + C.G - 1) / C.G, task0 = (int)blockIdx.x * per; int nt = 3072 - task0; if (nt > per) nt = per;
        if (nt > 0) scan_stage_a(C, cp, WSP(bf16, WS_XN), task0, nt);
    } SEAM(8);
    if (IN(9)) REP(9) { MKCTX();
        const bf16* P = WSP(bf16, WS_P); bf16* H = WSP(bf16, WS_H);
        const int GB = C.G > 96 ? 96 : C.G, vb = (int)blockIdx.x;
        if (vb < GB) {
            ScanBP sb{{WSP(bf16, WS_P), WSP(bf16, WS_F), INP(18), INP(19), INP(21), INP(23), INP(24), INP(25)}, WSP(bf16, WS_XN), WSP(bf16, WS_H), args.out, INP(26), INP(27)};
            for (int rp = 0; rp < (PROBE_SUB == 1 ? 2 : 1); ++rp)
            for (int bh = vb; bh < 96; bh += GB) scan_stage_b(C, sb, bh);
        }
        const int GO = C.G > 96 ? C.G - 96 : C.G, ob = C.G > 96 ? vb - 96 : vb;
        if (ob >= 0) for (int rp = 0; rp < (PROBE_SUB == 2 ? 2 : 1); ++rp) {
            for (int unit = ob; unit < 256; unit += GO) attn_b_unit(C, P, WSP(bf16, WS_MKV), H, unit);
            __syncthreads();
            { ScanP sp{WSP(bf16, WS_P), WSP(bf16, WS_F), WSP(bf16, WS_H), args.out, INP(7), INP(8), INP(18), INP(19), INP(21), INP(23), INP(24), INP(25), INP(26), INP(27)};
              for (int u = 96 + ob; u < 480; u += GO) scan_unit(C, sp, u); }
            const int ogw = ob * NWAVES + C.wave, ONGW = GO * NWAVES, ogt = ogw * 64 + C.lane, ONGT = ONGW * 64;
            for (int task = ogw; task < NSAMP * 4; task += ONGW) { const int m = TP + (task >> 2), hh = task & 3;
                const bf16* prow = P + (size_t)m * B_INP;
                float Mo, So, Oo; samp_part(P, nullptr, nullptr, nullptr, INP(3), m, hh, 3, 1, prow + CSH + hh * 64, C.lane, Mo, So, Oo); const float om = Oo / So;
                H[(size_t)m * 1024 + RW + hh * 64 + C.lane] = (bf16)f2bf(om * silu(bf2f(prow[2688 + RW + hh * 64 + C.lane]))); }
            for (int i = ogt; i < NBATCH * CSH; i += ONGT) { const int b = i / CSH, c = i % CSH; args.out[O_SHP + i] = bf2f(P[(size_t)(b * SEQ + SEQ - 1) * B_INP + c]); }
            for (int i = ogt; i < SBATCH * CSH; i += ONGT) { const int sb = i / CSH, c = i % CSH; args.out[O_SHS + i] = bf2f(P[(size_t)(TP + sb * 4 + 3) * B_INP + c]); }
        }
    } SEAM(9);
    if (IN(10)) REP(10) { MKCTX(); GEMM_BF16(WSP(bf16, WS_H), WSP(bf16, WS_WBOUT), WSP(bf16, WS_F), MROWS, DM, DM); } SEAM(10);
    if (IN(11)) { MKCTX();
        for (int m = C.gw; m < NREAL; m += C.NGW) { const bool samp = m >= TP;
            float* xo = args.out + (samp ? O_YS + (size_t)(m - TP) * DM : O_YP + (size_t)m * DM);
            row_pass(WSP(bf16, WS_F) + (size_t)m * DM, xo, xo, INP(10) + DM, nullptr, C.lane); }
    }
#undef IN
#undef SEAM
}

extern "C" void kernel_launch(void* const* d_in, const int* in_sizes, int n_in, void* d_out, int out_size, void* d_ws, size_t ws_size, hipStream_t stream) {
    static int grid = 0;
    if (grid == 0) {
        if (n_in != 28 || in_sizes[0] != TP * DM || (size_t)out_size != O_END || ws_size < WS_END) {
            fprintf(stderr, "kernel_launch: unexpected shapes: n_in %d in0 %d out %d ws %zu (need >= %zu); nothing launched\n", n_in, n_in > 0 ? in_sizes[0] : -1, out_size, ws_size, (size_t)WS_END); grid = -1; return; }
        int dev = 0, cus = 0, per_cu = 0;
        if (hipGetDevice(&dev) != hipSuccess || hipDeviceGetAttribute(&cus, hipDeviceAttributeMultiprocessorCount, dev) != hipSuccess) { fprintf(stderr, "kernel_launch: device query failed\n"); grid = -1; return; }
        if (hipFuncSetAttribute((const void*)hyb_fwd, hipFuncAttributeMaxDynamicSharedMemorySize, LDS_BYTES) != hipSuccess) { fprintf(stderr, "kernel_launch: hipFuncSetAttribute failed\n"); grid = -1; return; }
        if (hipOccupancyMaxActiveBlocksPerMultiprocessor(&per_cu, (const void*)hyb_fwd, NWAVES * 64, LDS_BYTES) != hipSuccess || per_cu < 1) {
            fprintf(stderr, "kernel_launch: occupancy query reports %d workgroups per CU\n", per_cu); }
        (void)hipGetLastError();
        grid = cus;
    }
    if (grid < 0) return;
    if (hipMemsetAsync((char*)d_ws + WS_CTL, 0, CTL_ZERO_BYTES, stream) != hipSuccess) { fprintf(stderr, "kernel_launch: memset failed\n"); return; }
    Args a{};
    for (int i = 0; i < 28; ++i) a.in[i] = (const float*)d_in[i];
    a.out = (float*)d_out; a.ws = (unsigned char*)d_ws;
#if MK_N_LAUNCHES == 1
    a.ph_lo = 0; a.ph_hi = N_PHASES;
    hipLaunchKernelGGL(hyb_fwd, dim3(grid), dim3(NWAVES * 64), LDS_BYTES, stream, a);
#else
    for (int li = 0; li < N_PHASES; ++li) { a.ph_lo = li; a.ph_hi = li + 1;
        hipLaunchKernelGGL(hyb_fwd, dim3(grid), dim3(NWAVES * 64), LDS_BYTES, stream, a); }
#endif
    const hipError_t le = hipPeekAtLastError();
    if (le != hipSuccess) fprintf(stderr, "kernel_launch: launch failed: %s\n", hipGetErrorName(le));
}
```

```cpp
#include <hip/hip_runtime.h>
#include <cstdio>
#include <cstdint>
namespace pg8 {
#define PG8_LAS __attribute__((address_space(3)))
typedef unsigned short bf16_t;
typedef short bf16x8 __attribute__((ext_vector_type(8)));
typedef float f32x4 __attribute__((ext_vector_type(4)));
typedef unsigned u32x4 __attribute__((ext_vector_type(4)));
constexpr int BM = 256, BK = 64, HALF = 128, HTB = HALF * BK * 2  , STAGE_BYTES = 8 * HTB, NXCD = 8, WGM = 8;

__host__ __device__ __forceinline__ int lds_byte(int r, int c) { const int st = (r >> 4) * 2 + (c >> 5), rr = r & 15, cc = c & 31, ob = rr * 64 + cc * 2; return st * 1024 + (ob ^ (((ob >> 9) & 1) << 5)); }
__host__ __device__ __forceinline__ void stage_rc(int b, int& R, int& C) { const int st = b / 1024, sb = b % 1024, swz = sb ^ (((sb >> 9) & 1) << 5); R = (st >> 1) * 16 + swz / 64; C = (st & 1) * 32 + (swz % 64) / 2; }
__host__ __device__ __forceinline__ int perm32(int rho) { const int n = rho >> 4, i = rho & 15; return 8 * (i >> 2) + 4 * n + (i & 3); }

struct Unit { int pm, pn; };
struct Gemm { const bf16_t* A; const bf16_t* Bt; int M, N, K; };

struct StaticOrder {
    int nM, nN, nwg, G, c;
    __host__ __device__ void init(int M, int N, int G_, int c_) { nM = M / BM; nN = N / BM; nwg = nM * nN; G = G_; c = c_; }
    __host__ __device__ bool next(int i, Unit& u) const {
        const long L = (long)i * G + c; if (L >= nwg) return false;
        int wgid = (int)L; { const int q = nwg / NXCD, r = nwg % NXCD, xcd = wgid % NXCD, off = wgid / NXCD; wgid = (xcd < r ? xcd * (q + 1) : r * (q + 1) + (xcd - r) * q) + off; }
        const int nig = WGM * nN, gid = wgid / nig, fm = gid * WGM, gsz = (nM - fm) < WGM ? (nM - fm) : WGM;
        u.pm = fm + ((wgid % nig) % gsz); u.pn = (wgid % nig) / gsz; return true;
    }
    __device__ __forceinline__ void a_ready(const Unit&) const {}
    __device__ __forceinline__ void done(const Unit&) const {}
};

__device__ __forceinline__ unsigned cvt_pk_bf16(float lo, float hi) { unsigned r; asm volatile("v_cvt_pk_bf16_f32 %0, %1, %2" : "=v"(r) : "v"(lo), "v"(hi)); return r; }
typedef float f32x2 __attribute__((ext_vector_type(2)));
__device__ __forceinline__ f32x2 gelu_pk(f32x2 v) {
    const f32x2 av = __builtin_elementwise_abs(v), d = av * 0.2316418882f + 1.0f;
    f32x2 t; t.x = __builtin_amdgcn_rcpf(d.x); t.y = __builtin_amdgcn_rcpf(d.y);
    f32x2 q = t * 0.5307027145f + (-0.7265760135f); q = q * t + 0.7107068705f; q = q * t + (-0.142248368f); q = q * t + 0.127414796f; q = q * t;
    const f32x2 s = (v * v) * (-0.72134752044f);
    f32x2 e; e.x = __builtin_amdgcn_exp2f(s.x); e.y = __builtin_amdgcn_exp2f(s.y);
    const f32x2 m = v * (q * e), r = v - m;
    f32x2 o; o.x = v.x < 0.f ? m.x : r.x; o.y = v.y < 0.f ? m.y : r.y; return o;
}

template <int ACT  > struct EpiBf16 {
    static constexpr bool PERM = true, AFTER_DRAIN = false; static_assert(ACT == 0 || ACT == 1, "EpiBf16: ACT is 0 (none) or 1 (gelu_pk)");
    bf16_t* O; int ldc; const float* bias; int split_cols; size_t split_stride; float scale0;
    __device__ __forceinline__ void operator()(const f32x4 (&acc)[2][2][4][2], const Unit& u, int wr, int wc, int fr, int fq) const {
        const int row0 = u.pm * BM + wr * 64 + fr; int colt = u.pn * BM; bf16_t* base = O;
        float sc = 1.f; if (split_cols) { const int t = colt / split_cols; base += (size_t)t * split_stride; colt -= t * split_cols; if (t == 0) sc = scale0; }
        const int col0 = colt + wc * 32 + 8 * fq, bcol0 = u.pn * BM + wc * 32 + 8 * fq;
        f32x4 bv[2][2];
#pragma unroll
        for (int bj = 0; bj < 2; ++bj)
#pragma unroll
            for (int n = 0; n < 2; ++n) bv[bj][n] = bias ? *(const f32x4*)(bias + bcol0 + bj * HALF + 4 * n) : (f32x4){0.f, 0.f, 0.f, 0.f};
#pragma unroll
        for (int ai = 0; ai < 2; ++ai)
#pragma unroll
            for (int m = 0; m < 4; ++m) { bf16_t* rowp = base + (size_t)(row0 + ai * HALF + m * 16) * ldc + col0;
#pragma unroll
                for (int bj = 0; bj < 2; ++bj) { f32x4 v0 = acc[ai][bj][m][0] + bv[bj][0], v1 = acc[ai][bj][m][1] + bv[bj][1];
                    if (ACT == 1) { f32x2 a = gelu_pk((f32x2){v0[0], v0[1]}), b = gelu_pk((f32x2){v0[2], v0[3]}), c = gelu_pk((f32x2){v1[0], v1[1]}), d = gelu_pk((f32x2){v1[2], v1[3]});
                        v0 = (f32x4){a.x, a.y, b.x, b.y}; v1 = (f32x4){c.x, c.y, d.x, d.y}; }
                    v0 = v0 * sc; v1 = v1 * sc; u32x4 w; w.x = cvt_pk_bf16(v0[0], v0[1]); w.y = cvt_pk_bf16(v0[2], v0[3]); w.z = cvt_pk_bf16(v1[0], v1[1]); w.w = cvt_pk_bf16(v1[2], v1[3]);
                    *(u32x4*)(rowp + bj * HALF) = w; } }
    }
};
template <class Epi, class Sched, bool ALIGN_EPI = false, bool SP2 = false>
__device__ __forceinline__ void gemm_phase(PG8_LAS unsigned char* lds, const Gemm g, const Sched& S, const Epi& E) {
    const int tid = threadIdx.x, wid = __builtin_amdgcn_readfirstlane(tid >> 6), lane = tid & 63, wr = wid >> 2, wc = wid & 3, fr = lane & 15, fq = lane >> 4;
    const int K = g.K, nt = K / BK;
    unsigned voffA[2], voffB[2];
#pragma unroll
    for (int i = 0; i < 2; ++i) { int R, C; stage_rc(tid * 16 + i * 8192, R, C); const int Rb = Epi::PERM ? ((R & ~31) + perm32(R & 31)) : R;
        voffA[i] = (unsigned)(R * K + C) * 2u; voffB[i] = (unsigned)(Rb * K + C) * 2u; }
    const size_t kstep = (size_t)(BK * 2);
    const size_t hstep = (size_t)HALF * K * 2;
    const size_t tstep = 2 * hstep;
    const unsigned ldsw = (unsigned)wid * 1024u;
    const int aoff = lds_byte(wr * 64 + fr, fq * 8), boff = lds_byte(wc * 32 + fr, fq * 8);
#define PG8_SA(b, h) (((b) * 2 + (h)) * HTB)
#define PG8_SB(b, h) ((4 + (b) * 2 + (h)) * HTB)
#define PG8_STAGE(bufoff, gbase, voff) do { _Pragma("unroll") for (int _i = 0; _i < 2; ++_i) \
        __builtin_amdgcn_global_load_lds((const unsigned*)((const char*)(gbase) + (voff)[_i]), (PG8_LAS unsigned*)(lds + (bufoff) + ldsw + _i * 8192), 16, 0, 0); } while (0)
#define PG8_LDA(dst, b, h) do { _Pragma("unroll") for (int m = 0; m < 4; ++m) _Pragma("unroll") for (int k = 0; k < 2; ++k) dst[m][k] = *(const PG8_LAS bf16x8*)(lds + PG8_SA(b, h) + aoff + m * 2048 + k * 1024); } while (0)
#define PG8_LDB(dst, b, h) do { _Pragma("unroll") for (int n = 0; n < 2; ++n) _Pragma("unroll") for (int k = 0; k < 2; ++k) dst[n][k] = *(const PG8_LAS bf16x8*)(lds + PG8_SB(b, h) + boff + n * 2048 + k * 1024); } while (0)
#define PG8_MMA(ai, bj, At, Bt) do { __builtin_amdgcn_s_setprio(1); _Pragma("unroll") for (int m = 0; m < 4; ++m) _Pragma("unroll") for (int n = 0; n < 2; ++n) _Pragma("unroll") for (int k = 0; k < 2; ++k) \
        acc[ai][bj][m][n] = __builtin_amdgcn_mfma_f32_16x16x32_bf16(Bt[n][k], At[m][k], acc[ai][bj][m][n], 0, 0, 0); __builtin_amdgcn_s_setprio(0); } while (0)
#define PG8_WAIT_V(n) asm volatile("s_waitcnt vmcnt(" #n ")" ::: "memory")
#define PG8_WAIT_L(n) asm volatile("s_waitcnt lgkmcnt(" #n ")" ::: "memory")
#define PG8_BAR __builtin_amdgcn_s_barrier()
#define PG8_SCHED __builtin_amdgcn_sched_barrier(0)
    Unit cur, nxt; int ui = 0;
    if (!S.next(0, cur)) return;
    f32x4 acc[2][2][4][2];
#pragma unroll
    for (int a = 0; a < 2; ++a)
#pragma unroll
        for (int b = 0; b < 2; ++b)
#pragma unroll
            for (int m = 0; m < 4; ++m)
#pragma unroll
                for (int n = 0; n < 2; ++n) acc[a][b][m][n] = (f32x4){0.f, 0.f, 0.f, 0.f};
    bf16x8 At[4][2], B0[2][2], B1[2][2];
    const char* cA = (const char*)g.A + (size_t)cur.pm * tstep; const char* cB = (const char*)g.Bt + (size_t)cur.pn * tstep;
    S.a_ready(cur);
    if constexpr (SP2) {
        PG8_STAGE(PG8_SB(0, 0), cB, voffB); PG8_STAGE(PG8_SB(0, 1), cB + hstep, voffB); PG8_STAGE(PG8_SA(0, 0), cA, voffA); PG8_STAGE(PG8_SA(0, 1), cA + hstep, voffA);
        if (wr == 1) PG8_BAR;
        PG8_WAIT_V(2); PG8_BAR;
        PG8_STAGE(PG8_SB(1, 0), cB + kstep, voffB); PG8_STAGE(PG8_SA(1, 0), cA + kstep, voffA); PG8_STAGE(PG8_SB(1, 1), cB + hstep + kstep, voffB);
        PG8_WAIT_V(6); PG8_BAR;
    } else {
        PG8_STAGE(PG8_SB(0, 0), cB, voffB); PG8_STAGE(PG8_SA(0, 0), cA, voffA); PG8_STAGE(PG8_SB(0, 1), cB + hstep, voffB); PG8_STAGE(PG8_SA(0, 1), cA + hstep, voffA);
        if (wr == 1) PG8_BAR;
        PG8_WAIT_V(4); PG8_BAR;
        PG8_STAGE(PG8_SB(1, 0), cB + kstep, voffB); PG8_STAGE(PG8_SA(1, 0), cA + kstep, voffA); PG8_STAGE(PG8_SB(1, 1), cB + hstep + kstep, voffB);
        PG8_WAIT_V(6); PG8_BAR;
    }
    for (;;) {
        const bool has_next = S.next(ui + 1, nxt);
        const char* nA = has_next ? (const char*)g.A + (size_t)nxt.pm * tstep : cA; const char* nB = has_next ? (const char*)g.Bt + (size_t)nxt.pn * tstep : cB;
        for (int t = 0; t < nt; t += 2) {
            const bool last = (t == nt - 2);
            const char* a1 = cA + (size_t)(t + 1) * kstep;
            const char* a2 = last ? nA : cA + (size_t)(t + 2) * kstep; const char* b2 = last ? nB : cB + (size_t)(t + 2) * kstep;
            const char* a3 = a2 + kstep; const char* b3 = b2 + kstep;
            if (last && has_next) S.a_ready(nxt);
            if constexpr (SP2) {
            PG8_LDB(B0, 0, 0); PG8_LDB(B1, 0, 1); PG8_SCHED; PG8_LDA(At, 0, 0); PG8_STAGE(PG8_SA(1, 1), a1 + hstep, voffA);
            PG8_WAIT_V(8); PG8_WAIT_L(0); PG8_BAR; PG8_MMA(0, 0, At, B0); PG8_MMA(0, 1, At, B1); PG8_BAR; PG8_SCHED;
            PG8_LDA(At, 0, 1); PG8_STAGE(PG8_SB(0, 0), b2, voffB); PG8_STAGE(PG8_SB(0, 1), b2 + hstep, voffB); PG8_STAGE(PG8_SA(0, 0), a2, voffA);
            PG8_WAIT_V(8); PG8_WAIT_L(0); PG8_BAR; PG8_MMA(1, 0, At, B0); PG8_MMA(1, 1, At, B1); PG8_BAR; PG8_SCHED;
            PG8_LDB(B0, 1, 0); PG8_LDB(B1, 1, 1); PG8_SCHED; PG8_LDA(At, 1, 0); PG8_STAGE(PG8_SA(0, 1), a2 + hstep, voffA);
            PG8_WAIT_V(8); PG8_WAIT_L(0); PG8_BAR; PG8_MMA(0, 0, At, B0); PG8_MMA(0, 1, At, B1); PG8_BAR; PG8_SCHED;
            PG8_LDA(At, 1, 1); PG8_STAGE(PG8_SB(1, 0), b3, voffB); PG8_STAGE(PG8_SB(1, 1), b3 + hstep, voffB); PG8_STAGE(PG8_SA(1, 0), a3, voffA);
            PG8_WAIT_V(8); PG8_WAIT_L(0); PG8_BAR; PG8_MMA(1, 0, At, B0); PG8_MMA(1, 1, At, B1); PG8_BAR; PG8_SCHED;
            } else {
            PG8_LDB(B0, 0, 0); PG8_SCHED; PG8_LDA(At, 0, 0); PG8_STAGE(PG8_SA(1, 1), a1 + hstep, voffA);
            PG8_WAIT_L(8); PG8_BAR; PG8_WAIT_L(0); PG8_MMA(0, 0, At, B0); PG8_BAR; PG8_SCHED;
            PG8_LDB(B1, 0, 1); PG8_STAGE(PG8_SB(0, 0), b2, voffB);
            PG8_BAR; PG8_WAIT_L(0); PG8_MMA(0, 1, At, B1); PG8_BAR;
            PG8_LDA(At, 0, 1); PG8_STAGE(PG8_SA(0, 0), a2, voffA);
            PG8_BAR; PG8_WAIT_L(0); PG8_MMA(1, 0, At, B0); PG8_BAR; PG8_SCHED;
            PG8_STAGE(PG8_SB(0, 1), b2 + hstep, voffB);
            PG8_WAIT_V(6); PG8_BAR; PG8_MMA(1, 1, At, B1); PG8_BAR;
            PG8_LDB(B0, 1, 0); PG8_SCHED; PG8_LDA(At, 1, 0); PG8_STAGE(PG8_SA(0, 1), a2 + hstep, voffA);
            PG8_WAIT_L(8); PG8_BAR; PG8_WAIT_L(0); PG8_MMA(0, 0, At, B0); PG8_BAR; PG8_SCHED;
            PG8_LDB(B1, 1, 1); PG8_STAGE(PG8_SB(1, 0), b3, voffB);
            PG8_BAR; PG8_WAIT_L(0); PG8_MMA(0, 1, At, B1); PG8_BAR;
            PG8_LDA(At, 1, 1); PG8_STAGE(PG8_SA(1, 0), a3, voffA);
            PG8_BAR; PG8_WAIT_L(0); PG8_MMA(1, 0, At, B0); PG8_BAR; PG8_SCHED;
            PG8_STAGE(PG8_SB(1, 1), b3 + hstep, voffB);
            PG8_WAIT_V(6); PG8_BAR; PG8_MMA(1, 1, At, B1); PG8_BAR;
            }
        }
        if constexpr (ALIGN_EPI) { if (wr == 0) PG8_BAR; }
        if constexpr (!Epi::AFTER_DRAIN) { E(acc, cur, wr, wc, fr, fq); S.done(cur); }
        if (!has_next) break;
#pragma unroll
        for (int a = 0; a < 2; ++a)
#pragma unroll
            for (int b = 0; b < 2; ++b)
#pragma unroll
                for (int m = 0; m < 4; ++m)
#pragma unroll
                    for (int n = 0; n < 2; ++n) acc[a][b][m][n] = (f32x4){0.f, 0.f, 0.f, 0.f};
        cur = nxt; cA = nA; cB = nB; ++ui;
        if constexpr (ALIGN_EPI) { if (wr == 1) PG8_BAR; }
    }
    PG8_WAIT_V(0);
    if constexpr (!ALIGN_EPI) { if (wr == 0) PG8_BAR; }
    PG8_BAR;
    if constexpr (Epi::AFTER_DRAIN) { E.fused(acc, cur, wr, wc, fr, fq, lds, wid, lane); S.done(cur); }
#undef PG8_SA
#undef PG8_SB
#undef PG8_STAGE
#undef PG8_LDA
#undef PG8_LDB
#undef PG8_MMA
#undef PG8_WAIT_V
#undef PG8_WAIT_L
#undef PG8_BAR
#undef PG8_SCHED
}
}

#ifndef PG8_SP2
#define PG8_SP2 true
#endif
#ifndef PG8_ALIGN
#define PG8_ALIGN true
#endif

constexpr int NWAVES = 8;
#ifndef MK_N_LAUNCHES
#define MK_N_LAUNCHES 1
#endif
constexpr int N_PHASES = 10;
constexpr int TP = 16384, NSAMP = 128, NREAL = TP + NSAMP, MROWS = 16640, DM = 1024;
constexpr int SEQ = 2048, NBATCH = 8, SBATCH = 32, STOK = 4, NMEM = 256;
constexpr int A_IN = 3072, B_IN = 3712, B_INP = 3840, CSH = 2432, RW = 768;
constexpr float RMS_EPS = 1e-6f, GN_EPS = 64e-5f;
constexpr size_t O_YP = 0, O_YS = 16777216, O_MEM = 16908288, O_W0P = 19005440, O_W1P = 19529728, O_W2P = 21626880,
                 O_W0S = 30015488, O_W1S = 30081024, O_W2S = 30146560, O_WKVP = 30212096, O_WKVS = 30605312, O_SHP = 32178176, O_SHS = 32197632, O_END = 32275456;
constexpr size_t MiB = 1u << 20;
constexpr size_t WS_CTL = 0, CTL_ZERO_BYTES = 1 * MiB;
constexpr size_t WS_WAIN = 1 * MiB, WS_WAOUT = 7 * MiB, WS_WBIN = 8 * MiB, WS_WBOUT = 16 * MiB, WS_WM = 18 * MiB, WS_WL = 20 * MiB, WS_BT = 20 * MiB + 512 * 1024;
constexpr size_t WS_MEMN = 21 * MiB, WS_MKV = 25 * MiB, WS_TW = 29 * MiB, WS_XN = 34 * MiB, WS_H = 67 * MiB, WS_F = 100 * MiB, WS_P = 149 * MiB, WS_END = 271 * MiB + 1125 * 41472 + 65536;
constexpr int CW_TMO = 0, CW_BAR = 4096;

constexpr int RING_OFF = 0, RING_BYTES = 161792;
constexpr int LDSCTL_OFF = RING_BYTES, MISC_OFF = LDSCTL_OFF + 320;
constexpr int LDS_BYTES = 163840;

#define GAS __attribute__((address_space(1)))
#define LAS __attribute__((address_space(3)))
typedef unsigned short bf16;
typedef unsigned v4u __attribute__((ext_vector_type(4)));
typedef unsigned v2u __attribute__((ext_vector_type(2)));
typedef float f32x4 __attribute__((ext_vector_type(4)));
typedef GAS unsigned gu32;
#define RLX_AGENT __ATOMIC_RELAXED, __HIP_MEMORY_SCOPE_AGENT
#define LDS_WAIT() asm volatile("s_waitcnt lgkmcnt(0)" ::: "memory")
#define VM_WAIT() asm volatile("s_waitcnt vmcnt(0)" ::: "memory")
__device__ __forceinline__ unsigned f2bf(float f) { unsigned u = __builtin_bit_cast(unsigned, f); return (u + 0x7fffu + ((u >> 16) & 1u)) >> 16; }
typedef float f32x2_t __attribute__((ext_vector_type(2))); typedef __bf16 bf16x2_t __attribute__((ext_vector_type(2)));
__device__ __forceinline__ unsigned pk2(float lo, float hi) { const f32x2_t v = {lo, hi}; const bf16x2_t b = __builtin_convertvector(v, bf16x2_t); return __builtin_bit_cast(unsigned, b); }
__device__ __forceinline__ float bflo(unsigned u) { return __builtin_bit_cast(float, u << 16); }
__device__ __forceinline__ float bfhi(unsigned u) { return __builtin_bit_cast(float, u & 0xffff0000u); }
__device__ __forceinline__ float bf2f(bf16 h) { return __builtin_bit_cast(float, (unsigned)h << 16); }

#define XB_TMO      128
#define XB_XCNT(j)  (256  + 64 * (j))
#define XB_XSUB(j)  (1280 + 64 * (j))
#define XB_XGEN(j)  (2304 + 64 * (j))
#define XB_TOP      3328
#define XB_TOPGEN   3392
#define XCD_BAR_WORDS 3456
#define XB_SPIN_CAP (1u << 20)
__device__ __forceinline__ unsigned xb_ld(unsigned* p)              { return __hip_atomic_load(p, __ATOMIC_RELAXED, __HIP_MEMORY_SCOPE_AGENT); }
__device__ __forceinline__ unsigned xb_add(unsigned* p, unsigned v) { return __hip_atomic_fetch_add(p, v, __ATOMIC_RELAXED, __HIP_MEMORY_SCOPE_AGENT); }
__device__ __forceinline__ unsigned xb_xcc_id() { return (unsigned)__builtin_amdgcn_s_getreg((3 << 11) | 20) & 0xFu; }
#define XB_SPIN(cond, bar) do { unsigned _sp = 0; while (cond) { __builtin_amdgcn_s_sleep(1); \
    if ((++_sp & 255u) == 0u) { if (xb_ld(&(bar)[XB_TMO])) break; if (_sp > XB_SPIN_CAP) { atomicAdd(&(bar)[XB_TMO], 1u); break; } } } } while (0)
struct XcdBarrier { unsigned* bar; unsigned x; volatile LAS unsigned* st; };
__device__ __forceinline__ XcdBarrier xcd_barrier_post(unsigned* bar, volatile LAS unsigned* st) {
    XcdBarrier b; b.bar = bar; b.x = xb_xcc_id(); b.st = st;
    if (threadIdx.x == 0) (void)xb_add(&bar[XB_XCNT(b.x)], 1u);
    return b;
}
__device__ __forceinline__ void xcd_barrier_complete(unsigned* bar, unsigned x, unsigned& nloc, unsigned& nx) {
    const unsigned G = gridDim.x * gridDim.y * gridDim.z;
    unsigned sum, cnt, mine, sp = 0u;
    for (;;) {
        sum = 0u; cnt = 0u; mine = 0u;
#pragma unroll
        for (unsigned j = 0; j < 16; ++j) { const unsigned c = xb_ld(&bar[XB_XCNT(j)]); sum += c; cnt += (c > 0u) ? 1u : 0u; mine = (j == x) ? c : mine; }
        if (sum == G) break;
        __builtin_amdgcn_s_sleep(1);
        if ((++sp & 255u) == 0u) { if (xb_ld(&bar[XB_TMO])) break; if (sp > XB_SPIN_CAP) { atomicAdd(&bar[XB_TMO], 1u); break; } }
    }
    nloc = mine > 0u ? mine : 1u; nx = cnt > 0u ? cnt : 1u;
}
__device__ __forceinline__ void xcd_barrier(const XcdBarrier& b) {
    asm volatile("s_waitcnt vmcnt(0)" ::: "memory");
    __syncthreads();
    if (threadIdx.x == 0) {
        unsigned* bar = b.bar;
        __builtin_amdgcn_s_waitcnt(0);
        unsigned nloc = b.st[0], nx = b.st[1];
        if (nloc == 0u) { xcd_barrier_complete(bar, b.x, nloc, nx); b.st[0] = nloc; b.st[1] = nx; }
        const unsigned old = xb_add(&bar[XB_XSUB(b.x)], 1u);
        const unsigned gen = old / nloc;
        if (old + 1u == (gen + 1u) * nloc) {
            __builtin_amdgcn_fence(__ATOMIC_RELEASE, "agent");
            asm volatile("s_waitcnt vmcnt(0)" ::: "memory");
            const unsigned og = xb_add(&bar[XB_TOP], 1u);
            const unsigned tg = og / nx;
            if (og + 1u == (tg + 1u) * nx) xb_add(&bar[XB_TOPGEN], 1u);
            else XB_SPIN(xb_ld(&bar[XB_TOPGEN]) == tg, bar);
            __builtin_amdgcn_fence(__ATOMIC_ACQUIRE, "agent");
            xb_add(&bar[XB_XGEN(b.x)], 1u);
            asm volatile("s_waitcnt vmcnt(0)" ::: "memory");
        } else {
            XB_SPIN(xb_ld(&bar[XB_XGEN(b.x)]) == gen, bar);
            __builtin_amdgcn_fence(__ATOMIC_ACQUIRE, "agent");
            asm volatile("s_waitcnt vmcnt(0)" ::: "memory");
        }
    }
    __syncthreads();
}

struct Ctx { LAS unsigned char* lds; int tid, lane, wave, vcu, G, gw, NGW; };

__device__ __forceinline__ float wave_sum(float v) {
#pragma unroll
    for (int o = 1; o < 64; o <<= 1) v += __shfl_xor(v, o);
    return v;
}
__device__ __forceinline__ float wave_max(float v) {
#pragma unroll
    for (int o = 1; o < 64; o <<= 1) v = fmaxf(v, __shfl_xor(v, o));
    return v;
}
__device__ __forceinline__ float rdlane(float v, int l) { return __builtin_bit_cast(float, __builtin_amdgcn_readlane(__builtin_bit_cast(int, v), l)); }

__device__ __forceinline__ void p0_transpose_item(const float* W, int N, const float* gain, bf16* WT, int ldo, int col_off, int row_off, LAS float* scr, int item, int nblk, int lane) {
    const int kb = item / nblk, nb = item % nblk, k0 = 64 * kb, n0 = 32 * nb;
#pragma unroll 8
    for (int i = 0; i < 32; ++i) { const int kk = 2 * i + (lane >> 5); const float g = gain ? gain[k0 + kk] : 1.f; scr[kk * 33 + (lane & 31)] = W[(size_t)(k0 + kk) * N + n0 + (lane & 31)] * g; }
    LDS_WAIT(); asm volatile("" ::: "memory");
    const int c = lane & 7;
#pragma unroll
    for (int j = 0; j < 4; ++j) { const int n = (lane >> 3) + 8 * j; const LAS float* s = scr + (8 * c) * 33 + n;
        v4u o; o.x = pk2(s[0 * 33], s[1 * 33]); o.y = pk2(s[2 * 33], s[3 * 33]); o.z = pk2(s[4 * 33], s[5 * 33]); o.w = pk2(s[6 * 33], s[7 * 33]);
        *(GAS v4u*)(WT + (size_t)(row_off + n0 + n) * ldo + col_off + k0 + 8 * c) = o; }
    LDS_WAIT(); asm volatile("" ::: "memory");
}
__device__ __forceinline__ void rms_row_to_bf16(const float* xrow, bf16* orow, int lane) {
    const GAS f32x4* xr = (const GAS f32x4*)xrow + lane;
    f32x4 v[4]; float s = 0.f;
#pragma unroll
    for (int j = 0; j < 4; ++j) { v[j] = xr[64 * j]; s += (v[j].x * v[j].x + v[j].y * v[j].y) + (v[j].z * v[j].z + v[j].w * v[j].w); }
    const float r = 1.f / sqrtf(wave_sum(s) * (1.f / DM) + RMS_EPS);
    GAS unsigned long long* o8 = (GAS unsigned long long*)orow + lane;
#pragma unroll
    for (int j = 0; j < 4; ++j) o8[64 * j] = (unsigned long long)pk2(v[j].x * r, v[j].y * r) | ((unsigned long long)pk2(v[j].z * r, v[j].w * r) << 32);
}
__device__ __forceinline__ int t5_bucket(int dist) {
    if (dist < 16) return dist;
    const double x = log((double)dist / 16.0) / log(128.0) * 16.0;
    int large = 16 + (int)x; return large < 31 ? large : 31;
}

__device__ __forceinline__ void ldq64(const bf16* p, float (&q)[64]) {
#pragma unroll
    for (int i = 0; i < 8; ++i) { const v4u u = *(const GAS v4u*)(p + 8 * i);
        q[8 * i + 0] = bflo(u.x); q[8 * i + 1] = bfhi(u.x); q[8 * i + 2] = bflo(u.y); q[8 * i + 3] = bfhi(u.y);
        q[8 * i + 4] = bflo(u.z); q[8 * i + 5] = bfhi(u.z); q[8 * i + 6] = bflo(u.w); q[8 * i + 7] = bfhi(u.w); }
}
__device__ __forceinline__ float dot64_bf(const float (&q)[64], const bf16* p) {
    float s0 = 0.f, s1 = 0.f;
#pragma unroll
    for (int i = 0; i < 8; ++i) { const v4u u = *(const GAS v4u*)(p + 8 * i);
        s0 += q[8 * i + 0] * bflo(u.x); s1 += q[8 * i + 1] * bfhi(u.x); s0 += q[8 * i + 2] * bflo(u.y); s1 += q[8 * i + 3] * bfhi(u.y);
        s0 += q[8 * i + 4] * bflo(u.z); s1 += q[8 * i + 5] * bfhi(u.z); s0 += q[8 * i + 6] * bflo(u.w); s1 += q[8 * i + 7] * bfhi(u.w); }
    return s0 + s1;
}
__device__ __forceinline__ float dot64_f32(const float (&q)[64], const float* p) {
    float s0 = 0.f, s1 = 0.f;
#pragma unroll
    for (int i = 0; i < 16; ++i) { const f32x4 u = *(const GAS f32x4*)(p + 4 * i);
        s0 += q[4 * i + 0] * u.x; s1 += q[4 * i + 1] * u.y; s0 += q[4 * i + 2] * u.z; s1 += q[4 * i + 3] * u.w; }
    return s0 + s1;
}
__device__ __forceinline__ float silu(float x) { return x / (1.f + __expf(-x)); }

__device__ __forceinline__ float cross_attn_task(const bf16* MKV, const float* c_mem, const bf16* qptr, int m, int hh, int layer, int lane) {
    float q[64]; ldq64(qptr, q);
    const bool samp = m >= TP;
    float l[4]; float mx = -3.0e38f, o = 0.f, s = 0.f;
    if (!samp) {
        const bf16* kb = MKV + (size_t)((m >> 11) * NMEM) * 1024 + layer * 512 + hh * 64;
#pragma unroll
        for (int r = 0; r < 4; ++r) { l[r] = dot64_bf(q, kb + (size_t)(r * 64 + lane) * 1024) * 0.125f; mx = fmaxf(mx, l[r]); }
        mx = wave_max(mx);
#pragma unroll
        for (int r = 0; r < 4; ++r) { l[r] = __expf(l[r] - mx); s += l[r]; }
        s = wave_sum(s);
#pragma unroll
        for (int r = 0; r < 4; ++r)
            for (int kk = 0; kk < 64; ++kk) o += rdlane(l[r], kk) * bf2f(kb[(size_t)(r * 64 + kk) * 1024 + 256 + lane]);
    } else {
        const float* kf = c_mem + ((size_t)(layer * SBATCH + ((m - TP) >> 2)) * NMEM) * 512 + hh * 64;
#pragma unroll
        for (int r = 0; r < 4; ++r) { l[r] = dot64_f32(q, kf + (size_t)(r * 64 + lane) * 512) * 0.125f; mx = fmaxf(mx, l[r]); }
        mx = wave_max(mx);
#pragma unroll
        for (int r = 0; r < 4; ++r) { l[r] = __expf(l[r] - mx); s += l[r]; }
        s = wave_sum(s);
#pragma unroll
        for (int r = 0; r < 4; ++r)
            for (int kk = 0; kk < 64; ++kk) o += rdlane(l[r], kk) * kf[(size_t)(r * 64 + kk) * 512 + 256 + lane];
    }
    return o / s;
}

template <int G>
__device__ __forceinline__ void attn_group(const bf16* P, const float* BT, const float* cw, int m, int hh, int lane, float& Mx, float& Ss, float& O) {
    constexpr int dil = G == 0 ? 1 : (G == 1 ? 4 : 16), Wg = G == 0 ? 128 : (G == 1 ? 512 : 2048), head0 = G * 4;
    const bool samp = m >= TP;
    const int b = m >> 11, t = m & 2047, sb = (m - TP) >> 2, st = (m - TP) & 3, head = head0 + hh;
    float q[64]; ldq64(P + (size_t)m * A_IN + head * 64, q);
    const float* bt = BT + (G * 4 + hh) * 132;
    float l[3]; float gm = -3.0e38f;
#pragma unroll
    for (int r = 0; r < 3; ++r) { const int kidx = r * 64 + lane; float lv = -3.0e38f;
        if (kidx < 129) {
            if (!samp) { const int tk = t - dil * kidx; if (tk >= 0) lv = dot64_bf(q, P + (size_t)((b << 11) + tk) * A_IN + RW + head * 64) * 0.125f + bt[kidx]; }
            else { const int idx = Wg + st - dil * kidx;
                if (idx >= Wg) lv = dot64_bf(q, P + (size_t)(TP + sb * 4 + idx - Wg) * A_IN + RW + head * 64) * 0.125f + bt[kidx];
                else lv = dot64_f32(q, cw + ((size_t)(sb * Wg + idx) * 2) * 256 + hh * 64) * 0.125f + bt[kidx]; }
        }
        l[r] = lv; gm = fmaxf(gm, lv); }
    gm = wave_max(gm);
    const float Mn = fmaxf(Mx, gm), sc = __expf(Mx - Mn);
    float ps = 0.f;
#pragma unroll
    for (int r = 0; r < 3; ++r) { l[r] = l[r] > -1.0e38f ? __expf(l[r] - Mn) : 0.f; ps += l[r]; }
    Ss = Ss * sc + wave_sum(ps); O *= sc; Mx = Mn;
#pragma unroll
    for (int r = 0; r < 3; ++r)
        for (int kk = 0; kk < 64; ++kk) { const int kidx = r * 64 + kk; if (kidx >= 129) break;
            const float p = rdlane(l[r], kk);
            if (p != 0.f) { float v;
                if (!samp) { const int tk = t - dil * kidx; v = bf2f(P[(size_t)((b << 11) + tk) * A_IN + 2 * RW + head * 64 + lane]); }
                else { const int idx = Wg + st - dil * kidx;
                    if (idx >= Wg) v = bf2f(P[(size_t)(TP + sb * 4 + idx - Wg) * A_IN + 2 * RW + head * 64 + lane]);
                    else v = cw[((size_t)(sb * Wg + idx) * 2 + 1) * 256 + hh * 64 + lane]; }
                O += p * v; } }
}


__device__ __forceinline__ void samp_dot_rounds3(const bf16* P, const float* cw, const float* bt, const float (&q)[64], int g, int sb, int st, int hh, int lane, float (&l)[3]) {
    const int dil = g == 0 ? 1 : (g == 1 ? 4 : 16), Wg = g == 0 ? 128 : (g == 1 ? 512 : 2048), head = g * 4 + hh;
#pragma unroll
    for (int r = 0; r < 3; ++r) { const int kidx = r * 64 + lane; float lv = -3.0e38f;
        if (kidx < 129) { const int idx = Wg + st - dil * kidx;
            if (idx >= Wg) lv = dot64_bf(q, P + (size_t)(TP + sb * 4 + idx - Wg) * A_IN + RW + head * 64) * 0.125f + bt[kidx];
            else lv = dot64_f32(q, cw + ((size_t)(sb * Wg + idx) * 2) * 256 + hh * 64) * 0.125f + bt[kidx]; }
        l[r] = lv; }
}
__device__ __forceinline__ void samp_part(const bf16* P, const float* BT, const float* cw, const bf16* MKVunused, const float* c_mem, int m, int hh, int part, int layer, const bf16* qmem, int lane, float& Mo, float& So, float& Oo) {
    const int sb = (m - TP) >> 2, st = (m - TP) & 3;
    float q[64];
    if (part < 3) {
        const int g = part, dil = g == 0 ? 1 : (g == 1 ? 4 : 16), Wg = g == 0 ? 128 : (g == 1 ? 512 : 2048), head = g * 4 + hh;
        ldq64(P + (size_t)m * A_IN + head * 64, q);
        float l[3]; samp_dot_rounds3(P, cw, BT + (g * 4 + hh) * 132, q, g, sb, st, hh, lane, l);
        float gm = wave_max(fmaxf(fmaxf(l[0], l[1]), l[2])); float ps = 0.f;
#pragma unroll
        for (int r = 0; r < 3; ++r) { l[r] = l[r] > -1.0e38f ? __expf(l[r] - gm) : 0.f; ps += l[r]; }
        const float S = wave_sum(ps); float O = 0.f;
#pragma unroll
        for (int r = 0; r < 3; ++r) {
#pragma unroll 1
            for (int k0 = 0; k0 < 64; k0 += 8) { if (r * 64 + k0 >= 129) break;
                float v[8];
#pragma unroll
                for (int e = 0; e < 8; ++e) { int kidx = r * 64 + k0 + e; if (kidx > 128) kidx = 128; const int idx = Wg + st - dil * kidx;
                    v[e] = (idx >= Wg) ? bf2f(P[(size_t)(TP + sb * 4 + idx - Wg) * A_IN + 2 * RW + head * 64 + lane]) : cw[((size_t)(sb * Wg + idx) * 2 + 1) * 256 + hh * 64 + lane]; }
#pragma unroll
                for (int e = 0; e < 8; ++e) O += rdlane(l[r], k0 + e) * v[e]; } }
        Mo = gm; So = S; Oo = O;
    } else {
        ldq64(qmem, q);
        const float* kf = c_mem + ((size_t)(layer * SBATCH + sb) * NMEM) * 512 + hh * 64;
        float l[4]; float mx = -3.0e38f, s = 0.f, o = 0.f;
#pragma unroll
        for (int r = 0; r < 4; ++r) { l[r] = dot64_f32(q, kf + (size_t)(r * 64 + lane) * 512) * 0.125f; mx = fmaxf(mx, l[r]); }
        mx = wave_max(mx);
#pragma unroll
        for (int r = 0; r < 4; ++r) { l[r] = __expf(l[r] - mx); s += l[r]; }
        s = wave_sum(s);
#pragma unroll
        for (int r = 0; r < 4; ++r) {
#pragma unroll 1
            for (int k0 = 0; k0 < 64; k0 += 8) { float v[8];
#pragma unroll
                for (int e = 0; e < 8; ++e) v[e] = kf[(size_t)(r * 64 + k0 + e) * 512 + 256 + lane];
#pragma unroll
                for (int e = 0; e < 8; ++e) o += rdlane(l[r], k0 + e) * v[e]; } }
        Mo = mx; So = s; Oo = o;
    }
}

typedef short s16x4 __attribute__((ext_vector_type(4)));
typedef short bf16x8 __attribute__((ext_vector_type(8)));
constexpr int VROW = 160;
constexpr int VBUF = 32 * VROW;
constexpr float LOG2E = 1.4426950408889634f;
template <int OFF> __device__ __forceinline__ s16x4 tr_read(unsigned vb) {
    s16x4 r; asm volatile("ds_read_b64_tr_b16 %0, %1 offset:%2" : "=&v"(r) : "v"(vb), "i"(OFF) : "memory"); return r;
}
struct AttnSt { float m, s; f32x4 o[4]; };
__device__ __forceinline__ void attn_init(AttnSt& st) { st.m = -1.0e30f; st.s = 0.f;
#pragma unroll
    for (int i = 0; i < 4; ++i) st.o[i] = (f32x4){0.f, 0.f, 0.f, 0.f}; }
__device__ __forceinline__ unsigned cvt_pk_bf16f(float lo, float hi) { unsigned r; asm volatile("v_cvt_pk_bf16_f32 %0, %1, %2" : "=v"(r) : "v"(lo), "v"(hi)); return r; }

template <bool MASKED>
__device__ __forceinline__ void attn_pairs(const bf16* kbase, const bf16* vbase, int pitch, int tb, int dil, int qs, int tmax, int j0, int j1,
                                           const bf16x8 (&qf)[2], const LAS float* bias2, LAS unsigned char* vbuf, int lane, AttnSt& st) {
    const int n = lane & 15, quad = lane >> 4, vr8 = lane >> 3, vc8 = lane & 7;
    const unsigned vwr = (unsigned)(size_t)vbuf + (unsigned)(vr8 * VROW + vc8 * 16);
    const unsigned vrd = (unsigned)(size_t)vbuf + (unsigned)((4 * quad + (n >> 2)) * VROW + 8 * (n & 3));
    const float C2 = 0.125f * LOG2E;
    bf16x8 ka[2][2]; v4u vr[4];
#define ATT_LOAD(JP, KA, VR) do { _Pragma("unroll") for (int tt = 0; tt < 2; ++tt) { int tk = tb + dil * (32 * (JP) + 16 * tt + n); if (MASKED) tk = tk < 0 ? 0 : (tk > tmax ? tmax : tk); \
            const bf16* kp = kbase + (size_t)tk * pitch + 8 * quad; \
            KA[tt][0] = __builtin_bit_cast(bf16x8, *(const GAS v4u*)kp); KA[tt][1] = __builtin_bit_cast(bf16x8, *(const GAS v4u*)(kp + 32)); } \
        _Pragma("unroll") for (int c = 0; c < 4; ++c) { int tk = tb + dil * (32 * (JP) + 8 * c + vr8); if (MASKED) tk = tk < 0 ? 0 : (tk > tmax ? tmax : tk); \
            VR[c] = *(const GAS v4u*)(vbase + (size_t)tk * pitch + 8 * vc8); } } while (0)
    if (j0 < j1) ATT_LOAD(j0, ka, vr);
#pragma unroll 1
    for (int jp = j0; jp < j1; ++jp) {
        bf16x8 kn[2][2]; v4u vn[4];
        { const int jn = (jp + 1 < j1) ? jp + 1 : jp; ATT_LOAD(jn, kn, vn); }
        f32x4 sA = {0.f, 0.f, 0.f, 0.f}, sB = {0.f, 0.f, 0.f, 0.f};
        sA = __builtin_amdgcn_mfma_f32_16x16x32_bf16(ka[0][0], qf[0], sA, 0, 0, 0); sA = __builtin_amdgcn_mfma_f32_16x16x32_bf16(ka[0][1], qf[1], sA, 0, 0, 0);
        sB = __builtin_amdgcn_mfma_f32_16x16x32_bf16(ka[1][0], qf[0], sB, 0, 0, 0); sB = __builtin_amdgcn_mfma_f32_16x16x32_bf16(ka[1][1], qf[1], sB, 0, 0, 0);
        float l[8]; bool ok[8]; float mloc = -1.0e30f;
#pragma unroll
        for (int e = 0; e < 8; ++e) { const int u = 32 * jp + (e >> 2) * 16 + 4 * quad + (e & 3); const float a = (e < 4 ? sA[e & 3] : sB[e & 3]) * C2;
            if (MASKED) { const int kidx = 128 + qs * n - u; ok[e] = (kidx >= 0) && (kidx <= 128) && (tb + dil * u >= 0);
                const int kc = kidx < 0 ? 0 : (kidx > 128 ? 128 : kidx); l[e] = ok[e] ? a + bias2[kc] : -1.0e30f; }
            else { ok[e] = true; l[e] = a; }
            mloc = fmaxf(mloc, l[e]); }
        mloc = fmaxf(mloc, __shfl_xor(mloc, 16)); mloc = fmaxf(mloc, __shfl_xor(mloc, 32));
        const float mn = fmaxf(st.m, mloc), alpha = __builtin_amdgcn_exp2f(st.m - mn);
        float ps = 0.f; float p[8];
#pragma unroll
        for (int e = 0; e < 8; ++e) { p[e] = ok[e] ? __builtin_amdgcn_exp2f(l[e] - mn) : 0.f; ps += p[e]; }
        st.s = st.s * alpha + ps; st.m = mn;
#pragma unroll
        for (int i = 0; i < 4; ++i) st.o[i] = st.o[i] * alpha;
        v4u pk; pk.x = cvt_pk_bf16f(p[0], p[1]); pk.y = cvt_pk_bf16f(p[2], p[3]); pk.z = cvt_pk_bf16f(p[4], p[5]); pk.w = cvt_pk_bf16f(p[6], p[7]);
        const bf16x8 pb = __builtin_bit_cast(bf16x8, pk);
#pragma unroll
        for (int c = 0; c < 4; ++c) *(LAS v4u*)(size_t)(vwr + c * 8 * VROW) = vr[c];
        asm volatile("s_waitcnt lgkmcnt(0)" ::: "memory");
        const s16x4 a0 = tr_read<0>(vrd), b0 = tr_read<16 * VROW>(vrd), a1 = tr_read<32>(vrd), b1 = tr_read<16 * VROW + 32>(vrd);
        const s16x4 a2 = tr_read<64>(vrd), b2 = tr_read<16 * VROW + 64>(vrd), a3 = tr_read<96>(vrd), b3 = tr_read<16 * VROW + 96>(vrd);
        asm volatile("s_waitcnt lgkmcnt(0)" ::: "memory"); __builtin_amdgcn_sched_barrier(0);
#define PKV(L, H) (bf16x8){L[0], L[1], L[2], L[3], H[0], H[1], H[2], H[3]}
        st.o[0] = __builtin_amdgcn_mfma_f32_16x16x32_bf16(PKV(a0, b0), pb, st.o[0], 0, 0, 0);
        st.o[1] = __builtin_amdgcn_mfma_f32_16x16x32_bf16(PKV(a1, b1), pb, st.o[1], 0, 0, 0);
        st.o[2] = __builtin_amdgcn_mfma_f32_16x16x32_bf16(PKV(a2, b2), pb, st.o[2], 0, 0, 0);
        st.o[3] = __builtin_amdgcn_mfma_f32_16x16x32_bf16(PKV(a3, b3), pb, st.o[3], 0, 0, 0);
#undef PKV
        __builtin_amdgcn_sched_barrier(0);
#pragma unroll
        for (int tt = 0; tt < 2; ++tt) { ka[tt][0] = kn[tt][0]; ka[tt][1] = kn[tt][1]; }
#pragma unroll
        for (int c = 0; c < 4; ++c) vr[c] = vn[c];
    }
#undef ATT_LOAD
}
__device__ __forceinline__ void attn_store(const AttnSt& st, const bf16* gate_row  , bf16* out_row, int lane) {
    const int quad = lane >> 4;
    float s = st.s; s += __shfl_xor(s, 16); s += __shfl_xor(s, 32);
    const float inv = 1.f / s;
#pragma unroll
    for (int mt = 0; mt < 4; ++mt) { const v2u g = *(const GAS v2u*)(gate_row + 16 * mt + 4 * quad);
        const float o0 = st.o[mt][0] * inv * silu(bflo(g.x)), o1 = st.o[mt][1] * inv * silu(bfhi(g.x)), o2 = st.o[mt][2] * inv * silu(bflo(g.y)), o3 = st.o[mt][3] * inv * silu(bfhi(g.y));
        *(GAS v2u*)(out_row + 16 * mt + 4 * quad) = (v2u){pk2(o0, o1), pk2(o2, o3)}; }
}
__device__ __forceinline__ void load_qf(const bf16* qrow, int lane, bf16x8 (&qf)[2]) {
    const int quad = lane >> 4;
    qf[0] = __builtin_bit_cast(bf16x8, *(const GAS v4u*)(qrow + 8 * quad)); qf[1] = __builtin_bit_cast(bf16x8, *(const GAS v4u*)(qrow + 32 + 8 * quad));
}
__device__ __forceinline__ void attn_a_unit(const Ctx& C, const bf16* P, const bf16* MKV, bf16* H, const float* BT, int unit) {
    const int b = unit >> 5, hh = (unit >> 3) & 3, t0 = (unit & 7) * 256;
    LAS float* bias2 = (LAS float*)(C.lds + RING_OFF);
    LAS unsigned char* vbuf = C.lds + RING_OFF + 4096 + C.wave * VBUF;
    __syncthreads();
    for (int i = C.tid; i < 3 * 132; i += NWAVES * 64) { const int g = i / 132, k = i % 132; bias2[i] = k < 129 ? BT[(g * 4 + hh) * 132 + k] * LOG2E : 0.f; }
    __syncthreads();
    const int n = C.lane & 15;
    const bf16* Pb = P + (size_t)(b << 11) * A_IN;
#pragma unroll 1
    for (int set = 0; set < 2; ++set) {
        const int r = 2 * C.wave + set, tq = t0 + r + 16 * n;
        const bf16* qrow = Pb + (size_t)tq * A_IN;
        AttnSt st; attn_init(st);
#pragma unroll 1
        for (int g = 0; g < 3; ++g) {
            const int dil = g == 0 ? 1 : (g == 1 ? 4 : 16), qs = 16 / dil, np = g == 0 ? 12 : (g == 1 ? 6 : 5), head = g * 4 + hh;
            const int tb = t0 + r - 128 * dil;
            int j0 = 0; if (tb < 0) { j0 = (-tb - 31 * dil + 32 * dil - 1) / (32 * dil); if (j0 < 0) j0 = 0; }
            bf16x8 qf[2]; load_qf(qrow + head * 64, C.lane, qf);
            attn_pairs<true>(Pb + RW + head * 64, Pb + 2 * RW + head * 64, A_IN, tb, dil, qs, SEQ - 1, j0, np, qf, bias2 + g * 132, vbuf, C.lane, st);
        }
        attn_store(st, qrow + 2560 + hh * 64, H + ((size_t)(b << 11) + tq) * 512 + hh * 64, C.lane);
        AttnSt sm; attn_init(sm);
        { bf16x8 qf[2]; load_qf(qrow + 2304 + hh * 64, C.lane, qf);
          const bf16* kb = MKV + (size_t)(b * NMEM) * 1024 + hh * 64;
          attn_pairs<false>(kb, kb + 256, 1024, 0, 1, 0, NMEM - 1, 0, 8, qf, nullptr, vbuf, C.lane, sm); }
        attn_store(sm, qrow + 2560 + 256 + hh * 64, H + ((size_t)(b << 11) + tq) * 512 + 256 + hh * 64, C.lane);
    }
}
__device__ __forceinline__ void attn_b_unit(const Ctx& C, const bf16* P, const bf16* MKV, bf16* H, int unit) {
    const int b = unit >> 5, hh = (unit >> 3) & 3, t0 = (unit & 7) * 256;
    LAS unsigned char* vbuf = C.lds + RING_OFF + 4096 + C.wave * VBUF;
    const int n = C.lane & 15;
#pragma unroll 1
    for (int set = 0; set < 2; ++set) {
        const int r = 2 * C.wave + set, tq = t0 + r + 16 * n;
        const bf16* qrow = P + ((size_t)(b << 11) + tq) * B_INP;
        AttnSt sm; attn_init(sm);
        bf16x8 qf[2]; load_qf(qrow + CSH + hh * 64, C.lane, qf);
        const bf16* kb = MKV + (size_t)(b * NMEM) * 1024 + 512 + hh * 64;
        attn_pairs<false>(kb, kb + 256, 1024, 0, 1, 0, NMEM - 1, 0, 8, qf, nullptr, vbuf, C.lane, sm);
        attn_store(sm, qrow + 2688 + RW + hh * 64, H + ((size_t)(b << 11) + tq) * 1024 + RW + hh * 64, C.lane);
    }
}

__device__ __forceinline__ void row_pass(const bf16* hp, const float* xin, float* xout, const float* gpost, bf16* xn, int lane) {
    const GAS v2u* h2 = (const GAS v2u*)hp + lane; const GAS f32x4* xr = (const GAS f32x4*)xin + lane; const GAS f32x4* gp = (const GAS f32x4*)gpost + lane;
    f32x4 h[4], x[4]; float s = 0.f;
#pragma unroll
    for (int j = 0; j < 4; ++j) { const v2u u = h2[64 * j]; h[j] = (f32x4){bflo(u.x), bfhi(u.x), bflo(u.y), bfhi(u.y)}; x[j] = xr[64 * j];
        s += (h[j].x * h[j].x + h[j].y * h[j].y) + (h[j].z * h[j].z + h[j].w * h[j].w); }
    const float r = 1.f / sqrtf(wave_sum(s) * (1.f / DM) + RMS_EPS);
    float s2 = 0.f;
#pragma unroll
    for (int j = 0; j < 4; ++j) { const f32x4 g = gp[64 * j]; x[j] = x[j] + h[j] * r * g; s2 += (x[j].x * x[j].x + x[j].y * x[j].y) + (x[j].z * x[j].z + x[j].w * x[j].w);
        *((GAS f32x4*)xout + lane + 64 * j) = x[j]; }
    if (xn) { const float r2 = 1.f / sqrtf(wave_sum(s2) * (1.f / DM) + RMS_EPS);
        GAS unsigned long long* o8 = (GAS unsigned long long*)xn + lane;
#pragma unroll
        for (int j = 0; j < 4; ++j) o8[64 * j] = (unsigned long long)pk2(x[j].x * r2, x[j].y * r2) | ((unsigned long long)pk2(x[j].z * r2, x[j].w * r2) << 32); }
}

struct ScanP { const bf16* P; bf16* H; float* out; const float *st_wkv, *st_shift, *mu, *w0, *a0, *k_k, *k_a, *r_k, *ln_w, *ln_b, *w_up, *a_up; };
__device__ __forceinline__ void scan_unit(const Ctx& C, const ScanP& sp, int u) {
    LAS float* L = (LAS float*)(C.lds + RING_OFF);
    LAS float *LA = L, *LB = L + 4096, *LW = L + 8192, *LK = L + 12288, *LRW = L + 16384, *LV = L + 20480, *LSC = L + 24576, *LY = L + 24576 + 256;
    const bool samp = u >= 96; const int seq = samp ? (u - 96) / 12 : u / 12, h = samp ? (u - 96) % 12 : u % 12;
    const int T = samp ? STOK : SEQ, row0 = samp ? TP + seq * 4 : seq * SEQ;
    int row = C.wave * 8 + (C.lane >> 3), p = C.lane & 7;
    asm volatile("" : "+v"(row), "+v"(p));
    float S[8];
#pragma unroll
    for (int j = 0; j < 8; ++j) S[j] = samp ? sp.st_wkv[((size_t)(seq * 12 + h) * 64 + row) * 64 + p * 8 + j] : 0.f;
#pragma unroll 1
    for (int c0 = 0; c0 < T; c0 += 64) {
        const int n = (T - c0) < 64 ? (T - c0) : 64;
        int tok = C.tid >> 3, part = C.tid & 7;
        asm volatile("" : "+v"(tok), "+v"(part));
        __syncthreads();
        LAS float* LTW = L + 28928; LAS float* LR = LTW + 512;
        { const int tk = C.tid >> 7, j = C.tid & 127;
          if (tk < n) { const int t = c0 + tk, m = row0 + t, cc = 2304 + j; const float cur = bf2f(sp.P[(size_t)m * B_INP + cc]);
              float prev = 0.f; if (t > 0) prev = bf2f(sp.P[(size_t)(m - 1) * B_INP + cc]); else if (samp) prev = sp.st_shift[(size_t)seq * CSH + cc];
              const float xs = cur + sp.mu[cc] * (prev - cur); LTW[tk * 128 + j] = j < 64 ? tanhf(xs) : xs; } }
        __syncthreads();
        { const int tk = C.tid >> 7, which = (C.tid >> 6) & 1, cc = C.tid & 63;
          if (tk < n) { const float* W = (which ? sp.a_up : sp.w_up) + h * 64 + cc; const LAS float* x = LTW + tk * 128 + which * 64; float acc = 0.f;
#pragma unroll 8
              for (int j = 0; j < 64; ++j) acc += x[j] * W[(size_t)j * RW];
              LR[tk * 128 + which * 64 + cc] = acc; } }
        __syncthreads();
        if (tok < n) {
            const int t = c0 + tok, m = row0 + t;
            const bf16* cur = sp.P + (size_t)m * B_INP; const bf16* prv = cur - B_INP; const LAS float* lo = LR + tok * 128 + part * 8;
            float xr[8], xk[8], xv[8], kk[8], av[8], dv[8];
            float nrm = 0.f;
#pragma unroll
            for (int j = 0; j < 8; ++j) { const int c = h * 64 + part * 8 + j;
                const float cr = bf2f(cur[c]), ck = bf2f(cur[RW + c]), cv = bf2f(cur[2 * RW + c]);
                float pr = 0.f, pk = 0.f, pv = 0.f;
                if (t > 0) { pr = bf2f(prv[c]); pk = bf2f(prv[RW + c]); pv = bf2f(prv[2 * RW + c]); }
                else if (samp) { const float* ss = sp.st_shift + (size_t)seq * CSH; pr = ss[c]; pk = ss[RW + c]; pv = ss[2 * RW + c]; }
                xr[j] = cr + sp.mu[c] * (pr - cr); xk[j] = ck + sp.mu[RW + c] * (pk - ck); xv[j] = cv + sp.mu[2 * RW + c] * (pv - cv);
                const float dpre = sp.w0[c] + lo[j], apre = sp.a0[c] + lo[64 + j];
                dv[j] = __expf(-0.6065306597f * __builtin_amdgcn_rcpf(1.f + __expf(-dpre)));
                av[j] = __builtin_amdgcn_rcpf(1.f + __expf(-apre));
                kk[j] = xk[j] * sp.k_k[c]; nrm += kk[j] * kk[j]; }
            nrm += __shfl_xor(nrm, 1); nrm += __shfl_xor(nrm, 2); nrm += __shfl_xor(nrm, 4);
            const float inv = 1.f / fmaxf(sqrtf(nrm), 1e-12f);
            float br = 0.f, kr = 0.f, bon = 0.f;
#pragma unroll
            for (int j = 0; j < 8; ++j) { const int c = h * 64 + part * 8 + j, d = part * 8 + j;
                const float kn = kk[j] * inv, k2 = xk[j] * (1.f + (av[j] - 1.f) * sp.k_a[c]);
                const float bb = kn * av[j];
                LA[tok * 64 + d] = -kn; LB[tok * 64 + d] = bb; LW[tok * 64 + d] = dv[j]; LK[tok * 64 + d] = k2; LRW[tok * 64 + d] = xr[j] * dv[j]; LV[tok * 64 + d] = xv[j];
                br += bb * xr[j]; kr += k2 * xr[j]; bon += xr[j] * k2 * sp.r_k[c]; }
            br += __shfl_xor(br, 1); br += __shfl_xor(br, 2); br += __shfl_xor(br, 4);
            kr += __shfl_xor(kr, 1); kr += __shfl_xor(kr, 2); kr += __shfl_xor(kr, 4);
            bon += __shfl_xor(bon, 1); bon += __shfl_xor(bon, 2); bon += __shfl_xor(bon, 4);
            if (part == 0) { LSC[tok * 4 + 0] = br; LSC[tok * 4 + 1] = kr; LSC[tok * 4 + 2] = bon; }
        }
        __syncthreads();
#pragma unroll 1
        for (int i = 0; i < n; ++i) {
            const LAS f32x4* a4 = (const LAS f32x4*)(LA + i * 64 + p * 8); const LAS f32x4* r4 = (const LAS f32x4*)(LRW + i * 64 + p * 8);
            const LAS f32x4* w4 = (const LAS f32x4*)(LW + i * 64 + p * 8); const LAS f32x4* b4 = (const LAS f32x4*)(LB + i * 64 + p * 8); const LAS f32x4* k4 = (const LAS f32x4*)(LK + i * 64 + p * 8);
            const f32x4 a0 = a4[0], a1 = a4[1], r0 = r4[0], r1 = r4[1];
            float sa = (S[0] * a0.x + S[1] * a0.y) + (S[2] * a0.z + S[3] * a0.w) + (S[4] * a1.x + S[5] * a1.y) + (S[6] * a1.z + S[7] * a1.w);
            float yp = (S[0] * r0.x + S[1] * r0.y) + (S[2] * r0.z + S[3] * r0.w) + (S[4] * r1.x + S[5] * r1.y) + (S[6] * r1.z + S[7] * r1.w);
            sa += __shfl_xor(sa, 1); sa += __shfl_xor(sa, 2); sa += __shfl_xor(sa, 4);
            yp += __shfl_xor(yp, 1); yp += __shfl_xor(yp, 2); yp += __shfl_xor(yp, 4);
            const float v = LV[i * 64 + row], br = LSC[i * 4 + 0], kr = LSC[i * 4 + 1];
            const f32x4 w0 = w4[0], w1 = w4[1], b0 = b4[0], b1 = b4[1], k0 = k4[0], k1 = k4[1];
            S[0] = S[0] * w0.x + sa * b0.x + v * k0.x; S[1] = S[1] * w0.y + sa * b0.y + v * k0.y; S[2] = S[2] * w0.z + sa * b0.z + v * k0.z; S[3] = S[3] * w0.w + sa * b0.w + v * k0.w;
            S[4] = S[4] * w1.x + sa * b1.x + v * k1.x; S[5] = S[5] * w1.y + sa * b1.y + v * k1.y; S[6] = S[6] * w1.z + sa * b1.z + v * k1.z; S[7] = S[7] * w1.w + sa * b1.w + v * k1.w;
            if (p == 0) LY[i * 64 + row] = yp + sa * br + v * kr;
        }
        __syncthreads();
        asm volatile("" : "+v"(tok), "+v"(part));
        if (tok < n) {
            const int m = row0 + c0 + tok;
            float y[8]; float s = 0.f;
#pragma unroll
            for (int j = 0; j < 8; ++j) { y[j] = LY[tok * 64 + part * 8 + j]; s += y[j]; }
            s += __shfl_xor(s, 1); s += __shfl_xor(s, 2); s += __shfl_xor(s, 4);
            const float mean = s * (1.f / 64.f); float q = 0.f;
#pragma unroll
            for (int j = 0; j < 8; ++j) { y[j] -= mean; q += y[j] * y[j]; }
            q += __shfl_xor(q, 1); q += __shfl_xor(q, 2); q += __shfl_xor(q, 4);
            const float rstd = 1.f / sqrtf(q * (1.f / 64.f) + GN_EPS), bon = LSC[tok * 4 + 2];
            unsigned w[4];
#pragma unroll
            for (int j = 0; j < 8; j += 2) { float o2[2];
#pragma unroll
                for (int e = 0; e < 2; ++e) { const int c = h * 64 + part * 8 + j + e;
                    const float yy = y[j + e] * rstd * sp.ln_w[c] + sp.ln_b[c] + bon * LV[tok * 64 + part * 8 + j + e];
                    o2[e] = yy * silu(bf2f(sp.P[(size_t)m * B_INP + 2688 + c])); }
                w[j >> 1] = pk2(o2[0], o2[1]); }
            *(GAS v4u*)(sp.H + (size_t)m * 1024 + h * 64 + part * 8) = (v4u){w[0], w[1], w[2], w[3]};
        }
    }
    float* so = sp.out + (samp ? O_WKVS : O_WKVP) + ((size_t)(seq * 12 + h) * 64 + row) * 64 + p * 8;
    *(GAS f32x4*)so = (f32x4){S[0], S[1], S[2], S[3]}; *((GAS f32x4*)so + 1) = (f32x4){S[4], S[5], S[6], S[7]};
    __syncthreads();
}

constexpr int TS = 72;
constexpr int IMG = 64 * TS * 2;
constexpr int REC_AT = 0, REC_RT = 8192, REC_BT = 16384, REC_KT = 24576, REC_TT = 32768, REC_PC = 40960, REC_BON = 41216, REC_BYTES = 41472;
constexpr int REC_N1 = 960, REC_N2 = 1238, REC_N3 = 1125;
static_assert(REC_N1 + REC_N2 + REC_N3 >= 3072 && (size_t)REC_N1 * REC_BYTES <= 38 * MiB && (size_t)REC_N2 * REC_BYTES <= 49 * MiB && (size_t)REC_N3 * REC_BYTES <= WS_END - 271 * MiB, "chunk records");
__device__ __forceinline__ unsigned char* rec_ptr(unsigned char* ws, int id) {
    return id < REC_N1 ? ws + 29 * MiB + (size_t)id * REC_BYTES : (id < REC_N1 + REC_N2 ? ws + 100 * MiB + (size_t)(id - REC_N1) * REC_BYTES : ws + 271 * MiB + (size_t)(id - REC_N1 - REC_N2) * REC_BYTES);
}
constexpr int LA_TWD = 0, LA_TAD = IMG, LA_AT = 0, LA_BT = IMG, LA_DW = 2 * IMG, LA_DA = LA_DW + 16384, LA_SEG = LA_DA + 16384, LA_SLOT0 = LA_SEG + 2048, NSLOT = 6;
static_assert(LA_SLOT0 + NSLOT * 16384 <= RING_BYTES, "stage A LDS map");
constexpr int L_AT = 0, L_RT = IMG, L_BT = 2 * IMG, L_KT = 3 * IMG, L_VV = 4 * IMG, L_SB = 5 * IMG, L_SB2 = 6 * IMG, L_Z = 7 * IMG, L_SA = 8 * IMG,
              L_NKA = 9 * IMG, L_NBR = 10 * IMG, L_NKR = 11 * IMG, L_TT = 12 * IMG, L_Y = 13 * IMG, L_PC = L_Y + 16384  , L_PRM = L_PC + 1024, L_B_END = L_PRM + 1024;
static_assert(L_B_END <= RING_BYTES, "stage B LDS map");

struct ChunkP { const bf16 *P, *WL; const float *mu, *w0, *a0, *k_k, *k_a, *r_k; };
__device__ __forceinline__ float tanh_fast(float x) { return 1.f - 2.f * __builtin_amdgcn_rcpf(1.f + __expf(2.f * x)); }
__device__ __forceinline__ void ld8(const LAS float* p, float (&x)[8]) { const f32x4 a = *(const LAS f32x4*)p, b = *((const LAS f32x4*)p + 1);
    x[0] = a[0]; x[1] = a[1]; x[2] = a[2]; x[3] = a[3]; x[4] = b[0]; x[5] = b[1]; x[6] = b[2]; x[7] = b[3]; }
__device__ __forceinline__ void ld8g(const float* p, float (&x)[8]) { const f32x4 a = *(const GAS f32x4*)p, b = *((const GAS f32x4*)p + 1);
    x[0] = a[0]; x[1] = a[1]; x[2] = a[2]; x[3] = a[3]; x[4] = b[0]; x[5] = b[1]; x[6] = b[2]; x[7] = b[3]; }
__device__ __forceinline__ void unpk8(v4u u, float (&x)[8]) { x[0] = bflo(u.x); x[1] = bfhi(u.x); x[2] = bflo(u.y); x[3] = bfhi(u.y); x[4] = bflo(u.z); x[5] = bfhi(u.z); x[6] = bflo(u.w); x[7] = bfhi(u.w); }
__device__ __forceinline__ v4u pk8(const float (&x)[8]) { return (v4u){pk2(x[0], x[1]), pk2(x[2], x[3]), pk2(x[4], x[5]), pk2(x[6], x[7])}; }
__device__ __forceinline__ void st8bf(LAS unsigned char* lds, int off, int tok, int part, const float (&x)[8]) { *(LAS v4u*)(lds + off + (tok * TS + part * 8) * 2) = pk8(x); }
__device__ __forceinline__ bf16x8 frag_nat(const LAS unsigned char* img, int R0, int ks, int lane) {
    return __builtin_bit_cast(bf16x8, *(const LAS v4u*)(img + ((R0 + (lane & 15)) * TS + 32 * ks + 8 * (lane >> 4)) * 2));
}
#define MFMA16(a, b, c) __builtin_amdgcn_mfma_f32_16x16x32_bf16((a), (b), (c), 0, 0, 0)
__device__ __forceinline__ void st_tile_T(LAS unsigned char* img, int C0, int R0, int lane, f32x4 v) {
    *(LAS v2u*)(img + ((C0 + (lane & 15)) * TS + R0 + 4 * (lane >> 4)) * 2) = (v2u){pk2(v[0], v[1]), pk2(v[2], v[3])};
}
#define LBAR() do { asm volatile("s_waitcnt lgkmcnt(0)" ::: "memory"); __builtin_amdgcn_s_barrier(); asm volatile("" ::: "memory"); } while (0)

struct ALoad { v4u cr, ck, cv, pr, pk, pv, cwd, cad, pwd, pad; };
__device__ __forceinline__ void a_load(const ChunkP& cp, int m0, int t0tok, int h, int tok, int part, ALoad& L) {
    const int m = m0 + tok; const bool first = (t0tok + tok) == 0;
    const bf16* row = cp.P + (size_t)m * B_INP; const bf16* cur = row + h * 64 + part * 8;
    L.cr = *(const GAS v4u*)cur; L.ck = *(const GAS v4u*)(cur + RW); L.cv = *(const GAS v4u*)(cur + 2 * RW);
    L.cwd = *(const GAS v4u*)(row + 2304 + part * 8); L.cad = *(const GAS v4u*)(row + 2368 + part * 8);
    const v4u z = {0u, 0u, 0u, 0u}; L.pr = z; L.pk = z; L.pv = z; L.pwd = z; L.pad = z;
    if (!first) { L.pr = *(const GAS v4u*)(cur - B_INP); L.pk = *(const GAS v4u*)(cur - B_INP + RW); L.pv = *(const GAS v4u*)(cur - B_INP + 2 * RW);
        L.pwd = *(const GAS v4u*)(row - B_INP + 2304 + part * 8); L.pad = *(const GAS v4u*)(row - B_INP + 2368 + part * 8); }
}
__device__ __forceinline__ void scan_stage_a(const Ctx& C, const ChunkP& cp, unsigned char* ws, int task0, int ntask) {
    LAS unsigned char* lds = C.lds + RING_OFF;
    const int tok = C.tid >> 3, part = C.tid & 7, tl = C.lane >> 3, vs = C.wave & 3, rh = C.wave >> 2, l15 = C.lane & 15, quad = C.lane >> 4;
    ALoad Ln; { const int bh = task0 >> 5, c = task0 & 31; a_load(cp, (bh / 12) * SEQ + c * 64, c * 64, bh % 12, tok, part, Ln); }
    __syncthreads();
#pragma unroll 1
    for (int base = 0; base < ntask; base += NSLOT) {
        const int nr = (ntask - base) < NSLOT ? (ntask - base) : NSLOT;
#pragma unroll 1
        for (int s = 0; s < nr; ++s) {
            const int task = task0 + base + s, bh = task >> 5, c = task & 31, h = bh % 12;
            unsigned char* rec = rec_ptr(ws, task);
            float xr[8], xk[8], xv[8];
            {   float cw[8], pw[8], ca[8], pa[8], m8[8], tw[8], ta[8];
                unpk8(Ln.cwd, cw); unpk8(Ln.pwd, pw); unpk8(Ln.cad, ca); unpk8(Ln.pad, pa);
                ld8g(cp.mu + 2304 + part * 8, m8);
#pragma unroll
                for (int j = 0; j < 8; ++j) tw[j] = tanh_fast(cw[j] + m8[j] * (pw[j] - cw[j]));
                ld8g(cp.mu + 2368 + part * 8, m8);
#pragma unroll
                for (int j = 0; j < 8; ++j) ta[j] = ca[j] + m8[j] * (pa[j] - ca[j]);
                st8bf(lds, LA_TWD, tok, part, tw); st8bf(lds, LA_TAD, tok, part, ta);
                float c8[8], p8[8];
                ld8g(cp.mu + h * 64 + part * 8, m8); unpk8(Ln.cr, c8); unpk8(Ln.pr, p8);
#pragma unroll
                for (int j = 0; j < 8; ++j) xr[j] = c8[j] + m8[j] * (p8[j] - c8[j]);
                ld8g(cp.mu + RW + h * 64 + part * 8, m8); unpk8(Ln.ck, c8); unpk8(Ln.pk, p8);
#pragma unroll
                for (int j = 0; j < 8; ++j) xk[j] = c8[j] + m8[j] * (p8[j] - c8[j]);
                ld8g(cp.mu + 2 * RW + h * 64 + part * 8, m8); unpk8(Ln.cv, c8); unpk8(Ln.pv, p8);
#pragma unroll
                for (int j = 0; j < 8; ++j) xv[j] = c8[j] + m8[j] * (p8[j] - c8[j]);
            }
            bf16x8 wf[2][2], af[2][2];
#pragma unroll
            for (int q = 0; q < 2; ++q)
#pragma unroll
                for (int ks = 0; ks < 2; ++ks) { const int cc = h * 64 + 16 * (2 * rh + q) + l15;
                    wf[q][ks] = __builtin_bit_cast(bf16x8, *(const GAS v4u*)(cp.WL + (size_t)cc * 128 + 32 * ks + 8 * quad));
                    af[q][ks] = __builtin_bit_cast(bf16x8, *(const GAS v4u*)(cp.WL + (size_t)(RW + cc) * 128 + 64 + 32 * ks + 8 * quad)); }
            if (base + s + 1 < ntask) { const int tn = task + 1, bhn = tn >> 5, cn = tn & 31; a_load(cp, (bhn / 12) * SEQ + cn * 64, cn * 64, bhn % 12, tok, part, Ln); }
            LBAR();
            {   const bf16x8 b0 = frag_nat(lds + LA_TWD, 16 * vs, 0, C.lane), b1 = frag_nat(lds + LA_TWD, 16 * vs, 1, C.lane);
                const bf16x8 d0 = frag_nat(lds + LA_TAD, 16 * vs, 0, C.lane), d1 = frag_nat(lds + LA_TAD, 16 * vs, 1, C.lane);
#pragma unroll
                for (int q = 0; q < 2; ++q) { f32x4 aw = {0.f, 0.f, 0.f, 0.f}, aa = aw;
                    aw = MFMA16(wf[q][0], b0, aw); aw = MFMA16(wf[q][1], b1, aw); aa = MFMA16(af[q][0], d0, aa); aa = MFMA16(af[q][1], d1, aa);
                    const int t = 16 * vs + l15, c0 = 16 * (2 * rh + q) + 4 * quad;
                    *(LAS f32x4*)(lds + LA_DW + (t * 64 + c0) * 4) = aw; *(LAS f32x4*)(lds + LA_DA + (t * 64 + c0) * 4) = aa; }
            }
            LBAR();
            float kn[8], as[8], k2[8], e[8], cum[8]; float bon;
            {   float dw[8], da[8], p8[8], kk[8]; float nrm = 0.f;
                ld8((const LAS float*)(lds + LA_DW) + tok * 64 + part * 8, dw); ld8((const LAS float*)(lds + LA_DA) + tok * 64 + part * 8, da);
                ld8g(cp.w0 + h * 64 + part * 8, p8);
#pragma unroll
                for (int j = 0; j < 8; ++j) e[j] = 0.6065306597f * __builtin_amdgcn_rcpf(1.f + __expf(-(p8[j] + dw[j])));
                ld8g(cp.a0 + h * 64 + part * 8, p8);
#pragma unroll
                for (int j = 0; j < 8; ++j) as[j] = __builtin_amdgcn_rcpf(1.f + __expf(-(p8[j] + da[j])));
                ld8g(cp.k_k + h * 64 + part * 8, p8);
#pragma unroll
                for (int j = 0; j < 8; ++j) { kk[j] = xk[j] * p8[j]; nrm += kk[j] * kk[j]; }
                nrm += __shfl_xor(nrm, 1); nrm += __shfl_xor(nrm, 2); nrm += __shfl_xor(nrm, 4);
                const float inv = __builtin_amdgcn_rsqf(fmaxf(nrm, 1e-24f));
                ld8g(cp.k_a + h * 64 + part * 8, p8);
#pragma unroll
                for (int j = 0; j < 8; ++j) { kn[j] = kk[j] * inv; k2[j] = xk[j] * (1.f + (as[j] - 1.f) * p8[j]); }
                ld8g(cp.r_k + h * 64 + part * 8, p8); bon = 0.f;
#pragma unroll
                for (int j = 0; j < 8; ++j) bon += xr[j] * k2[j] * p8[j];
                bon += __shfl_xor(bon, 1); bon += __shfl_xor(bon, 2); bon += __shfl_xor(bon, 4);
#pragma unroll
                for (int j = 0; j < 8; ++j) { float x = e[j]; float y = __shfl_up(x, 8); if (tl >= 1) x += y; y = __shfl_up(x, 16); if (tl >= 2) x += y; y = __shfl_up(x, 32); if (tl >= 4) x += y; cum[j] = x; }
                if (tl == 7) { LAS float* sg = (LAS float*)(lds + LA_SEG) + C.wave * 64 + part * 8;
                    *(LAS f32x4*)sg = (f32x4){cum[0], cum[1], cum[2], cum[3]}; *((LAS f32x4*)sg + 1) = (f32x4){cum[4], cum[5], cum[6], cum[7]}; }
            }
            LBAR();
            {   float off[8] = {0.f, 0.f, 0.f, 0.f, 0.f, 0.f, 0.f, 0.f};
                for (int w = 0; w < C.wave; ++w) { float t8[8]; ld8((const LAS float*)(lds + LA_SEG) + w * 64 + part * 8, t8);
#pragma unroll
                    for (int j = 0; j < 8; ++j) off[j] += t8[j]; }
                float at[8], bt[8], rt[8], kt[8], pt8[8];
#pragma unroll
                for (int j = 0; j < 8; ++j) { const float cm = cum[j] + off[j]; const float pm1 = __expf(e[j] - cm), ip = __expf(cm), pt = __builtin_amdgcn_rcpf(ip);
                    at[j] = -kn[j] * pm1; bt[j] = kn[j] * as[j] * ip; rt[j] = xr[j] * pt; kt[j] = k2[j] * ip; pt8[j] = pt; }
                const v4u pa = pk8(at), pb = pk8(bt);
                *(LAS v4u*)(lds + LA_AT + (tok * TS + part * 8) * 2) = pa; *(LAS v4u*)(lds + LA_BT + (tok * TS + part * 8) * 2) = pb;
                const int go = (tok * 64 + part * 8) * 2;
                *(GAS v4u*)(rec + REC_AT + go) = pa; *(GAS v4u*)(rec + REC_BT + go) = pb; *(GAS v4u*)(rec + REC_RT + go) = pk8(rt); *(GAS v4u*)(rec + REC_KT + go) = pk8(kt);
                if (tok == 63) { float* pc = (float*)(rec + REC_PC) + part * 8; *(GAS f32x4*)pc = (f32x4){pt8[0], pt8[1], pt8[2], pt8[3]}; *((GAS f32x4*)pc + 1) = (f32x4){pt8[4], pt8[5], pt8[6], pt8[7]}; }
                if (part == 0) ((float*)(rec + REC_BON))[tok] = bon;
            }
            LBAR();
            {   LAS float* slot = (LAS float*)(lds + LA_SLOT0 + s * 16384);
                const bf16x8 b0 = frag_nat(lds + LA_AT, 16 * vs, 0, C.lane), b1 = frag_nat(lds + LA_AT, 16 * vs, 1, C.lane);
#pragma unroll
                for (int q = 0; q < 2; ++q) { const int it = 2 * rh + q;
                    f32x4 acc = {0.f, 0.f, 0.f, 0.f};
                    acc = MFMA16(frag_nat(lds + LA_BT, 16 * it, 0, C.lane), b0, acc); acc = MFMA16(frag_nat(lds + LA_BT, 16 * it, 1, C.lane), b1, acc);
                    const int t = 16 * vs + l15, i0 = 16 * it + 4 * quad;
                    f32x4 o; o[0] = (i0 + 0 < t) ? acc[0] : 0.f; o[1] = (i0 + 1 < t) ? acc[1] : 0.f; o[2] = (i0 + 2 < t) ? acc[2] : 0.f; o[3] = (i0 + 3 < t) ? acc[3] : 0.f;
                    *(LAS f32x4*)(slot + t * 64 + i0) = o; }
            }
            __syncthreads();
        }
        if (C.wave < nr) {
            const LAS float* Nl = (const LAS float*)(lds + LA_SLOT0 + C.wave * 16384);
            float Tr[64]; int ln = C.lane; asm volatile("" : "+v"(ln));
#pragma clang loop unroll(full)
            for (int t = 0; t < 64; ++t) { float acc = (ln == t) ? 1.f : 0.f;
#pragma clang loop unroll(full)
                for (int g = 0; g < (t + 3) / 4; ++g) { const f32x4 nv = *(const volatile LAS f32x4*)(Nl + t * 64 + 4 * g);
                    acc += Tr[4 * g] * nv[0]; if (4 * g + 1 < t) acc += Tr[4 * g + 1] * nv[1]; if (4 * g + 2 < t) acc += Tr[4 * g + 2] * nv[2]; if (4 * g + 3 < t) acc += Tr[4 * g + 3] * nv[3]; }
                asm volatile("" : "+v"(acc));
                Tr[t] = acc; }
            bf16* o = (bf16*)(rec_ptr(ws, task0 + base + C.wave) + REC_TT) + C.lane;
#pragma clang loop unroll(full)
            for (int t = 0; t < 64; ++t) o[t * 64] = (bf16)f2bf(Tr[t]);
        }
        LBAR();
    }
    __syncthreads();
}

struct ScanBP { const bf16* P; bf16* H; float* out; const float *mu, *ln_w, *ln_b; unsigned char* ws; };
struct BLoad { v4u at, rt, bt, kt, tt, cv, pv, g4; f32x4 pcb; };
__device__ __forceinline__ void b_load(const ScanBP& sb, const unsigned char* rec, int m0, int t0tok, int h, int tid, BLoad& L) {
    const int tok = tid >> 3, part = tid & 7;
    const GAS v4u* r16 = (const GAS v4u*)rec + tid;
    L.at = r16[REC_AT / 16]; L.rt = r16[REC_RT / 16]; L.bt = r16[REC_BT / 16]; L.kt = r16[REC_KT / 16]; L.tt = r16[REC_TT / 16];
    const bf16* cur = sb.P + (size_t)(m0 + tok) * B_INP + h * 64 + part * 8;
    L.cv = *(const GAS v4u*)(cur + 2 * RW); L.g4 = *(const GAS v4u*)(cur + 2688);
    L.pv = (v4u){0u, 0u, 0u, 0u}; if ((t0tok + tok) != 0) L.pv = *(const GAS v4u*)(cur - B_INP + 2 * RW);
    L.pcb = (f32x4){0.f, 0.f, 0.f, 0.f}; if (tid < 32) L.pcb = *((const GAS f32x4*)(rec + REC_PC) + tid);
}
__device__ __forceinline__ void scan_stage_b(const Ctx& C, const ScanBP& sb, int bh) {
    LAS unsigned char* lds = C.lds + RING_OFF;
    const int b = bh / 12, h = bh % 12;
    const int tok = C.tid >> 3, part = C.tid & 7, vs = C.wave & 3, rh = C.wave >> 2, l15 = C.lane & 15, quad = C.lane >> 4;
    f32x4 St[2] = {{0.f, 0.f, 0.f, 0.f}, {0.f, 0.f, 0.f, 0.f}};
    __syncthreads();
    for (int i = C.tid; i < IMG / 4; i += NWAVES * 64) ((LAS unsigned*)(lds + L_SB))[i] = 0u;
    { LAS float* prm = (LAS float*)(lds + L_PRM);
      for (int i = C.tid; i < 192; i += NWAVES * 64) { const int a = i >> 6, c = h * 64 + (i & 63); prm[i] = a == 0 ? sb.mu[2 * RW + c] : (a == 1 ? sb.ln_w[c] : sb.ln_b[c]); } }
    BLoad Ln; b_load(sb, rec_ptr(sb.ws, bh * 32), b * SEQ, 0, h, C.tid, Ln);
    float xvp[8] = {0.f, 0.f, 0.f, 0.f, 0.f, 0.f, 0.f, 0.f}; v4u g4p = {0u, 0u, 0u, 0u};
    __syncthreads();
    const LAS float* prm = (const LAS float*)(lds + L_PRM) + part * 8;
    const int ioff = (tok * TS + part * 8) * 2;
#pragma unroll 1
    for (int c = 0; c <= 32; ++c) {
        const int m0 = b * SEQ + c * 64;
        if (c > 0) { const int m = m0 - 64 + tok; float y[8]; ld8((const LAS float*)(lds + L_Y) + tok * 64 + part * 8, y); float s = 0.f;
#pragma unroll
            for (int j = 0; j < 8; ++j) s += y[j];
            s += __shfl_xor(s, 1); s += __shfl_xor(s, 2); s += __shfl_xor(s, 4);
            const float mean = s * (1.f / 64.f); float qq = 0.f;
#pragma unroll
            for (int j = 0; j < 8; ++j) { y[j] -= mean; qq += y[j] * y[j]; }
            qq += __shfl_xor(qq, 1); qq += __shfl_xor(qq, 2); qq += __shfl_xor(qq, 4);
            const float rstd = __builtin_amdgcn_rsqf(qq * (1.f / 64.f) + GN_EPS), bonp = ((const LAS float*)(lds + L_PC + ((c - 1) & 1) * 512 + 256))[tok];
            float lw[8], lb[8], g[8], o[8]; ld8(prm + 64, lw); ld8(prm + 128, lb); unpk8(g4p, g);
#pragma unroll
            for (int j = 0; j < 8; ++j) o[j] = (y[j] * rstd * lw[j] + lb[j] + bonp * xvp[j]) * silu(g[j]);
            *(GAS v4u*)(sb.H + (size_t)m * 1024 + h * 64 + part * 8) = pk8(o);
        }
        if (c == 32) break;
        *(LAS v4u*)(lds + L_AT + ioff) = Ln.at; *(LAS v4u*)(lds + L_RT + ioff) = Ln.rt; *(LAS v4u*)(lds + L_BT + ioff) = Ln.bt; *(LAS v4u*)(lds + L_KT + ioff) = Ln.kt; *(LAS v4u*)(lds + L_TT + ioff) = Ln.tt;
        if (C.tid < 32) *((LAS f32x4*)(lds + L_PC + (c & 1) * 512) + C.tid) = Ln.pcb;
        {   float cv[8], pv[8], mv[8]; unpk8(Ln.cv, cv); unpk8(Ln.pv, pv); ld8(prm, mv);
#pragma unroll
            for (int j = 0; j < 8; ++j) xvp[j] = cv[j] + mv[j] * (pv[j] - cv[j]);
            *(LAS v4u*)(lds + L_VV + ioff) = pk8(xvp); g4p = Ln.g4; }
        if (c < 31) b_load(sb, rec_ptr(sb.ws, bh * 32 + c + 1), m0 + 64, c * 64 + 64, h, C.tid, Ln);
        LBAR();
        {   const bf16x8 a0 = frag_nat(lds + L_AT, 16 * vs, 0, C.lane), a1 = frag_nat(lds + L_AT, 16 * vs, 1, C.lane);
            const bf16x8 r0 = frag_nat(lds + L_RT, 16 * vs, 0, C.lane), r1 = frag_nat(lds + L_RT, 16 * vs, 1, C.lane);
#pragma unroll
            for (int q = 0; q < 2; ++q) { const int it = 2 * rh + q;
                const bf16x8 k0 = frag_nat(lds + L_KT, 16 * it, 0, C.lane), k1 = frag_nat(lds + L_KT, 16 * it, 1, C.lane);
                const bf16x8 bb0 = frag_nat(lds + L_BT, 16 * it, 0, C.lane), bb1 = frag_nat(lds + L_BT, 16 * it, 1, C.lane);
                f32x4 nka = {0.f, 0.f, 0.f, 0.f}, nbr = nka, nkr = nka;
                nka = MFMA16(k0, a0, nka); nka = MFMA16(k1, a1, nka);
                nbr = MFMA16(bb0, r0, nbr); nbr = MFMA16(bb1, r1, nbr);
                nkr = MFMA16(k0, r0, nkr); nkr = MFMA16(k1, r1, nkr);
                const int t = 16 * vs + l15, i0 = 16 * it + 4 * quad;
#pragma unroll
                for (int ee = 0; ee < 4; ++ee) { if (!(i0 + ee < t)) nka[ee] = 0.f; if (!(i0 + ee <= t)) { nbr[ee] = 0.f; nkr[ee] = 0.f; } }
                st_tile_T(lds + L_NKA, 16 * vs, 16 * it, C.lane, nka); st_tile_T(lds + L_NBR, 16 * vs, 16 * it, C.lane, nbr); st_tile_T(lds + L_NKR, 16 * vs, 16 * it, C.lane, nkr); }
        }
        bf16x8 v0, v1;
        {   const unsigned av = (unsigned)(size_t)(lds + L_VV) + (unsigned)(((8 * quad + (l15 >> 2)) * TS + 16 * vs + 4 * (l15 & 3)) * 2);
            const s16x4 p0 = tr_read<0>(av), p1 = tr_read<4 * TS * 2>(av), p2 = tr_read<32 * TS * 2>(av), p3 = tr_read<36 * TS * 2>(av);
            asm volatile("s_waitcnt lgkmcnt(0)" ::: "memory"); __builtin_amdgcn_sched_barrier(0);
            v0 = (bf16x8){p0[0], p0[1], p0[2], p0[3], p1[0], p1[1], p1[2], p1[3]}; v1 = (bf16x8){p2[0], p2[1], p2[2], p2[3], p3[0], p3[1], p3[2], p3[3]}; }
        LBAR();
        const int sbc = (c & 1) ? L_SB2 : L_SB, sbn = (c & 1) ? L_SB : L_SB2;
        {   const bf16x8 s0 = frag_nat(lds + sbc, 16 * vs, 0, C.lane), s1 = frag_nat(lds + sbc, 16 * vs, 1, C.lane);
#pragma unroll
            for (int q = 0; q < 2; ++q) { const int tt = 2 * rh + q; f32x4 z = {0.f, 0.f, 0.f, 0.f};
                z = MFMA16(frag_nat(lds + L_AT, 16 * tt, 0, C.lane), s0, z); z = MFMA16(frag_nat(lds + L_AT, 16 * tt, 1, C.lane), s1, z);
                z = MFMA16(frag_nat(lds + L_NKA, 16 * tt, 0, C.lane), v0, z); z = MFMA16(frag_nat(lds + L_NKA, 16 * tt, 1, C.lane), v1, z);
                st_tile_T(lds + L_Z, 16 * vs, 16 * tt, C.lane, z); }
        }
        LBAR();
        {   const bf16x8 z0 = frag_nat(lds + L_Z, 16 * vs, 0, C.lane), z1 = frag_nat(lds + L_Z, 16 * vs, 1, C.lane);
#pragma unroll
            for (int q = 0; q < 2; ++q) { const int tt = 2 * rh + q; f32x4 sa = {0.f, 0.f, 0.f, 0.f};
                sa = MFMA16(frag_nat(lds + L_TT, 16 * tt, 0, C.lane), z0, sa); sa = MFMA16(frag_nat(lds + L_TT, 16 * tt, 1, C.lane), z1, sa);
                st_tile_T(lds + L_SA, 16 * vs, 16 * tt, C.lane, sa); }
        }
        bf16x8 tb[2][2], tk[2][2];
        {   s16x4 pb[2][2][2], pk[2][2][2];
#pragma unroll
            for (int q = 0; q < 2; ++q) { const int kt0 = 16 * (2 * rh + q);
                const unsigned ab = (unsigned)(size_t)(lds + L_BT) + (unsigned)(((8 * quad + (l15 >> 2)) * TS + kt0 + 4 * (l15 & 3)) * 2);
                const unsigned ak = (unsigned)(size_t)(lds + L_KT) + (unsigned)(((8 * quad + (l15 >> 2)) * TS + kt0 + 4 * (l15 & 3)) * 2);
                pb[q][0][0] = tr_read<0>(ab); pb[q][0][1] = tr_read<4 * TS * 2>(ab); pb[q][1][0] = tr_read<32 * TS * 2>(ab); pb[q][1][1] = tr_read<36 * TS * 2>(ab);
                pk[q][0][0] = tr_read<0>(ak); pk[q][0][1] = tr_read<4 * TS * 2>(ak); pk[q][1][0] = tr_read<32 * TS * 2>(ak); pk[q][1][1] = tr_read<36 * TS * 2>(ak); }
            asm volatile("s_waitcnt lgkmcnt(0)" ::: "memory"); __builtin_amdgcn_sched_barrier(0);
#pragma unroll
            for (int q = 0; q < 2; ++q)
#pragma unroll
                for (int ks = 0; ks < 2; ++ks) {
                    tb[q][ks] = (bf16x8){pb[q][ks][0][0], pb[q][ks][0][1], pb[q][ks][0][2], pb[q][ks][0][3], pb[q][ks][1][0], pb[q][ks][1][1], pb[q][ks][1][2], pb[q][ks][1][3]};
                    tk[q][ks] = (bf16x8){pk[q][ks][0][0], pk[q][ks][0][1], pk[q][ks][0][2], pk[q][ks][0][3], pk[q][ks][1][0], pk[q][ks][1][1], pk[q][ks][1][2], pk[q][ks][1][3]}; }
        }
        LBAR();
        {   const bf16x8 s0 = frag_nat(lds + sbc, 16 * vs, 0, C.lane), s1 = frag_nat(lds + sbc, 16 * vs, 1, C.lane);
            const bf16x8 sa0 = frag_nat(lds + L_SA, 16 * vs, 0, C.lane), sa1 = frag_nat(lds + L_SA, 16 * vs, 1, C.lane);
            LAS float* Y = (LAS float*)(lds + L_Y);
#pragma unroll
            for (int q = 0; q < 2; ++q) { const int tt = 2 * rh + q; f32x4 yy = {0.f, 0.f, 0.f, 0.f};
                yy = MFMA16(frag_nat(lds + L_RT, 16 * tt, 0, C.lane), s0, yy); yy = MFMA16(frag_nat(lds + L_RT, 16 * tt, 1, C.lane), s1, yy);
                yy = MFMA16(frag_nat(lds + L_NBR, 16 * tt, 0, C.lane), sa0, yy); yy = MFMA16(frag_nat(lds + L_NBR, 16 * tt, 1, C.lane), sa1, yy);
                yy = MFMA16(frag_nat(lds + L_NKR, 16 * tt, 0, C.lane), v0, yy); yy = MFMA16(frag_nat(lds + L_NKR, 16 * tt, 1, C.lane), v1, yy);
                f32x4 dd = {0.f, 0.f, 0.f, 0.f};
                dd = MFMA16(tb[q][0], sa0, dd); dd = MFMA16(tb[q][1], sa1, dd); dd = MFMA16(tk[q][0], v0, dd); dd = MFMA16(tk[q][1], v1, dd);
                const int r0 = 16 * tt + 4 * quad, v = 16 * vs + l15;
#pragma unroll
                for (int ee = 0; ee < 4; ++ee) Y[(r0 + ee) * 64 + v] = yy[ee];
                const f32x4 pc = *(const LAS f32x4*)(lds + L_PC + (c & 1) * 512 + r0 * 4);
                St[q] = (St[q] + dd) * pc;
                st_tile_T(lds + sbn, 16 * vs, 16 * tt, C.lane, St[q]); }
        }
        LBAR();
    }
#pragma unroll
    for (int q = 0; q < 2; ++q) { float* so = sb.out + O_WKVP + ((size_t)bh * 64 + 16 * vs + l15) * 64 + 16 * (2 * rh + q) + 4 * quad; *(GAS f32x4*)so = St[q]; }
    __syncthreads();
}

constexpr int PTAB_OFF = LDSCTL_OFF + 512;
__device__ __forceinline__ const float* inptr(LAS unsigned char* ldsb, int i) {
    const LAS unsigned* p = (const LAS unsigned*)(ldsb + PTAB_OFF) + 2 * i;
    const unsigned lo = __builtin_amdgcn_readfirstlane(p[0]), hi = __builtin_amdgcn_readfirstlane(p[1]);
    return (const float*)(((unsigned long long)hi << 32) | lo);
}
struct Args { const float* in[28]; float* out; unsigned char* ws; int ph_lo, ph_hi; };
#define WSP(T, off) ((T*)(args.ws + (off)))
#define GEMM_BF16(Aptr, Bptr, Optr, Mv, Nv, Kv) do { pg8::Gemm g{Aptr, Bptr, Mv, Nv, Kv}; pg8::StaticOrder S; S.init(Mv, Nv, C.G, (int)blockIdx.x); \
        pg8::EpiBf16<0> E{Optr, Nv, nullptr, 0, 0, 1.f}; pg8::gemm_phase<pg8::EpiBf16<0>, pg8::StaticOrder, PG8_ALIGN, PG8_SP2>(C.lds + RING_OFF, g, S, E); } while (0)
__global__ void __launch_bounds__(NWAVES * 64, 2) hyb_fwd(Args args) {
    extern __shared__ __attribute__((aligned(16))) unsigned char lds[];
    LAS unsigned char* const ldsb = (LAS unsigned char*)lds;
    for (int u = threadIdx.x; u < (LDS_BYTES - LDSCTL_OFF) / 4; u += NWAVES * 64) ((LAS unsigned*)(ldsb + LDSCTL_OFF))[u] = 0u;
    __syncthreads();
    if (threadIdx.x < 28) ((LAS unsigned long long*)(ldsb + PTAB_OFF))[threadIdx.x] = (unsigned long long)args.in[threadIdx.x];
    __syncthreads();
#define INP(i) inptr(ldsb, (i))
#define MKCTX() Ctx C; { int t_ = threadIdx.x; asm volatile("" : "+v"(t_)); C.lds = ldsb; C.tid = t_; C.lane = t_ & 63; C.wave = __builtin_amdgcn_readfirstlane(t_ >> 6); \
        C.G = gridDim.x; const int bx_ = blockIdx.x; C.vcu = (C.G % 8 == 0) ? (bx_ % 8) * (C.G / 8) + bx_ / 8 : bx_; C.gw = C.vcu * NWAVES + C.wave; C.NGW = C.G * NWAVES; } \
        const int gt = C.gw * 64 + C.lane, NGT = C.NGW * 64; (void)gt; (void)NGT
    const int lo = args.ph_lo, hi = args.ph_hi;
    const bool fused = (hi - lo) > 1;
    XcdBarrier bar; bar.bar = WSP(unsigned, WS_CTL) + CW_BAR; bar.x = 0; bar.st = nullptr;
    if (fused) bar = xcd_barrier_post(WSP(unsigned, WS_CTL) + CW_BAR, (volatile LAS unsigned*)(ldsb + MISC_OFF) + 8);
#ifndef PROBE_PHASE
#define PROBE_PHASE -1
#endif
#ifndef PROBE_SUB
#define PROBE_SUB 0
#endif
#define IN(k) (lo <= (k) && (k) < hi)
#define REP(k) for (int rep_ = 0; rep_ < ((k) == PROBE_PHASE ? 2 : 1); ++rep_)
#define SEAM(k) do { if (IN(k) && IN((k) + 1)) xcd_barrier(bar); } while (0)

    if (IN(0)) REP(0) { MKCTX();
        LAS float* scr = (LAS float*)(C.lds + RING_OFF + C.wave * 16384);
        constexpr int I0 = 16 * 96, I1 = 8 * 32, I2 = 16 * 116, I3 = 16 * 32, I4 = 16 * 16, I5 = 16 * 16, I6 = 24, I7 = 24;
        constexpr int NITEMS = I0 + I1 + I2 + I3 + I4 + I5 + I6 + I7;
        for (int it = C.gw; it < NITEMS; it += C.NGW) {
            int r = it;
            if (r < I0) { p0_transpose_item(INP(14), A_IN, INP(9), WSP(bf16, WS_WAIN), 1024, 0, 0, scr, r, 96, C.lane); continue; } r -= I0;
            if (r < I1) { p0_transpose_item(INP(15), 1024, nullptr, WSP(bf16, WS_WAOUT), 512, 0, 0, scr, r, 32, C.lane); continue; } r -= I1;
            if (r < I2) { p0_transpose_item(INP(16), B_IN, INP(9) + DM, WSP(bf16, WS_WBIN), 1024, 0, 0, scr, r, 116, C.lane); continue; } r -= I2;
            if (r < I3) { p0_transpose_item(INP(17), 1024, nullptr, WSP(bf16, WS_WBOUT), 1024, 0, 0, scr, r, 32, C.lane); continue; } r -= I3;
            if (r < I4) { p0_transpose_item(INP(12), 512, INP(11), WSP(bf16, WS_WM), 1024, 0, 0, scr, r, 16, C.lane); continue; } r -= I4;
            if (r < I5) { p0_transpose_item(INP(12) + 1024 * 512, 512, INP(11) + DM, WSP(bf16, WS_WM), 1024, 0, 512, scr, r, 16, C.lane); continue; } r -= I5;
            if (r < I6) { p0_transpose_item(INP(20), RW, nullptr, WSP(bf16, WS_WL), 128, 0, 0, scr, r, 24, C.lane); continue; } r -= I6;
            p0_transpose_item(INP(22), RW, nullptr, WSP(bf16, WS_WL), 128, 64, RW, scr, r, 24, C.lane);
        }
        const v4u z4 = {0u, 0u, 0u, 0u};
        for (int i = gt; i < 16384; i += NGT) *((GAS v4u*)(WSP(bf16, WS_WBIN) + (size_t)B_IN * 1024) + i) = z4;
        for (int i = gt; i < 1536 * 8; i += NGT) { const int n = i >> 3, c = i & 7; *(GAS v4u*)(WSP(bf16, WS_WL) + (size_t)n * 128 + (n < RW ? 64 : 0) + c * 8) = z4; }
        for (int i = gt; i < 128 * 128; i += NGT) *((GAS v4u*)(WSP(bf16, WS_XN) + (size_t)NREAL * 1024) + i) = z4;
        for (int i = gt; i < 3 * 4 * 129; i += NGT) { const int g = i / (4 * 129), r = i % (4 * 129), hh = r / 129, k = r % 129; const int dil = g == 0 ? 1 : (g == 1 ? 4 : 16);
            WSP(float, WS_BT)[(g * 4 + hh) * 132 + k] = INP(13)[t5_bucket(dil * k) * 12 + g * 4 + hh]; }
        for (int m = C.gw; m < NREAL + 2048; m += C.NGW) {
            if (m < TP) rms_row_to_bf16(INP(0) + (size_t)m * DM, WSP(bf16, WS_XN) + (size_t)m * DM, C.lane);
            else if (m < NREAL) rms_row_to_bf16(INP(1) + (size_t)(m - TP) * DM, WSP(bf16, WS_XN) + (size_t)m * DM, C.lane);
            else rms_row_to_bf16(INP(2) + (size_t)(m - NREAL) * DM, WSP(bf16, WS_MEMN) + (size_t)(m - NREAL) * DM, C.lane);
        }
    } SEAM(0);
    if (IN(1)) REP(1) { MKCTX();
        GEMM_BF16(WSP(bf16, WS_XN), WSP(bf16, WS_WAIN), WSP(bf16, WS_P), MROWS, A_IN, DM);
        GEMM_BF16(WSP(bf16, WS_MEMN), WSP(bf16, WS_WM), WSP(bf16, WS_MKV), 2048, 1024, DM);
    } SEAM(1);
    if (IN(2)) REP(2) { MKCTX();
        const bf16* P = WSP(bf16, WS_P); const bf16* MKV = WSP(bf16, WS_MKV); float* out = args.out;
        for (int rp_ = 0; rp_ < (PROBE_SUB == 23 ? 2 : 1); ++rp_) {
        for (int i = gt; i < 2 * 2048 * 512; i += NGT) { const int l = i / (2048 * 512), r = (i / 512) % 2048, c = i % 512; out[O_MEM + i] = bf2f(MKV[(size_t)r * 1024 + l * 512 + c]); }
#pragma unroll
        for (int g = 0; g < 3; ++g) { const int Wg = g == 0 ? 128 : (g == 1 ? 512 : 2048); const size_t ob = g == 0 ? O_W0P : (g == 1 ? O_W1P : O_W2P);
            const int n = NBATCH * Wg * 512;
            for (int i = gt; i < n; i += NGT) { const int c = i % 512, ri = (i / 512) % Wg, b = i / (512 * Wg); const int t = SEQ - Wg + ri, kv = c >> 8, cc = c & 255;
                out[ob + i] = bf2f(P[(size_t)((b << 11) + t) * A_IN + RW + kv * RW + g * 256 + cc]); }
            const size_t os = g == 0 ? O_W0S : (g == 1 ? O_W1S : O_W2S);
            for (int i = gt; i < NSAMP * 512; i += NGT) { const int c = i % 512, r = i / 512, kv = c >> 8, cc = c & 255;
                out[os + i] = bf2f(P[(size_t)(TP + r) * A_IN + RW + kv * RW + g * 256 + cc]); } }
        }
        bf16* H = WSP(bf16, WS_H); const float* BT = WSP(float, WS_BT);
        for (int rp_ = 0; rp_ < (PROBE_SUB == 21 ? 2 : 1); ++rp_)
        for (int unit = blockIdx.x; unit < 256; unit += C.G) attn_a_unit(C, P, MKV, H, BT, unit);
        { LAS float* mg = (LAS float*)(C.lds + RING_OFF + 65536);
          for (int rp_ = 0; rp_ < (PROBE_SUB == 22 ? 2 : 1); ++rp_)
          for (int base = 0; base < NSAMP * 16; base += C.NGW) { const int task = base + C.gw; const bool on = task < NSAMP * 16;
            const int tq = task >> 2, part = task & 3, m = TP + (tq >> 2), hh = tq & 3;
            float Mo = 0.f, So = 1.f, Oo = 0.f;
            if (on) samp_part(P, BT, part == 0 ? INP(4) : (part == 1 ? INP(5) : INP(6)), MKV, INP(3), m, hh, part, 0, P + (size_t)m * A_IN + 2304 + hh * 64, C.lane, Mo, So, Oo);
            __syncthreads();
            mg[C.wave * 66 + C.lane] = Oo; if (C.lane == 0) { mg[C.wave * 66 + 64] = Mo; mg[C.wave * 66 + 65] = So; }
            __syncthreads();
            if (on && (part == 0 || part == 3)) { const bf16* prow = P + (size_t)m * A_IN; float o;
                if (part == 0) { const LAS float* w0 = mg + C.wave * 66; const float M0 = w0[64], M1 = w0[66 + 64], M2 = w0[132 + 64];
                    const float M = fmaxf(fmaxf(M0, M1), M2), e0 = __expf(M0 - M), e1 = __expf(M1 - M), e2 = __expf(M2 - M);
                    const float S = w0[65] * e0 + w0[66 + 65] * e1 + w0[132 + 65] * e2;
                    o = (w0[C.lane] * e0 + w0[66 + C.lane] * e1 + w0[132 + C.lane] * e2) / S;
                    H[(size_t)m * 512 + hh * 64 + C.lane] = (bf16)f2bf(o * silu(bf2f(prow[2560 + hh * 64 + C.lane]))); }
                else { o = Oo / So; H[(size_t)m * 512 + 256 + hh * 64 + C.lane] = (bf16)f2bf(o * silu(bf2f(prow[2560 + 256 + hh * 64 + C.lane]))); } }
          } }
    } SEAM(2);
    if (IN(3)) REP(3) { MKCTX(); GEMM_BF16(WSP(bf16, WS_H), WSP(bf16, WS_WAOUT), WSP(bf16, WS_F), MROWS, DM, 512); } SEAM(3);
    if (IN(4)) REP(4) { MKCTX();
        for (int m = C.gw; m < NREAL; m += C.NGW) { const bool samp = m >= TP;
            row_pass(WSP(bf16, WS_F) + (size_t)m * DM, samp ? INP(1) + (size_t)(m - TP) * DM : INP(0) + (size_t)m * DM,
                     args.out + (samp ? O_YS + (size_t)(m - TP) * DM : O_YP + (size_t)m * DM), INP(10), WSP(bf16, WS_XN) + (size_t)m * DM, C.lane); }
    } SEAM(4);
    if (IN(5)) REP(5) { MKCTX(); GEMM_BF16(WSP(bf16, WS_XN), WSP(bf16, WS_WBIN), WSP(bf16, WS_P), MROWS, B_INP, DM); } SEAM(5);
    if (IN(6)) REP(6) { MKCTX();
        ChunkP cp{WSP(bf16, WS_P), WSP(bf16, WS_WL), INP(18), INP(19), INP(21), INP(23), INP(24), INP(25)};
        const int per = (3072 + C.G - 1) / C.G, task0 = (int)blockIdx.x * per; int nt = 3072 - task0; if (nt > per) nt = per;
        if (nt > 0) scan_stage_a(C, cp, args.ws, task0, nt);
    } SEAM(6);
    if (IN(7)) REP(7) { MKCTX();
        const bf16* P = WSP(bf16, WS_P); bf16* H = WSP(bf16, WS_H);
        const int GB = C.G > 96 ? 96 : C.G, vb = (int)blockIdx.x;
        if (vb < GB) {
            ScanBP sb{WSP(bf16, WS_P), WSP(bf16, WS_H), args.out, INP(18), INP(26), INP(27), args.ws};
            for (int rp = 0; rp < (PROBE_SUB == 1 ? 2 : 1); ++rp)
            for (int bh = vb; bh < 96; bh += GB) scan_stage_b(C, sb, bh);
        }
        const int GO = C.G > 96 ? C.G - 96 : C.G, ob = C.G > 96 ? vb - 96 : vb;
        if (ob >= 0) for (int rp = 0; rp < (PROBE_SUB == 2 ? 2 : 1); ++rp) {
            for (int unit = ob; unit < 256; unit += GO) attn_b_unit(C, P, WSP(bf16, WS_MKV), H, unit);
            __syncthreads();
            { ScanP sp{WSP(bf16, WS_P), WSP(bf16, WS_H), args.out, INP(7), INP(8), INP(18), INP(19), INP(21), INP(23), INP(24), INP(25), INP(26), INP(27), INP(20), INP(22)};
              for (int u = 96 + ob; u < 480; u += GO) scan_unit(C, sp, u); }
            const int ogw = ob * NWAVES + C.wave, ONGW = GO * NWAVES, ogt = ogw * 64 + C.lane, ONGT = ONGW * 64;
            for (int task = ogw; task < NSAMP * 4; task += ONGW) { const int m = TP + (task >> 2), hh = task & 3;
                const bf16* prow = P + (size_t)m * B_INP;
                float Mo, So, Oo; samp_part(P, nullptr, nullptr, nullptr, INP(3), m, hh, 3, 1, prow + CSH + hh * 64, C.lane, Mo, So, Oo); const float om = Oo / So;
                H[(size_t)m * 1024 + RW + hh * 64 + C.lane] = (bf16)f2bf(om * silu(bf2f(prow[2688 + RW + hh * 64 + C.lane]))); }
            for (int i = ogt; i < NBATCH * CSH; i += ONGT) { const int b = i / CSH, c = i % CSH; args.out[O_SHP + i] = bf2f(P[(size_t)(b * SEQ + SEQ - 1) * B_INP + c]); }
            for (int i = ogt; i < SBATCH * CSH; i += ONGT) { const int sb = i / CSH, c = i % CSH; args.out[O_SHS + i] = bf2f(P[(size_t)(TP + sb * 4 + 3) * B_INP + c]); }
        }
    } SEAM(7);
    if (IN(8)) REP(8) { MKCTX(); GEMM_BF16(WSP(bf16, WS_H), WSP(bf16, WS_WBOUT), WSP(bf16, WS_F), MROWS, DM, DM); } SEAM(8);
    if (IN(9)) { MKCTX();
        for (int m = C.gw; m < NREAL; m += C.NGW) { const bool samp = m >= TP;
            float* xo = args.out + (samp ? O_YS + (size_t)(m - TP) * DM : O_YP + (size_t)m * DM);
            row_pass(WSP(bf16, WS_F) + (size_t)m * DM, xo, xo, INP(10) + DM, nullptr, C.lane); }
    }
#undef IN
#undef SEAM
}

extern "C" void kernel_launch(void* const* d_in, const int* in_sizes, int n_in, void* d_out, int out_size, void* d_ws, size_t ws_size, hipStream_t stream) {
    static int grid = 0;
    if (grid == 0) {
        if (n_in != 28 || in_sizes[0] != TP * DM || (size_t)out_size != O_END || ws_size < WS_END) {
            fprintf(stderr, "kernel_launch: unexpected shapes: n_in %d in0 %d out %d ws %zu (need >= %zu); nothing launched\n", n_in, n_in > 0 ? in_sizes[0] : -1, out_size, ws_size, (size_t)WS_END); grid = -1; return; }
        int dev = 0, cus = 0, per_cu = 0;
        if (hipGetDevice(&dev) != hipSuccess || hipDeviceGetAttribute(&cus, hipDeviceAttributeMultiprocessorCount, dev) != hipSuccess) { fprintf(stderr, "kernel_launch: device query failed\n"); grid = -1; return; }
        if (hipFuncSetAttribute((const void*)hyb_fwd, hipFuncAttributeMaxDynamicSharedMemorySize, LDS_BYTES) != hipSuccess) { fprintf(stderr, "kernel_launch: hipFuncSetAttribute failed\n"); grid = -1; return; }
        if (hipOccupancyMaxActiveBlocksPerMultiprocessor(&per_cu, (const void*)hyb_fwd, NWAVES * 64, LDS_BYTES) != hipSuccess || per_cu < 1) {
            fprintf(stderr, "kernel_launch: occupancy query reports %d workgroups per CU\n", per_cu); }
        (void)hipGetLastError();
        grid = cus;
    }
    if (grid < 0) return;
    if (hipMemsetAsync((char*)d_ws + WS_CTL, 0, CTL_ZERO_BYTES, stream) != hipSuccess) { fprintf(stderr, "kernel_launch: memset failed\n"); return; }
    Args a{};
    for (int i = 0; i < 28; ++i) a.in[i] = (const float*)d_in[i];
    a.out = (float*)d_out; a.ws = (unsigned char*)d_ws;
#if MK_N_LAUNCHES == 1
    a.ph_lo = 0; a.ph_hi = N_PHASES;
    hipLaunchKernelGGL(hyb_fwd, dim3(grid), dim3(NWAVES * 64), LDS_BYTES, stream, a);
#else
    for (int li = 0; li < N_PHASES; ++li) { a.ph_lo = li; a.ph_hi = li + 1;
        hipLaunchKernelGGL(hyb_fwd, dim3(grid), dim3(NWAVES * 64), LDS_BYTES, stream, a); }
#endif
    const hipError_t le = hipPeekAtLastError();
    if (le != hipSuccess) fprintf(stderr, "kernel_launch: launch failed: %s\n", hipGetErrorName(le));
}
```

```cpp
#include <hip/hip_runtime.h>
#include <cstdio>
#include <cstdint>
namespace pg8 {
#define PG8_LAS __attribute__((address_space(3)))
typedef unsigned short bf16_t;
typedef short bf16x8 __attribute__((ext_vector_type(8)));
typedef float f32x4 __attribute__((ext_vector_type(4)));
typedef unsigned u32x4 __attribute__((ext_vector_type(4)));
constexpr int BM = 256, BK = 64, HALF = 128, HTB = HALF * BK * 2  , STAGE_BYTES = 8 * HTB, NXCD = 8, WGM = 8;

__host__ __device__ __forceinline__ int lds_byte(int r, int c) { const int st = (r >> 4) * 2 + (c >> 5), rr = r & 15, cc = c & 31, ob = rr * 64 + cc * 2; return st * 1024 + (ob ^ (((ob >> 9) & 1) << 5)); }
__host__ __device__ __forceinline__ void stage_rc(int b, int& R, int& C) { const int st = b / 1024, sb = b % 1024, swz = sb ^ (((sb >> 9) & 1) << 5); R = (st >> 1) * 16 + swz / 64; C = (st & 1) * 32 + (swz % 64) / 2; }
__host__ __device__ __forceinline__ int perm32(int rho) { const int n = rho >> 4, i = rho & 15; return 8 * (i >> 2) + 4 * n + (i & 3); }

struct Unit { int pm, pn; };
struct Gemm { const bf16_t* A; const bf16_t* Bt; int M, N, K; };

struct StaticOrder {
    int nM, nN, nwg, G, c;
    __host__ __device__ void init(int M, int N, int G_, int c_) { nM = M / BM; nN = N / BM; nwg = nM * nN; G = G_; c = c_; }
    __host__ __device__ bool next(int i, Unit& u) const {
        const long L = (long)i * G + c; if (L >= nwg) return false;
        int wgid = (int)L; { const int q = nwg / NXCD, r = nwg % NXCD, xcd = wgid % NXCD, off = wgid / NXCD; wgid = (xcd < r ? xcd * (q + 1) : r * (q + 1) + (xcd - r) * q) + off; }
        const int nig = WGM * nN, gid = wgid / nig, fm = gid * WGM, gsz = (nM - fm) < WGM ? (nM - fm) : WGM;
        u.pm = fm + ((wgid % nig) % gsz); u.pn = (wgid % nig) / gsz; return true;
    }
    __device__ __forceinline__ void a_ready(const Unit&) const {}
    __device__ __forceinline__ void done(const Unit&) const {}
};

__device__ __forceinline__ unsigned cvt_pk_bf16(float lo, float hi) { unsigned r; asm volatile("v_cvt_pk_bf16_f32 %0, %1, %2" : "=v"(r) : "v"(lo), "v"(hi)); return r; }
typedef float f32x2 __attribute__((ext_vector_type(2)));
__device__ __forceinline__ f32x2 gelu_pk(f32x2 v) {
    const f32x2 av = __builtin_elementwise_abs(v), d = av * 0.2316418882f + 1.0f;
    f32x2 t; t.x = __builtin_amdgcn_rcpf(d.x); t.y = __builtin_amdgcn_rcpf(d.y);
    f32x2 q = t * 0.5307027145f + (-0.7265760135f); q = q * t + 0.7107068705f; q = q * t + (-0.142248368f); q = q * t + 0.127414796f; q = q * t;
    const f32x2 s = (v * v) * (-0.72134752044f);
    f32x2 e; e.x = __builtin_amdgcn_exp2f(s.x); e.y = __builtin_amdgcn_exp2f(s.y);
    const f32x2 m = v * (q * e), r = v - m;
    f32x2 o; o.x = v.x < 0.f ? m.x : r.x; o.y = v.y < 0.f ? m.y : r.y; return o;
}

template <int ACT  > struct EpiBf16 {
    static constexpr bool PERM = true, AFTER_DRAIN = false; static_assert(ACT == 0 || ACT == 1, "EpiBf16: ACT is 0 (none) or 1 (gelu_pk)");
    bf16_t* O; int ldc; const float* bias; int split_cols; size_t split_stride; float scale0;
    __device__ __forceinline__ void operator()(const f32x4 (&acc)[2][2][4][2], const Unit& u, int wr, int wc, int fr, int fq) const {
        const int row0 = u.pm * BM + wr * 64 + fr; int colt = u.pn * BM; bf16_t* base = O;
        float sc = 1.f; if (split_cols) { const int t = colt / split_cols; base += (size_t)t * split_stride; colt -= t * split_cols; if (t == 0) sc = scale0; }
        const int col0 = colt + wc * 32 + 8 * fq, bcol0 = u.pn * BM + wc * 32 + 8 * fq;
        f32x4 bv[2][2];
#pragma unroll
        for (int bj = 0; bj < 2; ++bj)
#pragma unroll
            for (int n = 0; n < 2; ++n) bv[bj][n] = bias ? *(const f32x4*)(bias + bcol0 + bj * HALF + 4 * n) : (f32x4){0.f, 0.f, 0.f, 0.f};
#pragma unroll
        for (int ai = 0; ai < 2; ++ai)
#pragma unroll
            for (int m = 0; m < 4; ++m) { bf16_t* rowp = base + (size_t)(row0 + ai * HALF + m * 16) * ldc + col0;
#pragma unroll
                for (int bj = 0; bj < 2; ++bj) { f32x4 v0 = acc[ai][bj][m][0] + bv[bj][0], v1 = acc[ai][bj][m][1] + bv[bj][1];
                    if (ACT == 1) { f32x2 a = gelu_pk((f32x2){v0[0], v0[1]}), b = gelu_pk((f32x2){v0[2], v0[3]}), c = gelu_pk((f32x2){v1[0], v1[1]}), d = gelu_pk((f32x2){v1[2], v1[3]});
                        v0 = (f32x4){a.x, a.y, b.x, b.y}; v1 = (f32x4){c.x, c.y, d.x, d.y}; }
                    v0 = v0 * sc; v1 = v1 * sc; u32x4 w; w.x = cvt_pk_bf16(v0[0], v0[1]); w.y = cvt_pk_bf16(v0[2], v0[3]); w.z = cvt_pk_bf16(v1[0], v1[1]); w.w = cvt_pk_bf16(v1[2], v1[3]);
                    *(u32x4*)(rowp + bj * HALF) = w; } }
    }
};
template <class Epi, class Sched, bool ALIGN_EPI = false, bool SP2 = false>
__device__ __forceinline__ void gemm_phase(PG8_LAS unsigned char* lds, const Gemm g, const Sched& S, const Epi& E) {
    const int tid = threadIdx.x, wid = __builtin_amdgcn_readfirstlane(tid >> 6), lane = tid & 63, wr = wid >> 2, wc = wid & 3, fr = lane & 15, fq = lane >> 4;
    const int K = g.K, nt = K / BK;
    unsigned voffA[2], voffB[2];
#pragma unroll
    for (int i = 0; i < 2; ++i) { int R, C; stage_rc(tid * 16 + i * 8192, R, C); const int Rb = Epi::PERM ? ((R & ~31) + perm32(R & 31)) : R;
        voffA[i] = (unsigned)(R * K + C) * 2u; voffB[i] = (unsigned)(Rb * K + C) * 2u; }
    const size_t kstep = (size_t)(BK * 2);
    const size_t hstep = (size_t)HALF * K * 2;
    const size_t tstep = 2 * hstep;
    const unsigned ldsw = (unsigned)wid * 1024u;
    const int aoff = lds_byte(wr * 64 + fr, fq * 8), boff = lds_byte(wc * 32 + fr, fq * 8);
#define PG8_SA(b, h) (((b) * 2 + (h)) * HTB)
#define PG8_SB(b, h) ((4 + (b) * 2 + (h)) * HTB)
#define PG8_STAGE(bufoff, gbase, voff) do { _Pragma("unroll") for (int _i = 0; _i < 2; ++_i) \
        __builtin_amdgcn_global_load_lds((const unsigned*)((const char*)(gbase) + (voff)[_i]), (PG8_LAS unsigned*)(lds + (bufoff) + ldsw + _i * 8192), 16, 0, 0); } while (0)
#define PG8_LDA(dst, b, h) do { _Pragma("unroll") for (int m = 0; m < 4; ++m) _Pragma("unroll") for (int k = 0; k < 2; ++k) dst[m][k] = *(const PG8_LAS bf16x8*)(lds + PG8_SA(b, h) + aoff + m * 2048 + k * 1024); } while (0)
#define PG8_LDB(dst, b, h) do { _Pragma("unroll") for (int n = 0; n < 2; ++n) _Pragma("unroll") for (int k = 0; k < 2; ++k) dst[n][k] = *(const PG8_LAS bf16x8*)(lds + PG8_SB(b, h) + boff + n * 2048 + k * 1024); } while (0)
#define PG8_MMA(ai, bj, At, Bt) do { __builtin_amdgcn_s_setprio(1); _Pragma("unroll") for (int m = 0; m < 4; ++m) _Pragma("unroll") for (int n = 0; n < 2; ++n) _Pragma("unroll") for (int k = 0; k < 2; ++k) \
        acc[ai][bj][m][n] = __builtin_amdgcn_mfma_f32_16x16x32_bf16(Bt[n][k], At[m][k], acc[ai][bj][m][n], 0, 0, 0); __builtin_amdgcn_s_setprio(0); } while (0)
#define PG8_WAIT_V(n) asm volatile("s_waitcnt vmcnt(" #n ")" ::: "memory")
#define PG8_WAIT_L(n) asm volatile("s_waitcnt lgkmcnt(" #n ")" ::: "memory")
#define PG8_BAR __builtin_amdgcn_s_barrier()
#define PG8_SCHED __builtin_amdgcn_sched_barrier(0)
    Unit cur, nxt; int ui = 0;
    if (!S.next(0, cur)) return;
    f32x4 acc[2][2][4][2];
#pragma unroll
    for (int a = 0; a < 2; ++a)
#pragma unroll
        for (int b = 0; b < 2; ++b)
#pragma unroll
            for (int m = 0; m < 4; ++m)
#pragma unroll
                for (int n = 0; n < 2; ++n) acc[a][b][m][n] = (f32x4){0.f, 0.f, 0.f, 0.f};
    bf16x8 At[4][2], B0[2][2], B1[2][2];
    const char* cA = (const char*)g.A + (size_t)cur.pm * tstep; const char* cB = (const char*)g.Bt + (size_t)cur.pn * tstep;
    S.a_ready(cur);
    if constexpr (SP2) {
        PG8_STAGE(PG8_SB(0, 0), cB, voffB); PG8_STAGE(PG8_SB(0, 1), cB + hstep, voffB); PG8_STAGE(PG8_SA(0, 0), cA, voffA); PG8_STAGE(PG8_SA(0, 1), cA + hstep, voffA);
        if (wr == 1) PG8_BAR;
        PG8_WAIT_V(2); PG8_BAR;
        PG8_STAGE(PG8_SB(1, 0), cB + kstep, voffB); PG8_STAGE(PG8_SA(1, 0), cA + kstep, voffA); PG8_STAGE(PG8_SB(1, 1), cB + hstep + kstep, voffB);
        PG8_WAIT_V(6); PG8_BAR;
    } else {
        PG8_STAGE(PG8_SB(0, 0), cB, voffB); PG8_STAGE(PG8_SA(0, 0), cA, voffA); PG8_STAGE(PG8_SB(0, 1), cB + hstep, voffB); PG8_STAGE(PG8_SA(0, 1), cA + hstep, voffA);
        if (wr == 1) PG8_BAR;
        PG8_WAIT_V(4); PG8_BAR;
        PG8_STAGE(PG8_SB(1, 0), cB + kstep, voffB); PG8_STAGE(PG8_SA(1, 0), cA + kstep, voffA); PG8_STAGE(PG8_SB(1, 1), cB + hstep + kstep, voffB);
        PG8_WAIT_V(6); PG8_BAR;
    }
    for (;;) {
        const bool has_next = S.next(ui + 1, nxt);
        const char* nA = has_next ? (const char*)g.A + (size_t)nxt.pm * tstep : cA; const char* nB = has_next ? (const char*)g.Bt + (size_t)nxt.pn * tstep : cB;
        for (int t = 0; t < nt; t += 2) {
            const bool last = (t == nt - 2);
            const char* a1 = cA + (size_t)(t + 1) * kstep;
            const char* a2 = last ? nA : cA + (size_t)(t + 2) * kstep; const char* b2 = last ? nB : cB + (size_t)(t + 2) * kstep;
            const char* a3 = a2 + kstep; const char* b3 = b2 + kstep;
            if (last && has_next) S.a_ready(nxt);
            if constexpr (SP2) {
            PG8_LDB(B0, 0, 0); PG8_LDB(B1, 0, 1); PG8_SCHED; PG8_LDA(At, 0, 0); PG8_STAGE(PG8_SA(1, 1), a1 + hstep, voffA);
            PG8_WAIT_V(8); PG8_WAIT_L(0); PG8_BAR; PG8_MMA(0, 0, At, B0); PG8_MMA(0, 1, At, B1); PG8_BAR; PG8_SCHED;
            PG8_LDA(At, 0, 1); PG8_STAGE(PG8_SB(0, 0), b2, voffB); PG8_STAGE(PG8_SB(0, 1), b2 + hstep, voffB); PG8_STAGE(PG8_SA(0, 0), a2, voffA);
            PG8_WAIT_V(8); PG8_WAIT_L(0); PG8_BAR; PG8_MMA(1, 0, At, B0); PG8_MMA(1, 1, At, B1); PG8_BAR; PG8_SCHED;
            PG8_LDB(B0, 1, 0); PG8_LDB(B1, 1, 1); PG8_SCHED; PG8_LDA(At, 1, 0); PG8_STAGE(PG8_SA(0, 1), a2 + hstep, voffA);
            PG8_WAIT_V(8); PG8_WAIT_L(0); PG8_BAR; PG8_MMA(0, 0, At, B0); PG8_MMA(0, 1, At, B1); PG8_BAR; PG8_SCHED;
            PG8_LDA(At, 1, 1); PG8_STAGE(PG8_SB(1, 0), b3, voffB); PG8_STAGE(PG8_SB(1, 1), b3 + hstep, voffB); PG8_STAGE(PG8_SA(1, 0), a3, voffA);
            PG8_WAIT_V(8); PG8_WAIT_L(0); PG8_BAR; PG8_MMA(1, 0, At, B0); PG8_MMA(1, 1, At, B1); PG8_BAR; PG8_SCHED;
            } else {
            PG8_LDB(B0, 0, 0); PG8_SCHED; PG8_LDA(At, 0, 0); PG8_STAGE(PG8_SA(1, 1), a1 + hstep, voffA);
            PG8_WAIT_L(8); PG8_BAR; PG8_WAIT_L(0); PG8_MMA(0, 0, At, B0); PG8_BAR; PG8_SCHED;
            PG8_LDB(B1, 0, 1); PG8_STAGE(PG8_SB(0, 0), b2, voffB);
            PG8_BAR; PG8_WAIT_L(0); PG8_MMA(0, 1, At, B1); PG8_BAR;
            PG8_LDA(At, 0, 1); PG8_STAGE(PG8_SA(0, 0), a2, voffA);
            PG8_BAR; PG8_WAIT_L(0); PG8_MMA(1, 0, At, B0); PG8_BAR; PG8_SCHED;
            PG8_STAGE(PG8_SB(0, 1), b2 + hstep, voffB);
            PG8_WAIT_V(6); PG8_BAR; PG8_MMA(1, 1, At, B1); PG8_BAR;
            PG8_LDB(B0, 1, 0); PG8_SCHED; PG8_LDA(At, 1, 0); PG8_STAGE(PG8_SA(0, 1), a2 + hstep, voffA);
            PG8_WAIT_L(8); PG8_BAR; PG8_WAIT_L(0); PG8_MMA(0, 0, At, B0); PG8_BAR; PG8_SCHED;
            PG8_LDB(B1, 1, 1); PG8_STAGE(PG8_SB(1, 0), b3, voffB);
            PG8_BAR; PG8_WAIT_L(0); PG8_MMA(0, 1, At, B1); PG8_BAR;
            PG8_LDA(At, 1, 1); PG8_STAGE(PG8_SA(1, 0), a3, voffA);
            PG8_BAR; PG8_WAIT_L(0); PG8_MMA(1, 0, At, B0); PG8_BAR; PG8_SCHED;
            PG8_STAGE(PG8_SB(1, 1), b3 + hstep, voffB);
            PG8_WAIT_V(6); PG8_BAR; PG8_MMA(1, 1, At, B1); PG8_BAR;
            }
        }
        if constexpr (ALIGN_EPI) { if (wr == 0) PG8_BAR; }
        if constexpr (!Epi::AFTER_DRAIN) { E(acc, cur, wr, wc, fr, fq); S.done(cur); }
        if (!has_next) break;
#pragma unroll
        for (int a = 0; a < 2; ++a)
#pragma unroll
            for (int b = 0; b < 2; ++b)
#pragma unroll
                for (int m = 0; m < 4; ++m)
#pragma unroll
                    for (int n = 0; n < 2; ++n) acc[a][b][m][n] = (f32x4){0.f, 0.f, 0.f, 0.f};
        cur = nxt; cA = nA; cB = nB; ++ui;
        if constexpr (ALIGN_EPI) { if (wr == 1) PG8_BAR; }
    }
    PG8_WAIT_V(0);
    if constexpr (!ALIGN_EPI) { if (wr == 0) PG8_BAR; }
    PG8_BAR;
    if constexpr (Epi::AFTER_DRAIN) { E.fused(acc, cur, wr, wc, fr, fq, lds, wid, lane); S.done(cur); }
#undef PG8_SA
#undef PG8_SB
#undef PG8_STAGE
#undef PG8_LDA
#undef PG8_LDB
#undef PG8_MMA
#undef PG8_WAIT_V
#undef PG8_WAIT_L
#undef PG8_BAR
#undef PG8_SCHED
}
}

#ifndef PG8_SP2
#define PG8_SP2 true
#endif
#ifndef PG8_ALIGN
#define PG8_ALIGN true
#endif

constexpr int NWAVES = 8;
#ifndef MK_N_LAUNCHES
#define MK_N_LAUNCHES 1
#endif
constexpr int N_PHASES = 10;
constexpr int TP = 16384, NSAMP = 128, NREAL = TP + NSAMP, MROWS = 16640, DM = 1024;
constexpr int SEQ = 2048, NBATCH = 8, SBATCH = 32, STOK = 4, NMEM = 256;
constexpr int A_IN = 3072, B_IN = 3712, B_INP = 3840, CSH = 2432, RW = 768;
constexpr float RMS_EPS = 1e-6f, GN_EPS = 64e-5f;
constexpr size_t O_YP = 0, O_YS = 16777216, O_MEM = 16908288, O_W0P = 19005440, O_W1P = 19529728, O_W2P = 21626880,
                 O_W0S = 30015488, O_W1S = 30081024, O_W2S = 30146560, O_WKVP = 30212096, O_WKVS = 30605312, O_SHP = 32178176, O_SHS = 32197632, O_END = 32275456;
constexpr size_t MiB = 1u << 20;
constexpr size_t WS_CTL = 0, CTL_ZERO_BYTES = 1 * MiB;
constexpr size_t WS_WAIN = 1 * MiB, WS_WAOUT = 7 * MiB, WS_WBIN = 8 * MiB, WS_WBOUT = 16 * MiB, WS_WM = 18 * MiB, WS_WL = 20 * MiB, WS_BT = 20 * MiB + 512 * 1024;
constexpr size_t WS_MEMN = 21 * MiB, WS_MKV = 25 * MiB, WS_TW = 29 * MiB, WS_XN = 34 * MiB, WS_H = 67 * MiB, WS_F = 100 * MiB, WS_P = 149 * MiB, WS_END = 271 * MiB + 1125 * 41472 + 65536;
constexpr int CW_TMO = 0, CW_BAR = 4096;

constexpr int RING_OFF = 0, RING_BYTES = 161792;
constexpr int LDSCTL_OFF = RING_BYTES, MISC_OFF = LDSCTL_OFF + 320;
constexpr int LDS_BYTES = 163840;

#define GAS __attribute__((address_space(1)))
#define LAS __attribute__((address_space(3)))
typedef unsigned short bf16;
typedef unsigned v4u __attribute__((ext_vector_type(4)));
typedef unsigned v2u __attribute__((ext_vector_type(2)));
typedef float f32x4 __attribute__((ext_vector_type(4)));
typedef GAS unsigned gu32;
#define RLX_AGENT __ATOMIC_RELAXED, __HIP_MEMORY_SCOPE_AGENT
#define LDS_WAIT() asm volatile("s_waitcnt lgkmcnt(0)" ::: "memory")
#define VM_WAIT() asm volatile("s_waitcnt vmcnt(0)" ::: "memory")
__device__ __forceinline__ unsigned f2bf(float f) { unsigned u = __builtin_bit_cast(unsigned, f); return (u + 0x7fffu + ((u >> 16) & 1u)) >> 16; }
typedef float f32x2_t __attribute__((ext_vector_type(2))); typedef __bf16 bf16x2_t __attribute__((ext_vector_type(2)));
__device__ __forceinline__ unsigned pk2(float lo, float hi) { const f32x2_t v = {lo, hi}; const bf16x2_t b = __builtin_convertvector(v, bf16x2_t); return __builtin_bit_cast(unsigned, b); }
__device__ __forceinline__ float bflo(unsigned u) { return __builtin_bit_cast(float, u << 16); }
__device__ __forceinline__ float bfhi(unsigned u) { return __builtin_bit_cast(float, u & 0xffff0000u); }
__device__ __forceinline__ float bf2f(bf16 h) { return __builtin_bit_cast(float, (unsigned)h << 16); }

#define XB_TMO      128
#define XB_XCNT(j)  (256  + 64 * (j))
#define XB_XSUB(j)  (1280 + 64 * (j))
#define XB_XGEN(j)  (2304 + 64 * (j))
#define XB_TOP      3328
#define XB_TOPGEN   3392
#define XCD_BAR_WORDS 3456
#define XB_SPIN_CAP (1u << 20)
__device__ __forceinline__ unsigned xb_ld(unsigned* p)              { return __hip_atomic_load(p, __ATOMIC_RELAXED, __HIP_MEMORY_SCOPE_AGENT); }
__device__ __forceinline__ unsigned xb_add(unsigned* p, unsigned v) { return __hip_atomic_fetch_add(p, v, __ATOMIC_RELAXED, __HIP_MEMORY_SCOPE_AGENT); }
__device__ __forceinline__ unsigned xb_xcc_id() { return (unsigned)__builtin_amdgcn_s_getreg((3 << 11) | 20) & 0xFu; }
#define XB_SPIN(cond, bar) do { unsigned _sp = 0; while (cond) { __builtin_amdgcn_s_sleep(1); \
    if ((++_sp & 255u) == 0u) { if (xb_ld(&(bar)[XB_TMO])) break; if (_sp > XB_SPIN_CAP) { atomicAdd(&(bar)[XB_TMO], 1u); break; } } } } while (0)
struct XcdBarrier { unsigned* bar; unsigned x; volatile LAS unsigned* st; };
__device__ __forceinline__ XcdBarrier xcd_barrier_post(unsigned* bar, volatile LAS unsigned* st) {
    XcdBarrier b; b.bar = bar; b.x = xb_xcc_id(); b.st = st;
    if (threadIdx.x == 0) (void)xb_add(&bar[XB_XCNT(b.x)], 1u);
    return b;
}
__device__ __forceinline__ void xcd_barrier_complete(unsigned* bar, unsigned x, unsigned& nloc, unsigned& nx) {
    const unsigned G = gridDim.x * gridDim.y * gridDim.z;
    unsigned sum, cnt, mine, sp = 0u;
    for (;;) {
        sum = 0u; cnt = 0u; mine = 0u;
#pragma unroll
        for (unsigned j = 0; j < 16; ++j) { const unsigned c = xb_ld(&bar[XB_XCNT(j)]); sum += c; cnt += (c > 0u) ? 1u : 0u; mine = (j == x) ? c : mine; }
        if (sum == G) break;
        __builtin_amdgcn_s_sleep(1);
        if ((++sp & 255u) == 0u) { if (xb_ld(&bar[XB_TMO])) break; if (sp > XB_SPIN_CAP) { atomicAdd(&bar[XB_TMO], 1u); break; } }
    }
    nloc = mine > 0u ? mine : 1u; nx = cnt > 0u ? cnt : 1u;
}
__device__ __forceinline__ void xcd_barrier(const XcdBarrier& b) {
    asm volatile("s_waitcnt vmcnt(0)" ::: "memory");
    __syncthreads();
    if (threadIdx.x == 0) {
        unsigned* bar = b.bar;
        __builtin_amdgcn_s_waitcnt(0);
        unsigned nloc = b.st[0], nx = b.st[1];
        if (nloc == 0u) { xcd_barrier_complete(bar, b.x, nloc, nx); b.st[0] = nloc; b.st[1] = nx; }
        const unsigned old = xb_add(&bar[XB_XSUB(b.x)], 1u);
        const unsigned gen = old / nloc;
        if (old + 1u == (gen + 1u) * nloc) {
            __builtin_amdgcn_fence(__ATOMIC_RELEASE, "agent");
            asm volatile("s_waitcnt vmcnt(0)" ::: "memory");
            const unsigned og = xb_add(&bar[XB_TOP], 1u);
            const unsigned tg = og / nx;
            if (og + 1u == (tg + 1u) * nx) xb_add(&bar[XB_TOPGEN], 1u);
            else XB_SPIN(xb_ld(&bar[XB_TOPGEN]) == tg, bar);
            __builtin_amdgcn_fence(__ATOMIC_ACQUIRE, "agent");
            xb_add(&bar[XB_XGEN(b.x)], 1u);
            asm volatile("s_waitcnt vmcnt(0)" ::: "memory");
        } else {
            XB_SPIN(xb_ld(&bar[XB_XGEN(b.x)]) == gen, bar);
            __builtin_amdgcn_fence(__ATOMIC_ACQUIRE, "agent");
            asm volatile("s_waitcnt vmcnt(0)" ::: "memory");
        }
    }
    __syncthreads();
}

struct Ctx { LAS unsigned char* lds; int tid, lane, wave, vcu, G, gw, NGW; };

__device__ __forceinline__ float wave_sum(float v) {
#pragma unroll
    for (int o = 1; o < 64; o <<= 1) v += __shfl_xor(v, o);
    return v;
}
__device__ __forceinline__ float wave_max(float v) {
#pragma unroll
    for (int o = 1; o < 64; o <<= 1) v = fmaxf(v, __shfl_xor(v, o));
    return v;
}
__device__ __forceinline__ float rdlane(float v, int l) { return __builtin_bit_cast(float, __builtin_amdgcn_readlane(__builtin_bit_cast(int, v), l)); }

__device__ __forceinline__ void p0_transpose_item(const float* W, int N, const float* gain, bf16* WT, int ldo, int col_off, int row_off, LAS float* scr, int item, int nblk, int lane) {
    const int kb = item / nblk, nb = item % nblk, k0 = 64 * kb, n0 = 32 * nb;
#pragma unroll 8
    for (int i = 0; i < 32; ++i) { const int kk = 2 * i + (lane >> 5); const float g = gain ? gain[k0 + kk] : 1.f; scr[kk * 33 + (lane & 31)] = W[(size_t)(k0 + kk) * N + n0 + (lane & 31)] * g; }
    LDS_WAIT(); asm volatile("" ::: "memory");
    const int c = lane & 7;
#pragma unroll
    for (int j = 0; j < 4; ++j) { const int n = (lane >> 3) + 8 * j; const LAS float* s = scr + (8 * c) * 33 + n;
        v4u o; o.x = pk2(s[0 * 33], s[1 * 33]); o.y = pk2(s[2 * 33], s[3 * 33]); o.z = pk2(s[4 * 33], s[5 * 33]); o.w = pk2(s[6 * 33], s[7 * 33]);
        *(GAS v4u*)(WT + (size_t)(row_off + n0 + n) * ldo + col_off + k0 + 8 * c) = o; }
    LDS_WAIT(); asm volatile("" ::: "memory");
}
__device__ __forceinline__ void rms_row_to_bf16(const float* xrow, bf16* orow, int lane) {
    const GAS f32x4* xr = (const GAS f32x4*)xrow + lane;
    f32x4 v[4]; float s = 0.f;
#pragma unroll
    for (int j = 0; j < 4; ++j) { v[j] = xr[64 * j]; s += (v[j].x * v[j].x + v[j].y * v[j].y) + (v[j].z * v[j].z + v[j].w * v[j].w); }
    const float r = 1.f / sqrtf(wave_sum(s) * (1.f / DM) + RMS_EPS);
    GAS unsigned long long* o8 = (GAS unsigned long long*)orow + lane;
#pragma unroll
    for (int j = 0; j < 4; ++j) o8[64 * j] = (unsigned long long)pk2(v[j].x * r, v[j].y * r) | ((unsigned long long)pk2(v[j].z * r, v[j].w * r) << 32);
}
__device__ __forceinline__ int t5_bucket(int dist) {
    if (dist < 16) return dist;
    const double x = log((double)dist / 16.0) / log(128.0) * 16.0;
    int large = 16 + (int)x; return large < 31 ? large : 31;
}

__device__ __forceinline__ void ldq64(const bf16* p, float (&q)[64]) {
#pragma unroll
    for (int i = 0; i < 8; ++i) { const v4u u = *(const GAS v4u*)(p + 8 * i);
        q[8 * i + 0] = bflo(u.x); q[8 * i + 1] = bfhi(u.x); q[8 * i + 2] = bflo(u.y); q[8 * i + 3] = bfhi(u.y);
        q[8 * i + 4] = bflo(u.z); q[8 * i + 5] = bfhi(u.z); q[8 * i + 6] = bflo(u.w); q[8 * i + 7] = bfhi(u.w); }
}
__device__ __forceinline__ float dot64_bf(const float (&q)[64], const bf16* p) {
    float s0 = 0.f, s1 = 0.f;
#pragma unroll
    for (int i = 0; i < 8; ++i) { const v4u u = *(const GAS v4u*)(p + 8 * i);
        s0 += q[8 * i + 0] * bflo(u.x); s1 += q[8 * i + 1] * bfhi(u.x); s0 += q[8 * i + 2] * bflo(u.y); s1 += q[8 * i + 3] * bfhi(u.y);
        s0 += q[8 * i + 4] * bflo(u.z); s1 += q[8 * i + 5] * bfhi(u.z); s0 += q[8 * i + 6] * bflo(u.w); s1 += q[8 * i + 7] * bfhi(u.w); }
    return s0 + s1;
}
__device__ __forceinline__ float dot64_f32(const float (&q)[64], const float* p) {
    float s0 = 0.f, s1 = 0.f;
#pragma unroll
    for (int i = 0; i < 16; ++i) { const f32x4 u = *(const GAS f32x4*)(p + 4 * i);
        s0 += q[4 * i + 0] * u.x; s1 += q[4 * i + 1] * u.y; s0 += q[4 * i + 2] * u.z; s1 += q[4 * i + 3] * u.w; }
    return s0 + s1;
}
__device__ __forceinline__ float silu(float x) { return x * __builtin_amdgcn_rcpf(1.f + __expf(-x)); }
__device__ __forceinline__ float tanh_fast(float x) { return 1.f - 2.f * __builtin_amdgcn_rcpf(1.f + __expf(2.f * x)); }

__device__ __forceinline__ float cross_attn_task(const bf16* MKV, const float* c_mem, const bf16* qptr, int m, int hh, int layer, int lane) {
    float q[64]; ldq64(qptr, q);
    const bool samp = m >= TP;
    float l[4]; float mx = -3.0e38f, o = 0.f, s = 0.f;
    if (!samp) {
        const bf16* kb = MKV + (size_t)((m >> 11) * NMEM) * 1024 + layer * 512 + hh * 64;
#pragma unroll
        for (int r = 0; r < 4; ++r) { l[r] = dot64_bf(q, kb + (size_t)(r * 64 + lane) * 1024) * 0.125f; mx = fmaxf(mx, l[r]); }
        mx = wave_max(mx);
#pragma unroll
        for (int r = 0; r < 4; ++r) { l[r] = __expf(l[r] - mx); s += l[r]; }
        s = wave_sum(s);
#pragma unroll
        for (int r = 0; r < 4; ++r)
            for (int kk = 0; kk < 64; ++kk) o += rdlane(l[r], kk) * bf2f(kb[(size_t)(r * 64 + kk) * 1024 + 256 + lane]);
    } else {
        const float* kf = c_mem + ((size_t)(layer * SBATCH + ((m - TP) >> 2)) * NMEM) * 512 + hh * 64;
#pragma unroll
        for (int r = 0; r < 4; ++r) { l[r] = dot64_f32(q, kf + (size_t)(r * 64 + lane) * 512) * 0.125f; mx = fmaxf(mx, l[r]); }
        mx = wave_max(mx);
#pragma unroll
        for (int r = 0; r < 4; ++r) { l[r] = __expf(l[r] - mx); s += l[r]; }
        s = wave_sum(s);
#pragma unroll
        for (int r = 0; r < 4; ++r)
            for (int kk = 0; kk < 64; ++kk) o += rdlane(l[r], kk) * kf[(size_t)(r * 64 + kk) * 512 + 256 + lane];
    }
    return o / s;
}

template <int G>
__device__ __forceinline__ void attn_group(const bf16* P, const float* BT, const float* cw, int m, int hh, int lane, float& Mx, float& Ss, float& O) {
    constexpr int dil = G == 0 ? 1 : (G == 1 ? 4 : 16), Wg = G == 0 ? 128 : (G == 1 ? 512 : 2048), head0 = G * 4;
    const bool samp = m >= TP;
    const int b = m >> 11, t = m & 2047, sb = (m - TP) >> 2, st = (m - TP) & 3, head = head0 + hh;
    float q[64]; ldq64(P + (size_t)m * A_IN + head * 64, q);
    const float* bt = BT + (G * 4 + hh) * 132;
    float l[3]; float gm = -3.0e38f;
#pragma unroll
    for (int r = 0; r < 3; ++r) { const int kidx = r * 64 + lane; float lv = -3.0e38f;
        if (kidx < 129) {
            if (!samp) { const int tk = t - dil * kidx; if (tk >= 0) lv = dot64_bf(q, P + (size_t)((b << 11) + tk) * A_IN + RW + head * 64) * 0.125f + bt[kidx]; }
            else { const int idx = Wg + st - dil * kidx;
                if (idx >= Wg) lv = dot64_bf(q, P + (size_t)(TP + sb * 4 + idx - Wg) * A_IN + RW + head * 64) * 0.125f + bt[kidx];
                else lv = dot64_f32(q, cw + ((size_t)(sb * Wg + idx) * 2) * 256 + hh * 64) * 0.125f + bt[kidx]; }
        }
        l[r] = lv; gm = fmaxf(gm, lv); }
    gm = wave_max(gm);
    const float Mn = fmaxf(Mx, gm), sc = __expf(Mx - Mn);
    float ps = 0.f;
#pragma unroll
    for (int r = 0; r < 3; ++r) { l[r] = l[r] > -1.0e38f ? __expf(l[r] - Mn) : 0.f; ps += l[r]; }
    Ss = Ss * sc + wave_sum(ps); O *= sc; Mx = Mn;
#pragma unroll
    for (int r = 0; r < 3; ++r)
        for (int kk = 0; kk < 64; ++kk) { const int kidx = r * 64 + kk; if (kidx >= 129) break;
            const float p = rdlane(l[r], kk);
            if (p != 0.f) { float v;
                if (!samp) { const int tk = t - dil * kidx; v = bf2f(P[(size_t)((b << 11) + tk) * A_IN + 2 * RW + head * 64 + lane]); }
                else { const int idx = Wg + st - dil * kidx;
                    if (idx >= Wg) v = bf2f(P[(size_t)(TP + sb * 4 + idx - Wg) * A_IN + 2 * RW + head * 64 + lane]);
                    else v = cw[((size_t)(sb * Wg + idx) * 2 + 1) * 256 + hh * 64 + lane]; }
                O += p * v; } }
}


__device__ __forceinline__ void samp_dot_rounds3(const bf16* P, const float* cw, const float* bt, const float (&q)[64], int g, int sb, int st, int hh, int lane, float (&l)[3]) {
    const int dil = g == 0 ? 1 : (g == 1 ? 4 : 16), Wg = g == 0 ? 128 : (g == 1 ? 512 : 2048), head = g * 4 + hh;
#pragma unroll
    for (int r = 0; r < 3; ++r) { const int kidx = r * 64 + lane; float lv = -3.0e38f;
        if (kidx < 129) { const int idx = Wg + st - dil * kidx;
            if (idx >= Wg) lv = dot64_bf(q, P + (size_t)(TP + sb * 4 + idx - Wg) * A_IN + RW + head * 64) * 0.125f + bt[kidx];
            else lv = dot64_f32(q, cw + ((size_t)(sb * Wg + idx) * 2) * 256 + hh * 64) * 0.125f + bt[kidx]; }
        l[r] = lv; }
}
__device__ __forceinline__ void samp_part(const bf16* P, const float* BT, const float* cw, const bf16* MKVunused, const float* c_mem, int m, int hh, int part, int layer, const bf16* qmem, int lane, float& Mo, float& So, float& Oo) {
    const int sb = (m - TP) >> 2, st = (m - TP) & 3;
    float q[64];
    if (part < 3) {
        const int g = part, dil = g == 0 ? 1 : (g == 1 ? 4 : 16), Wg = g == 0 ? 128 : (g == 1 ? 512 : 2048), head = g * 4 + hh;
        ldq64(P + (size_t)m * A_IN + head * 64, q);
        float l[3]; samp_dot_rounds3(P, cw, BT + (g * 4 + hh) * 132, q, g, sb, st, hh, lane, l);
        float gm = wave_max(fmaxf(fmaxf(l[0], l[1]), l[2])); float ps = 0.f;
#pragma unroll
        for (int r = 0; r < 3; ++r) { l[r] = l[r] > -1.0e38f ? __expf(l[r] - gm) : 0.f; ps += l[r]; }
        const float S = wave_sum(ps); float O = 0.f;
#pragma unroll
        for (int r = 0; r < 3; ++r) {
#pragma unroll 1
            for (int k0 = 0; k0 < 64; k0 += 8) { if (r * 64 + k0 >= 129) break;
                float v[8];
#pragma unroll
                for (int e = 0; e < 8; ++e) { int kidx = r * 64 + k0 + e; if (kidx > 128) kidx = 128; const int idx = Wg + st - dil * kidx;
                    v[e] = (idx >= Wg) ? bf2f(P[(size_t)(TP + sb * 4 + idx - Wg) * A_IN + 2 * RW + head * 64 + lane]) : cw[((size_t)(sb * Wg + idx) * 2 + 1) * 256 + hh * 64 + lane]; }
#pragma unroll
                for (int e = 0; e < 8; ++e) O += rdlane(l[r], k0 + e) * v[e]; } }
        Mo = gm; So = S; Oo = O;
    } else {
        ldq64(qmem, q);
        const float* kf = c_mem + ((size_t)(layer * SBATCH + sb) * NMEM) * 512 + hh * 64;
        float l[4]; float mx = -3.0e38f, s = 0.f, o = 0.f;
#pragma unroll
        for (int r = 0; r < 4; ++r) { l[r] = dot64_f32(q, kf + (size_t)(r * 64 + lane) * 512) * 0.125f; mx = fmaxf(mx, l[r]); }
        mx = wave_max(mx);
#pragma unroll
        for (int r = 0; r < 4; ++r) { l[r] = __expf(l[r] - mx); s += l[r]; }
        s = wave_sum(s);
#pragma unroll
        for (int r = 0; r < 4; ++r) {
#pragma unroll 1
            for (int k0 = 0; k0 < 64; k0 += 8) { float v[8];
#pragma unroll
                for (int e = 0; e < 8; ++e) v[e] = kf[(size_t)(r * 64 + k0 + e) * 512 + 256 + lane];
#pragma unroll
                for (int e = 0; e < 8; ++e) o += rdlane(l[r], k0 + e) * v[e]; } }
        Mo = mx; So = s; Oo = o;
    }
}


__device__ __forceinline__ void samp_mem_quarter(const float* c_mem, int m, int hh, int qr, int layer, const bf16* qmem, int lane, float& Mo, float& So, float& Oo) {
    const int sb = (m - TP) >> 2;
    float q[64]; ldq64(qmem, q);
    const float* kf = c_mem + ((size_t)(layer * SBATCH + sb) * NMEM + 64 * qr) * 512 + hh * 64;
    const float l = dot64_f32(q, kf + (size_t)lane * 512) * 0.125f;
    const float mx = wave_max(l), p = __expf(l - mx), s = wave_sum(p);
    float o = 0.f;
#pragma unroll 1
    for (int k0 = 0; k0 < 64; k0 += 16) { float v[16];
#pragma unroll
        for (int e = 0; e < 16; ++e) v[e] = kf[(size_t)(k0 + e) * 512 + 256 + lane];
#pragma unroll
        for (int e = 0; e < 16; ++e) o += rdlane(p, k0 + e) * v[e]; }
    Mo = mx; So = s; Oo = o;
}

typedef short s16x4 __attribute__((ext_vector_type(4)));
typedef short bf16x8 __attribute__((ext_vector_type(8)));
constexpr int VROW = 160;
constexpr int VBUF = 32 * VROW;
constexpr float LOG2E = 1.4426950408889634f;
template <int OFF> __device__ __forceinline__ s16x4 tr_read(unsigned vb) {
    s16x4 r; asm volatile("ds_read_b64_tr_b16 %0, %1 offset:%2" : "=&v"(r) : "v"(vb), "i"(OFF) : "memory"); return r;
}
struct AttnSt { float m, s; f32x4 o[4]; };
__device__ __forceinline__ void attn_init(AttnSt& st) { st.m = -1.0e30f; st.s = 0.f;
#pragma unroll
    for (int i = 0; i < 4; ++i) st.o[i] = (f32x4){0.f, 0.f, 0.f, 0.f}; }
__device__ __forceinline__ unsigned cvt_pk_bf16f(float lo, float hi) { unsigned r; asm volatile("v_cvt_pk_bf16_f32 %0, %1, %2" : "=v"(r) : "v"(lo), "v"(hi)); return r; }

template <bool MASKED>
__device__ __forceinline__ void attn_pairs(const bf16* kbase, const bf16* vbase, int pitch, int tb, int dil, int qs, int tmax, int j0, int j1,
                                           const bf16x8 (&qf)[2], const LAS float* bias2, LAS unsigned char* vbuf, int lane, AttnSt& st) {
    const int n = lane & 15, quad = lane >> 4, vr8 = lane >> 3, vc8 = lane & 7;
    const unsigned vwr = (unsigned)(size_t)vbuf + (unsigned)(vr8 * VROW + vc8 * 16);
    const unsigned vrd = (unsigned)(size_t)vbuf + (unsigned)((4 * quad + (n >> 2)) * VROW + 8 * (n & 3));
    const float C2 = 0.125f * LOG2E;
    bf16x8 ka[2][2]; v4u vr[4];
#define ATT_LOAD(JP, KA, VR) do { _Pragma("unroll") for (int tt = 0; tt < 2; ++tt) { int tk = tb + dil * (32 * (JP) + 16 * tt + n); if (MASKED) tk = tk < 0 ? 0 : (tk > tmax ? tmax : tk); \
            const bf16* kp = kbase + (size_t)tk * pitch + 8 * quad; \
            KA[tt][0] = __builtin_bit_cast(bf16x8, *(const GAS v4u*)kp); KA[tt][1] = __builtin_bit_cast(bf16x8, *(const GAS v4u*)(kp + 32)); } \
        _Pragma("unroll") for (int c = 0; c < 4; ++c) { int tk = tb + dil * (32 * (JP) + 8 * c + vr8); if (MASKED) tk = tk < 0 ? 0 : (tk > tmax ? tmax : tk); \
            VR[c] = *(const GAS v4u*)(vbase + (size_t)tk * pitch + 8 * vc8); } } while (0)
    if (j0 < j1) ATT_LOAD(j0, ka, vr);
#pragma unroll 1
    for (int jp = j0; jp < j1; ++jp) {
        bf16x8 kn[2][2]; v4u vn[4];
        { const int jn = (jp + 1 < j1) ? jp + 1 : jp; ATT_LOAD(jn, kn, vn); }
        f32x4 sA = {0.f, 0.f, 0.f, 0.f}, sB = {0.f, 0.f, 0.f, 0.f};
        sA = __builtin_amdgcn_mfma_f32_16x16x32_bf16(ka[0][0], qf[0], sA, 0, 0, 0); sA = __builtin_amdgcn_mfma_f32_16x16x32_bf16(ka[0][1], qf[1], sA, 0, 0, 0);
        sB = __builtin_amdgcn_mfma_f32_16x16x32_bf16(ka[1][0], qf[0], sB, 0, 0, 0); sB = __builtin_amdgcn_mfma_f32_16x16x32_bf16(ka[1][1], qf[1], sB, 0, 0, 0);
        float l[8]; bool ok[8]; float mloc = -1.0e30f;
#pragma unroll
        for (int e = 0; e < 8; ++e) { const int u = 32 * jp + (e >> 2) * 16 + 4 * quad + (e & 3); const float a = (e < 4 ? sA[e & 3] : sB[e & 3]) * C2;
            if (MASKED) { const int kidx = 128 + qs * n - u; ok[e] = (kidx >= 0) && (kidx <= 128) && (tb + dil * u >= 0);
                const int kc = kidx < 0 ? 0 : (kidx > 128 ? 128 : kidx); l[e] = ok[e] ? a + bias2[kc] : -1.0e30f; }
            else { ok[e] = true; l[e] = a; }
            mloc = fmaxf(mloc, l[e]); }
        mloc = fmaxf(mloc, __shfl_xor(mloc, 16)); mloc = fmaxf(mloc, __shfl_xor(mloc, 32));
        const float mn = fmaxf(st.m, mloc), alpha = __builtin_amdgcn_exp2f(st.m - mn);
        float ps = 0.f; float p[8];
#pragma unroll
        for (int e = 0; e < 8; ++e) { p[e] = ok[e] ? __builtin_amdgcn_exp2f(l[e] - mn) : 0.f; ps += p[e]; }
        st.s = st.s * alpha + ps; st.m = mn;
#pragma unroll
        for (int i = 0; i < 4; ++i) st.o[i] = st.o[i] * alpha;
        v4u pk; pk.x = cvt_pk_bf16f(p[0], p[1]); pk.y = cvt_pk_bf16f(p[2], p[3]); pk.z = cvt_pk_bf16f(p[4], p[5]); pk.w = cvt_pk_bf16f(p[6], p[7]);
        const bf16x8 pb = __builtin_bit_cast(bf16x8, pk);
#pragma unroll
        for (int c = 0; c < 4; ++c) *(LAS v4u*)(size_t)(vwr + c * 8 * VROW) = vr[c];
        asm volatile("s_waitcnt lgkmcnt(0)" ::: "memory");
        const s16x4 a0 = tr_read<0>(vrd), b0 = tr_read<16 * VROW>(vrd), a1 = tr_read<32>(vrd), b1 = tr_read<16 * VROW + 32>(vrd);
        const s16x4 a2 = tr_read<64>(vrd), b2 = tr_read<16 * VROW + 64>(vrd), a3 = tr_read<96>(vrd), b3 = tr_read<16 * VROW + 96>(vrd);
        asm volatile("s_waitcnt lgkmcnt(0)" ::: "memory"); __builtin_amdgcn_sched_barrier(0);
#define PKV(L, H) (bf16x8){L[0], L[1], L[2], L[3], H[0], H[1], H[2], H[3]}
        st.o[0] = __builtin_amdgcn_mfma_f32_16x16x32_bf16(PKV(a0, b0), pb, st.o[0], 0, 0, 0);
        st.o[1] = __builtin_amdgcn_mfma_f32_16x16x32_bf16(PKV(a1, b1), pb, st.o[1], 0, 0, 0);
        st.o[2] = __builtin_amdgcn_mfma_f32_16x16x32_bf16(PKV(a2, b2), pb, st.o[2], 0, 0, 0);
        st.o[3] = __builtin_amdgcn_mfma_f32_16x16x32_bf16(PKV(a3, b3), pb, st.o[3], 0, 0, 0);
#undef PKV
        __builtin_amdgcn_sched_barrier(0);
#pragma unroll
        for (int tt = 0; tt < 2; ++tt) { ka[tt][0] = kn[tt][0]; ka[tt][1] = kn[tt][1]; }
#pragma unroll
        for (int c = 0; c < 4; ++c) vr[c] = vn[c];
    }
#undef ATT_LOAD
}
__device__ __forceinline__ void attn_store(const AttnSt& st, const bf16* gate_row  , bf16* out_row, int lane) {
    const int quad = lane >> 4;
    float s = st.s; s += __shfl_xor(s, 16); s += __shfl_xor(s, 32);
    const float inv = 1.f / s;
#pragma unroll
    for (int mt = 0; mt < 4; ++mt) { const v2u g = *(const GAS v2u*)(gate_row + 16 * mt + 4 * quad);
        const float o0 = st.o[mt][0] * inv * silu(bflo(g.x)), o1 = st.o[mt][1] * inv * silu(bfhi(g.x)), o2 = st.o[mt][2] * inv * silu(bflo(g.y)), o3 = st.o[mt][3] * inv * silu(bfhi(g.y));
        *(GAS v2u*)(out_row + 16 * mt + 4 * quad) = (v2u){pk2(o0, o1), pk2(o2, o3)}; }
}
__device__ __forceinline__ void load_qf(const bf16* qrow, int lane, bf16x8 (&qf)[2]) {
    const int quad = lane >> 4;
    qf[0] = __builtin_bit_cast(bf16x8, *(const GAS v4u*)(qrow + 8 * quad)); qf[1] = __builtin_bit_cast(bf16x8, *(const GAS v4u*)(qrow + 32 + 8 * quad));
}
__device__ __forceinline__ void attn_a_unit(const Ctx& C, const bf16* P, const bf16* MKV, bf16* H, const float* BT, int unit) {
    const int b = unit >> 5, hh = (unit >> 3) & 3, t0 = (unit & 7) * 256;
    LAS float* bias2 = (LAS float*)(C.lds + RING_OFF);
    LAS unsigned char* vbuf = C.lds + RING_OFF + 4096 + C.wave * VBUF;
    __syncthreads();
    for (int i = C.tid; i < 3 * 132; i += NWAVES * 64) { const int g = i / 132, k = i % 132; bias2[i] = k < 129 ? BT[(g * 4 + hh) * 132 + k] * LOG2E : 0.f; }
    __syncthreads();
    const int n = C.lane & 15;
    const bf16* Pb = P + (size_t)(b << 11) * A_IN;
#pragma unroll 1
    for (int set = 0; set < 2; ++set) {
        const int r = 2 * C.wave + set, tq = t0 + r + 16 * n;
        const bf16* qrow = Pb + (size_t)tq * A_IN;
        AttnSt st; attn_init(st);
#pragma unroll 1
        for (int g = 0; g < 3; ++g) {
            const int dil = g == 0 ? 1 : (g == 1 ? 4 : 16), qs = 16 / dil, np = g == 0 ? 12 : (g == 1 ? 6 : 5), head = g * 4 + hh;
            const int tb = t0 + r - 128 * dil;
            int j0 = 0; if (tb < 0) { j0 = (-tb - 31 * dil + 32 * dil - 1) / (32 * dil); if (j0 < 0) j0 = 0; }
            bf16x8 qf[2]; load_qf(qrow + head * 64, C.lane, qf);
            attn_pairs<true>(Pb + RW + head * 64, Pb + 2 * RW + head * 64, A_IN, tb, dil, qs, SEQ - 1, j0, np, qf, bias2 + g * 132, vbuf, C.lane, st);
        }
        attn_store(st, qrow + 2560 + hh * 64, H + ((size_t)(b << 11) + tq) * 512 + hh * 64, C.lane);
        AttnSt sm; attn_init(sm);
        { bf16x8 qf[2]; load_qf(qrow + 2304 + hh * 64, C.lane, qf);
          const bf16* kb = MKV + (size_t)(b * NMEM) * 1024 + hh * 64;
          attn_pairs<false>(kb, kb + 256, 1024, 0, 1, 0, NMEM - 1, 0, 8, qf, nullptr, vbuf, C.lane, sm); }
        attn_store(sm, qrow + 2560 + 256 + hh * 64, H + ((size_t)(b << 11) + tq) * 512 + 256 + hh * 64, C.lane);
    }
}
__device__ __forceinline__ void attn_b_unit(const Ctx& C, const bf16* P, const bf16* MKV, bf16* H, int unit) {
    const int b = unit >> 5, hh = (unit >> 3) & 3, t0 = (unit & 7) * 256;
    LAS unsigned char* vbuf = C.lds + RING_OFF + 4096 + C.wave * VBUF;
    const int n = C.lane & 15;
#pragma unroll 1
    for (int set = 0; set < 2; ++set) {
        const int r = 2 * C.wave + set, tq = t0 + r + 16 * n;
        const bf16* qrow = P + ((size_t)(b << 11) + tq) * B_INP;
        AttnSt sm; attn_init(sm);
        bf16x8 qf[2]; load_qf(qrow + CSH + hh * 64, C.lane, qf);
        const bf16* kb = MKV + (size_t)(b * NMEM) * 1024 + 512 + hh * 64;
        attn_pairs<false>(kb, kb + 256, 1024, 0, 1, 0, NMEM - 1, 0, 8, qf, nullptr, vbuf, C.lane, sm);
        attn_store(sm, qrow + 2688 + RW + hh * 64, H + ((size_t)(b << 11) + tq) * 1024 + RW + hh * 64, C.lane);
    }
}


__device__ __forceinline__ void row_pass(const bf16* hp, const float* xin, float* xout, const float* gpost, bf16* xn, int lane) {
    const GAS v2u* h2 = (const GAS v2u*)hp + lane; const GAS f32x4* xr = (const GAS f32x4*)xin + lane; const GAS f32x4* gp = (const GAS f32x4*)gpost + lane;
    f32x4 h[4], x[4]; float s = 0.f;
#pragma unroll
    for (int j = 0; j < 4; ++j) { const v2u u = h2[64 * j]; h[j] = (f32x4){bflo(u.x), bfhi(u.x), bflo(u.y), bfhi(u.y)}; x[j] = xr[64 * j];
        s += (h[j].x * h[j].x + h[j].y * h[j].y) + (h[j].z * h[j].z + h[j].w * h[j].w); }
    const float r = 1.f / sqrtf(wave_sum(s) * (1.f / DM) + RMS_EPS);
    float s2 = 0.f;
#pragma unroll
    for (int j = 0; j < 4; ++j) { const f32x4 g = gp[64 * j]; x[j] = x[j] + h[j] * r * g; s2 += (x[j].x * x[j].x + x[j].y * x[j].y) + (x[j].z * x[j].z + x[j].w * x[j].w);
        *((GAS f32x4*)xout + lane + 64 * j) = x[j]; }
    if (xn) { const float r2 = 1.f / sqrtf(wave_sum(s2) * (1.f / DM) + RMS_EPS);
        GAS unsigned long long* o8 = (GAS unsigned long long*)xn + lane;
#pragma unroll
        for (int j = 0; j < 4; ++j) o8[64 * j] = (unsigned long long)pk2(x[j].x * r2, x[j].y * r2) | ((unsigned long long)pk2(x[j].z * r2, x[j].w * r2) << 32); }
}

struct ScanP { const bf16* P; bf16* H; float* out; const float *st_wkv, *st_shift, *mu, *w0, *a0, *k_k, *k_a, *r_k, *ln_w, *ln_b, *w_up, *a_up; };
__device__ __forceinline__ void scan_unit(const Ctx& C, const ScanP& sp, int u) {
    LAS float* L = (LAS float*)(C.lds + RING_OFF);
    LAS float *LA = L, *LB = L + 4096, *LW = L + 8192, *LK = L + 12288, *LRW = L + 16384, *LV = L + 20480, *LSC = L + 24576, *LY = L + 24576 + 256;
    const bool samp = u >= 96; const int seq = samp ? (u - 96) / 12 : u / 12, h = samp ? (u - 96) % 12 : u % 12;
    const int T = samp ? STOK : SEQ, row0 = samp ? TP + seq * 4 : seq * SEQ;
    int row = C.wave * 8 + (C.lane >> 3), p = C.lane & 7;
    asm volatile("" : "+v"(row), "+v"(p));
    float S[8];
#pragma unroll
    for (int j = 0; j < 8; ++j) S[j] = samp ? sp.st_wkv[((size_t)(seq * 12 + h) * 64 + row) * 64 + p * 8 + j] : 0.f;
#pragma unroll 1
    for (int c0 = 0; c0 < T; c0 += 64) {
        const int n = (T - c0) < 64 ? (T - c0) : 64;
        int tok = C.tid >> 3, part = C.tid & 7;
        asm volatile("" : "+v"(tok), "+v"(part));
        __syncthreads();
        LAS float* LTW = L + 28928; LAS float* LR = LTW + 512;
        { const int tk = C.tid >> 7, j = C.tid & 127;
          if (tk < n) { const int t = c0 + tk, m = row0 + t, cc = 2304 + j; const float cur = bf2f(sp.P[(size_t)m * B_INP + cc]);
              float prev = 0.f; if (t > 0) prev = bf2f(sp.P[(size_t)(m - 1) * B_INP + cc]); else if (samp) prev = sp.st_shift[(size_t)seq * CSH + cc];
              const float xs = cur + sp.mu[cc] * (prev - cur); LTW[tk * 128 + j] = j < 64 ? tanh_fast(xs) : xs; } }
        __syncthreads();
        { const int tk = C.tid >> 7, which = (C.tid >> 6) & 1, cc = C.tid & 63;
          if (tk < n) { const float* W = (which ? sp.a_up : sp.w_up) + h * 64 + cc; const LAS float* x = LTW + tk * 128 + which * 64; float acc = 0.f;
#pragma unroll 32
              for (int j = 0; j < 64; ++j) acc += x[j] * W[(size_t)j * RW];
              LR[tk * 128 + which * 64 + cc] = acc; } }
        __syncthreads();
        if (tok < n) {
            const int t = c0 + tok, m = row0 + t;
            const bf16* cur = sp.P + (size_t)m * B_INP; const bf16* prv = cur - B_INP; const LAS float* lo = LR + tok * 128 + part * 8;
            float xr[8], xk[8], xv[8], kk[8], av[8], dv[8];
            float nrm = 0.f;
#pragma unroll
            for (int j = 0; j < 8; ++j) { const int c = h * 64 + part * 8 + j;
                const float cr = bf2f(cur[c]), ck = bf2f(cur[RW + c]), cv = bf2f(cur[2 * RW + c]);
                float pr = 0.f, pk = 0.f, pv = 0.f;
                if (t > 0) { pr = bf2f(prv[c]); pk = bf2f(prv[RW + c]); pv = bf2f(prv[2 * RW + c]); }
                else if (samp) { const float* ss = sp.st_shift + (size_t)seq * CSH; pr = ss[c]; pk = ss[RW + c]; pv = ss[2 * RW + c]; }
                xr[j] = cr + sp.mu[c] * (pr - cr); xk[j] = ck + sp.mu[RW + c] * (pk - ck); xv[j] = cv + sp.mu[2 * RW + c] * (pv - cv);
                const float dpre = sp.w0[c] + lo[j], apre = sp.a0[c] + lo[64 + j];
                dv[j] = __expf(-0.6065306597f * __builtin_amdgcn_rcpf(1.f + __expf(-dpre)));
                av[j] = __builtin_amdgcn_rcpf(1.f + __expf(-apre));
                kk[j] = xk[j] * sp.k_k[c]; nrm += kk[j] * kk[j]; }
            nrm += __shfl_xor(nrm, 1); nrm += __shfl_xor(nrm, 2); nrm += __shfl_xor(nrm, 4);
            const float inv = 1.f / fmaxf(sqrtf(nrm), 1e-12f);
            float br = 0.f, kr = 0.f, bon = 0.f;
#pragma unroll
            for (int j = 0; j < 8; ++j) { const int c = h * 64 + part * 8 + j, d = part * 8 + j;
                const float kn = kk[j] * inv, k2 = xk[j] * (1.f + (av[j] - 1.f) * sp.k_a[c]);
                const float bb = kn * av[j];
                LA[tok * 64 + d] = -kn; LB[tok * 64 + d] = bb; LW[tok * 64 + d] = dv[j]; LK[tok * 64 + d] = k2; LRW[tok * 64 + d] = xr[j] * dv[j]; LV[tok * 64 + d] = xv[j];
                br += bb * xr[j]; kr += k2 * xr[j]; bon += xr[j] * k2 * sp.r_k[c]; }
            br += __shfl_xor(br, 1); br += __shfl_xor(br, 2); br += __shfl_xor(br, 4);
            kr += __shfl_xor(kr, 1); kr += __shfl_xor(kr, 2); kr += __shfl_xor(kr, 4);
            bon += __shfl_xor(bon, 1); bon += __shfl_xor(bon, 2); bon += __shfl_xor(bon, 4);
            if (part == 0) { LSC[tok * 4 + 0] = br; LSC[tok * 4 + 1] = kr; LSC[tok * 4 + 2] = bon; }
        }
        __syncthreads();
#pragma unroll 1
        for (int i = 0; i < n; ++i) {
            const LAS f32x4* a4 = (const LAS f32x4*)(LA + i * 64 + p * 8); const LAS f32x4* r4 = (const LAS f32x4*)(LRW + i * 64 + p * 8);
            const LAS f32x4* w4 = (const LAS f32x4*)(LW + i * 64 + p * 8); const LAS f32x4* b4 = (const LAS f32x4*)(LB + i * 64 + p * 8); const LAS f32x4* k4 = (const LAS f32x4*)(LK + i * 64 + p * 8);
            const f32x4 a0 = a4[0], a1 = a4[1], r0 = r4[0], r1 = r4[1];
            float sa = (S[0] * a0.x + S[1] * a0.y) + (S[2] * a0.z + S[3] * a0.w) + (S[4] * a1.x + S[5] * a1.y) + (S[6] * a1.z + S[7] * a1.w);
            float yp = (S[0] * r0.x + S[1] * r0.y) + (S[2] * r0.z + S[3] * r0.w) + (S[4] * r1.x + S[5] * r1.y) + (S[6] * r1.z + S[7] * r1.w);
            sa += __shfl_xor(sa, 1); sa += __shfl_xor(sa, 2); sa += __shfl_xor(sa, 4);
            yp += __shfl_xor(yp, 1); yp += __shfl_xor(yp, 2); yp += __shfl_xor(yp, 4);
            const float v = LV[i * 64 + row], br = LSC[i * 4 + 0], kr = LSC[i * 4 + 1];
            const f32x4 w0 = w4[0], w1 = w4[1], b0 = b4[0], b1 = b4[1], k0 = k4[0], k1 = k4[1];
            S[0] = S[0] * w0.x + sa * b0.x + v * k0.x; S[1] = S[1] * w0.y + sa * b0.y + v * k0.y; S[2] = S[2] * w0.z + sa * b0.z + v * k0.z; S[3] = S[3] * w0.w + sa * b0.w + v * k0.w;
            S[4] = S[4] * w1.x + sa * b1.x + v * k1.x; S[5] = S[5] * w1.y + sa * b1.y + v * k1.y; S[6] = S[6] * w1.z + sa * b1.z + v * k1.z; S[7] = S[7] * w1.w + sa * b1.w + v * k1.w;
            if (p == 0) LY[i * 64 + row] = yp + sa * br + v * kr;
        }
        __syncthreads();
        asm volatile("" : "+v"(tok), "+v"(part));
        if (tok < n) {
            const int m = row0 + c0 + tok;
            float y[8]; float s = 0.f;
#pragma unroll
            for (int j = 0; j < 8; ++j) { y[j] = LY[tok * 64 + part * 8 + j]; s += y[j]; }
            s += __shfl_xor(s, 1); s += __shfl_xor(s, 2); s += __shfl_xor(s, 4);
            const float mean = s * (1.f / 64.f); float q = 0.f;
#pragma unroll
            for (int j = 0; j < 8; ++j) { y[j] -= mean; q += y[j] * y[j]; }
            q += __shfl_xor(q, 1); q += __shfl_xor(q, 2); q += __shfl_xor(q, 4);
            const float rstd = 1.f / sqrtf(q * (1.f / 64.f) + GN_EPS), bon = LSC[tok * 4 + 2];
            unsigned w[4];
#pragma unroll
            for (int j = 0; j < 8; j += 2) { float o2[2];
#pragma unroll
                for (int e = 0; e < 2; ++e) { const int c = h * 64 + part * 8 + j + e;
                    const float yy = y[j + e] * rstd * sp.ln_w[c] + sp.ln_b[c] + bon * LV[tok * 64 + part * 8 + j + e];
                    o2[e] = yy * silu(bf2f(sp.P[(size_t)m * B_INP + 2688 + c])); }
                w[j >> 1] = pk2(o2[0], o2[1]); }
            *(GAS v4u*)(sp.H + (size_t)m * 1024 + h * 64 + part * 8) = (v4u){w[0], w[1], w[2], w[3]};
        }
    }
    float* so = sp.out + (samp ? O_WKVS : O_WKVP) + ((size_t)(seq * 12 + h) * 64 + row) * 64 + p * 8;
    *(GAS f32x4*)so = (f32x4){S[0], S[1], S[2], S[3]}; *((GAS f32x4*)so + 1) = (f32x4){S[4], S[5], S[6], S[7]};
    __syncthreads();
}

constexpr int TS = 72;
constexpr int IMG = 64 * TS * 2;
constexpr int REC_AT = 0, REC_RT = 8192, REC_BT = 16384, REC_KT = 24576, REC_TT = 32768, REC_PC = 40960, REC_BON = 41216, REC_BYTES = 41472;
constexpr int REC_N1 = 960, REC_N2 = 1238, REC_N3 = 1125;
static_assert(REC_N1 + REC_N2 + REC_N3 >= 3072 && (size_t)REC_N1 * REC_BYTES <= 38 * MiB && (size_t)REC_N2 * REC_BYTES <= 49 * MiB && (size_t)REC_N3 * REC_BYTES <= WS_END - 271 * MiB, "chunk records");
__device__ __forceinline__ unsigned char* rec_ptr(unsigned char* ws, int id) {
    return id < REC_N1 ? ws + 29 * MiB + (size_t)id * REC_BYTES : (id < REC_N1 + REC_N2 ? ws + 100 * MiB + (size_t)(id - REC_N1) * REC_BYTES : ws + 271 * MiB + (size_t)(id - REC_N1 - REC_N2) * REC_BYTES);
}
constexpr int LA_TWD = 0, LA_TAD = IMG, LA_AT = 0, LA_BT = IMG, LA_DW = 2 * IMG, LA_DA = LA_DW + 16384, LA_SEG = LA_DA + 16384, LA_SLOT0 = LA_SEG + 2048, NSLOT = 6;
static_assert(LA_SLOT0 + NSLOT * 16384 <= RING_BYTES, "stage A LDS map");
constexpr int L_AT = 0, L_RT = IMG, L_BT = 2 * IMG, L_KT = 3 * IMG, L_VV = 4 * IMG, L_SB = 5 * IMG, L_SB2 = 6 * IMG, L_Z = 7 * IMG, L_SA = 8 * IMG,
              L_NKA = 9 * IMG, L_NBR = 10 * IMG, L_NKR = 11 * IMG, L_TT = 12 * IMG, L_Y = 13 * IMG, L_PC = L_Y + 16384  , L_PRM = L_PC + 1024, L_B_END = L_PRM + 1024;
static_assert(L_B_END <= RING_BYTES, "stage B LDS map");

struct ChunkP { const bf16 *P, *WL; const float *mu, *w0, *a0, *k_k, *k_a, *r_k; };
__device__ __forceinline__ void ld8(const LAS float* p, float (&x)[8]) { const f32x4 a = *(const LAS f32x4*)p, b = *((const LAS f32x4*)p + 1);
    x[0] = a[0]; x[1] = a[1]; x[2] = a[2]; x[3] = a[3]; x[4] = b[0]; x[5] = b[1]; x[6] = b[2]; x[7] = b[3]; }
__device__ __forceinline__ void ld8g(const float* p, float (&x)[8]) { const f32x4 a = *(const GAS f32x4*)p, b = *((const GAS f32x4*)p + 1);
    x[0] = a[0]; x[1] = a[1]; x[2] = a[2]; x[3] = a[3]; x[4] = b[0]; x[5] = b[1]; x[6] = b[2]; x[7] = b[3]; }
__device__ __forceinline__ void unpk8(v4u u, float (&x)[8]) { x[0] = bflo(u.x); x[1] = bfhi(u.x); x[2] = bflo(u.y); x[3] = bfhi(u.y); x[4] = bflo(u.z); x[5] = bfhi(u.z); x[6] = bflo(u.w); x[7] = bfhi(u.w); }
__device__ __forceinline__ v4u pk8(const float (&x)[8]) { return (v4u){pk2(x[0], x[1]), pk2(x[2], x[3]), pk2(x[4], x[5]), pk2(x[6], x[7])}; }
__device__ __forceinline__ void st8bf(LAS unsigned char* lds, int off, int tok, int part, const float (&x)[8]) { *(LAS v4u*)(lds + off + (tok * TS + part * 8) * 2) = pk8(x); }
__device__ __forceinline__ bf16x8 frag_nat(const LAS unsigned char* img, int R0, int ks, int lane) {
    return __builtin_bit_cast(bf16x8, *(const LAS v4u*)(img + ((R0 + (lane & 15)) * TS + 32 * ks + 8 * (lane >> 4)) * 2));
}
#define MFMA16(a, b, c) __builtin_amdgcn_mfma_f32_16x16x32_bf16((a), (b), (c), 0, 0, 0)
__device__ __forceinline__ void st_tile_T(LAS unsigned char* img, int C0, int R0, int lane, f32x4 v) {
    *(LAS v2u*)(img + ((C0 + (lane & 15)) * TS + R0 + 4 * (lane >> 4)) * 2) = (v2u){pk2(v[0], v[1]), pk2(v[2], v[3])};
}
#define LBAR() do { asm volatile("s_waitcnt lgkmcnt(0)" ::: "memory"); __builtin_amdgcn_s_barrier(); asm volatile("" ::: "memory"); } while (0)

struct ALoad { v4u cr, ck, cv, pr, pk, pv, cwd, cad, pwd, pad; };
__device__ __forceinline__ void a_load(const ChunkP& cp, int m0, int t0tok, int h, int tok, int part, ALoad& L) {
    const int m = m0 + tok; const bool first = (t0tok + tok) == 0;
    const bf16* row = cp.P + (size_t)m * B_INP; const bf16* cur = row + h * 64 + part * 8;
    L.cr = *(const GAS v4u*)cur; L.ck = *(const GAS v4u*)(cur + RW); L.cv = *(const GAS v4u*)(cur + 2 * RW);
    L.cwd = *(const GAS v4u*)(row + 2304 + part * 8); L.cad = *(const GAS v4u*)(row + 2368 + part * 8);
    const v4u z = {0u, 0u, 0u, 0u}; L.pr = z; L.pk = z; L.pv = z; L.pwd = z; L.pad = z;
    if (!first) { L.pr = *(const GAS v4u*)(cur - B_INP); L.pk = *(const GAS v4u*)(cur - B_INP + RW); L.pv = *(const GAS v4u*)(cur - B_INP + 2 * RW);
        L.pwd = *(const GAS v4u*)(row - B_INP + 2304 + part * 8); L.pad = *(const GAS v4u*)(row - B_INP + 2368 + part * 8); }
}
__device__ __forceinline__ void scan_stage_a(const Ctx& C, const ChunkP& cp, unsigned char* ws, int task0, int ntask) {
    LAS unsigned char* lds = C.lds + RING_OFF;
    const int tok = C.tid >> 3, part = C.tid & 7, tl = C.lane >> 3, vs = C.wave & 3, rh = C.wave >> 2, l15 = C.lane & 15, quad = C.lane >> 4;
    ALoad Ln; { const int bh = task0 >> 5, c = task0 & 31; a_load(cp, (bh / 12) * SEQ + c * 64, c * 64, bh % 12, tok, part, Ln); }
    __syncthreads();
#pragma unroll 1
    for (int base = 0; base < ntask; base += NSLOT) {
        const int nr = (ntask - base) < NSLOT ? (ntask - base) : NSLOT;
#pragma unroll 1
        for (int s = 0; s < nr; ++s) {
            const int task = task0 + base + s, bh = task >> 5, c = task & 31, h = bh % 12;
            unsigned char* rec = rec_ptr(ws, task);
            float xr[8], xk[8], xv[8];
            {   float cw[8], pw[8], ca[8], pa[8], m8[8], tw[8], ta[8];
                unpk8(Ln.cwd, cw); unpk8(Ln.pwd, pw); unpk8(Ln.cad, ca); unpk8(Ln.pad, pa);
                ld8g(cp.mu + 2304 + part * 8, m8);
#pragma unroll
                for (int j = 0; j < 8; ++j) tw[j] = tanh_fast(cw[j] + m8[j] * (pw[j] - cw[j]));
                ld8g(cp.mu + 2368 + part * 8, m8);
#pragma unroll
                for (int j = 0; j < 8; ++j) ta[j] = ca[j] + m8[j] * (pa[j] - ca[j]);
                st8bf(lds, LA_TWD, tok, part, tw); st8bf(lds, LA_TAD, tok, part, ta);
                float c8[8], p8[8];
                ld8g(cp.mu + h * 64 + part * 8, m8); unpk8(Ln.cr, c8); unpk8(Ln.pr, p8);
#pragma unroll
                for (int j = 0; j < 8; ++j) xr[j] = c8[j] + m8[j] * (p8[j] - c8[j]);
                ld8g(cp.mu + RW + h * 64 + part * 8, m8); unpk8(Ln.ck, c8); unpk8(Ln.pk, p8);
#pragma unroll
                for (int j = 0; j < 8; ++j) xk[j] = c8[j] + m8[j] * (p8[j] - c8[j]);
                ld8g(cp.mu + 2 * RW + h * 64 + part * 8, m8); unpk8(Ln.cv, c8); unpk8(Ln.pv, p8);
#pragma unroll
                for (int j = 0; j < 8; ++j) xv[j] = c8[j] + m8[j] * (p8[j] - c8[j]);
            }
            bf16x8 wf[2][2], af[2][2];
#pragma unroll
            for (int q = 0; q < 2; ++q)
#pragma unroll
                for (int ks = 0; ks < 2; ++ks) { const int cc = h * 64 + 16 * (2 * rh + q) + l15;
                    wf[q][ks] = __builtin_bit_cast(bf16x8, *(const GAS v4u*)(cp.WL + (size_t)cc * 128 + 32 * ks + 8 * quad));
                    af[q][ks] = __builtin_bit_cast(bf16x8, *(const GAS v4u*)(cp.WL + (size_t)(RW + cc) * 128 + 64 + 32 * ks + 8 * quad)); }
            if (base + s + 1 < ntask) { const int tn = task + 1, bhn = tn >> 5, cn = tn & 31; a_load(cp, (bhn / 12) * SEQ + cn * 64, cn * 64, bhn % 12, tok, part, Ln); }
            LBAR();
            {   const bf16x8 b0 = frag_nat(lds + LA_TWD, 16 * vs, 0, C.lane), b1 = frag_nat(lds + LA_TWD, 16 * vs, 1, C.lane);
                const bf16x8 d0 = frag_nat(lds + LA_TAD, 16 * vs, 0, C.lane), d1 = frag_nat(lds + LA_TAD, 16 * vs, 1, C.lane);
#pragma unroll
                for (int q = 0; q < 2; ++q) { f32x4 aw = {0.f, 0.f, 0.f, 0.f}, aa = aw;
                    aw = MFMA16(wf[q][0], b0, aw); aw = MFMA16(wf[q][1], b1, aw); aa = MFMA16(af[q][0], d0, aa); aa = MFMA16(af[q][1], d1, aa);
                    const int t = 16 * vs + l15, c0 = 16 * (2 * rh + q) + 4 * quad;
                    *(LAS f32x4*)(lds + LA_DW + (t * 64 + c0) * 4) = aw; *(LAS f32x4*)(lds + LA_DA + (t * 64 + c0) * 4) = aa; }
            }
            LBAR();
            float kn[8], as[8], k2[8], e[8], cum[8]; float bon;
            {   float dw[8], da[8], p8[8], kk[8]; float nrm = 0.f;
                ld8((const LAS float*)(lds + LA_DW) + tok * 64 + part * 8, dw); ld8((const LAS float*)(lds + LA_DA) + tok * 64 + part * 8, da);
                ld8g(cp.w0 + h * 64 + part * 8, p8);
#pragma unroll
                for (int j = 0; j < 8; ++j) e[j] = 0.6065306597f * __builtin_amdgcn_rcpf(1.f + __expf(-(p8[j] + dw[j])));
                ld8g(cp.a0 + h * 64 + part * 8, p8);
#pragma unroll
                for (int j = 0; j < 8; ++j) as[j] = __builtin_amdgcn_rcpf(1.f + __expf(-(p8[j] + da[j])));
                ld8g(cp.k_k + h * 64 + part * 8, p8);
#pragma unroll
                for (int j = 0; j < 8; ++j) { kk[j] = xk[j] * p8[j]; nrm += kk[j] * kk[j]; }
                nrm += __shfl_xor(nrm, 1); nrm += __shfl_xor(nrm, 2); nrm += __shfl_xor(nrm, 4);
                const float inv = __builtin_amdgcn_rsqf(fmaxf(nrm, 1e-24f));
                ld8g(cp.k_a + h * 64 + part * 8, p8);
#pragma unroll
                for (int j = 0; j < 8; ++j) { kn[j] = kk[j] * inv; k2[j] = xk[j] * (1.f + (as[j] - 1.f) * p8[j]); }
                ld8g(cp.r_k + h * 64 + part * 8, p8); bon = 0.f;
#pragma unroll
                for (int j = 0; j < 8; ++j) bon += xr[j] * k2[j] * p8[j];
                bon += __shfl_xor(bon, 1); bon += __shfl_xor(bon, 2); bon += __shfl_xor(bon, 4);
#pragma unroll
                for (int j = 0; j < 8; ++j) { float x = e[j]; float y = __shfl_up(x, 8); if (tl >= 1) x += y; y = __shfl_up(x, 16); if (tl >= 2) x += y; y = __shfl_up(x, 32); if (tl >= 4) x += y; cum[j] = x; }
                if (tl == 7) { LAS float* sg = (LAS float*)(lds + LA_SEG) + C.wave * 64 + part * 8;
                    *(LAS f32x4*)sg = (f32x4){cum[0], cum[1], cum[2], cum[3]}; *((LAS f32x4*)sg + 1) = (f32x4){cum[4], cum[5], cum[6], cum[7]}; }
            }
            LBAR();
            {   float off[8] = {0.f, 0.f, 0.f, 0.f, 0.f, 0.f, 0.f, 0.f};
                for (int w = 0; w < C.wave; ++w) { float t8[8]; ld8((const LAS float*)(lds + LA_SEG) + w * 64 + part * 8, t8);
#pragma unroll
                    for (int j = 0; j < 8; ++j) off[j] += t8[j]; }
                float at[8], bt[8], rt[8], kt[8], pt8[8];
#pragma unroll
                for (int j = 0; j < 8; ++j) { const float cm = cum[j] + off[j]; const float pm1 = __expf(e[j] - cm), ip = __expf(cm), pt = __builtin_amdgcn_rcpf(ip);
                    at[j] = -kn[j] * pm1; bt[j] = kn[j] * as[j] * ip; rt[j] = xr[j] * pt; kt[j] = k2[j] * ip; pt8[j] = pt; }
                const v4u pa = pk8(at), pb = pk8(bt);
                *(LAS v4u*)(lds + LA_AT + (tok * TS + part * 8) * 2) = pa; *(LAS v4u*)(lds + LA_BT + (tok * TS + part * 8) * 2) = pb;
                const int go = (tok * 64 + part * 8) * 2;
                *(GAS v4u*)(rec + REC_AT + go) = pa; *(GAS v4u*)(rec + REC_BT + go) = pb; *(GAS v4u*)(rec + REC_RT + go) = pk8(rt); *(GAS v4u*)(rec + REC_KT + go) = pk8(kt);
                if (tok == 63) { float* pc = (float*)(rec + REC_PC) + part * 8; *(GAS f32x4*)pc = (f32x4){pt8[0], pt8[1], pt8[2], pt8[3]}; *((GAS f32x4*)pc + 1) = (f32x4){pt8[4], pt8[5], pt8[6], pt8[7]}; }
                if (part == 0) ((float*)(rec + REC_BON))[tok] = bon;
            }
            LBAR();
            {   LAS float* slot = (LAS float*)(lds + LA_SLOT0 + s * 16384);
                const bf16x8 b0 = frag_nat(lds + LA_AT, 16 * vs, 0, C.lane), b1 = frag_nat(lds + LA_AT, 16 * vs, 1, C.lane);
#pragma unroll
                for (int q = 0; q < 2; ++q) { const int it = 2 * rh + q;
                    f32x4 acc = {0.f, 0.f, 0.f, 0.f};
                    acc = MFMA16(frag_nat(lds + LA_BT, 16 * it, 0, C.lane), b0, acc); acc = MFMA16(frag_nat(lds + LA_BT, 16 * it, 1, C.lane), b1, acc);
                    const int t = 16 * vs + l15, i0 = 16 * it + 4 * quad;
                    f32x4 o; o[0] = (i0 + 0 < t) ? acc[0] : 0.f; o[1] = (i0 + 1 < t) ? acc[1] : 0.f; o[2] = (i0 + 2 < t) ? acc[2] : 0.f; o[3] = (i0 + 3 < t) ? acc[3] : 0.f;
                    *(LAS f32x4*)(slot + t * 64 + i0) = o; }
            }
            __syncthreads();
        }
        if (C.wave < nr) {
            const LAS float* Nl = (const LAS float*)(lds + LA_SLOT0 + C.wave * 16384);
            float Tr[64]; int ln = C.lane; asm volatile("" : "+v"(ln));
#pragma clang loop unroll(full)
            for (int t = 0; t < 64; ++t) { float acc = (ln == t) ? 1.f : 0.f;
#pragma clang loop unroll(full)
                for (int g = 0; g < (t + 3) / 4; ++g) { const f32x4 nv = *(const volatile LAS f32x4*)(Nl + t * 64 + 4 * g);
                    acc += Tr[4 * g] * nv[0]; if (4 * g + 1 < t) acc += Tr[4 * g + 1] * nv[1]; if (4 * g + 2 < t) acc += Tr[4 * g + 2] * nv[2]; if (4 * g + 3 < t) acc += Tr[4 * g + 3] * nv[3]; }
                asm volatile("" : "+v"(acc));
                Tr[t] = acc; }
            bf16* o = (bf16*)(rec_ptr(ws, task0 + base + C.wave) + REC_TT) + C.lane;
#pragma clang loop unroll(full)
            for (int t = 0; t < 64; ++t) o[t * 64] = (bf16)f2bf(Tr[t]);
        }
        LBAR();
    }
    __syncthreads();
}

struct ScanBP { const bf16* P; bf16* H; float* out; const float *mu, *ln_w, *ln_b; unsigned char* ws; };
struct BLoad { v4u at, rt, bt, kt, tt, cv, pv, g4; f32x4 pcb; };
__device__ __forceinline__ void b_load(const ScanBP& sb, const unsigned char* rec, int m0, int t0tok, int h, int tid, BLoad& L) {
    const int tok = tid >> 3, part = tid & 7;
    const GAS v4u* r16 = (const GAS v4u*)rec + tid;
    L.at = r16[REC_AT / 16]; L.rt = r16[REC_RT / 16]; L.bt = r16[REC_BT / 16]; L.kt = r16[REC_KT / 16]; L.tt = r16[REC_TT / 16];
    const bf16* cur = sb.P + (size_t)(m0 + tok) * B_INP + h * 64 + part * 8;
    L.cv = *(const GAS v4u*)(cur + 2 * RW); L.g4 = *(const GAS v4u*)(cur + 2688);
    L.pv = (v4u){0u, 0u, 0u, 0u}; if ((t0tok + tok) != 0) L.pv = *(const GAS v4u*)(cur - B_INP + 2 * RW);
    L.pcb = (f32x4){0.f, 0.f, 0.f, 0.f}; if (tid < 32) L.pcb = *((const GAS f32x4*)(rec + REC_PC) + tid);
}
__device__ __forceinline__ void scan_stage_b(const Ctx& C, const ScanBP& sb, int bh) {
    LAS unsigned char* lds = C.lds + RING_OFF;
    const int b = bh / 12, h = bh % 12;
    const int tok = C.tid >> 3, part = C.tid & 7, vs = C.wave & 3, rh = C.wave >> 2, l15 = C.lane & 15, quad = C.lane >> 4;
    f32x4 St[2] = {{0.f, 0.f, 0.f, 0.f}, {0.f, 0.f, 0.f, 0.f}};
    __syncthreads();
    for (int i = C.tid; i < IMG / 4; i += NWAVES * 64) ((LAS unsigned*)(lds + L_SB))[i] = 0u;
    { LAS float* prm = (LAS float*)(lds + L_PRM);
      for (int i = C.tid; i < 192; i += NWAVES * 64) { const int a = i >> 6, c = h * 64 + (i & 63); prm[i] = a == 0 ? sb.mu[2 * RW + c] : (a == 1 ? sb.ln_w[c] : sb.ln_b[c]); } }
    BLoad Ln; b_load(sb, rec_ptr(sb.ws, bh * 32), b * SEQ, 0, h, C.tid, Ln);
    float xvp[8] = {0.f, 0.f, 0.f, 0.f, 0.f, 0.f, 0.f, 0.f}; v4u g4p = {0u, 0u, 0u, 0u};
    __syncthreads();
    const LAS float* prm = (const LAS float*)(lds + L_PRM) + part * 8;
    const int ioff = (tok * TS + part * 8) * 2;
#pragma unroll 1
    for (int c = 0; c <= 32; ++c) {
        const int m0 = b * SEQ + c * 64;
        float xvn[8]; v4u g4n = {0u, 0u, 0u, 0u};
        if (c < 32) {
            *(LAS v4u*)(lds + L_AT + ioff) = Ln.at; *(LAS v4u*)(lds + L_RT + ioff) = Ln.rt; *(LAS v4u*)(lds + L_BT + ioff) = Ln.bt; *(LAS v4u*)(lds + L_KT + ioff) = Ln.kt; *(LAS v4u*)(lds + L_TT + ioff) = Ln.tt;
            if (C.tid < 32) *((LAS f32x4*)(lds + L_PC + (c & 1) * 512) + C.tid) = Ln.pcb;
            float cv[8], pv[8], mv[8]; unpk8(Ln.cv, cv); unpk8(Ln.pv, pv); ld8(prm, mv);
#pragma unroll
            for (int j = 0; j < 8; ++j) xvn[j] = cv[j] + mv[j] * (pv[j] - cv[j]);
            *(LAS v4u*)(lds + L_VV + ioff) = pk8(xvn); g4n = Ln.g4;
            if (c < 31) b_load(sb, rec_ptr(sb.ws, bh * 32 + c + 1), m0 + 64, c * 64 + 64, h, C.tid, Ln);
        }
        if (c > 0) { const int m = m0 - 64 + tok; float y[8]; ld8((const LAS float*)(lds + L_Y) + tok * 64 + part * 8, y); float s = 0.f;
#pragma unroll
            for (int j = 0; j < 8; ++j) s += y[j];
            s += __shfl_xor(s, 1); s += __shfl_xor(s, 2); s += __shfl_xor(s, 4);
            const float mean = s * (1.f / 64.f); float qq = 0.f;
#pragma unroll
            for (int j = 0; j < 8; ++j) { y[j] -= mean; qq += y[j] * y[j]; }
            qq += __shfl_xor(qq, 1); qq += __shfl_xor(qq, 2); qq += __shfl_xor(qq, 4);
            const float rstd = __builtin_amdgcn_rsqf(qq * (1.f / 64.f) + GN_EPS), bonp = ((const LAS float*)(lds + L_PC + ((c - 1) & 1) * 512 + 256))[tok];
            float lw[8], lb[8], g[8], o[8]; ld8(prm + 64, lw); ld8(prm + 128, lb); unpk8(g4p, g);
#pragma unroll
            for (int j = 0; j < 8; ++j) o[j] = (y[j] * rstd * lw[j] + lb[j] + bonp * xvp[j]) * silu(g[j]);
            *(GAS v4u*)(sb.H + (size_t)m * 1024 + h * 64 + part * 8) = pk8(o);
        }
        if (c == 32) break;
#pragma unroll
        for (int j = 0; j < 8; ++j) xvp[j] = xvn[j];
        g4p = g4n;
        LBAR();
        {   const bf16x8 a0 = frag_nat(lds + L_AT, 16 * vs, 0, C.lane), a1 = frag_nat(lds + L_AT, 16 * vs, 1, C.lane);
            const bf16x8 r0 = frag_nat(lds + L_RT, 16 * vs, 0, C.lane), r1 = frag_nat(lds + L_RT, 16 * vs, 1, C.lane);
#pragma unroll
            for (int q = 0; q < 2; ++q) { const int it = 2 * rh + q;
                const bf16x8 k0 = frag_nat(lds + L_KT, 16 * it, 0, C.lane), k1 = frag_nat(lds + L_KT, 16 * it, 1, C.lane);
                const bf16x8 bb0 = frag_nat(lds + L_BT, 16 * it, 0, C.lane), bb1 = frag_nat(lds + L_BT, 16 * it, 1, C.lane);
                f32x4 nka = {0.f, 0.f, 0.f, 0.f}, nbr = nka, nkr = nka;
                nka = MFMA16(k0, a0, nka); nka = MFMA16(k1, a1, nka);
                nbr = MFMA16(bb0, r0, nbr); nbr = MFMA16(bb1, r1, nbr);
                nkr = MFMA16(k0, r0, nkr); nkr = MFMA16(k1, r1, nkr);
                const int t = 16 * vs + l15, i0 = 16 * it + 4 * quad;
#pragma unroll
                for (int ee = 0; ee < 4; ++ee) { if (!(i0 + ee < t)) nka[ee] = 0.f; if (!(i0 + ee <= t)) { nbr[ee] = 0.f; nkr[ee] = 0.f; } }
                st_tile_T(lds + L_NKA, 16 * vs, 16 * it, C.lane, nka); st_tile_T(lds + L_NBR, 16 * vs, 16 * it, C.lane, nbr); st_tile_T(lds + L_NKR, 16 * vs, 16 * it, C.lane, nkr); }
        }
        bf16x8 v0, v1;
        {   const unsigned av = (unsigned)(size_t)(lds + L_VV) + (unsigned)(((8 * quad + (l15 >> 2)) * TS + 16 * vs + 4 * (l15 & 3)) * 2);
            const s16x4 p0 = tr_read<0>(av), p1 = tr_read<4 * TS * 2>(av), p2 = tr_read<32 * TS * 2>(av), p3 = tr_read<36 * TS * 2>(av);
            asm volatile("s_waitcnt lgkmcnt(0)" ::: "memory"); __builtin_amdgcn_sched_barrier(0);
            v0 = (bf16x8){p0[0], p0[1], p0[2], p0[3], p1[0], p1[1], p1[2], p1[3]}; v1 = (bf16x8){p2[0], p2[1], p2[2], p2[3], p3[0], p3[1], p3[2], p3[3]}; }
        LBAR();
        const int sbc = (c & 1) ? L_SB2 : L_SB, sbn = (c & 1) ? L_SB : L_SB2;
        {   const bf16x8 s0 = frag_nat(lds + sbc, 16 * vs, 0, C.lane), s1 = frag_nat(lds + sbc, 16 * vs, 1, C.lane);
#pragma unroll
            for (int q = 0; q < 2; ++q) { const int tt = 2 * rh + q; f32x4 z = {0.f, 0.f, 0.f, 0.f};
                z = MFMA16(frag_nat(lds + L_AT, 16 * tt, 0, C.lane), s0, z); z = MFMA16(frag_nat(lds + L_AT, 16 * tt, 1, C.lane), s1, z);
                z = MFMA16(frag_nat(lds + L_NKA, 16 * tt, 0, C.lane), v0, z); z = MFMA16(frag_nat(lds + L_NKA, 16 * tt, 1, C.lane), v1, z);
                st_tile_T(lds + L_Z, 16 * vs, 16 * tt, C.lane, z); }
        }
        LBAR();
        {   const bf16x8 z0 = frag_nat(lds + L_Z, 16 * vs, 0, C.lane), z1 = frag_nat(lds + L_Z, 16 * vs, 1, C.lane);
#pragma unroll
            for (int q = 0; q < 2; ++q) { const int tt = 2 * rh + q; f32x4 sa = {0.f, 0.f, 0.f, 0.f};
                sa = MFMA16(frag_nat(lds + L_TT, 16 * tt, 0, C.lane), z0, sa); sa = MFMA16(frag_nat(lds + L_TT, 16 * tt, 1, C.lane), z1, sa);
                st_tile_T(lds + L_SA, 16 * vs, 16 * tt, C.lane, sa); }
        }
        bf16x8 tb[2][2], tk[2][2];
        {   s16x4 pb[2][2][2], pk[2][2][2];
#pragma unroll
            for (int q = 0; q < 2; ++q) { const int kt0 = 16 * (2 * rh + q);
                const unsigned ab = (unsigned)(size_t)(lds + L_BT) + (unsigned)(((8 * quad + (l15 >> 2)) * TS + kt0 + 4 * (l15 & 3)) * 2);
                const unsigned ak = (unsigned)(size_t)(lds + L_KT) + (unsigned)(((8 * quad + (l15 >> 2)) * TS + kt0 + 4 * (l15 & 3)) * 2);
                pb[q][0][0] = tr_read<0>(ab); pb[q][0][1] = tr_read<4 * TS * 2>(ab); pb[q][1][0] = tr_read<32 * TS * 2>(ab); pb[q][1][1] = tr_read<36 * TS * 2>(ab);
                pk[q][0][0] = tr_read<0>(ak); pk[q][0][1] = tr_read<4 * TS * 2>(ak); pk[q][1][0] = tr_read<32 * TS * 2>(ak); pk[q][1][1] = tr_read<36 * TS * 2>(ak); }
            asm volatile("s_waitcnt lgkmcnt(0)" ::: "memory"); __builtin_amdgcn_sched_barrier(0);
#pragma unroll
            for (int q = 0; q < 2; ++q)
#pragma unroll
                for (int ks = 0; ks < 2; ++ks) {
                    tb[q][ks] = (bf16x8){pb[q][ks][0][0], pb[q][ks][0][1], pb[q][ks][0][2], pb[q][ks][0][3], pb[q][ks][1][0], pb[q][ks][1][1], pb[q][ks][1][2], pb[q][ks][1][3]};
                    tk[q][ks] = (bf16x8){pk[q][ks][0][0], pk[q][ks][0][1], pk[q][ks][0][2], pk[q][ks][0][3], pk[q][ks][1][0], pk[q][ks][1][1], pk[q][ks][1][2], pk[q][ks][1][3]}; }
        }
        LBAR();
        {   const bf16x8 s0 = frag_nat(lds + sbc, 16 * vs, 0, C.lane), s1 = frag_nat(lds + sbc, 16 * vs, 1, C.lane);
            const bf16x8 sa0 = frag_nat(lds + L_SA, 16 * vs, 0, C.lane), sa1 = frag_nat(lds + L_SA, 16 * vs, 1, C.lane);
            LAS float* Y = (LAS float*)(lds + L_Y);
#pragma unroll
            for (int q = 0; q < 2; ++q) { const int tt = 2 * rh + q; f32x4 yy = {0.f, 0.f, 0.f, 0.f};
                yy = MFMA16(frag_nat(lds + L_RT, 16 * tt, 0, C.lane), s0, yy); yy = MFMA16(frag_nat(lds + L_RT, 16 * tt, 1, C.lane), s1, yy);
                yy = MFMA16(frag_nat(lds + L_NBR, 16 * tt, 0, C.lane), sa0, yy); yy = MFMA16(frag_nat(lds + L_NBR, 16 * tt, 1, C.lane), sa1, yy);
                yy = MFMA16(frag_nat(lds + L_NKR, 16 * tt, 0, C.lane), v0, yy); yy = MFMA16(frag_nat(lds + L_NKR, 16 * tt, 1, C.lane), v1, yy);
                f32x4 dd = {0.f, 0.f, 0.f, 0.f};
                dd = MFMA16(tb[q][0], sa0, dd); dd = MFMA16(tb[q][1], sa1, dd); dd = MFMA16(tk[q][0], v0, dd); dd = MFMA16(tk[q][1], v1, dd);
                const int r0 = 16 * tt + 4 * quad, v = 16 * vs + l15;
#pragma unroll
                for (int ee = 0; ee < 4; ++ee) Y[(r0 + ee) * 64 + v] = yy[ee];
                const f32x4 pc = *(const LAS f32x4*)(lds + L_PC + (c & 1) * 512 + r0 * 4);
                St[q] = (St[q] + dd) * pc;
                st_tile_T(lds + sbn, 16 * vs, 16 * tt, C.lane, St[q]); }
        }
        LBAR();
    }
#pragma unroll
    for (int q = 0; q < 2; ++q) { float* so = sb.out + O_WKVP + ((size_t)bh * 64 + 16 * vs + l15) * 64 + 16 * (2 * rh + q) + 4 * quad; *(GAS f32x4*)so = St[q]; }
    __syncthreads();
}

constexpr int TG_A = 128 * 72 * 2, TG_B = 64 * 72 * 2, TG_BUF = TG_A + TG_B;
__device__ __forceinline__ void tile_gemm(const Ctx& C, const bf16* A, int lda, const bf16* Bt, int ldb, bf16* out, int ldc, int m0, int n0, int K) {
    LAS unsigned char* lds = C.lds + RING_OFF;
    const int row = C.tid >> 3, ch = C.tid & 7, l15 = C.lane & 15, quad = C.lane >> 4;
    const bf16* a0p = A + (size_t)(m0 + row) * lda + ch * 8; const bf16* a1p = A + (size_t)(m0 + 64 + row) * lda + ch * 8; const bf16* bp = Bt + (size_t)(n0 + row) * ldb + ch * 8;
    const int so = (row * 72 + ch * 8) * 2;
    f32x4 acc[4];
#pragma unroll
    for (int i = 0; i < 4; ++i) acc[i] = (f32x4){0.f, 0.f, 0.f, 0.f};
    v4u ra0 = *(const GAS v4u*)a0p, ra1 = *(const GAS v4u*)a1p, rb = *(const GAS v4u*)bp;
    __syncthreads();
    *(LAS v4u*)(lds + so) = ra0; *(LAS v4u*)(lds + 64 * 72 * 2 + so) = ra1; *(LAS v4u*)(lds + TG_A + so) = rb;
    LBAR();
    int cur = 0;
#pragma unroll 1
    for (int k0 = 0; k0 < K; k0 += 64) {
        const bool more = k0 + 64 < K;
        if (more) { ra0 = *(const GAS v4u*)(a0p + k0 + 64); ra1 = *(const GAS v4u*)(a1p + k0 + 64); rb = *(const GAS v4u*)(bp + k0 + 64); }
        const LAS unsigned char* ia = lds + cur * TG_BUF; const LAS unsigned char* ib = ia + TG_A;
        const bf16x8 a0 = frag_nat(ia, 16 * C.wave, 0, C.lane), a1 = frag_nat(ia, 16 * C.wave, 1, C.lane);
#pragma unroll
        for (int ct = 0; ct < 4; ++ct) { acc[ct] = MFMA16(frag_nat(ib, 16 * ct, 0, C.lane), a0, acc[ct]); acc[ct] = MFMA16(frag_nat(ib, 16 * ct, 1, C.lane), a1, acc[ct]); }
        if (more) { LAS unsigned char* nb = lds + (cur ^ 1) * TG_BUF; *(LAS v4u*)(nb + so) = ra0; *(LAS v4u*)(nb + 64 * 72 * 2 + so) = ra1; *(LAS v4u*)(nb + TG_A + so) = rb; }
        LBAR();
        cur ^= 1;
    }
    bf16* orow = out + (size_t)(m0 + 16 * C.wave + l15) * ldc + n0 + 4 * quad;
#pragma unroll
    for (int ct = 0; ct < 4; ++ct) *(GAS v2u*)(orow + 16 * ct) = (v2u){pk2(acc[ct][0], acc[ct][1]), pk2(acc[ct][2], acc[ct][3])};
}
__device__ __forceinline__ void tile_gemm_job(const Ctx& C, const bf16* A, int lda, const bf16* Bt, int ldb, bf16* out, int ldc, int M, int N, int K, int first) {
    const int tn = N / 64, ntile = (M / 128) * tn;
    int w = C.vcu - first; if (w < 0) w += C.G;
    for (int t = w; t < ntile; t += C.G) tile_gemm(C, A, lda, Bt, ldb, out, ldc, (t / tn) * 128, (t % tn) * 64, K);
}

constexpr int PTAB_OFF = LDSCTL_OFF + 512;
__device__ __forceinline__ const float* inptr(LAS unsigned char* ldsb, int i) {
    const LAS unsigned* p = (const LAS unsigned*)(ldsb + PTAB_OFF) + 2 * i;
    const unsigned lo = __builtin_amdgcn_readfirstlane(p[0]), hi = __builtin_amdgcn_readfirstlane(p[1]);
    return (const float*)(((unsigned long long)hi << 32) | lo);
}
struct Args { const float* in[28]; float* out; unsigned char* ws; int ph_lo, ph_hi; };
#define WSP(T, off) ((T*)(args.ws + (off)))
#define GEMM_BF16(Aptr, Bptr, Optr, Mv, Nv, Kv) do { pg8::Gemm g{Aptr, Bptr, Mv, Nv, Kv}; pg8::StaticOrder S; S.init(Mv, Nv, C.G, (int)blockIdx.x); \
        pg8::EpiBf16<0> E{Optr, Nv, nullptr, 0, 0, 1.f}; pg8::gemm_phase<pg8::EpiBf16<0>, pg8::StaticOrder, PG8_ALIGN, PG8_SP2>(C.lds + RING_OFF, g, S, E); } while (0)
__global__ void __launch_bounds__(NWAVES * 64, 2) hyb_fwd(Args args) {
    extern __shared__ __attribute__((aligned(16))) unsigned char lds[];
    LAS unsigned char* const ldsb = (LAS unsigned char*)lds;
    for (int u = threadIdx.x; u < (LDS_BYTES - LDSCTL_OFF) / 4; u += NWAVES * 64) ((LAS unsigned*)(ldsb + LDSCTL_OFF))[u] = 0u;
    __syncthreads();
    if (threadIdx.x < 28) ((LAS unsigned long long*)(ldsb + PTAB_OFF))[threadIdx.x] = (unsigned long long)args.in[threadIdx.x];
    __syncthreads();
#define INP(i) inptr(ldsb, (i))
#define MKCTX() Ctx C; { int t_ = threadIdx.x; asm volatile("" : "+v"(t_)); C.lds = ldsb; C.tid = t_; C.lane = t_ & 63; C.wave = __builtin_amdgcn_readfirstlane(t_ >> 6); \
        C.G = gridDim.x; const int bx_ = blockIdx.x; C.vcu = (C.G % 8 == 0) ? (bx_ % 8) * (C.G / 8) + bx_ / 8 : bx_; C.gw = C.vcu * NWAVES + C.wave; C.NGW = C.G * NWAVES; } \
        const int gt = C.gw * 64 + C.lane, NGT = C.NGW * 64; (void)gt; (void)NGT
    const int lo = args.ph_lo, hi = args.ph_hi;
    const bool fused = (hi - lo) > 1;
    XcdBarrier bar; bar.bar = WSP(unsigned, WS_CTL) + CW_BAR; bar.x = 0; bar.st = nullptr;
    if (fused) bar = xcd_barrier_post(WSP(unsigned, WS_CTL) + CW_BAR, (volatile LAS unsigned*)(ldsb + MISC_OFF) + 8);
#ifndef PROBE_PHASE
#define PROBE_PHASE -1
#endif
#ifndef PROBE_SUB
#define PROBE_SUB 0
#endif
#define IN(k) (lo <= (k) && (k) < hi)
#define REP(k) for (int rep_ = 0; rep_ < ((k) == PROBE_PHASE ? 2 : 1); ++rep_)
#define SEAM(k) do { if (IN(k) && IN((k) + 1)) xcd_barrier(bar); } while (0)

    if (IN(0)) REP(0) { MKCTX();
        LAS float* scr = (LAS float*)(C.lds + RING_OFF + C.wave * 16384);
        constexpr int I0 = 16 * 96, I1 = 8 * 32, I2 = 16 * 116, I3 = 16 * 32, I4 = 16 * 16, I5 = 16 * 16, I6 = 24, I7 = 24;
        constexpr int NITEMS = I0 + I1 + I2 + I3 + I4 + I5 + I6 + I7;
        for (int it = C.gw; it < NITEMS; it += C.NGW) {
            int r = it;
            if (r < I0) { p0_transpose_item(INP(14), A_IN, INP(9), WSP(bf16, WS_WAIN), 1024, 0, 0, scr, r, 96, C.lane); continue; } r -= I0;
            if (r < I1) { p0_transpose_item(INP(15), 1024, nullptr, WSP(bf16, WS_WAOUT), 512, 0, 0, scr, r, 32, C.lane); continue; } r -= I1;
            if (r < I2) { p0_transpose_item(INP(16), B_IN, INP(9) + DM, WSP(bf16, WS_WBIN), 1024, 0, 0, scr, r, 116, C.lane); continue; } r -= I2;
            if (r < I3) { p0_transpose_item(INP(17), 1024, nullptr, WSP(bf16, WS_WBOUT), 1024, 0, 0, scr, r, 32, C.lane); continue; } r -= I3;
            if (r < I4) { p0_transpose_item(INP(12), 512, INP(11), WSP(bf16, WS_WM), 1024, 0, 0, scr, r, 16, C.lane); continue; } r -= I4;
            if (r < I5) { p0_transpose_item(INP(12) + 1024 * 512, 512, INP(11) + DM, WSP(bf16, WS_WM), 1024, 0, 512, scr, r, 16, C.lane); continue; } r -= I5;
            if (r < I6) { p0_transpose_item(INP(20), RW, nullptr, WSP(bf16, WS_WL), 128, 0, 0, scr, r, 24, C.lane); continue; } r -= I6;
            p0_transpose_item(INP(22), RW, nullptr, WSP(bf16, WS_WL), 128, 64, RW, scr, r, 24, C.lane);
        }
        const v4u z4 = {0u, 0u, 0u, 0u};
        for (int i = gt; i < 16384; i += NGT) *((GAS v4u*)(WSP(bf16, WS_WBIN) + (size_t)B_IN * 1024) + i) = z4;
        for (int i = gt; i < 1536 * 8; i += NGT) { const int n = i >> 3, c = i & 7; *(GAS v4u*)(WSP(bf16, WS_WL) + (size_t)n * 128 + (n < RW ? 64 : 0) + c * 8) = z4; }
        for (int i = gt; i < 128 * 128; i += NGT) *((GAS v4u*)(WSP(bf16, WS_XN) + (size_t)NREAL * 1024) + i) = z4;
        for (int i = gt; i < 3 * 4 * 129; i += NGT) { const int g = i / (4 * 129), r = i % (4 * 129), hh = r / 129, k = r % 129; const int dil = g == 0 ? 1 : (g == 1 ? 4 : 16);
            WSP(float, WS_BT)[(g * 4 + hh) * 132 + k] = INP(13)[t5_bucket(dil * k) * 12 + g * 4 + hh]; }
        for (int m = C.gw; m < NREAL + 2048; m += C.NGW) {
            if (m < TP) rms_row_to_bf16(INP(0) + (size_t)m * DM, WSP(bf16, WS_XN) + (size_t)m * DM, C.lane);
            else if (m < NREAL) rms_row_to_bf16(INP(1) + (size_t)(m - TP) * DM, WSP(bf16, WS_XN) + (size_t)m * DM, C.lane);
            else rms_row_to_bf16(INP(2) + (size_t)(m - NREAL) * DM, WSP(bf16, WS_MEMN) + (size_t)(m - NREAL) * DM, C.lane);
        }
    } SEAM(0);
    if (IN(1)) REP(1) { MKCTX();
        GEMM_BF16(WSP(bf16, WS_XN), WSP(bf16, WS_WAIN), WSP(bf16, WS_P), TP, A_IN, DM);
        tile_gemm_job(C, WSP(bf16, WS_MEMN), DM, WSP(bf16, WS_WM), DM, WSP(bf16, WS_MKV), 1024, 2048, 1024, DM, 0);
        tile_gemm_job(C, WSP(bf16, WS_XN) + (size_t)TP * DM, DM, WSP(bf16, WS_WAIN), DM, WSP(bf16, WS_P) + (size_t)TP * A_IN, A_IN, NSAMP, A_IN, DM, 0);
    } SEAM(1);
    if (IN(2)) REP(2) { MKCTX();
        const bf16* P = WSP(bf16, WS_P); const bf16* MKV = WSP(bf16, WS_MKV); float* out = args.out;
        for (int rp_ = 0; rp_ < (PROBE_SUB == 23 ? 2 : 1); ++rp_) {
        for (int i = gt; i < 2 * 2048 * 512; i += NGT) { const int l = i / (2048 * 512), r = (i / 512) % 2048, c = i % 512; out[O_MEM + i] = bf2f(MKV[(size_t)r * 1024 + l * 512 + c]); }
#pragma unroll
        for (int g = 0; g < 3; ++g) { const int Wg = g == 0 ? 128 : (g == 1 ? 512 : 2048); const size_t ob = g == 0 ? O_W0P : (g == 1 ? O_W1P : O_W2P);
            const int n = NBATCH * Wg * 512;
            for (int i = gt; i < n; i += NGT) { const int c = i % 512, ri = (i / 512) % Wg, b = i / (512 * Wg); const int t = SEQ - Wg + ri, kv = c >> 8, cc = c & 255;
                out[ob + i] = bf2f(P[(size_t)((b << 11) + t) * A_IN + RW + kv * RW + g * 256 + cc]); }
            const size_t os = g == 0 ? O_W0S : (g == 1 ? O_W1S : O_W2S);
            for (int i = gt; i < NSAMP * 512; i += NGT) { const int c = i % 512, r = i / 512, kv = c >> 8, cc = c & 255;
                out[os + i] = bf2f(P[(size_t)(TP + r) * A_IN + RW + kv * RW + g * 256 + cc]); } }
        }
        bf16* H = WSP(bf16, WS_H); const float* BT = WSP(float, WS_BT);
        for (int rp_ = 0; rp_ < (PROBE_SUB == 21 ? 2 : 1); ++rp_)
        for (int unit = blockIdx.x; unit < 256; unit += C.G) attn_a_unit(C, P, MKV, H, BT, unit);
        { LAS float* mg = (LAS float*)(C.lds + RING_OFF + 65536);
          for (int rp_ = 0; rp_ < (PROBE_SUB == 22 ? 2 : 1); ++rp_)
          for (int base = 0; base < NSAMP * 16; base += C.NGW) { const int task = base + C.gw; const bool on = task < NSAMP * 16;
            const int tq = task >> 2, part = task & 3, m = TP + (tq >> 2), hh = tq & 3;
            float Mo = 0.f, So = 1.f, Oo = 0.f;
            if (on) samp_part(P, BT, part == 0 ? INP(4) : (part == 1 ? INP(5) : INP(6)), MKV, INP(3), m, hh, part, 0, P + (size_t)m * A_IN + 2304 + hh * 64, C.lane, Mo, So, Oo);
            __syncthreads();
            mg[C.wave * 66 + C.lane] = Oo; if (C.lane == 0) { mg[C.wave * 66 + 64] = Mo; mg[C.wave * 66 + 65] = So; }
            __syncthreads();
            if (on && (part == 0 || part == 3)) { const bf16* prow = P + (size_t)m * A_IN; float o;
                if (part == 0) { const LAS float* w0 = mg + C.wave * 66; const float M0 = w0[64], M1 = w0[66 + 64], M2 = w0[132 + 64];
                    const float M = fmaxf(fmaxf(M0, M1), M2), e0 = __expf(M0 - M), e1 = __expf(M1 - M), e2 = __expf(M2 - M);
                    const float S = w0[65] * e0 + w0[66 + 65] * e1 + w0[132 + 65] * e2;
                    o = (w0[C.lane] * e0 + w0[66 + C.lane] * e1 + w0[132 + C.lane] * e2) / S;
                    H[(size_t)m * 512 + hh * 64 + C.lane] = (bf16)f2bf(o * silu(bf2f(prow[2560 + hh * 64 + C.lane]))); }
                else { o = Oo / So; H[(size_t)m * 512 + 256 + hh * 64 + C.lane] = (bf16)f2bf(o * silu(bf2f(prow[2560 + 256 + hh * 64 + C.lane]))); } }
          } }
    } SEAM(2);
    if (IN(3)) REP(3) { MKCTX(); GEMM_BF16(WSP(bf16, WS_H), WSP(bf16, WS_WAOUT), WSP(bf16, WS_F), TP, DM, 512);
        tile_gemm_job(C, WSP(bf16, WS_H) + (size_t)TP * 512, 512, WSP(bf16, WS_WAOUT), 512, WSP(bf16, WS_F) + (size_t)TP * DM, DM, NSAMP, DM, 512, 0); } SEAM(3);
    if (IN(4)) REP(4) { MKCTX();
        for (int m = C.gw; m < NREAL; m += C.NGW) { const bool samp = m >= TP;
            row_pass(WSP(bf16, WS_F) + (size_t)m * DM, samp ? INP(1) + (size_t)(m - TP) * DM : INP(0) + (size_t)m * DM,
                     args.out + (samp ? O_YS + (size_t)(m - TP) * DM : O_YP + (size_t)m * DM), INP(10), WSP(bf16, WS_XN) + (size_t)m * DM, C.lane); }
    } SEAM(4);
    if (IN(5)) REP(5) { MKCTX(); GEMM_BF16(WSP(bf16, WS_XN), WSP(bf16, WS_WBIN), WSP(bf16, WS_P), TP, B_INP, DM);
        tile_gemm_job(C, WSP(bf16, WS_XN) + (size_t)TP * DM, DM, WSP(bf16, WS_WBIN), DM, WSP(bf16, WS_P) + (size_t)TP * B_INP, B_INP, NSAMP, B_INP, DM, 0); } SEAM(5);
    if (IN(6)) REP(6) { MKCTX();
        ChunkP cp{WSP(bf16, WS_P), WSP(bf16, WS_WL), INP(18), INP(19), INP(21), INP(23), INP(24), INP(25)};
        const int per = (3072 + C.G - 1) / C.G, task0 = (int)blockIdx.x * per; int nt = 3072 - task0; if (nt > per) nt = per;
        if (nt > 0) scan_stage_a(C, cp, args.ws, task0, nt);
    } SEAM(6);
    if (IN(7)) REP(7) { MKCTX();
        const bf16* P = WSP(bf16, WS_P); bf16* H = WSP(bf16, WS_H);
        const int GB = C.G > 96 ? 96 : C.G, vb = (int)blockIdx.x;
        if (vb < GB) {
            ScanBP sb{WSP(bf16, WS_P), WSP(bf16, WS_H), args.out, INP(18), INP(26), INP(27), args.ws};
            for (int rp = 0; rp < (PROBE_SUB == 1 ? 2 : 1); ++rp)
            for (int bh = vb; bh < 96; bh += GB) scan_stage_b(C, sb, bh);
        }
        const int GO = C.G > 96 ? C.G - 96 : C.G, ob = C.G > 96 ? vb - 96 : vb;
        if (ob >= 0) for (int rp = 0; rp < (PROBE_SUB == 2 ? 2 : 1); ++rp) {
            for (int unit = ob; unit < 256; unit += GO) attn_b_unit(C, P, WSP(bf16, WS_MKV), H, unit);
            __syncthreads();
            { ScanP sp{WSP(bf16, WS_P), WSP(bf16, WS_H), args.out, INP(7), INP(8), INP(18), INP(19), INP(21), INP(23), INP(24), INP(25), INP(26), INP(27), INP(20), INP(22)};
              for (int u = 96 + ob; u < 480; u += GO) scan_unit(C, sp, u); }
            const int ogw = ob * NWAVES + C.wave, ONGW = GO * NWAVES, ogt = ogw * 64 + C.lane, ONGT = ONGW * 64;
            for (int task = ogw; task < NSAMP * 4; task += ONGW) { const int m = TP + (task >> 2), hh = task & 3;
                const bf16* prow = P + (size_t)m * B_INP;
                float Mo, So, Oo; samp_part(P, nullptr, nullptr, nullptr, INP(3), m, hh, 3, 1, prow + CSH + hh * 64, C.lane, Mo, So, Oo); const float om = Oo / So;
                H[(size_t)m * 1024 + RW + hh * 64 + C.lane] = (bf16)f2bf(om * silu(bf2f(prow[2688 + RW + hh * 64 + C.lane]))); }
            for (int i = ogt; i < NBATCH * CSH; i += ONGT) { const int b = i / CSH, c = i % CSH; args.out[O_SHP + i] = bf2f(P[(size_t)(b * SEQ + SEQ - 1) * B_INP + c]); }
            for (int i = ogt; i < SBATCH * CSH; i += ONGT) { const int sb = i / CSH, c = i % CSH; args.out[O_SHS + i] = bf2f(P[(size_t)(TP + sb * 4 + 3) * B_INP + c]); }
        }
    } SEAM(7);
    if (IN(8)) REP(8) { MKCTX(); GEMM_BF16(WSP(bf16, WS_H), WSP(bf16, WS_WBOUT), WSP(bf16, WS_F), TP, DM, DM);
        tile_gemm_job(C, WSP(bf16, WS_H) + (size_t)TP * DM, DM, WSP(bf16, WS_WBOUT), DM, WSP(bf16, WS_F) + (size_t)TP * DM, DM, NSAMP, DM, DM, 0); } SEAM(8);
    if (IN(9)) { MKCTX();
        for (int m = C.gw; m < NREAL; m += C.NGW) { const bool samp = m >= TP;
            float* xo = args.out + (samp ? O_YS + (size_t)(m - TP) * DM : O_YP + (size_t)m * DM);
            row_pass(WSP(bf16, WS_F) + (size_t)m * DM, xo, xo, INP(10) + DM, nullptr, C.lane); }
    }
#undef IN
#undef SEAM
}

extern "C" void kernel_launch(void* const* d_in, const int* in_sizes, int n_in, void* d_out, int out_size, void* d_ws, size_t ws_size, hipStream_t stream) {
    static int grid = 0;
    if (grid == 0) {
        if (n_in != 28 || in_sizes[0] != TP * DM || (size_t)out_size != O_END || ws_size < WS_END) {
            fprintf(stderr, "kernel_launch: unexpected shapes: n_in %d in0 %d out %d ws %zu (need >= %zu); nothing launched\n", n_in, n_in > 0 ? in_sizes[0] : -1, out_size, ws_size, (size_t)WS_END); grid = -1; return; }
        int dev = 0, cus = 0, per_cu = 0;
        if (hipGetDevice(&dev) != hipSuccess || hipDeviceGetAttribute(&cus, hipDeviceAttributeMultiprocessorCount, dev) != hipSuccess) { fprintf(stderr, "kernel_launch: device query failed\n"); grid = -1; return; }
        if (hipFuncSetAttribute((const void*)hyb_fwd, hipFuncAttributeMaxDynamicSharedMemorySize, LDS_BYTES) != hipSuccess) { fprintf(stderr, "kernel_launch: hipFuncSetAttribute failed\n"); grid = -1; return; }
        if (hipOccupancyMaxActiveBlocksPerMultiprocessor(&per_cu, (const void*)hyb_fwd, NWAVES * 64, LDS_BYTES) != hipSuccess || per_cu < 1) {
            fprintf(stderr, "kernel_launch: occupancy query reports %d workgroups per CU\n", per_cu); }
        (void)hipGetLastError();
        grid = cus;
    }
    if (grid < 0) return;
    if (hipMemsetAsync((char*)d_ws + WS_CTL, 0, CTL_ZERO_BYTES, stream) != hipSuccess) { fprintf(stderr, "kernel_launch: memset failed\n"); return; }
    Args a{};
    for (int i = 0; i < 28; ++i) a.in[i] = (const float*)d_in[i];
    a.out = (float*)d_out; a.ws = (unsigned char*)d_ws;
#if MK_N_LAUNCHES == 1
    a.ph_lo = 0; a.ph_hi = N_PHASES;
    hipLaunchKernelGGL(hyb_fwd, dim3(grid), dim3(NWAVES * 64), LDS_BYTES, stream, a);
#else
    for (int li = 0; li < N_PHASES; ++li) { a.ph_lo = li; a.ph_hi = li + 1;
        hipLaunchKernelGGL(hyb_fwd, dim3(grid), dim3(NWAVES * 64), LDS_BYTES, stream, a); }
#endif
    const hipError_t le = hipPeekAtLastError();
    if (le != hipSuccess) fprintf(stderr, "kernel_launch: launch failed: %s\n", hipGetErrorName(le));
}
```
